# Optimizing an MI355X kernel written in HIP

```python
import math
import jax, jax.numpy as jnp
from jax import lax
import numpy as np

D_MODEL = 1024
BATCH = 32
SEQ = 2048
DEPTH = 4

GRID_W = 64
CTX_LEN = 256
HEAD_DIM = 64
N_MIX_HEADS = D_MODEL // HEAD_DIM
MLSTM_HEADS = N_MIX_HEADS // 4
MLSTM_DH = HEAD_DIM
GLA_HEADS = N_MIX_HEADS // 4
GLA_DV = HEAD_DIM
GLA_DK = HEAD_DIM // 2
GLA_RANK = 16
GLA_TAU = 16.0
NAT_HEADS = N_MIX_HEADS // 2
NAT_DH = HEAD_DIM
WIN_ROWS = 8
WIN_COLS = 16
CONV_K = 3
CHUNK = 64
ROPE_BASE = 10000.0
N_EXPERTS = 16
EXPERT_FF = 2 * D_MODEL
CAPACITY_FACTOR = 2
LN_EPS = 1e-5
DEEPNORM_ALPHA = (2 * DEPTH) ** 0.25
DEEPNORM_BETA = (8 * DEPTH) ** -0.25

MLSTM_W = MLSTM_HEADS * MLSTM_DH
GLA_W = GLA_HEADS * GLA_DV
GLA_KW = GLA_HEADS * GLA_DK
NAT_W = NAT_HEADS * NAT_DH
MIX_W = MLSTM_W + GLA_W + NAT_W

SPLIT_NAMES = ("m_q", "m_k", "m_v", "m_o", "m_i_f", "m_f_f", "m_i_b", "m_f_b",
               "g_q", "g_k", "g_v", "g_r", "g_lr_f", "g_lr_b",
               "n_q", "n_k", "n_v")
SPLIT_SIZES = (MLSTM_W, MLSTM_W, MLSTM_W, MLSTM_W, MLSTM_HEADS, MLSTM_HEADS, MLSTM_HEADS, MLSTM_HEADS,
               GLA_KW, GLA_KW, GLA_W, GLA_W, GLA_RANK, GLA_RANK,
               NAT_W, NAT_W, NAT_W)
PROJ_W = sum(SPLIT_SIZES)

kernel_name = "hybrid_mlstm_gla_natten_ec_moe_dit"


def layer_norm(x, g, b):
    xf = x.astype(jnp.float32)
    mu = xf.mean(-1, keepdims=True)
    var = jnp.mean(jnp.square(xf - mu), -1, keepdims=True)
    return ((xf - mu) * lax.rsqrt(var + LN_EPS) * g + b).astype(x.dtype)


def split_heads(x, h):
    B, T, F = x.shape
    return x.reshape(B, T, h, F // h).transpose(0, 2, 1, 3)


def merge_heads(x):
    B, H, T, d = x.shape
    return x.transpose(0, 2, 1, 3).reshape(B, T, H * d)


def head_norm(h, g):
    mu = h.mean(-1, keepdims=True)
    var = jnp.mean(jnp.square(h - mu), -1, keepdims=True)
    return merge_heads((h - mu) * lax.rsqrt(var + LN_EPS)) * g


def centred_conv(x, w):
    K = w.shape[0]
    T = x.shape[1]
    pad = K // 2
    xp = jnp.pad(x, ((0, 0), (pad, pad), (0, 0)))
    out = xp[:, 0:T] * w[0]
    for j in range(1, K):
        out = out + xp[:, j:j + T] * w[j]
    return out


def rope_1d(x, pos):
    d2 = x.shape[-1] // 2
    inv = ROPE_BASE ** (-jnp.arange(d2, dtype=jnp.float32) / d2)
    ang = pos[:, None] * inv[None, :]
    cos, sin = jnp.cos(ang), jnp.sin(ang)
    x1, x2 = x[..., :d2], x[..., d2:]
    return jnp.concatenate([x1 * cos - x2 * sin, x1 * sin + x2 * cos], -1)


def axial_rope(x, rows, cols):
    h = x.shape[-1] // 2
    return jnp.concatenate([rope_1d(x[..., :h], rows), rope_1d(x[..., h:], cols)], -1)


def to_chunks(a):
    B, H, T = a.shape[:3]
    return jnp.moveaxis(a.reshape(B, H, T // CHUNK, CHUNK, *a.shape[3:]), 2, 0)


def from_chunks(a):
    a = jnp.moveaxis(a, 0, 2)
    return a.reshape(a.shape[0], a.shape[1], -1, *a.shape[4:])


def mlstm_scan(q, k, v, li, lf, state):
    tri = jnp.tril(jnp.ones((CHUNK, CHUNK), dtype=bool))

    def step(carry, blk):
        C, n, m = carry
        qc, kc, vc, ic, fc = blk
        b = jnp.cumsum(fc, axis=-1)
        logw = jnp.where(tri, b[..., :, None] - b[..., None, :] + ic[..., None, :], -jnp.inf)
        inter = b + m[..., None]
        m_t = jnp.maximum(inter, logw.max(-1))
        s = jnp.einsum('bhtd,bhsd->bhts', qc, kc) * jnp.exp(logw - m_t[..., None])
        e = jnp.exp(inter - m_t)
        num = jnp.einsum('bhts,bhsv->bhtv', s, vc) + e[..., None] * jnp.einsum('bhvd,bhtd->bhtv', C, qc)
        den = s.sum(-1) + e * jnp.einsum('bhd,bhtd->bht', n, qc)
        h = num / jnp.maximum(jnp.abs(den), jnp.exp(-m_t))[..., None]
        bl = b[..., -1]
        lw_end = bl[..., None] - b + ic
        m_new = jnp.maximum(bl + m, lw_end.max(-1))
        w_end = jnp.exp(lw_end - m_new[..., None])
        decay = jnp.exp(bl + m - m_new)
        C_new = decay[..., None, None] * C + jnp.einsum('bhs,bhsv,bhsd->bhvd', w_end, vc, kc)
        n_new = decay[..., None] * n + jnp.einsum('bhs,bhsd->bhd', w_end, kc)
        return (C_new, n_new, m_new), h

    state, h = lax.scan(step, state, tuple(to_chunks(a) for a in (q, k, v, li, lf)))
    return from_chunks(h), state


def gla_scan(q, k, v, a, state):
    tri = jnp.tril(jnp.ones((CHUNK, CHUNK), dtype=bool))[:, :, None]

    def step(S, blk):
        qc, kc, vc, ac = blk
        b = jnp.cumsum(ac, axis=2)
        expo = jnp.where(tri, b[:, :, :, None, :] - b[:, :, None, :, :], -jnp.inf)
        A = jnp.einsum('bhtd,bhsd,bhtsd->bhts', qc, kc, jnp.exp(expo))
        o = jnp.einsum('bhts,bhsv->bhtv', A, vc) + jnp.einsum('bhtd,bhdv->bhtv', qc * jnp.exp(b), S)
        bl = b[:, :, -1:, :]
        S_new = jnp.exp(bl[:, :, 0])[..., None] * S + jnp.einsum('bhsd,bhsv->bhdv', kc * jnp.exp(bl - b), vc)
        return S_new, o

    state, o = lax.scan(step, state, tuple(to_chunks(t) for t in (q, k, v, a)))
    return from_chunks(o), state


def bidir(scan, ctx_f, lat_f, ctx_b, lat_b, init):
    flip = lambda seq: tuple(jnp.flip(t, axis=2) for t in seq)
    oc_f, st_f = scan(*ctx_f, init)
    ol_f, _ = scan(*lat_f, st_f)
    oc_b, st_b = scan(*flip(ctx_b), init)
    ol_b, _ = scan(*flip(lat_b), st_b)
    return oc_f + jnp.flip(oc_b, 2), ol_f + jnp.flip(ol_b, 2)


def natten_latent(q, k, v, k_ctx, v_ctx, rpb):
    B, H, T, d = q.shape
    R = T // GRID_W
    wh = min(WIN_ROWS, R)
    scale = d ** -0.5
    qg = q.reshape(B, H, R, GRID_W, d)
    kg = k.reshape(B, H, R, GRID_W, d)
    vg = v.reshape(B, H, R, GRID_W, d)
    col = jnp.arange(GRID_W)
    cstart = jnp.clip(col - WIN_COLS // 2, 0, GRID_W - WIN_COLS)
    col_ok = (col[None, :] >= cstart[:, None]) & (col[None, :] < cstart[:, None] + WIN_COLS)
    dc_idx = jnp.clip(col[None, :] - col[:, None] + WIN_COLS - 1, 0, 2 * WIN_COLS - 2)
    n_loc = wh * GRID_W

    def row_block(r):
        rs = jnp.clip(r - wh // 2, 0, R - wh)
        kr = lax.dynamic_slice_in_dim(kg, rs, wh, axis=2)
        vr = lax.dynamic_slice_in_dim(vg, rs, wh, axis=2)
        qr = lax.dynamic_index_in_dim(qg, r, axis=2, keepdims=False)
        s_loc = jnp.einsum('bhqd,bhrkd->bhqrk', qr, kr) * scale
        dr_idx = rs + jnp.arange(wh) - r + WIN_ROWS - 1
        bias = rpb[:, dr_idx][:, :, dc_idx].transpose(0, 2, 1, 3)
        s_loc = jnp.where(col_ok[:, None, :], s_loc + bias, -jnp.inf).reshape(B, H, GRID_W, n_loc)
        s_ctx = jnp.einsum('bhqd,bhcd->bhqc', qr, k_ctx) * scale
        p = jax.nn.softmax(jnp.concatenate([s_loc, s_ctx], -1).astype(jnp.float32), axis=-1)
        return (jnp.einsum('bhqk,bhkd->bhqd', p[..., :n_loc], vr.reshape(B, H, n_loc, d))
                + jnp.einsum('bhqc,bhcd->bhqd', p[..., n_loc:], v_ctx))

    out = lax.map(row_block, jnp.arange(R))
    return jnp.moveaxis(out, 0, 2).reshape(B, H, T, d)


def context_attention(q, k, v):
    s = jnp.einsum('bhqd,bhkd->bhqk', q, k) * q.shape[-1] ** -0.5
    return jnp.einsum('bhqk,bhkd->bhqd', jax.nn.softmax(s.astype(jnp.float32), -1), v)


def project_stream(u, w_in, b_in, conv_w, gla_w2, gla_b2, pos):
    p = (u @ w_in + b_in).astype(jnp.float32)
    cuts = np.cumsum(SPLIT_SIZES)[:-1].tolist()
    parts = dict(zip(SPLIT_NAMES, jnp.split(p, cuts, axis=-1)))
    qk = jax.nn.silu(centred_conv(jnp.concatenate([parts["m_q"], parts["m_k"]], -1),
                                  conv_w.astype(jnp.float32)))
    mq = split_heads(qk[..., :MLSTM_W], MLSTM_HEADS)
    mk = split_heads(qk[..., MLSTM_W:], MLSTM_HEADS) * MLSTM_DH ** -0.5
    mv = split_heads(parts["m_v"], MLSTM_HEADS)
    gq = split_heads(parts["g_q"], GLA_HEADS) * GLA_DK ** -0.5
    gk = split_heads(parts["g_k"], GLA_HEADS)
    gv = split_heads(parts["g_v"], GLA_HEADS)
    if pos is not None:
        rows, cols = pos
        mq, mk = axial_rope(mq, rows, cols), axial_rope(mk, rows, cols)
        gq, gk = axial_rope(gq, rows, cols), axial_rope(gk, rows, cols)
    w2 = gla_w2.astype(jnp.float32)
    b2 = gla_b2.astype(jnp.float32)
    gla_decay = lambda lr, d: split_heads(jax.nn.log_sigmoid(lr @ w2[d] + b2[d]) / GLA_TAU, GLA_HEADS)
    tr = lambda g: jnp.swapaxes(g, 1, 2)
    return {
        "m_q": mq, "m_k": mk, "m_v": mv, "m_o": parts["m_o"],
        "m_i_f": tr(parts["m_i_f"]), "m_f_f": tr(jax.nn.log_sigmoid(parts["m_f_f"])),
        "m_i_b": tr(parts["m_i_b"]), "m_f_b": tr(jax.nn.log_sigmoid(parts["m_f_b"])),
        "g_q": gq, "g_k": gk, "g_v": gv, "g_r": parts["g_r"],
        "g_a_f": gla_decay(parts["g_lr_f"], 0), "g_a_b": gla_decay(parts["g_lr_b"], 1),
        "n_q": split_heads(parts["n_q"], NAT_HEADS), "n_k": split_heads(parts["n_k"], NAT_HEADS),
        "n_v": split_heads(parts["n_v"], NAT_HEADS),
    }


def hybrid_mixer(u_lat, u_ctx, rows, cols, w_in, b_in, conv_w, gla_w2, gla_b2,
                 mlstm_norm_g, gla_norm_g, rpb, w_out, need_ctx):
    L = project_stream(u_lat, w_in, b_in, conv_w, gla_w2, gla_b2, (rows, cols))
    C = project_stream(u_ctx, w_in, b_in, conv_w, gla_w2, gla_b2, None)
    B = u_lat.shape[0]
    f32 = jnp.float32
    m_init = (jnp.zeros((B, MLSTM_HEADS, MLSTM_DH, MLSTM_DH), f32),
              jnp.zeros((B, MLSTM_HEADS, MLSTM_DH), f32), jnp.zeros((B, MLSTM_HEADS), f32))
    mf = lambda S: (S["m_q"], S["m_k"], S["m_v"], S["m_i_f"], S["m_f_f"])
    mb = lambda S: (S["m_q"], S["m_k"], S["m_v"], S["m_i_b"], S["m_f_b"])
    m_ctx, m_lat = bidir(mlstm_scan, mf(C), mf(L), mb(C), mb(L), m_init)
    g_init = jnp.zeros((B, GLA_HEADS, GLA_DK, GLA_DV), f32)
    gf = lambda S: (S["g_q"], S["g_k"], S["g_v"], S["g_a_f"])
    gb = lambda S: (S["g_q"], S["g_k"], S["g_v"], S["g_a_b"])
    g_ctx, g_lat = bidir(gla_scan, gf(C), gf(L), gb(C), gb(L), g_init)
    rpb = rpb.astype(f32)
    n_lat = natten_latent(L["n_q"], L["n_k"], L["n_v"], C["n_k"], C["n_v"], rpb)

    def merge(S, m, g, n, dtype):
        y = jnp.concatenate([head_norm(m, mlstm_norm_g) * jax.nn.sigmoid(S["m_o"]),
                             head_norm(g, gla_norm_g) * jax.nn.silu(S["g_r"]),
                             merge_heads(n)], -1)
        return y.astype(dtype) @ w_out

    y_lat = merge(L, m_lat, g_lat, n_lat, u_lat.dtype)
    y_ctx = None
    if need_ctx:
        n_ctx = context_attention(C["n_q"], C["n_k"], C["n_v"])
        y_ctx = merge(C, m_ctx, g_ctx, n_ctx, u_ctx.dtype)
    return y_lat, y_ctx


def ec_ffn(u, w_router, w_gate, w_up, w_down):
    B, T, D = u.shape
    cap = CAPACITY_FACTOR * T // N_EXPERTS
    aff = jax.nn.softmax((u @ w_router).astype(jnp.float32), -1)
    gate, idx = lax.top_k(jnp.swapaxes(aff, 1, 2), cap)
    bidx = jnp.arange(B)[:, None, None]
    xe = u[bidx, idx]
    h = jax.nn.silu(jnp.einsum('becd,edf->becf', xe, w_gate)) * jnp.einsum('becd,edf->becf', xe, w_up)
    y = (jnp.einsum('becf,efd->becd', h, w_down) * gate[..., None]).astype(u.dtype)
    return jnp.zeros_like(u).at[bidx, idx].add(y)


def setup_inputs(seed: int = 0) -> dict:
    key = jax.random.key(seed)
    ks = jax.random.split(key, 23)
    D = D_MODEL
    nrm = lambda k, shape, s: jax.random.normal(k, shape, jnp.float32) * s
    offs = np.cumsum((0,) + SPLIT_SIZES)
    start = dict(zip(SPLIT_NAMES, offs[:-1].tolist()))
    fbias = np.zeros((PROJ_W,), np.float32)
    for name in ("m_f_f", "m_f_b"):
        fbias[start[name]:start[name] + MLSTM_HEADS] = np.linspace(3.0, 6.0, MLSTM_HEADS)
    return {
        "x": nrm(ks[0], (BATCH, SEQ, D), 1.0),
        "c": nrm(ks[1], (BATCH, D), 1.0),
        "ctx": nrm(ks[2], (BATCH, CTX_LEN, D), 1.0),
        "c_ctx": nrm(ks[3], (D,), 1.0),
        "w_mod": nrm(ks[4], (DEPTH, D, 6 * D), 0.5 * D ** -0.5),
        "b_mod": nrm(ks[5], (DEPTH, 6 * D), 0.02),
        "w_in": nrm(ks[6], (DEPTH, D, PROJ_W), D ** -0.5),
        "b_in": nrm(ks[7], (DEPTH, PROJ_W), 0.02) + jnp.asarray(fbias),
        "conv_w": nrm(ks[8], (DEPTH, CONV_K, 2 * MLSTM_W), CONV_K ** -0.5),
        "gla_w2": nrm(ks[9], (DEPTH, 2, GLA_RANK, GLA_KW), GLA_RANK ** -0.5),
        "gla_b2": nrm(ks[10], (DEPTH, 2, GLA_KW), 0.1),
        "mlstm_norm_g": 1.0 + nrm(ks[11], (DEPTH, MLSTM_W), 0.02),
        "gla_norm_g": 1.0 + nrm(ks[12], (DEPTH, GLA_W), 0.02),
        "rpb": nrm(ks[13], (DEPTH, NAT_HEADS, 2 * WIN_ROWS - 1, 2 * WIN_COLS - 1), 0.05),
        "w_out": nrm(ks[14], (DEPTH, MIX_W, D), MIX_W ** -0.5 * DEEPNORM_BETA),
        "ln1_g": 1.0 + nrm(ks[15], (DEPTH, D), 0.02),
        "ln1_b": nrm(ks[16], (DEPTH, D), 0.02),
        "w_router": nrm(ks[17], (DEPTH, D, N_EXPERTS), D ** -0.5),
        "w_gate": nrm(ks[18], (DEPTH, N_EXPERTS, D, EXPERT_FF), D ** -0.5),
        "w_up": nrm(ks[19], (DEPTH, N_EXPERTS, D, EXPERT_FF), D ** -0.5),
        "w_down": nrm(ks[20], (DEPTH, N_EXPERTS, EXPERT_FF, D), EXPERT_FF ** -0.5 * DEEPNORM_BETA),
        "ln2_g": 1.0 + nrm(ks[21], (DEPTH, D), 0.02),
        "ln2_b": nrm(ks[22], (DEPTH, D), 0.02),
    }


def reference(x, c, ctx, c_ctx, w_mod, b_mod, w_in, b_in, conv_w, gla_w2, gla_b2,
              mlstm_norm_g, gla_norm_g, rpb, w_out, ln1_g, ln1_b, w_router, w_gate, w_up,
              w_down, ln2_g, ln2_b):
    T = x.shape[1]
    t = jnp.arange(T)
    rows = (t // GRID_W).astype(jnp.float32)
    cols = (t % GRID_W).astype(jnp.float32)
    silu_c = jax.nn.silu(c)
    silu_cc = jax.nn.silu(c_ctx)
    for l in range(DEPTH):
        need_ctx = l < DEPTH - 1
        mod = (silu_c @ w_mod[l] + b_mod[l])[:, None, :]
        modc = (silu_cc @ w_mod[l] + b_mod[l])[None, None, :]
        sh1, sc1, g1, sh2, sc2, g2 = jnp.split(mod, 6, axis=-1)
        sh1c, sc1c, g1c, sh2c, sc2c, g2c = jnp.split(modc, 6, axis=-1)
        y_lat, y_ctx = hybrid_mixer(x * (1 + sc1) + sh1, ctx * (1 + sc1c) + sh1c, rows, cols,
                                    w_in[l], b_in[l], conv_w[l], gla_w2[l], gla_b2[l],
                                    mlstm_norm_g[l], gla_norm_g[l], rpb[l], w_out[l], need_ctx)
        x = layer_norm(DEEPNORM_ALPHA * x + g1 * y_lat, ln1_g[l], ln1_b[l])
        f_lat = ec_ffn(x * (1 + sc2) + sh2, w_router[l], w_gate[l], w_up[l], w_down[l])
        x = layer_norm(DEEPNORM_ALPHA * x + g2 * f_lat, ln2_g[l], ln2_b[l])
        if need_ctx:
            ctx = layer_norm(DEEPNORM_ALPHA * ctx + g1c * y_ctx, ln1_g[l], ln1_b[l])
            f_ctx = ec_ffn(ctx * (1 + sc2c) + sh2c, w_router[l], w_gate[l], w_up[l], w_down[l])
            ctx = layer_norm(DEEPNORM_ALPHA * ctx + g2c * f_ctx, ln2_g[l], ln2_b[l])
    return x
```

```cpp
#ifdef HOST_EMU
#include "emu.h"
#else
#include <hip/hip_runtime.h>
#include <cstdio>
#include <cstdint>
#endif

#ifndef CFG_BATCH
#define CFG_BATCH 32
#define CFG_SEQ 2048
#define CFG_CTX 256
#define CFG_DEPTH 4
#endif
#ifndef ONE_LAUNCH
#define ONE_LAUNCH 1
#endif
#ifndef MOE_F8
#ifdef HOST_EMU
#define MOE_F8 0
#else
#define MOE_F8 1
#endif
#endif
#ifndef YEXP_F8
#define YEXP_F8 1
#endif

#define DEV __device__ __forceinline__
typedef unsigned short bf16_t;
typedef short bf16x8 __attribute__((ext_vector_type(8)));
typedef short bf16x4 __attribute__((ext_vector_type(4)));
typedef float f32x4 __attribute__((ext_vector_type(4)));
typedef float f32x2 __attribute__((ext_vector_type(2)));
typedef unsigned u32x4 __attribute__((ext_vector_type(4)));
typedef unsigned u32x2 __attribute__((ext_vector_type(2)));
typedef int i32x8 __attribute__((ext_vector_type(8)));

constexpr int B_ = CFG_BATCH, T_ = CFG_SEQ, TC_ = CFG_CTX, DEPTH_ = CFG_DEPTH;
constexpr int D_ = 1024, NL = B_ * T_, NC = B_ * TC_, NTOK = NL + NC;
constexpr int PROJ_W0 = 3376, PROJ_N = 3328, PROJ_NP = 3584, NG = 48;
constexpr int FF = 2048, NE = 16;
constexpr int CAP_L = 2 * T_ / NE, CAP_C = 2 * TC_ / NE;
constexpr int ROWS_L = B_ * CAP_L, ROWS_C = B_ * CAP_C;
constexpr int MROWS = ((ROWS_L + ROWS_C + 255) / 256) * 256;
constexpr int MROWS_LAST = ((ROWS_L + 255) / 256) * 256;
constexpr int NCH_C = TC_ / 64, NCH_L = T_ / 64, NCH = NCH_C + NCH_L;
constexpr int GRID_R = T_ / 64;
constexpr float LN_EPS = 1e-5f;
constexpr int C_MQ = 0, C_MK = 256, C_MV = 512, C_MO = 768, C_GQ = 1024, C_GK = 1152, C_GV = 1280, C_GR = 1536, C_NQ = 1792, C_NK = 2304, C_NV = 2816;
static_assert(T_ % 256 == 0 && TC_ % 256 == 0 && NL % 256 == 0 && NC % 256 == 0, "shape");
static_assert(GRID_R >= 8, "rows");

constexpr size_t al256(size_t x) { return (x + 255) & ~(size_t)255; }
constexpr size_t WS_CTL = 0;
constexpr size_t WS_CTL_BYTES = 16384;
constexpr size_t WS_MODS = WS_CTL + WS_CTL_BYTES;
constexpr size_t WS_ROPE = WS_MODS + al256((size_t)DEPTH_ * (B_ + 1) * 6144 * 4);
constexpr size_t WS_BIAS = WS_ROPE + al256((64 * 16 * 2 + 64 * 8 * 2) * 4);
constexpr size_t WS_BTIN = WS_BIAS + al256(PROJ_NP * 4);
constexpr size_t WS_BTOUT = WS_BTIN + al256((size_t)PROJ_NP * D_ * 2);
constexpr size_t WBYTES = MOE_F8 ? 1 : 2;
constexpr size_t WS_BTGU = WS_BTOUT + al256((size_t)D_ * D_ * 2);
constexpr size_t WS_BTDN = WS_BTGU + al256((size_t)NE * 2 * FF * D_ * WBYTES);
constexpr size_t WS_U = WS_BTDN + al256((size_t)NE * D_ * FF * WBYTES);
constexpr size_t WS_XH = WS_U + al256((size_t)NTOK * D_ * 2);
constexpr size_t WS_AFF = WS_XH + al256((size_t)NTOK * D_ * 2);
constexpr size_t WS_SLOT = WS_AFF + al256((size_t)NTOK * 16 * 4);
constexpr size_t WS_GSCAN = WS_SLOT + al256((size_t)NTOK * 16 * 4);
constexpr size_t WS_ROWTAB = WS_GSCAN + al256((size_t)B_ * 8 * NCH * 192 * 4);
constexpr size_t WS_YMIX = WS_ROWTAB + al256((size_t)NE * MROWS * 4);
constexpr size_t WS_YEXP = WS_YMIX + al256((size_t)NTOK * D_ * 2);
constexpr size_t WS_R1 = WS_YEXP + al256((size_t)NE * MROWS * D_ * 2);
constexpr size_t R1_PROJ = 0;
constexpr size_t R1_GATES = R1_PROJ + al256((size_t)NTOK * PROJ_N * 2);
constexpr size_t R1_OM = R1_GATES + al256((size_t)NTOK * NG * 4);
constexpr size_t R1_OG = R1_OM + al256((size_t)2 * NTOK * 256 * 2);
constexpr size_t R1_QK2 = R1_OG + al256((size_t)2 * NTOK * 256 * 2);
constexpr size_t R1_END = R1_QK2 + al256((size_t)NTOK * 512 * 2);
constexpr size_t R1_H_BYTES = al256((size_t)NE * MROWS * FF * 2);
constexpr size_t WS_YO = WS_R1 + (R1_END > R1_H_BYTES ? R1_END : R1_H_BYTES);
#if MOE_F8 && YEXP_F8
constexpr size_t WS_X1H = WS_YEXP + (size_t)NE * MROWS * D_;
constexpr size_t WS_END = WS_YO + al256((size_t)NTOK * D_ * 2);
#else
constexpr size_t WS_X1H = WS_YO + al256((size_t)NTOK * D_ * 2);
constexpr size_t WS_END = WS_X1H + al256((size_t)NTOK * D_ * 2);
#endif
static_assert((size_t)NE * MROWS * D_ >= (size_t)NTOK * D_ * 2, "x1 alias");

constexpr int LDS_BYTES = 144 * 1024;
constexpr int NPH = 10;
constexpr int NPHASES = 1 + DEPTH_ * NPH;

struct Params {
    const float* in[23];
    float* out;
    unsigned char* ws;
    int ph_lo, ph_hi;
};

#ifdef HOST_EMU
#define LAS
static inline unsigned f_as_u(float f) { unsigned u; memcpy(&u, &f, 4); return u; }
static inline float u_as_f(unsigned u) { float f; memcpy(&f, &u, 4); return f; }
static inline float shfl_xor_f(float v, int m) { auto t = emu::wave_all(&v, 4); float r; memcpy(&r, t[emu::lane() ^ m], 4); return r; }
static inline float shfl_up_f(float v, int d) { auto t = emu::wave_all(&v, 4); int l = emu::lane(); float r; memcpy(&r, t[l >= d ? l - d : l], 4); return r; }
static inline float shfl_idx_f(float v, int s) { auto t = emu::wave_all(&v, 4); float r; memcpy(&r, t[s & 63], 4); return r; }
static inline int shfl_idx_i(int v, int s) { auto t = emu::wave_all(&v, 4); int r; memcpy(&r, t[s & 63], 4); return r; }
static inline int rdlane_i(int v, int s) { return shfl_idx_i(v, s); }
static inline float rdlane_f(float v, int s) { return shfl_idx_f(v, s); }
static inline f32x4 mfma16(bf16x8 a, bf16x8 b, f32x4 c) {
    struct { bf16x8 a, b; } d; d.a = a; d.b = b;
    auto t = emu::wave_all(&d, 32);
    int l = emu::lane(), col = l & 15, g = l >> 4;
    for (int r = 0; r < 4; ++r) {
        int row = 4 * g + r; float s = c[r];
        for (int k = 0; k < 32; ++k) {
            unsigned short av, bv;
            memcpy(&av, t[row + 16 * (k >> 3)] + 2 * (k & 7), 2);
            memcpy(&bv, t[col + 16 * (k >> 3)] + 16 + 2 * (k & 7), 2);
            s += u_as_f((unsigned)av << 16) * u_as_f((unsigned)bv << 16);
        }
        c[r] = s;
    }
    return c;
}
static inline void glds16(const void* g, unsigned char* l) { memcpy(l + 16 * emu::lane(), g, 16); }
#define S_BARRIER() __syncthreads()
#define WAIT_V(n)
#define WAIT_L(n)
#define SCHED_BAR()
#define SETPRIO(n)
#define RFL(x) (x)
static inline float fast_exp(float x) { return expf(x); }
static inline float fast_rcp(float x) { return 1.0f / x; }
static inline float fast_exp2(float x) { return exp2f(x); }
static inline float fast_log(float x) { return logf(x); }
#else
#define LAS __attribute__((address_space(3)))
DEV unsigned f_as_u(float f) { return __float_as_uint(f); }
DEV float u_as_f(unsigned u) { return __uint_as_float(u); }
DEV float shfl_xor_f(float v, int m) { return __shfl_xor(v, m, 64); }
DEV float shfl_up_f(float v, int d) { return __shfl_up(v, d, 64); }
DEV float shfl_idx_f(float v, int s) { return __shfl(v, s, 64); }
DEV int shfl_idx_i(int v, int s) { return __shfl(v, s, 64); }
DEV int rdlane_i(int v, int s) { return __builtin_amdgcn_readlane(v, s); }
DEV float rdlane_f(float v, int s) { return __uint_as_float((unsigned)__builtin_amdgcn_readlane((int)__float_as_uint(v), s)); }
DEV f32x4 mfma16(bf16x8 a, bf16x8 b, f32x4 c) { return __builtin_amdgcn_mfma_f32_16x16x32_bf16(a, b, c, 0, 0, 0); }
DEV void glds16(const void* g, LAS unsigned char* l) { __builtin_amdgcn_global_load_lds((const unsigned*)g, (LAS unsigned*)l, 16, 0, 0); }
#define S_BARRIER() __builtin_amdgcn_s_barrier()
#define WAIT_V(n) asm volatile("s_waitcnt vmcnt(" #n ")" ::: "memory")
#define WAIT_L(n) asm volatile("s_waitcnt lgkmcnt(" #n ")" ::: "memory")
#define SCHED_BAR() __builtin_amdgcn_sched_barrier(0)
#define SETPRIO(n) __builtin_amdgcn_s_setprio(n)
#define RFL(x) __builtin_amdgcn_readfirstlane(x)
DEV float fast_exp(float x) { return __expf(x); }
DEV float fast_rcp(float x) { return __builtin_amdgcn_rcpf(x); }
DEV float fast_exp2(float x) { return __builtin_amdgcn_exp2f(x); }
DEV float fast_log(float x) { return __logf(x); }
#endif

#ifdef HOST_EMU
DEV int opaque_tid() { return (int)threadIdx.x; }
#else
DEV int opaque_tid() { int t = threadIdx.x; asm volatile("" : "+v"(t)); return t; }
#endif
#ifdef HOST_EMU
typedef const unsigned char* lds_addr_t;
static inline lds_addr_t lds_addr(const void* p) { return (lds_addr_t)p; }
template <int OFF> static inline bf16x4 tr_read4(lds_addr_t vb) {
    const unsigned char* a = vb + OFF; auto t = emu::wave_all(&a, 8); const int l = emu::lane(), G = l >> 4, i = l & 15; bf16x4 r;
    for (int q = 0; q < 4; ++q) { const unsigned char* src; memcpy(&src, t[16 * G + 4 * q + (i >> 2)], 8); short v; memcpy(&v, src + 2 * (i & 3), 2); r[q] = v; }
    return r; }
#define LGKM_WAIT0()
#define LDS_BARRIER() __syncthreads()
#else
typedef unsigned lds_addr_t;
DEV lds_addr_t lds_addr(const LAS void* p) { return (unsigned)(size_t)p; }
template <int OFF> DEV bf16x4 tr_read4(lds_addr_t vb) { bf16x4 r; asm volatile("ds_read_b64_tr_b16 %0, %1 offset:%2" : "=&v"(r) : "v"(vb), "i"(OFF) : "memory"); return r; }
#define LGKM_WAIT0() do { asm volatile("s_waitcnt lgkmcnt(0)" ::: "memory"); __builtin_amdgcn_sched_barrier(0); } while (0)
#define LDS_BARRIER() do { asm volatile("s_waitcnt lgkmcnt(0)" ::: "memory"); __builtin_amdgcn_s_barrier(); asm volatile("" ::: "memory"); } while (0)
#endif
DEV bf16_t f2bf(float f) { unsigned u = f_as_u(f); u += 0x7FFFu + ((u >> 16) & 1u); return (bf16_t)(u >> 16); }
DEV float bf2f(bf16_t b) { return u_as_f((unsigned)b << 16); }
#ifdef HOST_EMU
DEV unsigned pack2(float lo, float hi) { return (unsigned)f2bf(lo) | ((unsigned)f2bf(hi) << 16); }
#else
DEV unsigned pack2(float lo, float hi) { unsigned r; asm volatile("v_cvt_pk_bf16_f32 %0, %1, %2" : "=v"(r) : "v"(lo), "v"(hi)); return r; }
#endif
DEV float bflo(unsigned u) { return u_as_f(u << 16); }
DEV float bfhi(unsigned u) { return u_as_f(u & 0xFFFF0000u); }
DEV float siluf(float x) { return x / (1.0f + expf(-x)); }
DEV float sigmoidf_(float x) { return 1.0f / (1.0f + expf(-x)); }
DEV float logsigf(float x) { return fminf(x, 0.0f) - log1pf(expf(-fabsf(x))); }
#ifdef HOST_EMU
DEV float xrow16_max(float x) { x = fmaxf(x, shfl_xor_f(x, 16)); return fmaxf(x, shfl_xor_f(x, 32)); }
DEV float xrow16_sum(float x) { x += shfl_xor_f(x, 16); return x + shfl_xor_f(x, 32); }
#else
DEV float xrow16_max(float x) {
    auto s = __builtin_amdgcn_permlane16_swap(__float_as_uint(x), __float_as_uint(x), false, false);
    x = fmaxf(__uint_as_float(s[0]), __uint_as_float(s[1]));
    auto t = __builtin_amdgcn_permlane32_swap(__float_as_uint(x), __float_as_uint(x), false, false);
    return fmaxf(__uint_as_float(t[0]), __uint_as_float(t[1])); }
DEV float xrow16_sum(float x) {
    auto s = __builtin_amdgcn_permlane16_swap(__float_as_uint(x), __float_as_uint(x), false, false);
    x = __uint_as_float(s[0]) + __uint_as_float(s[1]);
    auto t = __builtin_amdgcn_permlane32_swap(__float_as_uint(x), __float_as_uint(x), false, false);
    return __uint_as_float(t[0]) + __uint_as_float(t[1]); }
#endif
#if MOE_F8
constexpr float F8_SW1 = 32.0f, F8_SH = 4.0f, F8_SW2 = 128.0f, F8_SY = 16.0f;
DEV float f8clamp(float x) { return fminf(fmaxf(x, -448.0f), 448.0f); }
DEV unsigned pack4_f8(float a, float b, float c, float d) {
    int p_ = __builtin_amdgcn_cvt_pk_fp8_f32(f8clamp(a), f8clamp(b), 0, false);
    p_ = __builtin_amdgcn_cvt_pk_fp8_f32(f8clamp(c), f8clamp(d), p_, true);
    return (unsigned)p_; }
typedef int i32x4 __attribute__((ext_vector_type(4)));
DEV void mfma_f8(f32x4& c, bf16x8 a0, bf16x8 a1, bf16x8 b0, bf16x8 b1, int sc) {
    i32x4 al, ah, bl, bh; __builtin_memcpy(&al, &a0, 16); __builtin_memcpy(&ah, &a1, 16); __builtin_memcpy(&bl, &b0, 16); __builtin_memcpy(&bh, &b1, 16);
    const i32x8 A = __builtin_shufflevector(al, ah, 0, 1, 2, 3, 4, 5, 6, 7), B = __builtin_shufflevector(bl, bh, 0, 1, 2, 3, 4, 5, 6, 7);
    asm volatile("v_mfma_scale_f32_16x16x128_f8f6f4 %0, %1, %2, %0, %3, %3 op_sel_hi:[0,0,0]" : "+v"(c) : "v"(A), "v"(B), "v"(sc)); }
#define MFMA_DRAIN() asm volatile("s_nop 15\n\ts_nop 15" ::: "memory")
#endif
typedef _Float16 h16x8 __attribute__((ext_vector_type(8)));
DEV u32x4 pack8_h(const float (&v)[8]) { h16x8 h; for (int j = 0; j < 8; ++j) h[j] = (_Float16)v[j]; u32x4 o; __builtin_memcpy(&o, &h, 16); return o; }
DEV void unpack8_h(u32x4 u, float (&v)[8]) { h16x8 h; __builtin_memcpy(&h, &u, 16); for (int j = 0; j < 8; ++j) v[j] = (float)h[j]; }
#ifdef HOST_EMU
DEV bool wave_any(bool b) { float v = b ? 1.f : 0.f; for (int m = 32; m >= 1; m >>= 1) v = fmaxf(v, shfl_xor_f(v, m)); return v > 0.f; }
#else
DEV bool wave_any(bool b) { return __builtin_amdgcn_ballot_w64(b) != 0ull; }
#endif
DEV float silu_fast(float x) { return x * fast_rcp(1.0f + fast_exp(-x)); }
DEV float sigmoid_fast(float x) { return fast_rcp(1.0f + fast_exp(-x)); }
DEV float logsig_fast(float x) { return fminf(x, 0.0f) - fast_log(1.0f + fast_exp(-fabsf(x))); }
#ifdef HOST_EMU
DEV float wave_sum(float v) { for (int m = 32; m >= 1; m >>= 1) v += shfl_xor_f(v, m); return v; }
DEV float wave_max(float v) { for (int m = 32; m >= 1; m >>= 1) v = fmaxf(v, shfl_xor_f(v, m)); return v; }
DEV float xsum32(float a, float b) { const float pa = shfl_xor_f(a, 32), pb = shfl_xor_f(b, 32); return (emu::lane() & 32) ? b + pb : a + pa; }
DEV float xsum16(float a, float b) { const float pa = shfl_xor_f(a, 16), pb = shfl_xor_f(b, 16); return (emu::lane() & 16) ? b + pb : a + pa; }
DEV float xsum8(float a, float b, int lane) { const float pa = shfl_xor_f(a, 8), pb = shfl_xor_f(b, 8); return (lane & 8) ? b + pb : a + pa; }
DEV float xsum4(float a, float b, int lane) { const float pa = shfl_xor_f(a, 4), pb = shfl_xor_f(b, 4); return (lane & 4) ? b + pb : a + pa; }
DEV float quad_sum(float v) { v += shfl_xor_f(v, 1); return v + shfl_xor_f(v, 2); }
#else
template <int CTRL> DEV float dpp_f(float x) { return __uint_as_float((unsigned)__builtin_amdgcn_update_dpp(0, (int)__float_as_uint(x), CTRL, 0xF, 0xF, false)); }
DEV float wave_sum(float v) {
    v += dpp_f<0x128>(v); v += dpp_f<0x124>(v); v += dpp_f<0x122>(v); v += dpp_f<0x121>(v);
    return xrow16_sum(v); }
DEV float wave_max(float v) {
    v = fmaxf(v, dpp_f<0x128>(v)); v = fmaxf(v, dpp_f<0x124>(v)); v = fmaxf(v, dpp_f<0x122>(v)); v = fmaxf(v, dpp_f<0x121>(v));
    return xrow16_max(v); }
DEV float xsum32(float a, float b) { auto s_ = __builtin_amdgcn_permlane32_swap(__float_as_uint(a), __float_as_uint(b), false, false); return __uint_as_float(s_[0]) + __uint_as_float(s_[1]); }
DEV float xsum16(float a, float b) { auto s_ = __builtin_amdgcn_permlane16_swap(__float_as_uint(a), __float_as_uint(b), false, false); return __uint_as_float(s_[0]) + __uint_as_float(s_[1]); }
DEV float xsum8(float a, float b, int lane) { const bool hi = (lane & 8) != 0; return (hi ? b : a) + dpp_f<0x128>(hi ? a : b); }
DEV float xsum4(float a, float b, int lane) { const bool hi = (lane & 4) != 0; return (hi ? b : a) + __shfl_xor(hi ? a : b, 4, 64); }
DEV float quad_sum(float v) { v += dpp_f<0xB1>(v); return v + dpp_f<0x4E>(v); }
#endif

#ifdef HOST_EMU
static std::atomic<unsigned> g_emu_bar{0};
struct XcdBarrier { unsigned n; };
static inline XcdBarrier xcd_barrier_post(unsigned*, unsigned*) { XcdBarrier b; b.n = 0; return b; }
static inline void xcd_barrier(XcdBarrier& b) {
    __syncthreads();
    if (threadIdx.x == 0) { b.n++; g_emu_bar.fetch_add(1); while (g_emu_bar.load() < b.n * gridDim.x) std::this_thread::yield(); }
    __syncthreads();
}
#else
#define XB_TMO      128
#define XB_XCNT(j)  (256  + 64 * (j))
#define XB_XSUB(j)  (1280 + 64 * (j))
#define XB_XGEN(j)  (2304 + 64 * (j))
#define XB_TOP      3328
#define XB_TOPGEN   3392
#define XCD_BAR_WORDS 3456
#define XB_QUEUE     3584
#define XB_SPIN_CAP (1u << 22)
DEV unsigned xb_ld(unsigned* p)              { return __hip_atomic_load(p, __ATOMIC_RELAXED, __HIP_MEMORY_SCOPE_AGENT); }
DEV unsigned xb_add(unsigned* p, unsigned v) { return __hip_atomic_fetch_add(p, v, __ATOMIC_RELAXED, __HIP_MEMORY_SCOPE_AGENT); }
DEV unsigned xb_xcc_id() { return (unsigned)__builtin_amdgcn_s_getreg((3 << 11) | 20) & 0xFu; }
#define XB_SPIN(cond, bar) do { unsigned _sp = 0; while (cond) { __builtin_amdgcn_s_sleep(1); \
    if ((++_sp & 255u) == 0u) { if (xb_ld(&(bar)[XB_TMO])) break; if (_sp > XB_SPIN_CAP) { atomicAdd(&(bar)[XB_TMO], 1u); break; } } } } while (0)
struct XcdBarrier { unsigned* bar; unsigned x; volatile LAS unsigned* st; };
DEV XcdBarrier xcd_barrier_post(unsigned* bar, volatile LAS unsigned* st) {
    XcdBarrier b; b.bar = bar; b.x = xb_xcc_id(); b.st = st;
    if (threadIdx.x == 0) (void)xb_add(&bar[XB_XCNT(b.x)], 1u);
    return b;
}
DEV void xcd_barrier_complete(unsigned* bar, unsigned x, unsigned& nloc, unsigned& nx) {
    const unsigned G = gridDim.x * gridDim.y * gridDim.z;
    unsigned sum, cnt, mine, sp = 0u;
    for (;;) {
        sum = 0u; cnt = 0u; mine = 0u;
#pragma unroll
        for (unsigned j = 0; j < 16; ++j) { const unsigned c = xb_ld(&bar[XB_XCNT(j)]); sum += c; cnt += (c > 0u) ? 1u : 0u; mine = (j == x) ? c : mine; }
        if (sum == G) break;
        __builtin_amdgcn_s_sleep(1);
        if ((++sp & 255u) == 0u) { if (xb_ld(&bar[XB_TMO])) break; if (sp > XB_SPIN_CAP) { atomicAdd(&bar[XB_TMO], 1u); break; } }
    }
    nloc = mine > 0u ? mine : 1u; nx = cnt > 0u ? cnt : 1u;
}
DEV void xcd_barrier(const XcdBarrier& b) {
    asm volatile("s_waitcnt vmcnt(0)" ::: "memory");
    __syncthreads();
    if (threadIdx.x == 0) {
        unsigned* bar = b.bar;
        __builtin_amdgcn_s_waitcnt(0);
        unsigned nloc = b.st[0], nx = b.st[1];
        if (nloc == 0u) { xcd_barrier_complete(bar, b.x, nloc, nx); b.st[0] = nloc; b.st[1] = nx; }
        const unsigned old = xb_add(&bar[XB_XSUB(b.x)], 1u);
        const unsigned gen = old / nloc;
        if (old + 1u == (gen + 1u) * nloc) {
            __builtin_amdgcn_fence(__ATOMIC_RELEASE, "agent");
            asm volatile("s_waitcnt vmcnt(0)" ::: "memory");
            const unsigned og = xb_add(&bar[XB_TOP], 1u);
            const unsigned tg = og / nx;
            if (og + 1u == (tg + 1u) * nx) xb_add(&bar[XB_TOPGEN], 1u);
            else XB_SPIN(xb_ld(&bar[XB_TOPGEN]) == tg, bar);
            __builtin_amdgcn_fence(__ATOMIC_ACQUIRE, "agent");
            xb_add(&bar[XB_XGEN(b.x)], 1u);
            asm volatile("s_waitcnt vmcnt(0)" ::: "memory");
        } else {
            XB_SPIN(xb_ld(&bar[XB_XGEN(b.x)]) == gen, bar);
            __builtin_amdgcn_fence(__ATOMIC_ACQUIRE, "agent");
            asm volatile("s_waitcnt vmcnt(0)" ::: "memory");
        }
    }
    __syncthreads();
}
#endif

namespace pg8 {
constexpr int BM = 256, BK = 64, HALF = 128, HTB = HALF * BK * 2, STAGE_BYTES = 8 * HTB, NXCD = 8, WGM = 8;
DEV int lds_byte(int r, int c) { const int st = (r >> 4) * 2 + (c >> 5), rr = r & 15, cc = c & 31, ob = rr * 64 + cc * 2; return st * 1024 + (ob ^ (((ob >> 9) & 1) << 5)); }
DEV void stage_rc(int b, int& R, int& C) { const int st = b / 1024, sb = b % 1024, swz = sb ^ (((sb >> 9) & 1) << 5); R = (st >> 1) * 16 + swz / 64; C = (st & 1) * 32 + (swz % 64) / 2; }
DEV int perm32(int rho) { const int n = rho >> 4, i = rho & 15; return 8 * (i >> 2) + 4 * n + (i & 3); }

struct Unit { int pm, pn, pb; };
struct Gemm { const bf16_t* A; const bf16_t* Bt; int K; const int* rowtab; };

struct Order {
    int nM, nN, nwg, G, c, mt, mts;
    DEV void init(int ngrp, int mt_, int mts_, int nN_, int G_, int c_) { mt = mt_; mts = mts_; nM = ngrp * mt_; nN = nN_; nwg = nM * nN; G = G_; c = c_; }
    DEV bool next(int i, Unit& u) const {
        const long L = (long)i * G + c; if (L >= nwg) return false;
        int wgid = (int)L; { const int q = nwg / NXCD, r = nwg % NXCD, xcd = wgid % NXCD, off = wgid / NXCD; wgid = (xcd < r ? xcd * (q + 1) : r * (q + 1) + (xcd - r) * q) + off; }
        const int nig = WGM * nN, gid = wgid / nig, fm = gid * WGM, gsz = (nM - fm) < WGM ? (nM - fm) : WGM;
        const int pmv = fm + ((wgid % nig) % gsz); u.pn = (wgid % nig) / gsz;
        const int e = pmv / mt, pl = pmv - e * mt; u.pm = e * mts + pl; u.pb = e * nN + u.pn; return true;
    }
};

template <class Epi, bool GATHER, bool F8 = false>
DEV void gemm_phase(LAS unsigned char* lds, const Gemm g, const Order& S, const Epi& E) {
    const int tid = opaque_tid(), wid = RFL(tid >> 6), lane = tid & 63, wr = wid >> 2, wc = wid & 3, fr = lane & 15, fq = lane >> 4;
    const int K = g.K, nt = K / BK;
    unsigned voffA[2], voffB[2];
#pragma unroll
    for (int i = 0; i < 2; ++i) { int R, C; stage_rc(tid * 16 + i * 8192, R, C); const int Rb = Epi::PERM ? ((R & ~31) + perm32(R & 31)) : R;
        voffA[i] = (unsigned)(R * K + C) * 2u; voffB[i] = (unsigned)(Rb * K + C) * 2u; }
    const size_t kstep = (size_t)(BK * 2);
    const size_t hstep = (size_t)HALF * K * 2;
    const size_t tstep = 2 * hstep;
    const unsigned ldsw = (unsigned)wid * 1024u;
    const int aoff = lds_byte(wr * 64 + fr, fq * 8), boff = lds_byte(wc * 32 + fr, fq * 8);
#define PG8_SA(b, h) (((b) * 2 + (h)) * HTB)
#define PG8_SB(b, h) ((4 + (b) * 2 + (h)) * HTB)
#define PG8_STAGE(bufoff, gbase, voff) do { _Pragma("unroll") for (int _i = 0; _i < 2; ++_i) \
        glds16((const char*)(gbase) + (voff)[_i], lds + (bufoff) + ldsw + _i * 8192); } while (0)
#define PG8_STAGE_A(bufoff, gbase, h, nx) do { _Pragma("unroll") for (int _i = 0; _i < 2; ++_i) { \
        if constexpr (GATHER) glds16((const char*)(gbase) + ((nx) ? na[h][_i] : ca[h][_i]), lds + (bufoff) + ldsw + _i * 8192); \
        else glds16((const char*)(gbase) + (size_t)(h) * hstep + voffA[_i], lds + (bufoff) + ldsw + _i * 8192); } } while (0)
#define PG8_LDA(dst, b, h) do { _Pragma("unroll") for (int m = 0; m < 4; ++m) _Pragma("unroll") for (int k = 0; k < 2; ++k) dst[m][k] = *(const LAS bf16x8*)(lds + PG8_SA(b, h) + aoff + m * 2048 + k * 1024); } while (0)
#define PG8_LDB(dst, b, h) do { _Pragma("unroll") for (int n = 0; n < 2; ++n) _Pragma("unroll") for (int k = 0; k < 2; ++k) dst[n][k] = *(const LAS bf16x8*)(lds + PG8_SB(b, h) + boff + n * 2048 + k * 1024); } while (0)
#if MOE_F8
#define PG8_MMA(ai, bj, At, Bt) do { SETPRIO(1); _Pragma("unroll") for (int m = 0; m < 4; ++m) _Pragma("unroll") for (int n = 0; n < 2; ++n) { \
        if constexpr (F8) mfma_f8(acc[ai][bj][m][n], Bt[n][0], Bt[n][1], At[m][0], At[m][1], f8sc); \
        else { _Pragma("unroll") for (int k = 0; k < 2; ++k) acc[ai][bj][m][n] = mfma16(Bt[n][k], At[m][k], acc[ai][bj][m][n]); } } SETPRIO(0); } while (0)
#else
#define PG8_MMA(ai, bj, At, Bt) do { SETPRIO(1); _Pragma("unroll") for (int m = 0; m < 4; ++m) _Pragma("unroll") for (int n = 0; n < 2; ++n) _Pragma("unroll") for (int k = 0; k < 2; ++k) \
        acc[ai][bj][m][n] = mfma16(Bt[n][k], At[m][k], acc[ai][bj][m][n]); SETPRIO(0); } while (0)
#endif
    Unit cur, nxt; int ui = 0;
    if (!S.next(0, cur)) return;
#if MOE_F8
    int f8sc = 0x7F7F7F7F; asm volatile("" : "+v"(f8sc));
#endif
    f32x4 acc[2][2][4][2];
#pragma unroll
    for (int a = 0; a < 2; ++a)
#pragma unroll
        for (int b = 0; b < 2; ++b)
#pragma unroll
            for (int m = 0; m < 4; ++m)
#pragma unroll
                for (int n = 0; n < 2; ++n) acc[a][b][m][n] = (f32x4){0.f, 0.f, 0.f, 0.f};
    bf16x8 At[4][2], B0[2][2], B1[2][2];
    unsigned ca[2][2], na[2][2];
    const char* cA; const char* nA;
    const char* cB = (const char*)g.Bt + (size_t)cur.pb * tstep;
#define PG8_SETA(u, base, off) do { if constexpr (GATHER) { base = (const char*)g.A; \
            _Pragma("unroll") for (int _h = 0; _h < 2; ++_h) _Pragma("unroll") for (int _i = 0; _i < 2; ++_i) { int _R, _C; stage_rc(tid * 16 + _i * 8192, _R, _C); \
                off[_h][_i] = (unsigned)g.rowtab[(u).pm * 256 + _h * 128 + _R] * (unsigned)(K * 2) + (unsigned)_C * 2u; } } \
        else { base = (const char*)g.A + (size_t)(u).pm * tstep; } } while (0)
    PG8_SETA(cur, cA, ca);
    nA = cA;
    if constexpr (GATHER) {
#pragma unroll
        for (int _h = 0; _h < 2; ++_h)
#pragma unroll
            for (int _i = 0; _i < 2; ++_i) na[_h][_i] = ca[_h][_i]; }
    PG8_STAGE(PG8_SB(0, 0), cB, voffB); PG8_STAGE_A(PG8_SA(0, 0), cA, 0, false); PG8_STAGE(PG8_SB(0, 1), cB + hstep, voffB); PG8_STAGE_A(PG8_SA(0, 1), cA, 1, false);
    if (wr == 1) S_BARRIER();
    WAIT_V(4); S_BARRIER();
    PG8_STAGE(PG8_SB(1, 0), cB + kstep, voffB); PG8_STAGE_A(PG8_SA(1, 0), cA + kstep, 0, false); PG8_STAGE(PG8_SB(1, 1), cB + hstep + kstep, voffB);
    WAIT_V(6); S_BARRIER();
    for (;;) {
        const bool has_next = S.next(ui + 1, nxt);
        const char* nB = cB;
        if (has_next) { PG8_SETA(nxt, nA, na); nB = (const char*)g.Bt + (size_t)nxt.pb * tstep; }
        else { nA = cA;
            if constexpr (GATHER) {
#pragma unroll
                for (int _h = 0; _h < 2; ++_h)
#pragma unroll
                    for (int _i = 0; _i < 2; ++_i) na[_h][_i] = ca[_h][_i]; } }
        for (int t = 0; t < nt; t += 2) {
            const bool last = (t == nt - 2);
            const char* a1 = cA + (size_t)(t + 1) * kstep;
            const char* a2 = last ? nA : cA + (size_t)(t + 2) * kstep; const char* b2 = last ? nB : cB + (size_t)(t + 2) * kstep;
            const char* a3 = a2 + kstep; const char* b3 = b2 + kstep;
            PG8_LDB(B0, 0, 0); SCHED_BAR(); PG8_LDA(At, 0, 0); PG8_STAGE_A(PG8_SA(1, 1), a1, 1, false);
            WAIT_L(8); S_BARRIER(); WAIT_L(0); PG8_MMA(0, 0, At, B0); S_BARRIER(); SCHED_BAR();
            PG8_LDB(B1, 0, 1); PG8_STAGE(PG8_SB(0, 0), b2, voffB);
            S_BARRIER(); WAIT_L(0); PG8_MMA(0, 1, At, B1); S_BARRIER();
            PG8_LDA(At, 0, 1); PG8_STAGE_A(PG8_SA(0, 0), a2, 0, last);
            S_BARRIER(); WAIT_L(0); PG8_MMA(1, 0, At, B0); S_BARRIER(); SCHED_BAR();
            PG8_STAGE(PG8_SB(0, 1), b2 + hstep, voffB);
            WAIT_V(6); S_BARRIER(); PG8_MMA(1, 1, At, B1); S_BARRIER();
            PG8_LDB(B0, 1, 0); SCHED_BAR(); PG8_LDA(At, 1, 0); PG8_STAGE_A(PG8_SA(0, 1), a2, 1, last);
            WAIT_L(8); S_BARRIER(); WAIT_L(0); PG8_MMA(0, 0, At, B0); S_BARRIER(); SCHED_BAR();
            PG8_LDB(B1, 1, 1); PG8_STAGE(PG8_SB(1, 0), b3, voffB);
            S_BARRIER(); WAIT_L(0); PG8_MMA(0, 1, At, B1); S_BARRIER();
            PG8_LDA(At, 1, 1); PG8_STAGE_A(PG8_SA(1, 0), a3, 0, last);
            S_BARRIER(); WAIT_L(0); PG8_MMA(1, 0, At, B0); S_BARRIER(); SCHED_BAR();
            PG8_STAGE(PG8_SB(1, 1), b3 + hstep, voffB);
            WAIT_V(6); S_BARRIER(); PG8_MMA(1, 1, At, B1); S_BARRIER();
        }
#if MOE_F8
        if constexpr (F8) MFMA_DRAIN();
#endif
        E(acc, cur, wr, wc, fr, fq);
        if (!has_next) break;
#pragma unroll
        for (int a = 0; a < 2; ++a)
#pragma unroll
            for (int b = 0; b < 2; ++b)
#pragma unroll
                for (int m = 0; m < 4; ++m)
#pragma unroll
                    for (int n = 0; n < 2; ++n) acc[a][b][m][n] = (f32x4){0.f, 0.f, 0.f, 0.f};
        cur = nxt; cA = nA; cB = nB; ++ui;
        if constexpr (GATHER) {
#pragma unroll
            for (int _h = 0; _h < 2; ++_h)
#pragma unroll
                for (int _i = 0; _i < 2; ++_i) ca[_h][_i] = na[_h][_i]; }
    }
    WAIT_V(0);
    if (wr == 0) S_BARRIER();
    S_BARRIER();
#undef PG8_SA
#undef PG8_SB
#undef PG8_STAGE
#undef PG8_STAGE_A
#undef PG8_LDA
#undef PG8_LDB
#undef PG8_MMA
#undef PG8_SETA
}
}
using pg8::Unit;

struct EpiProj {
    static constexpr bool PERM = true;
    bf16_t* proj; float* gates; const float* bias;
    DEV void operator()(const f32x4 (&acc)[2][2][4][2], const Unit& u, int wr, int wc, int fr, int fq) const {
        const int row0 = u.pm * 256 + wr * 64 + fr; const int colt = u.pn * 256, cl = wc * 32 + 8 * fq;
        if (u.pn < PROJ_N / 256) {
#pragma unroll
            for (int bj = 0; bj < 2; ++bj) { const f32x4 b0 = *(const f32x4*)(bias + colt + cl + bj * 128), b1 = *(const f32x4*)(bias + colt + cl + bj * 128 + 4);
#pragma unroll
                for (int ai = 0; ai < 2; ++ai)
#pragma unroll
                    for (int m = 0; m < 4; ++m) { bf16_t* rowp = proj + (size_t)(row0 + ai * 128 + m * 16) * PROJ_N + colt + cl + bj * 128;
                        const f32x4 v0 = acc[ai][bj][m][0] + b0, v1 = acc[ai][bj][m][1] + b1;
                        u32x4 o; o[0] = pack2(v0[0], v0[1]); o[1] = pack2(v0[2], v0[3]); o[2] = pack2(v1[0], v1[1]); o[3] = pack2(v1[2], v1[3]);
                        *(u32x4*)rowp = o; } }
        } else if (cl < NG) {
            const f32x4 b0 = *(const f32x4*)(bias + colt + cl), b1 = *(const f32x4*)(bias + colt + cl + 4);
#pragma unroll
            for (int ai = 0; ai < 2; ++ai)
#pragma unroll
                for (int m = 0; m < 4; ++m) { float* rowp = gates + (size_t)(row0 + ai * 128 + m * 16) * NG + cl;
                    *(f32x4*)(rowp) = acc[ai][0][m][0] + b0; *(f32x4*)(rowp + 4) = acc[ai][0][m][1] + b1; }
        }
    }
};
struct EpiSwiglu {
    static constexpr bool PERM = true;
    bf16_t* h;
    DEV void operator()(const f32x4 (&acc)[2][2][4][2], const Unit& u, int wr, int wc, int fr, int fq) const {
        const int row0 = u.pm * 256 + wr * 64 + fr; const int col0 = u.pn * 128 + wc * 32 + 8 * fq;
#if MOE_F8
        unsigned char* h8 = (unsigned char*)h;
        constexpr float isw = 1.0f / F8_SW1, kd = F8_SW1 * F8_SW1 / F8_SH;
#pragma unroll
        for (int ai = 0; ai < 2; ++ai)
#pragma unroll
            for (int m = 0; m < 4; ++m) { unsigned char* rowp = h8 + (size_t)(row0 + ai * 128 + m * 16) * FF + col0;
                float v[8];
#pragma unroll
                for (int n = 0; n < 2; ++n)
#pragma unroll
                    for (int j = 0; j < 4; ++j) {
                        const float e = fast_exp2(acc[ai][0][m][n][j] * (-isw * 1.44269504f)); v[n * 4 + j] = acc[ai][0][m][n][j] * acc[ai][1][m][n][j] * fast_rcp(e * kd + kd); }
                u32x2 o; o[0] = pack4_f8(v[0], v[1], v[2], v[3]); o[1] = pack4_f8(v[4], v[5], v[6], v[7]);
                *(u32x2*)rowp = o; }
        return;
#endif
#pragma unroll
        for (int ai = 0; ai < 2; ++ai)
#pragma unroll
            for (int m = 0; m < 4; ++m) { bf16_t* rowp = h + (size_t)(row0 + ai * 128 + m * 16) * FF + col0;
                float v[8];
#pragma unroll
                for (int n = 0; n < 2; ++n)
#pragma unroll
                    for (int j = 0; j < 4; ++j) { const float gt = acc[ai][0][m][n][j], up = acc[ai][1][m][n][j]; v[n * 4 + j] = gt * fast_rcp(1.0f + fast_exp(-gt)) * up; }
                u32x4 o; o[0] = pack2(v[0], v[1]); o[1] = pack2(v[2], v[3]); o[2] = pack2(v[4], v[5]); o[3] = pack2(v[6], v[7]);
                *(u32x4*)rowp = o; }
    }
};
template <bool F8OUT>
struct EpiDown {
    static constexpr bool PERM = true;
    bf16_t* y; float sc;
    DEV void operator()(const f32x4 (&acc)[2][2][4][2], const Unit& u, int wr, int wc, int fr, int fq) const {
        const int row0 = u.pm * 256 + wr * 64 + fr; const int col0 = u.pn * 256 + wc * 32 + 8 * fq;
#pragma unroll
        for (int ai = 0; ai < 2; ++ai)
#pragma unroll
            for (int m = 0; m < 4; ++m) {
#pragma unroll
                for (int bj = 0; bj < 2; ++bj) {
                    const f32x4 v0 = acc[ai][bj][m][0] * sc, v1 = acc[ai][bj][m][1] * sc;
#if MOE_F8
                    if constexpr (F8OUT) { unsigned char* rowp = (unsigned char*)y + (size_t)(row0 + ai * 128 + m * 16) * D_ + col0;
                        u32x2 o; o[0] = pack4_f8(v0[0], v0[1], v0[2], v0[3]); o[1] = pack4_f8(v1[0], v1[1], v1[2], v1[3]);
                        *(u32x2*)(rowp + bj * 128) = o; }
                    else
#endif
                    { bf16_t* rowp = y + (size_t)(row0 + ai * 128 + m * 16) * D_ + col0;
                        u32x4 o; o[0] = pack2(v0[0], v0[1]); o[1] = pack2(v0[2], v0[3]); o[2] = pack2(v1[0], v1[1]); o[3] = pack2(v1[2], v1[3]);
                        *(u32x4*)(rowp + bj * 128) = o; } } }
    }
};

DEV void phase_mods(const Params& p, LAS unsigned char* lds) {
    LAS float* sc = (LAS float*)lds;
    const int tid = opaque_tid(), col = tid & 63, ks = tid >> 6;
    float* mods = (float*)(p.ws + WS_MODS);
    constexpr int NB = B_ + 1;
    for (int u = blockIdx.x; u < DEPTH_ * 96; u += gridDim.x) {
        const int l = u / 96, cb = (u % 96) * 64;
        __syncthreads();
        for (int i = tid; i < NB * 1024; i += 512) { const int bb = i >> 10, k = i & 1023; const float cv = bb < B_ ? p.in[1][(size_t)bb * 1024 + k] : p.in[3][k]; sc[i] = siluf(cv); }
        __syncthreads();
        float acc[NB];
#pragma unroll
        for (int bb = 0; bb < NB; ++bb) acc[bb] = 0.f;
        const float* w = p.in[4] + (size_t)l * 1024 * 6144 + cb + col;
        for (int k = ks * 128; k < ks * 128 + 128; ++k) { const float wv = w[(size_t)k * 6144];
#pragma unroll
            for (int bb = 0; bb < NB; ++bb) acc[bb] += sc[bb * 1024 + k] * wv; }
        __syncthreads();
#pragma unroll
        for (int bb = 0; bb < NB; ++bb) sc[(ks * NB + bb) * 64 + col] = acc[bb];
        __syncthreads();
        for (int i = tid; i < NB * 64; i += 512) { const int bb = i >> 6, c2 = i & 63; float s = p.in[5][(size_t)l * 6144 + cb + c2];
            for (int q = 0; q < 8; ++q) s += sc[(q * NB + bb) * 64 + c2];
            mods[((size_t)l * NB + bb) * 6144 + cb + c2] = s; }
    }
    if (blockIdx.x == gridDim.x - 1) {
        float* rope = (float*)(p.ws + WS_ROPE);
        for (int i = tid; i < 64 * 16; i += 512) { const int pos = i >> 4, f = i & 15; const float inv = powf(10000.0f, -(float)f / 16.0f); const float a = (float)pos * inv; rope[i * 2] = cosf(a); rope[i * 2 + 1] = sinf(a); }
        for (int i = tid; i < 64 * 8; i += 512) { const int pos = i >> 3, f = i & 7; const float inv = powf(10000.0f, -(float)f / 8.0f); const float a = (float)pos * inv; rope[2048 + i * 2] = cosf(a); rope[2048 + i * 2 + 1] = sinf(a); }
    }
}

DEV int win_srccol(int n) {
    if (n < 1024) return n; if (n < 1792) return n + 16; if (n < 3328) return n + 48;
    if (n < 3344) return 1024 + (n - 3328); if (n < 3376) return 1808 + (n - 3344); return -1;
}
template <bool WIN>
DEV void conv_tile(const float* src, int ldn, int srcc0, bf16_t* dst, int ldk, int n0, int k0, LAS float* tile) {
    const int tid = opaque_tid(), nn = tid & 63, kk = tid >> 6;
    int sc_ = WIN ? win_srccol(n0 + nn) : srcc0 + nn;
#pragma unroll
    for (int i = 0; i < 8; ++i) { const int k = kk + 8 * i; tile[k * 65 + nn] = sc_ >= 0 ? src[(size_t)(k0 + k) * ldn + sc_] : 0.f; }
    __syncthreads();
    { const int n = tid >> 3, k8 = (tid & 7) * 8; float v[8];
#pragma unroll
      for (int j = 0; j < 8; ++j) v[j] = tile[(k8 + j) * 65 + n];
      u32x4 o; o[0] = pack2(v[0], v[1]); o[1] = pack2(v[2], v[3]); o[2] = pack2(v[4], v[5]); o[3] = pack2(v[6], v[7]);
      *(u32x4*)(dst + (size_t)(n0 + n) * ldk + k0 + k8) = o; }
    __syncthreads();
}
#if MOE_F8
constexpr float F8_SW1_ = F8_SW1, F8_SW2_ = F8_SW2;
#else
constexpr float F8_SW1_ = 0.f, F8_SW2_ = 0.f;
#endif
struct ConvTile { const float* s0; const float* s1; int ld; bf16_t* dst; int ldk; int n0, k0; int kind; };
DEV ConvTile conv_desc(const Params& p, int l, int t) {
    ConvTile c;
    bf16_t* btin = (bf16_t*)(p.ws + WS_BTIN); bf16_t* btout = (bf16_t*)(p.ws + WS_BTOUT); bf16_t* btgu = (bf16_t*)(p.ws + WS_BTGU); bf16_t* btdn = (bf16_t*)(p.ws + WS_BTDN);
    const float* w_in = p.in[6] + (size_t)l * D_ * PROJ_W0; const float* w_out = p.in[14] + (size_t)l * D_ * D_;
    const float* w_gate = p.in[18] + (size_t)l * NE * D_ * FF; const float* w_up = p.in[19] + (size_t)l * NE * D_ * FF; const float* w_down = p.in[20] + (size_t)l * NE * FF * D_;
    constexpr int T_IN = 13 * 16, T_OUT = 4 * 16, T_GU = NE * 16 * 16;
    if (t < T_IN) { const int nb = t / 16, kt = t % 16; const int sc = win_srccol(nb * 256);
        c.kind = 0; c.s0 = w_in + sc; c.s1 = w_in + sc + 128; c.ld = PROJ_W0; c.dst = btin; c.ldk = D_; c.n0 = nb * 256; c.k0 = kt * 64; }
    else if (t < T_IN + T_OUT) { const int q = t - T_IN, nb = q / 16, kt = q % 16;
        c.kind = 0; c.s0 = w_out + nb * 256; c.s1 = c.s0 + 128; c.ld = D_; c.dst = btout; c.ldk = D_; c.n0 = nb * 256; c.k0 = kt * 64; }
    else if (t < T_IN + T_OUT + T_GU) { const int q = t - T_IN - T_OUT, e = q / 256, r = q % 256, nb = r / 16, kt = r % 16;
        c.kind = MOE_F8 ? 1 : 0; c.s0 = w_gate + (size_t)e * D_ * FF + nb * 128; c.s1 = w_up + (size_t)e * D_ * FF + nb * 128; c.ld = FF; c.dst = btgu + (size_t)e * 2 * FF * D_ / (MOE_F8 ? 2 : 1); c.ldk = D_; c.n0 = nb * 256; c.k0 = kt * 64; }
    else { const int q = t - T_IN - T_OUT - T_GU, e = q / 128, r = q % 128, nb = r / 32, kt = r % 32;
        c.kind = MOE_F8 ? 2 : 0; c.s0 = w_down + (size_t)e * FF * D_ + nb * 256; c.s1 = c.s0 + 128; c.ld = D_; c.dst = btdn + (size_t)e * D_ * FF / (MOE_F8 ? 2 : 1); c.ldk = FF; c.n0 = nb * 256; c.k0 = kt * 64; }
    return c;
}
DEV void conv_issue(const ConvTile& c, f32x4 (&r)[8], int tid) {
    const int nn4 = (tid & 63) * 4; const float* src = (nn4 < 128 ? c.s0 + nn4 : c.s1 + (nn4 - 128)) + (size_t)(c.k0 + (tid >> 6)) * c.ld;
#pragma unroll
    for (int i = 0; i < 8; ++i) r[i] = *(const f32x4*)(src + (size_t)(8 * i) * c.ld);
}
DEV void conv_finish(const ConvTile& c, const f32x4 (&r)[8], LAS float* tile, int tid) {
    const int nn4 = (tid & 63) * 4, kk = tid >> 6;
#pragma unroll
    for (int i = 0; i < 8; ++i) { LAS float* d = tile + (kk + 8 * i) * 257 + nn4; d[0] = r[i][0]; d[1] = r[i][1]; d[2] = r[i][2]; d[3] = r[i][3]; }
    __syncthreads();
#if MOE_F8
    if (c.kind != 0) { const int n = tid >> 1, kh = (tid & 1) * 32; unsigned char* drow = (unsigned char*)c.dst + (size_t)(c.n0 + n) * c.ldk + c.k0 + kh;
#pragma unroll
      for (int q = 0; q < 2; ++q) { float v[16];
          if (c.kind == 1) {
#pragma unroll
              for (int j = 0; j < 16; ++j) v[j] = tile[(kh + 16 * q + j) * 257 + n] * F8_SW1; }
          else {
#pragma unroll
              for (int j = 0; j < 16; ++j) v[j] = tile[(kh + 16 * q + j) * 257 + n] * F8_SW2; }
          u32x4 o; o[0] = pack4_f8(v[0], v[1], v[2], v[3]); o[1] = pack4_f8(v[4], v[5], v[6], v[7]); o[2] = pack4_f8(v[8], v[9], v[10], v[11]); o[3] = pack4_f8(v[12], v[13], v[14], v[15]);
          *(u32x4*)(drow + 16 * q) = o; } }
    else
#endif
    { const int n = tid >> 1, kh = (tid & 1) * 32; bf16_t* drow = c.dst + (size_t)(c.n0 + n) * c.ldk + c.k0 + kh;
#pragma unroll
      for (int q = 0; q < 4; ++q) { float v[8];
#pragma unroll
          for (int j = 0; j < 8; ++j) v[j] = tile[(kh + 8 * q + j) * 257 + n];
          u32x4 o; o[0] = pack2(v[0], v[1]); o[1] = pack2(v[2], v[3]); o[2] = pack2(v[4], v[5]); o[3] = pack2(v[6], v[7]);
          *(u32x4*)(drow + 8 * q) = o; } }
    __syncthreads();
}
DEV void phase_convert(const Params& p, int l, LAS unsigned char* lds) {
    LAS float* tile = (LAS float*)lds;
    const int tid = opaque_tid();
    constexpr int T_MAIN = 13 * 16 + 4 * 16 + NE * 16 * 16 + NE * 4 * 32;
    {
        f32x4 ra[8], rb[8];
        int t = blockIdx.x;
        ConvTile ca, cb;
        if (t < T_MAIN) { ca = conv_desc(p, l, t); conv_issue(ca, ra, tid); }
        while (t < T_MAIN) {
            const int t1 = t + gridDim.x;
            if (t1 < T_MAIN) { cb = conv_desc(p, l, t1); conv_issue(cb, rb, tid); }
            conv_finish(ca, ra, tile, tid);
            const int t2 = t1 + gridDim.x;
            if (t1 < T_MAIN) { if (t2 < T_MAIN) { ca = conv_desc(p, l, t2); conv_issue(ca, ra, tid); } conv_finish(cb, rb, tile, tid); }
            t = t2;
        }
    }
    { bf16_t* btin = (bf16_t*)(p.ws + WS_BTIN); const float* w_in = p.in[6] + (size_t)l * D_ * PROJ_W0;
      for (int t = blockIdx.x; t < 4 * 16; t += gridDim.x) conv_tile<true>(w_in, PROJ_W0, 0, btin, D_, PROJ_N + (t / 16) * 64, (t % 16) * 64, tile); }
    if (blockIdx.x == 0) { float* bias = (float*)(p.ws + WS_BIAS); const float* b_in = p.in[7] + (size_t)l * PROJ_W0;
        for (int i = tid; i < PROJ_NP; i += 512) { const int s = win_srccol(i); bias[i] = s >= 0 ? b_in[s] : 0.f; } }
    if (l == 0) {
        const float* mods = (const float*)(p.ws + WS_MODS); bf16_t* ub = (bf16_t*)(p.ws + WS_U);
        const int lane = tid & 63, gw = blockIdx.x * 8 + (tid >> 6), nw = gridDim.x * 8;
        for (int row = gw; row < NTOK; row += nw) {
            const bool isl = row < NL; const int bb = isl ? row / T_ : B_;
            const float* xr = isl ? p.in[0] + (size_t)row * D_ : p.in[2] + (size_t)(row - NL) * D_;
            const float* md = mods + (size_t)bb * 6144;
#pragma unroll
            for (int i = 0; i < 2; ++i) { const int c = lane * 8 + i * 512;
                const f32x4 x0 = *(const f32x4*)(xr + c), x1 = *(const f32x4*)(xr + c + 4), s0 = *(const f32x4*)(md + 1024 + c), s1 = *(const f32x4*)(md + 1024 + c + 4), h0 = *(const f32x4*)(md + c), h1 = *(const f32x4*)(md + c + 4);
                const f32x4 a = x0 * (s0 + 1.0f) + h0, b = x1 * (s1 + 1.0f) + h1;
                u32x4 o; o[0] = pack2(a[0], a[1]); o[1] = pack2(a[2], a[3]); o[2] = pack2(b[0], b[1]); o[3] = pack2(b[2], b[3]);
                *(u32x4*)(ub + (size_t)row * D_ + c) = o; }
        }
    }
}

DEV int tok_row(bool lat, int b, int pos) { return lat ? b * T_ + pos : NL + b * TC_ + pos; }
DEV bf16x8 lds_frag(const LAS bf16_t* base, int row, int stride, int col) { return *(const LAS bf16x8*)(base + row * stride + col); }

#ifdef HOST_EMU
#define WAVE_SYNC() do { int z_ = 0; (void)emu::wave_all(&z_, 4); } while (0)
#else
#define WAVE_SYNC() __builtin_amdgcn_wave_barrier()
#endif
#ifdef HOST_EMU
DEV void wg_release_acquire() { __syncthreads(); }
#else
DEV void wg_release_acquire() {
    __builtin_amdgcn_fence(__ATOMIC_RELEASE, "workgroup"); asm volatile("s_waitcnt vmcnt(0)" ::: "memory"); __syncthreads();
    __builtin_amdgcn_fence(__ATOMIC_ACQUIRE, "agent"); asm volatile("s_waitcnt vmcnt(0)" ::: "memory"); }
#endif
DEV void merge_head(const Params& p, int l, int b, int part, int h, int tid) {
    const bool need_ctx = l < DEPTH_ - 1;
    const bf16_t* proj = (const bf16_t*)(p.ws + WS_R1 + R1_PROJ); bf16_t* ymix = (bf16_t*)(p.ws + WS_YMIX);
    const bf16_t* o0 = (const bf16_t*)(p.ws + WS_R1 + (part ? R1_OG : R1_OM)); const bf16_t* o1 = o0 + (size_t)NTOK * 256;
    const int ch = h * 64 + (tid & 7) * 8;
    const float* gn = (part ? p.in[12] : p.in[11]) + (size_t)l * 256 + ch;
    const f32x4 g0 = *(const f32x4*)gn, g1 = *(const f32x4*)(gn + 4);
    const int ntk = T_ + (need_ctx ? TC_ : 0);
    for (int i0 = tid >> 3; i0 < ntk; i0 += 256) {
        int rows[4]; u32x4 oa[4], ob[4]; u32x4 gtv[4];
#pragma unroll
        for (int k = 0; k < 4; ++k) { const int i = i0 + 64 * k; const int row = i < T_ ? b * T_ + i : NL + b * TC_ + (i - T_); rows[k] = row;
            oa[k] = *(const u32x4*)(o0 + (size_t)row * 256 + ch); ob[k] = *(const u32x4*)(o1 + (size_t)row * 256 + ch);
            gtv[k] = *(const u32x4*)(proj + (size_t)row * PROJ_N + (part ? C_GR : C_MO) + ch); }
#pragma unroll
        for (int k = 0; k < 4; ++k) {
            const f32x4 x0 = (f32x4){bflo(oa[k][0]) + bflo(ob[k][0]), bfhi(oa[k][0]) + bfhi(ob[k][0]), bflo(oa[k][1]) + bflo(ob[k][1]), bfhi(oa[k][1]) + bfhi(ob[k][1])};
            const f32x4 x1 = (f32x4){bflo(oa[k][2]) + bflo(ob[k][2]), bfhi(oa[k][2]) + bfhi(ob[k][2]), bflo(oa[k][3]) + bflo(ob[k][3]), bfhi(oa[k][3]) + bfhi(ob[k][3])};
            float s = x0[0] + x0[1] + x0[2] + x0[3] + x1[0] + x1[1] + x1[2] + x1[3];
            s += shfl_xor_f(s, 1); s += shfl_xor_f(s, 2); s += shfl_xor_f(s, 4);
            const float mu = s * (1.0f / 64.0f);
            const f32x4 d0 = x0 - mu, d1 = x1 - mu;
            float q = d0[0] * d0[0] + d0[1] * d0[1] + d0[2] * d0[2] + d0[3] * d0[3] + d1[0] * d1[0] + d1[1] * d1[1] + d1[2] * d1[2] + d1[3] * d1[3];
            q += shfl_xor_f(q, 1); q += shfl_xor_f(q, 2); q += shfl_xor_f(q, 4);
            const float rstd = 1.0f / sqrtf(q * (1.0f / 64.0f) + LN_EPS);
            float gv[8];
#pragma unroll
            for (int j = 0; j < 4; ++j) { gv[2 * j] = bflo(gtv[k][j]); gv[2 * j + 1] = bfhi(gtv[k][j]); }
            float y[8];
#pragma unroll
            for (int j = 0; j < 8; ++j) { const float nv = (j < 4 ? d0[j] : d1[j - 4]) * rstd * (j < 4 ? g0[j] : g1[j - 4]); y[j] = nv * (part ? silu_fast(gv[j]) : sigmoid_fast(gv[j])); }
            u32x4 ov; ov[0] = pack2(y[0], y[1]); ov[1] = pack2(y[2], y[3]); ov[2] = pack2(y[4], y[5]); ov[3] = pack2(y[6], y[7]);
            *(u32x4*)(ymix + (size_t)rows[k] * D_ + part * 256 + ch) = ov;
        }
    }
}

struct MlItem { u32x2 q1[3], q2[3], k1[3], k2[3]; };
struct MlChunk { u32x2 q[2][2], k[2][2]; u32x4 v[2]; float gtv, g_pt, cm63; };
DEV void mlstm_unit(const Params& p, int l, int b, int h, LAS unsigned char* lds) {
    constexpr int ST = 72;
    constexpr int DSZ = 4 * 64 * ST * 2 + 2 * 80 * ST * 2 + 3 * 64 * 4 + 3 * 128 * 4;
    static_assert(2 * DSZ <= LDS_BYTES - 32, "mlstm lds");
    const int tid = opaque_tid(), lane = tid & 63, w = tid >> 6, dir = w >> 2, wh = w & 3, t4 = tid & 255, fr = lane & 15, fq = lane >> 4;
    LAS unsigned char* db = lds + dir * DSZ;
    LAS bf16_t* Qs = (LAS bf16_t*)db;
    LAS bf16_t* Ks = Qs + 64 * ST;
    LAS bf16_t* KT = Ks + 64 * ST;
    LAS bf16_t* Ps = KT + 64 * ST;
    LAS bf16_t* VT = Ps + 64 * ST;
    LAS bf16_t* Cs = VT + 80 * ST;
    LAS float* gt = (LAS float*)(Cs + 80 * ST);
    LAS float* cw = gt + 3 * 64;
    const bf16_t* proj = (const bf16_t*)(p.ws + WS_R1 + R1_PROJ); const float* gates = (const float*)(p.ws + WS_R1 + R1_GATES);
    bf16_t* qk2 = (bf16_t*)(p.ws + WS_R1 + R1_QK2);
    bf16_t* om = (bf16_t*)(p.ws + WS_R1 + R1_OM) + (size_t)dir * NTOK * 256;
    float* gbuf = (float*)(p.ws + WS_GSCAN) + (size_t)((b * 4 + h) * 2 + dir) * NCH * 192;
    const float* ropeM = (const float*)(p.ws + WS_ROPE);
    __syncthreads();
    for (int i = t4; i < 3 * 128; i += 256) { const int j = i / 128, c = i % 128; cw[i] = p.in[8][((size_t)l * 3 + j) * 512 + (c < 64 ? h * 64 + c : 256 + h * 64 + (c - 64))]; }
    for (int i = t4; i < 80 * ST; i += 256) Cs[i] = 0;
    for (int i = t4; i < 16 * ST; i += 256) VT[64 * ST + i] = (bf16_t)0x3F80;
    for (int c0 = wh; c0 < NCH; c0 += 12) {
        float ig[3], fg[3];
#pragma unroll
        for (int k = 0; k < 3; ++k) { const int c = c0 + 4 * k; ig[k] = fg[k] = 0.f;
            if (c < NCH) { const bool lat = c >= NCH_C; const int cc = lat ? c - NCH_C : c; const int Ts = lat ? T_ : TC_;
                const int sp = dir == 0 ? cc * 64 + lane : Ts - 1 - (cc * 64 + lane);
                const float* gr = gates + (size_t)tok_row(lat, b, sp) * NG + dir * 8 + h; ig[k] = gr[0]; fg[k] = gr[4]; } }
#pragma unroll
        for (int k = 0; k < 3; ++k) { const int c = c0 + 4 * k;
            if (c < NCH) {
                float bs = logsigf(fg[k]);
                for (int d = 1; d < 64; d <<= 1) { const float o = shfl_up_f(bs, d); if (lane >= d) bs += o; }
                const float g = ig[k] - bs;
                float cm = g;
                for (int d = 1; d < 64; d <<= 1) { const float o = shfl_up_f(cm, d); if (lane >= d) cm = fmaxf(cm, o); }
                gbuf[c * 192 + lane] = bs; gbuf[c * 192 + 64 + lane] = g; gbuf[c * 192 + 128 + lane] = cm; } }
    }
    __syncthreads();
    {
        constexpr int NIT = (TC_ + T_) * 8;
        auto item_load = [&](int it, MlItem& R) {
            const int tk = it >> 3, pg = it & 7; const bool lat = tk >= TC_; const int sp = lat ? tk - TC_ : tk, Ts = lat ? T_ : TC_;
            const int hf = pg >> 2, i0 = 4 * (pg & 3), dA = 32 * hf + i0, dB = dA + 16;
#pragma unroll
            for (int tap = 0; tap < 3; ++tap) { const int sp2 = sp + tap - 1; const bool ok = sp2 >= 0 && sp2 < Ts; const int spc = ok ? sp2 : sp;
                const bf16_t* pr = proj + (size_t)tok_row(lat, b, spc) * PROJ_N + h * 64;
                const u32x2 z = (u32x2){0u, 0u};
                const u32x2 a = *(const u32x2*)(pr + C_MQ + dA), bq = *(const u32x2*)(pr + C_MQ + dB), c = *(const u32x2*)(pr + C_MK + dA), d = *(const u32x2*)(pr + C_MK + dB);
                R.q1[tap] = ok ? a : z; R.q2[tap] = ok ? bq : z; R.k1[tap] = ok ? c : z; R.k2[tap] = ok ? d : z; } };
        auto item_finish = [&](int it, const MlItem& R) {
            const int tk = it >> 3, pg = it & 7; const bool lat = tk >= TC_; const int sp = lat ? tk - TC_ : tk;
            const int hf = pg >> 2, i0 = 4 * (pg & 3), dA = 32 * hf + i0, dB = dA + 16;
            float qa[4], qb[4], ka[4], kb[4];
#pragma unroll
            for (int j = 0; j < 4; ++j) { qa[j] = qb[j] = ka[j] = kb[j] = 0.f; }
#pragma unroll
            for (int tap = 0; tap < 3; ++tap) { const LAS float* wq = cw + tap * 128;
                qa[0] += wq[dA] * bflo(R.q1[tap][0]); qa[1] += wq[dA + 1] * bfhi(R.q1[tap][0]); qa[2] += wq[dA + 2] * bflo(R.q1[tap][1]); qa[3] += wq[dA + 3] * bfhi(R.q1[tap][1]);
                qb[0] += wq[dB] * bflo(R.q2[tap][0]); qb[1] += wq[dB + 1] * bfhi(R.q2[tap][0]); qb[2] += wq[dB + 2] * bflo(R.q2[tap][1]); qb[3] += wq[dB + 3] * bfhi(R.q2[tap][1]);
                ka[0] += wq[64 + dA] * bflo(R.k1[tap][0]); ka[1] += wq[64 + dA + 1] * bfhi(R.k1[tap][0]); ka[2] += wq[64 + dA + 2] * bflo(R.k1[tap][1]); ka[3] += wq[64 + dA + 3] * bfhi(R.k1[tap][1]);
                kb[0] += wq[64 + dB] * bflo(R.k2[tap][0]); kb[1] += wq[64 + dB + 1] * bfhi(R.k2[tap][0]); kb[2] += wq[64 + dB + 2] * bflo(R.k2[tap][1]); kb[3] += wq[64 + dB + 3] * bfhi(R.k2[tap][1]); }
#pragma unroll
            for (int j = 0; j < 4; ++j) { qa[j] = silu_fast(qa[j]); qb[j] = silu_fast(qb[j]); ka[j] = silu_fast(ka[j]) * 0.125f; kb[j] = silu_fast(kb[j]) * 0.125f; }
            if (lat) { const int pos = hf == 0 ? (sp >> 6) : (sp & 63);
#pragma unroll
                for (int j = 0; j < 4; ++j) { const float cs = ropeM[(pos * 16 + i0 + j) * 2], sn = ropeM[(pos * 16 + i0 + j) * 2 + 1];
                    const float q1 = qa[j] * cs - qb[j] * sn, q2 = qa[j] * sn + qb[j] * cs; qa[j] = q1; qb[j] = q2;
                    const float k1 = ka[j] * cs - kb[j] * sn, k2 = ka[j] * sn + kb[j] * cs; ka[j] = k1; kb[j] = k2; } }
            bf16_t* dst = qk2 + (size_t)tok_row(lat, b, sp) * 512 + h * 128;
            u32x2 o;
            o[0] = pack2(qa[0], qa[1]); o[1] = pack2(qa[2], qa[3]); *(u32x2*)(dst + dA) = o;
            o[0] = pack2(qb[0], qb[1]); o[1] = pack2(qb[2], qb[3]); *(u32x2*)(dst + dB) = o;
            o[0] = pack2(ka[0], ka[1]); o[1] = pack2(ka[2], ka[3]); *(u32x2*)(dst + 64 + dA) = o;
            o[0] = pack2(kb[0], kb[1]); o[1] = pack2(kb[2], kb[3]); *(u32x2*)(dst + 64 + dB) = o; };
        for (int it0 = tid; it0 < NIT; it0 += 1024) {
            MlItem A, B; const bool two = it0 + 512 < NIT;
            item_load(it0, A); if (two) item_load(it0 + 512, B);
            item_finish(it0, A); if (two) item_finish(it0 + 512, B);
        }
    }
    wg_release_acquire();
    f32x4 cacc[5];
#pragma unroll
    for (int i = 0; i < 5; ++i) cacc[i] = (f32x4){0.f, 0.f, 0.f, 0.f};
    const int ti = wh;
    const int pt = t4 >> 2, pgq = t4 & 3;
    float m_in = 0.f;
    auto chunk_load = [&](int c, MlChunk& R) {
        const bool lat = c >= NCH_C; const int cc = lat ? c - NCH_C : c; const int Ts = lat ? T_ : TC_;
        const int sp = dir == 0 ? cc * 64 + pt : Ts - 1 - (cc * 64 + pt);
        const size_t row = (size_t)tok_row(lat, b, sp);
#pragma unroll
        for (int sub = 0; sub < 2; ++sub) { const int pg = pgq * 2 + sub; const int hf = pg >> 2, i0 = 4 * (pg & 3), dA = 32 * hf + i0, dB = dA + 16;
            const bf16_t* src = qk2 + row * 512 + h * 128;
            R.q[sub][0] = *(const u32x2*)(src + dA); R.q[sub][1] = *(const u32x2*)(src + dB); R.k[sub][0] = *(const u32x2*)(src + 64 + dA); R.k[sub][1] = *(const u32x2*)(src + 64 + dB);
            R.v[sub] = *(const u32x4*)(proj + row * PROJ_N + C_MV + h * 64 + pg * 8); }
        R.gtv = gbuf[c * 192 + (t4 < 192 ? t4 : 0)]; R.g_pt = gbuf[c * 192 + 64 + pt]; R.cm63 = gbuf[c * 192 + 128 + 63]; };
    MlChunk cur, nxt;
    chunk_load(0, cur); nxt = cur;
    for (int c = 0; c < NCH; ++c) {
        const bool lat = c >= NCH_C; const int cc = lat ? c - NCH_C : c; const int Ts = lat ? T_ : TC_;
        {
            if (t4 < 192) gt[t4] = cur.gtv;
            const float wsc = fast_exp(cur.g_pt - fmaxf(m_in, cur.cm63));
#pragma unroll
            for (int sub = 0; sub < 2; ++sub) { const int pg = pgq * 2 + sub; const int hf = pg >> 2, i0 = 4 * (pg & 3), dA = 32 * hf + i0, dB = dA + 16;
                *(LAS u32x2*)(Qs + pt * ST + dA) = cur.q[sub][0]; *(LAS u32x2*)(Qs + pt * ST + dB) = cur.q[sub][1];
                *(LAS u32x2*)(Ks + pt * ST + dA) = cur.k[sub][0]; *(LAS u32x2*)(Ks + pt * ST + dB) = cur.k[sub][1];
                const float ka[4] = {bflo(cur.k[sub][0][0]), bfhi(cur.k[sub][0][0]), bflo(cur.k[sub][0][1]), bfhi(cur.k[sub][0][1])};
                const float kb[4] = {bflo(cur.k[sub][1][0]), bfhi(cur.k[sub][1][0]), bflo(cur.k[sub][1][1]), bfhi(cur.k[sub][1][1])};
#pragma unroll
                for (int j = 0; j < 4; ++j) { KT[(dA + j) * ST + pt] = f2bf(ka[j] * wsc); KT[(dB + j) * ST + pt] = f2bf(kb[j] * wsc); }
                const u32x4 vv = cur.v[sub];
#pragma unroll
                for (int j = 0; j < 4; ++j) { VT[(pg * 8 + 2 * j) * ST + pt] = (bf16_t)(vv[j] & 0xFFFFu); VT[(pg * 8 + 2 * j + 1) * ST + pt] = (bf16_t)(vv[j] >> 16); } }
        }
        LDS_BARRIER();
        if (c + 1 < NCH) chunk_load(c + 1, nxt);
        const float M63 = fmaxf(m_in, gt[128 + 63]);
        float Mt[4];
#pragma unroll
        for (int r = 0; r < 4; ++r) Mt[r] = fmaxf(m_in, gt[128 + 16 * ti + 4 * fq + r]);
        {
            const bf16x8 a0 = lds_frag(Qs, 16 * ti + fr, ST, 8 * fq), a1 = lds_frag(Qs, 16 * ti + fr, ST, 32 + 8 * fq);
#pragma unroll
            for (int tj = 0; tj < 4; ++tj) {
                f32x4 s = (f32x4){0.f, 0.f, 0.f, 0.f};
                s = mfma16(a0, lds_frag(Ks, 16 * tj + fr, ST, 8 * fq), s);
                s = mfma16(a1, lds_frag(Ks, 16 * tj + fr, ST, 32 + 8 * fq), s);
                const int sc_ = 16 * tj + fr; const float gs = gt[64 + sc_];
#pragma unroll
                for (int r = 0; r < 4; ++r) { const int t = 16 * ti + 4 * fq + r;
                    const float pv = sc_ <= t ? s[r] * fast_exp(gs - Mt[r]) : 0.f; Ps[t * ST + sc_] = f2bf(pv); } }
            const float decay = fast_exp(m_in - M63);
            const bf16x8 v0 = lds_frag(VT, 16 * ti + fr, ST, 8 * fq), v1 = lds_frag(VT, 16 * ti + fr, ST, 32 + 8 * fq);
#pragma unroll
            for (int dj = 0; dj < 4; ++dj) { cacc[dj] = cacc[dj] * decay;
                cacc[dj] = mfma16(v0, lds_frag(KT, 16 * dj + fr, ST, 8 * fq), cacc[dj]);
                cacc[dj] = mfma16(v1, lds_frag(KT, 16 * dj + fr, ST, 32 + 8 * fq), cacc[dj]); }
            cacc[4] = cacc[4] * decay;
            cacc[4] = mfma16(lds_frag(VT, 64 + fr, ST, 8 * fq), lds_frag(KT, 16 * wh + fr, ST, 8 * fq), cacc[4]);
            cacc[4] = mfma16(lds_frag(VT, 64 + fr, ST, 32 + 8 * fq), lds_frag(KT, 16 * wh + fr, ST, 32 + 8 * fq), cacc[4]);
        }
        WAVE_SYNC();
        {
            const bf16x8 p0 = lds_frag(Ps, 16 * ti + fr, ST, 8 * fq), p1 = lds_frag(Ps, 16 * ti + fr, ST, 32 + 8 * fq);
            const bf16x8 q0 = lds_frag(Qs, 16 * ti + fr, ST, 8 * fq), q1 = lds_frag(Qs, 16 * ti + fr, ST, 32 + 8 * fq);
            f32x4 np_[5];
            float ev[4];
#pragma unroll
            for (int r = 0; r < 4; ++r) ev[r] = fast_exp(m_in - Mt[r]);
#pragma unroll
            for (int tj = 0; tj < 5; ++tj) { f32x4 nc = (f32x4){0.f, 0.f, 0.f, 0.f}; np_[tj] = (f32x4){0.f, 0.f, 0.f, 0.f};
                np_[tj] = mfma16(p0, lds_frag(VT, 16 * tj + fr, ST, 8 * fq), np_[tj]);
                np_[tj] = mfma16(p1, lds_frag(VT, 16 * tj + fr, ST, 32 + 8 * fq), np_[tj]);
                nc = mfma16(q0, lds_frag(Cs, 16 * tj + fr, ST, 8 * fq), nc);
                nc = mfma16(q1, lds_frag(Cs, 16 * tj + fr, ST, 32 + 8 * fq), nc);
#pragma unroll
                for (int r = 0; r < 4; ++r) np_[tj][r] += ev[r] * nc[r]; }
#pragma unroll
            for (int r = 0; r < 4; ++r) { const int t = 16 * ti + 4 * fq + r;
                const float dn = fmaxf(fabsf(np_[4][r]), fast_exp(-gt[t] - Mt[r])); const float inv = 1.0f / dn;
                const int sp = dir == 0 ? cc * 64 + t : Ts - 1 - (cc * 64 + t);
                bf16_t* orow = om + (size_t)tok_row(lat, b, sp) * 256 + h * 64;
#pragma unroll
                for (int tj = 0; tj < 4; ++tj) orow[16 * tj + fr] = f2bf(np_[tj][r] * inv); }
        }
        m_in = gt[63] + M63;
        LDS_BARRIER();
#pragma unroll
        for (int dj = 0; dj < 4; ++dj)
#pragma unroll
            for (int r = 0; r < 4; ++r) Cs[(16 * ti + 4 * fq + r) * ST + 16 * dj + fr] = f2bf(cacc[dj][r]);
#pragma unroll
        for (int r = 0; r < 4; ++r) Cs[(64 + 4 * fq + r) * ST + 16 * wh + fr] = f2bf(cacc[4][r]);
        cur = nxt;
    }
    wg_release_acquire();
    merge_head(p, l, b, 0, h, tid);
}

template <int KS, int HALF, int DJ> struct GlaTr { static constexpr int v = ((32 * KS + 4 * HALF) * 40 + 16 * DJ) * 2; };
struct GlChunk { f32x4 lr[4]; unsigned q[2][2], k[2][2]; u32x4 v[2]; };
DEV void gla_unit(const Params& p, int l, int b, int h, LAS unsigned char* lds) {
    constexpr int ST = 72, SQ = 40;
    constexpr int DSZ = 5 * 64 * SQ * 2 + 32 * ST * 2 + 2 * 64 * ST * 2 + 64 * 33 * 4 + 544 * 4;
    static_assert(2 * DSZ <= LDS_BYTES - 32, "gla lds");
    const int tid = opaque_tid(), lane = tid & 63, w = tid >> 6, dir = w >> 2, wh = w & 3, t4 = tid & 255, fr = lane & 15, fq = lane >> 4;
    LAS unsigned char* db = lds + dir * DSZ;
    LAS bf16_t* Qs = (LAS bf16_t*)db;
    LAS bf16_t* Ks = Qs + 64 * SQ;
    LAS bf16_t* Ss = Ks + 64 * SQ;
    LAS bf16_t* Ah = Ss + 64 * SQ;
    LAS bf16_t* Al = Ah + 64 * SQ;
    LAS bf16_t* KT = Al + 64 * SQ;
    LAS bf16_t* VT = KT + 32 * ST;
    LAS bf16_t* Ps = VT + 64 * ST;
    LAS float* bc = (LAS float*)(Ps + 64 * ST);
    LAS float* w2s = bc + 64 * 33;
    const bf16_t* proj = (const bf16_t*)(p.ws + WS_R1 + R1_PROJ); const float* gates = (const float*)(p.ws + WS_R1 + R1_GATES);
    bf16_t* og = (bf16_t*)(p.ws + WS_R1 + R1_OG) + (size_t)dir * NTOK * 256;
    const float* ropeG = (const float*)(p.ws + WS_ROPE) + 2048;
    __syncthreads();
    for (int i = t4; i < 16 * 32; i += 256) { const int r = i >> 5, d = i & 31; w2s[i] = p.in[9][(((size_t)l * 2 + dir) * 16 + r) * 128 + h * 32 + d]; }
    if (t4 < 32) w2s[512 + t4] = p.in[10][((size_t)l * 2 + dir) * 128 + h * 32 + t4];
    for (int i = t4; i < 64 * SQ; i += 256) Ss[i] = 0;
    __syncthreads();
    f32x4 sacc[2];
    sacc[0] = (f32x4){0.f, 0.f, 0.f, 0.f}; sacc[1] = (f32x4){0.f, 0.f, 0.f, 0.f};
    const int ti = wh;
    const int pt = t4 >> 2, pgq = t4 & 3;
    bf16x8 lf_[2];
#pragma unroll
    for (int ks = 0; ks < 2; ++ks)
#pragma unroll
        for (int j = 0; j < 8; ++j) lf_[ks][j] = (32 * ks + 8 * fq + j <= 16 * ti + fr) ? (short)0x3F80 : (short)0;
    auto chunk_load = [&](int c, GlChunk& R) {
        const bool lat = c >= NCH_C; const int cc = lat ? c - NCH_C : c; const int Ts = lat ? T_ : TC_;
        const int sp = dir == 0 ? cc * 64 + pt : Ts - 1 - (cc * 64 + pt);
        const size_t row = (size_t)tok_row(lat, b, sp);
        const float* lr = gates + row * NG + 16 + dir * 16;
#pragma unroll
        for (int r = 0; r < 4; ++r) R.lr[r] = *(const f32x4*)(lr + 4 * r);
        const bf16_t* pr = proj + row * PROJ_N;
#pragma unroll
        for (int sub = 0; sub < 2; ++sub) { const int pg = pgq * 2 + sub; const int hf = pg >> 2, i0 = 2 * (pg & 3), dA = 16 * hf + i0, dB = dA + 8;
            R.q[sub][0] = *(const unsigned*)(pr + C_GQ + h * 32 + dA); R.q[sub][1] = *(const unsigned*)(pr + C_GQ + h * 32 + dB);
            R.k[sub][0] = *(const unsigned*)(pr + C_GK + h * 32 + dA); R.k[sub][1] = *(const unsigned*)(pr + C_GK + h * 32 + dB);
            R.v[sub] = *(const u32x4*)(pr + C_GV + h * 64 + pg * 8); } };
    GlChunk cur, nxt;
    chunk_load(0, cur); nxt = cur;
    for (int c = 0; c < NCH; ++c) {
        const bool lat = c >= NCH_C; const int cc = lat ? c - NCH_C : c; const int Ts = lat ? T_ : TC_;
        const int sp = dir == 0 ? cc * 64 + pt : Ts - 1 - (cc * 64 + pt);
        { float lrv[16];
#pragma unroll
          for (int r = 0; r < 16; r += 4) { lrv[r] = cur.lr[r >> 2][0]; lrv[r + 1] = cur.lr[r >> 2][1]; lrv[r + 2] = cur.lr[r >> 2][2]; lrv[r + 3] = cur.lr[r >> 2][3]; }
          float av[8];
#pragma unroll
          for (int j = 0; j < 8; ++j) { const int d = pgq * 8 + j; float z = w2s[512 + d];
#pragma unroll
              for (int r = 0; r < 16; ++r) z += lrv[r] * w2s[r * 32 + d];
              av[j] = logsig_fast(z) * (1.0f / 16.0f); }
          u32x4 hi, lo;
#pragma unroll
          for (int j = 0; j < 4; ++j) { const bf16_t h0 = f2bf(av[2 * j]), h1 = f2bf(av[2 * j + 1]);
              hi[j] = (unsigned)h0 | ((unsigned)h1 << 16); lo[j] = (unsigned)f2bf(av[2 * j] - bf2f(h0)) | ((unsigned)f2bf(av[2 * j + 1] - bf2f(h1)) << 16); }
          *(LAS u32x4*)(Ah + pt * SQ + pgq * 8) = hi; *(LAS u32x4*)(Al + pt * SQ + pgq * 8) = lo; }
        LDS_BARRIER();
        {
            const lds_addr_t ah = lds_addr(Ah + (8 * fq + (fr >> 2)) * SQ + 4 * (fr & 3)), al = lds_addr(Al + (8 * fq + (fr >> 2)) * SQ + 4 * (fr & 3));
#define GLA_CS(DJ) do { \
            const bf16x4 h00 = tr_read4<GlaTr<0, 0, DJ>::v>(ah), h01 = tr_read4<GlaTr<0, 1, DJ>::v>(ah), h10 = tr_read4<GlaTr<1, 0, DJ>::v>(ah), h11 = tr_read4<GlaTr<1, 1, DJ>::v>(ah); \
            const bf16x4 l00 = tr_read4<GlaTr<0, 0, DJ>::v>(al), l01 = tr_read4<GlaTr<0, 1, DJ>::v>(al), l10 = tr_read4<GlaTr<1, 0, DJ>::v>(al), l11 = tr_read4<GlaTr<1, 1, DJ>::v>(al); \
            LGKM_WAIT0(); \
            f32x4 acc = (f32x4){0.f, 0.f, 0.f, 0.f}; \
            acc = mfma16(lf_[0], (bf16x8){h00[0], h00[1], h00[2], h00[3], h01[0], h01[1], h01[2], h01[3]}, acc); \
            acc = mfma16(lf_[1], (bf16x8){h10[0], h10[1], h10[2], h10[3], h11[0], h11[1], h11[2], h11[3]}, acc); \
            acc = mfma16(lf_[0], (bf16x8){l00[0], l00[1], l00[2], l00[3], l01[0], l01[1], l01[2], l01[3]}, acc); \
            acc = mfma16(lf_[1], (bf16x8){l10[0], l10[1], l10[2], l10[3], l11[0], l11[1], l11[2], l11[3]}, acc); \
            _Pragma("unroll") for (int r = 0; r < 4; ++r) bc[(16 * ti + 4 * fq + r) * 33 + 16 * DJ + fr] = acc[r]; } while (0)
            GLA_CS(0); GLA_CS(1);
#undef GLA_CS
        }
        WAVE_SYNC();
#pragma unroll
        for (int sub = 0; sub < 2; ++sub) {
            const int pg = pgq * 2 + sub;
            const int hf = pg >> 2, i0 = 2 * (pg & 3), dA = 16 * hf + i0, dB = dA + 8;
            const unsigned q1 = cur.q[sub][0], q2 = cur.q[sub][1], k1 = cur.k[sub][0], k2 = cur.k[sub][1];
            const float qs_ = 0.17677669529663687f;
            float qa[2] = {bflo(q1) * qs_, bfhi(q1) * qs_}, qb[2] = {bflo(q2) * qs_, bfhi(q2) * qs_}, ka[2] = {bflo(k1), bfhi(k1)}, kb[2] = {bflo(k2), bfhi(k2)};
            if (lat) { const int pos = hf == 0 ? (sp >> 6) : (sp & 63);
#pragma unroll
                for (int j = 0; j < 2; ++j) { const float cs = ropeG[(pos * 8 + i0 + j) * 2], sn = ropeG[(pos * 8 + i0 + j) * 2 + 1];
                    const float x1 = qa[j] * cs - qb[j] * sn, x2 = qa[j] * sn + qb[j] * cs; qa[j] = x1; qb[j] = x2;
                    const float y1 = ka[j] * cs - kb[j] * sn, y2 = ka[j] * sn + kb[j] * cs; ka[j] = y1; kb[j] = y2; } }
#pragma unroll
            for (int j = 0; j < 2; ++j) { const float bA = bc[pt * 33 + dA + j], bB = bc[pt * 33 + dB + j];
                qa[j] *= fast_exp(bA); qb[j] *= fast_exp(bB); ka[j] *= fast_exp(-bA); kb[j] *= fast_exp(-bB); }
            *(LAS unsigned*)(Qs + pt * SQ + dA) = pack2(qa[0], qa[1]); *(LAS unsigned*)(Qs + pt * SQ + dB) = pack2(qb[0], qb[1]);
            *(LAS unsigned*)(Ks + pt * SQ + dA) = pack2(ka[0], ka[1]); *(LAS unsigned*)(Ks + pt * SQ + dB) = pack2(kb[0], kb[1]);
#pragma unroll
            for (int j = 0; j < 2; ++j) { KT[(dA + j) * ST + pt] = f2bf(ka[j]); KT[(dB + j) * ST + pt] = f2bf(kb[j]); }
            const u32x4 vv = cur.v[sub];
#pragma unroll
            for (int j = 0; j < 4; ++j) { VT[(pg * 8 + 2 * j) * ST + pt] = (bf16_t)(vv[j] & 0xFFFFu); VT[(pg * 8 + 2 * j + 1) * ST + pt] = (bf16_t)(vv[j] >> 16); }
        }
        LDS_BARRIER();
        if (c + 1 < NCH) chunk_load(c + 1, nxt);
        {
            const bf16x8 a0 = lds_frag(Qs, 16 * ti + fr, SQ, 8 * fq);
#pragma unroll
            for (int tj = 0; tj < 4; ++tj) {
                f32x4 s = (f32x4){0.f, 0.f, 0.f, 0.f};
                s = mfma16(a0, lds_frag(Ks, 16 * tj + fr, SQ, 8 * fq), s);
                const int sc_ = 16 * tj + fr;
#pragma unroll
                for (int r = 0; r < 4; ++r) { const int t = 16 * ti + 4 * fq + r; Ps[t * ST + sc_] = f2bf(sc_ <= t ? s[r] : 0.f); } }
        }
        WAVE_SYNC();
        {
            const bf16x8 p0 = lds_frag(Ps, 16 * ti + fr, ST, 8 * fq), p1 = lds_frag(Ps, 16 * ti + fr, ST, 32 + 8 * fq), q0 = lds_frag(Qs, 16 * ti + fr, SQ, 8 * fq);
            f32x4 o[4];
#pragma unroll
            for (int tj = 0; tj < 4; ++tj) { o[tj] = (f32x4){0.f, 0.f, 0.f, 0.f};
                o[tj] = mfma16(p0, lds_frag(VT, 16 * tj + fr, ST, 8 * fq), o[tj]);
                o[tj] = mfma16(p1, lds_frag(VT, 16 * tj + fr, ST, 32 + 8 * fq), o[tj]);
                o[tj] = mfma16(q0, lds_frag(Ss, 16 * tj + fr, SQ, 8 * fq), o[tj]); }
#pragma unroll
            for (int r = 0; r < 4; ++r) { const int t = 16 * ti + 4 * fq + r; const int sp2 = dir == 0 ? cc * 64 + t : Ts - 1 - (cc * 64 + t);
                bf16_t* orow = og + (size_t)tok_row(lat, b, sp2) * 256 + h * 64;
#pragma unroll
                for (int tj = 0; tj < 4; ++tj) orow[16 * tj + fr] = f2bf(o[tj][r]); }
            const bf16x8 v0 = lds_frag(VT, 16 * wh + fr, ST, 8 * fq), v1 = lds_frag(VT, 16 * wh + fr, ST, 32 + 8 * fq);
#pragma unroll
            for (int dj = 0; dj < 2; ++dj) {
                sacc[dj] = mfma16(v0, lds_frag(KT, 16 * dj + fr, ST, 8 * fq), sacc[dj]);
                sacc[dj] = mfma16(v1, lds_frag(KT, 16 * dj + fr, ST, 32 + 8 * fq), sacc[dj]);
                sacc[dj] = sacc[dj] * fast_exp(bc[63 * 33 + 16 * dj + fr]); }
        }
        LDS_BARRIER();
#pragma unroll
        for (int dj = 0; dj < 2; ++dj)
#pragma unroll
            for (int r = 0; r < 4; ++r) Ss[(16 * wh + 4 * fq + r) * SQ + 16 * dj + fr] = f2bf(sacc[dj][r]);
        cur = nxt;
    }
    wg_release_acquire();
    merge_head(p, l, b, 1, h, tid);
}

template <int KS, int T16, int VT> struct TrOff { static constexpr int v = ((32 * KS + 16 * T16) * 72 + 16 * VT) * 2; };
template <int NT>
DEV void attn_ldkv(const LAS bf16_t* Kb, lds_addr_t vb, bf16x8 (&kf)[NT][2], bf16x8 (&vf)[NT / 2][4], int fr, int fq) {
#pragma unroll
    for (int kt = 0; kt < NT; ++kt) { kf[kt][0] = lds_frag(Kb, 16 * kt + fr, 72, 8 * fq); kf[kt][1] = lds_frag(Kb, 16 * kt + fr, 72, 32 + 8 * fq); }
    bf16x4 lo[NT / 2][4], hi[NT / 2][4];
#define ATT_TR(KS) do { lo[KS][0] = tr_read4<TrOff<KS, 0, 0>::v>(vb); hi[KS][0] = tr_read4<TrOff<KS, 1, 0>::v>(vb); lo[KS][1] = tr_read4<TrOff<KS, 0, 1>::v>(vb); hi[KS][1] = tr_read4<TrOff<KS, 1, 1>::v>(vb); \
        lo[KS][2] = tr_read4<TrOff<KS, 0, 2>::v>(vb); hi[KS][2] = tr_read4<TrOff<KS, 1, 2>::v>(vb); lo[KS][3] = tr_read4<TrOff<KS, 0, 3>::v>(vb); hi[KS][3] = tr_read4<TrOff<KS, 1, 3>::v>(vb); } while (0)
    ATT_TR(0);
    if constexpr (NT == 4) { ATT_TR(1); }
#undef ATT_TR
    LGKM_WAIT0();
#pragma unroll
    for (int ks = 0; ks < NT / 2; ++ks)
#pragma unroll
        for (int vt = 0; vt < 4; ++vt) vf[ks][vt] = (bf16x8){lo[ks][vt][0], lo[ks][vt][1], lo[ks][vt][2], lo[ks][vt][3], hi[ks][vt][0], hi[ks][vt][1], hi[ks][vt][2], hi[ks][vt][3]};
}
template <int NT, bool LOC>
DEV void attn_tile(const bf16x8 (&kf)[NT][2], const bf16x8 (&vf)[NT / 2][4], bf16x8 qf0, bf16x8 qf1, f32x4 (&o)[4], float& mrun, float& lrun, const LAS float* rpl, int d0) {
    f32x4 s[NT];
#pragma unroll
    for (int kt = 0; kt < NT; ++kt) { s[kt] = (f32x4){0.f, 0.f, 0.f, 0.f}; s[kt] = mfma16(kf[kt][0], qf0, s[kt]); s[kt] = mfma16(kf[kt][1], qf1, s[kt]); }
    float mx = -INFINITY;
#pragma unroll
    for (int kt = 0; kt < NT; ++kt)
#pragma unroll
        for (int j = 0; j < 4; ++j) { float v;
            if (LOC) { const bool ok = (unsigned)(16 * kt + j - d0) < 16u; v = ok ? s[kt][j] * 0.18033688f + rpl[16 * kt + j] : -INFINITY; }
            else v = s[kt][j] * 0.18033688f;
            s[kt][j] = v; mx = fmaxf(mx, v); }
    mx = xrow16_max(mx);
    if (wave_any(mx > mrun + 8.0f)) {
        const float mnew = fmaxf(mrun, mx);
        const float alpha = fast_exp2(mrun - mnew);
        lrun = lrun * alpha; mrun = mnew;
#pragma unroll
        for (int vt = 0; vt < 4; ++vt) o[vt] = o[vt] * alpha;
    }
    float ps = 0.f;
#pragma unroll
    for (int kt = 0; kt < NT; ++kt)
#pragma unroll
        for (int j = 0; j < 4; ++j) { const float pv = fast_exp2(s[kt][j] - mrun); s[kt][j] = pv; ps += pv; }
    lrun += ps;
#pragma unroll
    for (int ks = 0; ks < NT / 2; ++ks) { u32x4 pu; pu[0] = pack2(s[2 * ks][0], s[2 * ks][1]); pu[1] = pack2(s[2 * ks][2], s[2 * ks][3]); pu[2] = pack2(s[2 * ks + 1][0], s[2 * ks + 1][1]); pu[3] = pack2(s[2 * ks + 1][2], s[2 * ks + 1][3]);
        bf16x8 pf; __builtin_memcpy(&pf, &pu, 16);
#pragma unroll
        for (int vt = 0; vt < 4; ++vt) o[vt] = mfma16(vf[ks][vt], pf, o[vt]); }
}
template <bool LOCAL>
DEV void attn_unit(const Params& p, int l, int b, int head, int r0, LAS unsigned char* lds) {
    constexpr int NQT = 2, ST = 72, HB = 64 * ST, BUF = 2 * HB;
    LAS bf16_t* kv = (LAS bf16_t*)lds;
    LAS float* rp = (LAS float*)(kv + 2 * BUF) + 64;
    const int tid = opaque_tid(), lane = tid & 63, w = tid >> 6, fr = lane & 15, fq = lane >> 4;
    const int qt = w & 3, qc = 16 * qt + fr, rw = r0 + 2 * (w >> 2);
    const bf16_t* proj = (const bf16_t*)(p.ws + WS_R1 + R1_PROJ);
    bf16_t* ymix = (bf16_t*)(p.ws + WS_YMIX);
    const int rs_first = r0 - 4 < 0 ? 0 : (r0 - 4 > GRID_R - 8 ? GRID_R - 8 : r0 - 4);
    const int rl = r0 + 3, rs_last = rl - 4 < 0 ? 0 : (rl - 4 > GRID_R - 8 ? GRID_R - 8 : rl - 4);
    const int kr_lo = rs_first, nloc = LOCAL ? rs_last + 8 - rs_first : 0, nblk = nloc + NCH_C;
    const int skey = tid >> 3, sg8 = (tid & 7) * 8;
    const bf16_t* sbase = proj + (size_t)head * 64 + sg8;
    u32x4 kr0, vr0, kr1, vr1;
#define ATT_KROW(kb) ((kb) < nloc ? tok_row(true, b, (kr_lo + (kb)) * 64) : tok_row(false, b, ((kb) - nloc) * 64))
#define ATT_LOAD(kb, KR, VR) do { const bf16_t* pr_ = sbase + (size_t)(ATT_KROW(kb) + skey) * PROJ_N; KR = *(const u32x4*)(pr_ + C_NK); VR = *(const u32x4*)(pr_ + C_NV); } while (0)
#define ATT_STORE(bi, KR, VR) do { LAS bf16_t* d_ = kv + (bi) * BUF + skey * ST + sg8; *(LAS u32x4*)(d_) = KR; *(LAS u32x4*)(d_ + HB) = VR; } while (0)
    __syncthreads();
    ATT_LOAD(0, kr0, vr0);
    ATT_LOAD(1, kr1, vr1);
    if (LOCAL) for (int i = tid; i < 15 * 31; i += 512) rp[i] = p.in[13][((size_t)l * 8 + head) * 465 + i] * 1.44269504f;
    bf16x8 qf[NQT][2]; f32x4 o[NQT][4]; float mrun[NQT], lrun[NQT];
#pragma unroll
    for (int i = 0; i < NQT; ++i) { const bf16_t* qp = proj + (size_t)tok_row(LOCAL, b, (rw + i) * 64 + qc) * PROJ_N + C_NQ + head * 64;
        qf[i][0] = *(const bf16x8*)(qp + 8 * fq); qf[i][1] = *(const bf16x8*)(qp + 32 + 8 * fq); mrun[i] = -INFINITY; lrun[i] = 0.f;
#pragma unroll
        for (int vt = 0; vt < 4; ++vt) o[i][vt] = (f32x4){0.f, 0.f, 0.f, 0.f}; }
    ATT_STORE(0, kr0, vr0);
    ATT_LOAD(2, kr0, vr0);
    const int cs = qc - 8 < 0 ? 0 : (qc - 8 > 48 ? 48 : qc - 8);
    const int koff = qt == 0 ? 0 : (qt == 1 ? 8 : (qt == 2 ? 24 : 32));
    const int d0 = cs - koff - 4 * fq;
    const LAS float* rpl0 = rp + koff + 4 * fq - qc + 15;
    const int rs0 = rw - 4 < 0 ? 0 : (rw - 4 > GRID_R - 8 ? GRID_R - 8 : rw - 4), rs1 = rw - 3 < 0 ? 0 : (rw - 3 > GRID_R - 8 ? GRID_R - 8 : rw - 3);
    LDS_BARRIER();
#define ATT_ITER(kb, KR, VR) do { const int bi = (kb) & 1; \
        if ((kb) + 1 < nblk) ATT_STORE(bi ^ 1, KR, VR); \
        if ((kb) + 3 < nblk) ATT_LOAD((kb) + 3, KR, VR); \
        const LAS bf16_t* Kb = kv + bi * BUF; \
        const LAS bf16_t* Vl = kv + bi * BUF + HB + (4 * fq + (fr >> 2)) * ST + 4 * (fr & 3); \
        if ((kb) < nloc) { \
            const int krow = kr_lo + (kb); \
            const bool a0 = krow >= rs0 && krow < rs0 + 8, a1 = krow >= rs1 && krow < rs1 + 8; \
            if (a0 || a1) { \
                bf16x8 kf[2][2], vf[1][4]; \
                attn_ldkv<2>(Kb + koff * ST, lds_addr(Vl + koff * ST), kf, vf, fr, fq); \
                if (a0) attn_tile<2, true>(kf, vf, qf[0][0], qf[0][1], o[0], mrun[0], lrun[0], rpl0 + (krow - rw + 7) * 31, d0); \
                if (a1) attn_tile<2, true>(kf, vf, qf[1][0], qf[1][1], o[1], mrun[1], lrun[1], rpl0 + (krow - rw - 1 + 7) * 31, d0); \
            } \
        } else { \
            _Pragma("unroll") for (int hf = 0; hf < 2; ++hf) { \
                bf16x8 kf[2][2], vf[1][4]; \
                attn_ldkv<2>(Kb + 32 * hf * ST, lds_addr(Vl + 32 * hf * ST), kf, vf, fr, fq); \
                _Pragma("unroll") for (int i = 0; i < NQT; ++i) attn_tile<2, false>(kf, vf, qf[i][0], qf[i][1], o[i], mrun[i], lrun[i], rpl0, d0); } \
        } \
        LDS_BARRIER(); } while (0)
#pragma unroll 1
    for (int kb = 0; kb < nblk; kb += 2) {
        ATT_ITER(kb, kr1, vr1);
        if (kb + 1 < nblk) ATT_ITER(kb + 1, kr0, vr0);
    }
#undef ATT_ITER
#undef ATT_KROW
#undef ATT_LOAD
#undef ATT_STORE
#pragma unroll
    for (int i = 0; i < NQT; ++i) { const float lr = xrow16_sum(lrun[i]);
        const float inv = 1.0f / lr;
        bf16_t* yr = ymix + (size_t)tok_row(LOCAL, b, (rw + i) * 64 + qc) * D_ + 512 + head * 64;
#pragma unroll
        for (int vt = 0; vt < 4; ++vt) { u32x2 ov; ov[0] = pack2(o[i][vt][0] * inv, o[i][vt][1] * inv); ov[1] = pack2(o[i][vt][2] * inv, o[i][vt][3] * inv); *(u32x2*)(yr + 16 * vt + 4 * fq) = ov; } }
}

DEV void phase_mixer(const Params& p, int l, LAS unsigned char* lds) {
    const bool need_ctx = l < DEPTH_ - 1;
#ifndef REP_K
#define REP_K -1
#endif
#ifndef NO_SCAN
    for (int rep_ = 0; rep_ < ((REP_K == 20 || REP_K == 99) ? 2 : 1); ++rep_)
    for (int u = blockIdx.x; u < B_ * 8; u += gridDim.x) { if (u < B_ * 4) mlstm_unit(p, l, u >> 2, u & 3, lds); else gla_unit(p, l, (u - B_ * 4) >> 2, u & 3, lds); }
#endif
    static_assert(GRID_R % 4 == 0 && NCH_C == 4, "attention unit grouping");
    const int nloc = B_ * 8 * (GRID_R / 4), nctx = need_ctx ? B_ * 8 : 0;
#ifdef HOST_EMU
    for (int u = blockIdx.x; u < nloc + nctx; u += gridDim.x) {
        if (u < nloc) { const int rg = u % (GRID_R / 4), head = (u / (GRID_R / 4)) & 7, b = u / (GRID_R / 4 * 8); attn_unit<true>(p, l, b, head, rg * 4, lds); }
        else { const int q = u - nloc, head = q & 7, b = q >> 3; attn_unit<false>(p, l, b, head, 0, lds); }
    }
#else
    for (int rep_ = 0; rep_ < ((REP_K == 22 || REP_K == 99) ? 2 : 1); ++rep_) {
        unsigned* ctr = (unsigned*)(p.ws + WS_CTL) + XB_QUEUE + l * 2 + rep_;
        volatile LAS int* qs = (volatile LAS int*)(lds + LDS_BYTES - 32);
        const int tid = opaque_tid();
        __syncthreads();
        if (tid == 0) qs[0] = (int)atomicAdd(ctr, 1u);
        __syncthreads();
        int u = qs[0];
        while (u < nloc + nctx) {
            int pend = 0;
            if (tid == 0) pend = (int)atomicAdd(ctr, 1u);
            if (u < nloc) { const int rg = u % (GRID_R / 4), head = (u / (GRID_R / 4)) & 7, b = u / (GRID_R / 4 * 8); attn_unit<true>(p, l, b, head, rg * 4, lds); }
            else { const int q = u - nloc, head = q & 7, b = q >> 3; attn_unit<false>(p, l, b, head, 0, lds); }
            __syncthreads();
            if (tid == 0) qs[0] = pend;
            __syncthreads();
            u = qs[0];
        }
    }
#endif
}

DEV void ln_stats(const float (&v)[2][8], float& mu, float& rstd) {
    float s = 0.f;
#pragma unroll
    for (int i = 0; i < 2; ++i)
#pragma unroll
        for (int j = 0; j < 8; ++j) s += v[i][j];
    mu = wave_sum(s) * (1.0f / 1024.0f);
    float q = 0.f;
#pragma unroll
    for (int i = 0; i < 2; ++i)
#pragma unroll
        for (int j = 0; j < 8; ++j) { const float d = v[i][j] - mu; q += d * d; }
    rstd = 1.0f / sqrtf(wave_sum(q) * (1.0f / 1024.0f) + LN_EPS);
}
DEV void ln_apply(float (&v)[2][8], float mu, float rstd, const float* g, const float* bta, int lane) {
#pragma unroll
    for (int i = 0; i < 2; ++i) { const int c = lane * 8 + i * 512; const f32x4 ga = *(const f32x4*)(g + c), gb2 = *(const f32x4*)(g + c + 4), ba = *(const f32x4*)(bta + c), bb2 = *(const f32x4*)(bta + c + 4);
#pragma unroll
        for (int j = 0; j < 8; ++j) v[i][j] = (v[i][j] - mu) * rstd * (j < 4 ? ga[j] : gb2[j - 4]) + (j < 4 ? ba[j] : bb2[j - 4]); }
}
DEV void ln_row(float (&v)[2][8], const float* g, const float* bta, int lane) {
    float s = 0.f;
#pragma unroll
    for (int i = 0; i < 2; ++i)
#pragma unroll
        for (int j = 0; j < 8; ++j) s += v[i][j];
    const float mu = wave_sum(s) * (1.0f / 1024.0f);
    float q = 0.f;
#pragma unroll
    for (int i = 0; i < 2; ++i)
#pragma unroll
        for (int j = 0; j < 8; ++j) { v[i][j] -= mu; q += v[i][j] * v[i][j]; }
    const float rstd = 1.0f / sqrtf(wave_sum(q) * (1.0f / 1024.0f) + LN_EPS);
#pragma unroll
    for (int i = 0; i < 2; ++i) { const int c = lane * 8 + i * 512; const f32x4 ga = *(const f32x4*)(g + c), gb2 = *(const f32x4*)(g + c + 4), ba = *(const f32x4*)(bta + c), bb2 = *(const f32x4*)(bta + c + 4);
#pragma unroll
        for (int j = 0; j < 8; ++j) v[i][j] = v[i][j] * rstd * (j < 4 ? ga[j] : gb2[j - 4]) + (j < 4 ? ba[j] : bb2[j - 4]); }
}

DEV void phase_ln1_router(const Params& p, int l, LAS unsigned char* lds) {
    LAS float* wrT = (LAS float*)lds;
    const int tid = opaque_tid(), lane = tid & 63, gw = blockIdx.x * 8 + (tid >> 6), nw = gridDim.x * 8;
    const int ntok = l < DEPTH_ - 1 ? NTOK : NL;
    const float* wr = p.in[17] + (size_t)l * 1024 * 16;
    __syncthreads();
    for (int i = tid; i < 16 * 1024; i += 512) { const int k = i >> 4, e = i & 15; wrT[e * 1024 + k] = wr[i]; }
    __syncthreads();
    const float* mods = (const float*)(p.ws + WS_MODS) + (size_t)l * (B_ + 1) * 6144;
    bf16_t* ub = (bf16_t*)(p.ws + WS_U); float* aff = (float*)(p.ws + WS_AFF);
    const bf16_t* xh = (const bf16_t*)(p.ws + WS_XH); bf16_t* x1h = (bf16_t*)(p.ws + WS_X1H); const bf16_t* yo = (const bf16_t*)(p.ws + WS_YO);
    const float alpha = sqrtf(sqrtf((float)(2 * DEPTH_)));
    const float* lg = p.in[15] + (size_t)l * 1024; const float* lb = p.in[16] + (size_t)l * 1024;
    for (int row0 = gw; row0 < ntok; row0 += 2 * nw) {
        float uu[2][2][8];
#pragma unroll
        for (int r = 0; r < 2; ++r) {
            const int row = row0 + r * nw;
            if (row < ntok) {
                const bool isl = row < NL; const int bb = isl ? row / T_ : B_;
                const float* md = mods + (size_t)bb * 6144;
                float v[2][8];
#pragma unroll
                for (int i = 0; i < 2; ++i) { const int c = lane * 8 + i * 512; float xv[8];
                    if (l == 0) { const float* xr = isl ? p.in[0] + (size_t)row * D_ : p.in[2] + (size_t)(row - NL) * D_; const f32x4 a = *(const f32x4*)(xr + c), b2 = *(const f32x4*)(xr + c + 4);
#pragma unroll
                        for (int j = 0; j < 4; ++j) { xv[j] = a[j]; xv[4 + j] = b2[j]; } }
                    else unpack8_h(*(const u32x4*)(xh + (size_t)row * D_ + c), xv);
                    const u32x4 yv = *(const u32x4*)(yo + (size_t)row * D_ + c); const f32x4 g0 = *(const f32x4*)(md + 2048 + c), g1 = *(const f32x4*)(md + 2048 + c + 4);
#pragma unroll
                    for (int j = 0; j < 4; ++j) { v[i][j] = alpha * xv[j] + g0[j] * ((j & 1) ? bfhi(yv[j >> 1]) : bflo(yv[j >> 1])); v[i][4 + j] = alpha * xv[4 + j] + g1[j] * ((j & 1) ? bfhi(yv[2 + (j >> 1)]) : bflo(yv[2 + (j >> 1)])); } }
                float mu, rstd; ln_stats(v, mu, rstd);
                ln_apply(v, mu, rstd, lg, lb, lane);
#pragma unroll
                for (int i = 0; i < 2; ++i) { const int c = lane * 8 + i * 512;
                    *(u32x4*)(x1h + (size_t)row * D_ + c) = pack8_h(v[i]);
                    const f32x4 s0 = *(const f32x4*)(md + 4096 + c), s1 = *(const f32x4*)(md + 4096 + c + 4), h0 = *(const f32x4*)(md + 3072 + c), h1 = *(const f32x4*)(md + 3072 + c + 4);
#pragma unroll
                    for (int j = 0; j < 8; ++j) uu[r][i][j] = v[i][j] * ((j < 4 ? s0[j] : s1[j - 4]) + 1.0f) + (j < 4 ? h0[j] : h1[j - 4]);
#if MOE_F8
                    u32x2 o; o[0] = pack4_f8(uu[r][i][0], uu[r][i][1], uu[r][i][2], uu[r][i][3]); o[1] = pack4_f8(uu[r][i][4], uu[r][i][5], uu[r][i][6], uu[r][i][7]);
                    *(u32x2*)((unsigned char*)ub + (size_t)row * D_ + c) = o; }
#else
                    u32x4 o; o[0] = pack2(uu[r][i][0], uu[r][i][1]); o[1] = pack2(uu[r][i][2], uu[r][i][3]); o[2] = pack2(uu[r][i][4], uu[r][i][5]); o[3] = pack2(uu[r][i][6], uu[r][i][7]);
                    *(u32x4*)(ub + (size_t)row * D_ + c) = o; }
#endif
            } else {
#pragma unroll
                for (int i = 0; i < 2; ++i)
#pragma unroll
                    for (int j = 0; j < 8; ++j) uu[r][i][j] = 0.f;
            }
            SCHED_BAR();
        }
#ifndef HOST_EMU
        asm volatile("" ::: "memory");
#endif
        float p8a[2][8];
#pragma unroll
        for (int j = 0; j < 8; ++j) { float pe[2][2];
#pragma unroll
            for (int hh = 0; hh < 2; ++hh) { const int e = j + 8 * hh; float pe0 = 0.f, pe1 = 0.f;
#pragma unroll
                for (int i = 0; i < 2; ++i) { const int c = lane * 8 + i * 512; const f32x4 w0 = *(const LAS f32x4*)(wrT + e * 1024 + c), w1 = *(const LAS f32x4*)(wrT + e * 1024 + c + 4);
                    pe0 += uu[0][i][0] * w0[0] + uu[0][i][1] * w0[1] + uu[0][i][2] * w0[2] + uu[0][i][3] * w0[3] + uu[0][i][4] * w1[0] + uu[0][i][5] * w1[1] + uu[0][i][6] * w1[2] + uu[0][i][7] * w1[3];
                    pe1 += uu[1][i][0] * w0[0] + uu[1][i][1] * w0[1] + uu[1][i][2] * w0[2] + uu[1][i][3] * w0[3] + uu[1][i][4] * w1[0] + uu[1][i][5] * w1[1] + uu[1][i][6] * w1[2] + uu[1][i][7] * w1[3]; }
                pe[0][hh] = pe0; pe[1][hh] = pe1; }
            p8a[0][j] = xsum32(pe[0][0], pe[0][1]); p8a[1][j] = xsum32(pe[1][0], pe[1][1]); }
#pragma unroll
        for (int r = 0; r < 2; ++r) {
            const int row = row0 + r * nw;
            float p4[4], p2[2];
#pragma unroll
            for (int j = 0; j < 4; ++j) p4[j] = xsum16(p8a[r][j], p8a[r][4 + j]);
#pragma unroll
            for (int j = 0; j < 2; ++j) p2[j] = xsum8(p4[j], p4[2 + j], lane);
            float mine = quad_sum(xsum4(p2[0], p2[1], lane));
            const float mx = wave_max(mine);
            mine = expf(mine - mx);
            const float sm = wave_sum(mine) * 0.25f;
            if (row < ntok && (lane & 3) == 0) aff[(size_t)row * 16 + (lane >> 2)] = mine / sm;
        }
    }
}

#ifdef HOST_EMU
static inline void lds_inc(unsigned* p) { (*p)++; }
#else
DEV void lds_inc(LAS unsigned* p) { __hip_atomic_fetch_add(p, 1u, __ATOMIC_RELAXED, __HIP_MEMORY_SCOPE_WORKGROUP); }
#endif
DEV void phase_topk(const Params& p, int l, LAS unsigned char* lds) {
    LAS unsigned* keys = (LAS unsigned*)lds;
    LAS unsigned* hist = keys + T_;
    LAS unsigned* misc = hist + 256;
    const int tid = opaque_tid(), lane = tid & 63, w = tid >> 6;
    const bool need_ctx = l < DEPTH_ - 1;
    const float* aff = (const float*)(p.ws + WS_AFF); int* slot = (int*)(p.ws + WS_SLOT); int* rowtab = (int*)(p.ws + WS_ROWTAB);
    const int nun = B_ * 16 * (need_ctx ? 2 : 1);
    for (int u = blockIdx.x; u < nun; u += gridDim.x) {
        const bool lat = u < B_ * 16; const int q = lat ? u : u - B_ * 16, b = q >> 4, e = q & 15;
        const int n = lat ? T_ : TC_, cap = lat ? CAP_L : CAP_C, row0 = tok_row(lat, b, 0);
        __syncthreads();
        unsigned kv[4];
#pragma unroll
        for (int j = 0; j < 4; ++j) { const int t = tid * 4 + j; kv[j] = t < n ? f_as_u(aff[(size_t)(row0 + t) * 16 + e]) : 0u; }
        unsigned prefix = 0u, remaining = (unsigned)cap;
#pragma unroll 1
        for (int pass = 0; pass < 4; ++pass) {
            const int shift = 24 - 8 * pass;
            if (tid < 256) hist[tid] = 0u;
            __syncthreads();
#pragma unroll
            for (int j = 0; j < 4; ++j) { const int t = tid * 4 + j;
                if (t < n && (pass == 0 || (kv[j] >> (shift + 8)) == prefix)) lds_inc(&hist[(kv[j] >> shift) & 255u]); }
            __syncthreads();
            if (w == 0) {
                const unsigned h0 = hist[4 * lane], h1 = hist[4 * lane + 1], h2 = hist[4 * lane + 2], h3 = hist[4 * lane + 3];
                const unsigned sl = h0 + h1 + h2 + h3;
                unsigned S = sl;
                for (int d = 1; d < 64; d <<= 1) { const unsigned o = (unsigned)shfl_idx_i((int)S, lane + d < 64 ? lane + d : lane); if (lane + d < 64) S += o; }
                const unsigned above = S - sl;
                if (above < remaining && remaining <= S) {
                    unsigned acc = above; int bin;
                    if (acc + h3 >= remaining) { bin = 3; } else { acc += h3; if (acc + h2 >= remaining) { bin = 2; } else { acc += h2; if (acc + h1 >= remaining) { bin = 1; } else { acc += h1; bin = 0; } } }
                    misc[0] = (unsigned)(4 * lane + bin); misc[1] = remaining - acc; }
            }
            __syncthreads();
            prefix = (prefix << 8) | misc[0]; remaining = misc[1];
        }
        unsigned cnt = 0u;
#pragma unroll
        for (int j = 0; j < 4; ++j) { const int t = tid * 4 + j; if (t < n) cnt += (kv[j] > prefix ? 1u : 0u) + (kv[j] == prefix ? 65536u : 0u); }
        unsigned inc = cnt;
        for (int d = 1; d < 64; d <<= 1) { const unsigned o2 = (unsigned)shfl_idx_i((int)inc, lane >= d ? lane - d : lane); if (lane >= d) inc += o2; }
        if (lane == 63) misc[8 + w] = inc;
        __syncthreads();
        unsigned base = 0u, total = 0u;
#pragma unroll
        for (int ww = 0; ww < 8; ++ww) { const unsigned tw = misc[8 + ww]; if (ww < w) base += tw; total += tw; }
        unsigned run = base + inc - cnt;
        const unsigned ngt = total & 0xFFFFu;
#pragma unroll
        for (int j = 0; j < 4; ++j) { const int t = tid * 4 + j;
            if (t < n) { const bool gt = kv[j] > prefix, eq = kv[j] == prefix; const unsigned rg = run & 0xFFFFu, re = run >> 16;
                int sl = -1;
                if (gt) sl = (int)rg; else if (eq && re < remaining) sl = (int)(ngt + re);
                slot[(size_t)(row0 + t) * 16 + e] = sl;
                if (sl >= 0) rowtab[e * MROWS + (lat ? b * CAP_L + sl : ROWS_L + b * CAP_C + sl)] = row0 + t;
                run += (gt ? 1u : 0u) + (eq ? 65536u : 0u); } }
    }
    { const int used = need_ctx ? ROWS_L + ROWS_C : ROWS_L; const int mr = need_ctx ? MROWS : MROWS_LAST;
      if (blockIdx.x == gridDim.x - 1) for (int i = tid; i < 16 * (mr - used); i += 512) { const int e = i / (mr - used), r = used + i % (mr - used); rowtab[e * MROWS + r] = 0; } }
}

DEV void phase_combine(const Params& p, int l) {
    const int tid = opaque_tid(), lane = tid & 63, gw = blockIdx.x * 8 + (tid >> 6), nw = gridDim.x * 8;
    const bool need_ctx = l < DEPTH_ - 1; const int ntok = need_ctx ? NTOK : NL;
    const float* mods = (const float*)(p.ws + WS_MODS) + (size_t)l * (B_ + 1) * 6144;
    const float* modn = mods + (size_t)(B_ + 1) * 6144;
    const bf16_t* x1h = (const bf16_t*)(p.ws + WS_X1H); bf16_t* xh = (bf16_t*)(p.ws + WS_XH); bf16_t* ub = (bf16_t*)(p.ws + WS_U);
    const float* aff = (const float*)(p.ws + WS_AFF); const int* slot = (const int*)(p.ws + WS_SLOT); const bf16_t* yexp = (const bf16_t*)(p.ws + WS_YEXP);
    const float* lg = p.in[21] + (size_t)l * 1024; const float* lb = p.in[22] + (size_t)l * 1024;
    const float alpha = sqrtf(sqrtf((float)(2 * DEPTH_)));
    int slot_n[2]; float aff_n[2];
#pragma unroll
    for (int r = 0; r < 2; ++r) { const int row = gw + r * nw; slot_n[r] = -1; aff_n[r] = 0.f;
        if (row < ntok && lane < 16) { slot_n[r] = slot[(size_t)row * 16 + lane]; aff_n[r] = aff[(size_t)row * 16 + lane]; } }
    for (int row0 = gw; row0 < ntok; row0 += 2 * nw) {
        int myslot[2]; float myaff[2]; int rbase[2]; unsigned em[2];
        float v[2][2][8], f[2][2][8];
#pragma unroll
        for (int r = 0; r < 2; ++r) { const int row = row0 + r * nw; const bool act = row < ntok; const int rw = act ? row : row0;
            const bool isl = rw < NL; const int bidx = isl ? rw / T_ : (rw - NL) / TC_;
            rbase[r] = isl ? bidx * CAP_L : ROWS_L + bidx * CAP_C;
            myslot[r] = slot_n[r]; myaff[r] = aff_n[r];
            { const int rown = row + 2 * nw; slot_n[r] = -1; aff_n[r] = 0.f; if (rown < ntok && lane < 16) { slot_n[r] = slot[(size_t)rown * 16 + lane]; aff_n[r] = aff[(size_t)rown * 16 + lane]; } }
#pragma unroll
            for (int i = 0; i < 2; ++i) unpack8_h(*(const u32x4*)(x1h + (size_t)rw * D_ + lane * 8 + i * 512), v[r][i]);
#pragma unroll
            for (int i = 0; i < 2; ++i)
#pragma unroll
                for (int j = 0; j < 8; ++j) f[r][i][j] = 0.f;
            unsigned m_ = 0u;
#pragma unroll
            for (int e = 0; e < 16; ++e) m_ |= (rdlane_i(myslot[r], e) >= 0 ? 1u : 0u) << e;
            em[r] = act ? m_ : 0u; }
        while (em[0] | em[1]) {
#if MOE_F8 && YEXP_F8
            u32x2 yv[2][4][2]; float ga[2][4];
#pragma unroll
            for (int r = 0; r < 2; ++r)
#pragma unroll
                for (int k = 0; k < 4; ++k) { const bool ok = em[r] != 0u; const int ee = ok ? __builtin_ctz(em[r]) : 0; em[r] &= em[r] - 1u;
                    const int sl = rdlane_i(myslot[r], ee); ga[r][k] = ok ? rdlane_f(myaff[r], ee) * (1.0f / F8_SY) : 0.f;
                    const unsigned char* yr = (const unsigned char*)yexp + ((size_t)ee * MROWS + rbase[r] + (sl > 0 ? sl : 0)) * D_;
                    yv[r][k][0] = *(const u32x2*)(yr + lane * 8); yv[r][k][1] = *(const u32x2*)(yr + lane * 8 + 512); }
#pragma unroll
            for (int r = 0; r < 2; ++r)
#pragma unroll
                for (int k = 0; k < 4; ++k)
#pragma unroll
                    for (int i = 0; i < 2; ++i)
#pragma unroll
                        for (int j = 0; j < 2; ++j) { const f32x2 lo = __builtin_amdgcn_cvt_pk_f32_fp8((int)yv[r][k][i][j], false), hi = __builtin_amdgcn_cvt_pk_f32_fp8((int)yv[r][k][i][j], true);
                            f[r][i][4 * j] += ga[r][k] * lo[0]; f[r][i][4 * j + 1] += ga[r][k] * lo[1]; f[r][i][4 * j + 2] += ga[r][k] * hi[0]; f[r][i][4 * j + 3] += ga[r][k] * hi[1]; }
#else
            u32x4 yv[2][4][2]; float ga[2][4];
#pragma unroll
            for (int r = 0; r < 2; ++r)
#pragma unroll
                for (int k = 0; k < 4; ++k) { const bool ok = em[r] != 0u; const int ee = ok ? __builtin_ctz(em[r]) : 0; em[r] &= em[r] - 1u;
                    const int sl = rdlane_i(myslot[r], ee); ga[r][k] = ok ? rdlane_f(myaff[r], ee) : 0.f;
                    const bf16_t* yr = yexp + ((size_t)ee * MROWS + rbase[r] + (sl > 0 ? sl : 0)) * D_;
                    yv[r][k][0] = *(const u32x4*)(yr + lane * 8); yv[r][k][1] = *(const u32x4*)(yr + lane * 8 + 512); }
#pragma unroll
            for (int r = 0; r < 2; ++r)
#pragma unroll
                for (int k = 0; k < 4; ++k)
#pragma unroll
                    for (int i = 0; i < 2; ++i)
#pragma unroll
                        for (int j = 0; j < 4; ++j) { f[r][i][2 * j] += ga[r][k] * bflo(yv[r][k][i][j]); f[r][i][2 * j + 1] += ga[r][k] * bfhi(yv[r][k][i][j]); }
#endif
        }
#pragma unroll
        for (int r = 0; r < 2; ++r) { const int row = row0 + r * nw;
            if (row < ntok) {
                const bool isl = row < NL; const int bb = isl ? row / T_ : B_;
                const float* md = mods + (size_t)bb * 6144;
#pragma unroll
                for (int i = 0; i < 2; ++i) { const int c = lane * 8 + i * 512; const f32x4 g0 = *(const f32x4*)(md + 5120 + c), g1 = *(const f32x4*)(md + 5120 + c + 4);
#pragma unroll
                    for (int j = 0; j < 4; ++j) { v[r][i][j] = alpha * v[r][i][j] + g0[j] * f[r][i][j]; v[r][i][4 + j] = alpha * v[r][i][4 + j] + g1[j] * f[r][i][4 + j]; } }
                ln_row(v[r], lg, lb, lane);
#pragma unroll
                for (int i = 0; i < 2; ++i) { const int c = lane * 8 + i * 512;
                    if (!need_ctx) { float* xw = p.out + (size_t)row * D_; *(f32x4*)(xw + c) = (f32x4){v[r][i][0], v[r][i][1], v[r][i][2], v[r][i][3]}; *(f32x4*)(xw + c + 4) = (f32x4){v[r][i][4], v[r][i][5], v[r][i][6], v[r][i][7]}; }
                    else { const float* mn = modn + (size_t)bb * 6144;
                        *(u32x4*)(xh + (size_t)row * D_ + c) = pack8_h(v[r][i]);
                        const f32x4 s0 = *(const f32x4*)(mn + 1024 + c), s1 = *(const f32x4*)(mn + 1024 + c + 4), h0 = *(const f32x4*)(mn + c), h1 = *(const f32x4*)(mn + c + 4);
                        float uu[8];
#pragma unroll
                        for (int j = 0; j < 8; ++j) uu[j] = v[r][i][j] * ((j < 4 ? s0[j] : s1[j - 4]) + 1.0f) + (j < 4 ? h0[j] : h1[j - 4]);
                        u32x4 o; o[0] = pack2(uu[0], uu[1]); o[1] = pack2(uu[2], uu[3]); o[2] = pack2(uu[4], uu[5]); o[3] = pack2(uu[6], uu[7]);
                        *(u32x4*)(ub + (size_t)row * D_ + c) = o; } }
            }
        }
    }
}

__global__ void __launch_bounds__(512, 2) fwd(Params p) {
#ifdef HOST_EMU
    unsigned char* smem = emu::tls.dynsmem;
#else
    extern __shared__ __attribute__((aligned(16))) unsigned char smem_raw[];
    LAS unsigned char* smem = (LAS unsigned char*)smem_raw;
#endif
#ifdef HOST_EMU
    XcdBarrier bar = xcd_barrier_post(nullptr, nullptr);
#else
    volatile LAS unsigned* xbw = (volatile LAS unsigned*)(smem + LDS_BYTES - 16);
    if (threadIdx.x == 0) { xbw[0] = 0u; xbw[1] = 0u; xbw[2] = 0u; xbw[3] = 0u; }
    __syncthreads();
    XcdBarrier bar = xcd_barrier_post((unsigned*)(p.ws + WS_CTL), xbw);
#endif
#define SEAM(id) if ((id) > p.ph_lo && (id) < p.ph_hi) { xcd_barrier(bar); if (REP_K == 30) xcd_barrier(bar); }
#ifndef REP_K
#define REP_K -1
#endif
#define REPEAT(k) for (int rep_ = 0; rep_ < ((REP_K == (k) || REP_K == 99) ? 2 : 1); ++rep_)
#define REPBAR() if (rep_) xcd_barrier(bar)
#ifndef PH_MASK
#define PH_MASK 0xFFFF
#endif
#define RUN(id) if ((id) >= p.ph_lo && (id) < p.ph_hi)
#define RUNK(k) if (((PH_MASK >> (k)) & 1) && (base + (k)) >= p.ph_lo && (base + (k)) < p.ph_hi)
    if ((PH_MASK >> 15) & 1) RUN(0) REPEAT(15) { REPBAR(); phase_mods(p, smem); }
    const float alpha = sqrtf(sqrtf((float)(2 * DEPTH_)));
    for (int l = 0; l < DEPTH_; ++l) {
        const int base = 1 + l * NPH;
        const bool need_ctx = l < DEPTH_ - 1;
        SEAM(base + 0); RUNK(0) REPEAT(0) { REPBAR(); phase_convert(p, l, smem); }
        SEAM(base + 1); RUNK(1) REPEAT(1) { REPBAR();
            pg8::Gemm g; g.A = (const bf16_t*)(p.ws + WS_U); g.Bt = (const bf16_t*)(p.ws + WS_BTIN); g.K = D_; g.rowtab = nullptr;
            pg8::Order S; S.init(1, NTOK / 256, NTOK / 256, PROJ_NP / 256, gridDim.x, blockIdx.x);
            EpiProj E; E.proj = (bf16_t*)(p.ws + WS_R1 + R1_PROJ); E.gates = (float*)(p.ws + WS_R1 + R1_GATES); E.bias = (const float*)(p.ws + WS_BIAS);
            pg8::gemm_phase<EpiProj, false>(smem, g, S, E);
        }
        SEAM(base + 2); RUNK(2) REPEAT(2) { REPBAR(); phase_mixer(p, l, smem); }
        SEAM(base + 4); RUNK(4) REPEAT(4) { REPBAR();
            pg8::Gemm g; g.A = (const bf16_t*)(p.ws + WS_YMIX); g.Bt = (const bf16_t*)(p.ws + WS_BTOUT); g.K = D_; g.rowtab = nullptr;
            const int mt = (need_ctx ? NTOK : NL) / 256;
            pg8::Order S; S.init(1, mt, mt, D_ / 256, gridDim.x, blockIdx.x);
            EpiDown<false> E; E.y = (bf16_t*)(p.ws + WS_YO); E.sc = 1.0f;
            pg8::gemm_phase<EpiDown<false>, false>(smem, g, S, E);
        }
        SEAM(base + 5); RUNK(5) REPEAT(5) { REPBAR(); phase_ln1_router(p, l, smem); }
        SEAM(base + 6); RUNK(6) REPEAT(6) { REPBAR(); phase_topk(p, l, smem); }
        SEAM(base + 7); RUNK(7) REPEAT(7) { REPBAR();
            pg8::Gemm g; g.A = (const bf16_t*)(p.ws + WS_U); g.Bt = (const bf16_t*)(p.ws + WS_BTGU); g.K = MOE_F8 ? D_ / 2 : D_; g.rowtab = (const int*)(p.ws + WS_ROWTAB);
            pg8::Order S; S.init(NE, (need_ctx ? MROWS : MROWS_LAST) / 256, MROWS / 256, 2 * FF / 256, gridDim.x, blockIdx.x);
            EpiSwiglu E; E.h = (bf16_t*)(p.ws + WS_R1);
            pg8::gemm_phase<EpiSwiglu, true, MOE_F8 != 0>(smem, g, S, E);
        }
        SEAM(base + 8); RUNK(8) REPEAT(8) { REPBAR();
            pg8::Gemm g; g.A = (const bf16_t*)(p.ws + WS_R1); g.Bt = (const bf16_t*)(p.ws + WS_BTDN); g.K = MOE_F8 ? FF / 2 : FF; g.rowtab = nullptr;
            pg8::Order S; S.init(NE, (need_ctx ? MROWS : MROWS_LAST) / 256, MROWS / 256, D_ / 256, gridDim.x, blockIdx.x);
            EpiDown<(MOE_F8 && YEXP_F8)> E; E.y = (bf16_t*)(p.ws + WS_YEXP);
#if MOE_F8
            E.sc = (YEXP_F8 ? F8_SY : 1.0f) / (F8_SH * F8_SW2);
#else
            E.sc = 1.0f;
#endif
            pg8::gemm_phase<EpiDown<(MOE_F8 && YEXP_F8)>, false, MOE_F8 != 0>(smem, g, S, E);
        }
        SEAM(base + 9); RUNK(9) REPEAT(9) { REPBAR(); phase_combine(p, l); }
    }
}

extern "C" void kernel_launch(void* const* d_in, const int* in_sizes, int n_in, void* d_out, int out_size, void* d_ws, size_t ws_size, hipStream_t stream) {
    static int grid = 0;
    if (grid == 0) {
        if (n_in != 23 || out_size != NL * D_ || ws_size < WS_END) { fprintf(stderr, "kernel_launch: bad shapes: n_in %d out %d ws %zu (need %zu)\n", n_in, out_size, ws_size, (size_t)WS_END); grid = -1; return; }
        int dev = 0, cus = 0;
        if (hipGetDevice(&dev) != hipSuccess || hipDeviceGetAttribute(&cus, hipDeviceAttributeMultiprocessorCount, dev) != hipSuccess) { grid = -1; return; }
        if (hipFuncSetAttribute((const void*)fwd, hipFuncAttributeMaxDynamicSharedMemorySize, LDS_BYTES) != hipSuccess) { fprintf(stderr, "kernel_launch: hipFuncSetAttribute failed\n"); grid = -1; return; }
        (void)hipGetLastError();
        grid = cus;
    }
    if (grid < 0) return;
#ifdef HOST_EMU
    g_emu_bar.store(0);
#endif
    (void)hipMemsetAsync((char*)d_ws + WS_CTL, 0, WS_CTL_BYTES, stream);
    Params p{};
    for (int i = 0; i < 23; ++i) p.in[i] = (const float*)d_in[i];
    p.out = (float*)d_out; p.ws = (unsigned char*)d_ws;
#if ONE_LAUNCH
    p.ph_lo = 0; p.ph_hi = NPHASES;
#ifdef HOST_EMU
    if (getenv("EMU_PH_HI")) p.ph_hi = atoi(getenv("EMU_PH_HI"));
#endif
    hipLaunchKernelGGL(fwd, dim3(grid), dim3(512), LDS_BYTES, stream, p);
#else
    int nph = NPHASES;
#ifdef HOST_EMU
    if (getenv("EMU_PH_HI")) nph = atoi(getenv("EMU_PH_HI"));
#endif
    for (int ph = 0; ph < nph; ++ph) { p.ph_lo = ph; p.ph_hi = ph + 1; hipLaunchKernelGGL(fwd, dim3(grid), dim3(512), LDS_BYTES, stream, p); }
#endif
}
```

```cpp
#ifdef HOST_EMU
#include "emu.h"
#else
#include <hip/hip_runtime.h>
#include <cstdio>
#include <cstdint>
#endif

#ifndef CFG_BATCH
#define CFG_BATCH 32
#define CFG_SEQ 2048
#define CFG_CTX 256
#define CFG_DEPTH 4
#endif
#ifndef ONE_LAUNCH
#define ONE_LAUNCH 1
#endif
#ifndef MOE_F8
#ifdef HOST_EMU
#define MOE_F8 0
#else
#define MOE_F8 1
#endif
#endif
#ifndef YEXP_F8
#define YEXP_F8 1
#endif

#define DEV __device__ __forceinline__
typedef unsigned short bf16_t;
typedef short bf16x8 __attribute__((ext_vector_type(8)));
typedef short bf16x4 __attribute__((ext_vector_type(4)));
typedef float f32x4 __attribute__((ext_vector_type(4)));
typedef float f32x2 __attribute__((ext_vector_type(2)));
typedef unsigned u32x4 __attribute__((ext_vector_type(4)));
typedef unsigned u32x2 __attribute__((ext_vector_type(2)));
typedef int i32x8 __attribute__((ext_vector_type(8)));

constexpr int B_ = CFG_BATCH, T_ = CFG_SEQ, TC_ = CFG_CTX, DEPTH_ = CFG_DEPTH;
constexpr int D_ = 1024, NL = B_ * T_, NC = B_ * TC_, NTOK = NL + NC;
constexpr int PROJ_W0 = 3376, PROJ_N = 3328, PROJ_NP = 3584, NG = 48;
constexpr int FF = 2048, NE = 16;
constexpr int CAP_L = 2 * T_ / NE, CAP_C = 2 * TC_ / NE;
constexpr int ROWS_L = B_ * CAP_L, ROWS_C = B_ * CAP_C;
constexpr int MROWS = ((ROWS_L + ROWS_C + 255) / 256) * 256;
constexpr int MROWS_LAST = ((ROWS_L + 255) / 256) * 256;
constexpr int NCH_C = TC_ / 64, NCH_L = T_ / 64, NCH = NCH_C + NCH_L;
constexpr int GRID_R = T_ / 64;
constexpr float LN_EPS = 1e-5f;
constexpr int C_MQ = 0, C_MK = 256, C_MV = 512, C_MO = 768, C_GQ = 1024, C_GK = 1152, C_GV = 1280, C_GR = 1536, C_NQ = 1792, C_NK = 2304, C_NV = 2816;
static_assert(T_ % 256 == 0 && TC_ % 256 == 0 && NL % 256 == 0 && NC % 256 == 0, "shape");
static_assert(GRID_R >= 8, "rows");

constexpr size_t al256(size_t x) { return (x + 255) & ~(size_t)255; }
constexpr size_t WS_CTL = 0;
constexpr size_t WS_CTL_BYTES = 16384;
constexpr size_t WS_MODS = WS_CTL + WS_CTL_BYTES;
constexpr size_t WS_ROPE = WS_MODS + al256((size_t)DEPTH_ * (B_ + 1) * 6144 * 4);
constexpr size_t WS_BIAS = WS_ROPE + al256((64 * 16 * 2 + 64 * 8 * 2) * 4);
constexpr size_t WS_BTIN = WS_BIAS + al256(PROJ_NP * 4);
constexpr size_t WS_BTOUT = WS_BTIN + al256((size_t)PROJ_NP * D_ * 2);
constexpr size_t WBYTES = MOE_F8 ? 1 : 2;
constexpr size_t WS_BTGU = WS_BTOUT + al256((size_t)D_ * D_ * 2);
constexpr size_t WS_BTDN = WS_BTGU + al256((size_t)NE * 2 * FF * D_ * WBYTES);
constexpr size_t WS_U = WS_BTDN + al256((size_t)NE * D_ * FF * WBYTES);
constexpr size_t WS_XH = WS_U + al256((size_t)NTOK * D_ * 2);
constexpr size_t WS_AFF = WS_XH + al256((size_t)NTOK * D_ * 2);
constexpr size_t WS_SLOT = WS_AFF + al256((size_t)NTOK * 16 * 4);
constexpr size_t WS_GSCAN = WS_SLOT + al256((size_t)NTOK * 16 * 4);
constexpr size_t WS_ROWTAB = WS_GSCAN + al256((size_t)B_ * 8 * NCH * 192 * 4);
constexpr size_t WS_YMIX = WS_ROWTAB + al256((size_t)NE * MROWS * 4);
constexpr size_t WS_YEXP = WS_YMIX + al256((size_t)NTOK * D_ * 2);
constexpr size_t WS_R1 = WS_YEXP + al256((size_t)NE * MROWS * D_ * 2);
constexpr size_t R1_PROJ = 0;
constexpr size_t R1_GATES = R1_PROJ + al256((size_t)NTOK * PROJ_N * 2);
constexpr size_t R1_OM = R1_GATES + al256((size_t)NTOK * NG * 4);
constexpr size_t R1_OG = R1_OM + al256((size_t)2 * NTOK * 256 * 2);
constexpr size_t R1_QK2 = R1_OG + al256((size_t)2 * NTOK * 256 * 2);
constexpr size_t R1_END = R1_QK2 + al256((size_t)NTOK * 512 * 2);
constexpr size_t R1_H_BYTES = al256((size_t)NE * MROWS * FF * 2);
constexpr size_t WS_YO = WS_R1 + (R1_END > R1_H_BYTES ? R1_END : R1_H_BYTES);
#if MOE_F8 && YEXP_F8
constexpr size_t WS_X1H = WS_YEXP + (size_t)NE * MROWS * D_;
constexpr size_t WS_END = WS_YO + al256((size_t)NTOK * D_ * 2);
#else
constexpr size_t WS_X1H = WS_YO + al256((size_t)NTOK * D_ * 2);
constexpr size_t WS_END = WS_X1H + al256((size_t)NTOK * D_ * 2);
#endif
static_assert((size_t)NE * MROWS * D_ >= (size_t)NTOK * D_ * 2, "x1 alias");

constexpr int LDS_BYTES = 144 * 1024;
constexpr int NPH = 10;
constexpr int NPHASES = 1 + DEPTH_ * NPH;

struct Params {
    const float* in[23];
    float* out;
    unsigned char* ws;
    int ph_lo, ph_hi;
};

#ifdef HOST_EMU
#define LAS
static inline unsigned f_as_u(float f) { unsigned u; memcpy(&u, &f, 4); return u; }
static inline float u_as_f(unsigned u) { float f; memcpy(&f, &u, 4); return f; }
static inline float shfl_xor_f(float v, int m) { auto t = emu::wave_all(&v, 4); float r; memcpy(&r, t[emu::lane() ^ m], 4); return r; }
static inline float shfl_up_f(float v, int d) { auto t = emu::wave_all(&v, 4); int l = emu::lane(); float r; memcpy(&r, t[l >= d ? l - d : l], 4); return r; }
static inline float shfl_idx_f(float v, int s) { auto t = emu::wave_all(&v, 4); float r; memcpy(&r, t[s & 63], 4); return r; }
static inline int shfl_idx_i(int v, int s) { auto t = emu::wave_all(&v, 4); int r; memcpy(&r, t[s & 63], 4); return r; }
static inline int rdlane_i(int v, int s) { return shfl_idx_i(v, s); }
static inline float rdlane_f(float v, int s) { return shfl_idx_f(v, s); }
static inline f32x4 mfma16(bf16x8 a, bf16x8 b, f32x4 c) {
    struct { bf16x8 a, b; } d; d.a = a; d.b = b;
    auto t = emu::wave_all(&d, 32);
    int l = emu::lane(), col = l & 15, g = l >> 4;
    for (int r = 0; r < 4; ++r) {
        int row = 4 * g + r; float s = c[r];
        for (int k = 0; k < 32; ++k) {
            unsigned short av, bv;
            memcpy(&av, t[row + 16 * (k >> 3)] + 2 * (k & 7), 2);
            memcpy(&bv, t[col + 16 * (k >> 3)] + 16 + 2 * (k & 7), 2);
            s += u_as_f((unsigned)av << 16) * u_as_f((unsigned)bv << 16);
        }
        c[r] = s;
    }
    return c;
}
static inline void glds16(const void* g, unsigned char* l) { memcpy(l + 16 * emu::lane(), g, 16); }
#define S_BARRIER() __syncthreads()
#define WAIT_V(n)
#define WAIT_L(n)
#define SCHED_BAR()
#define SETPRIO(n)
#define RFL(x) (x)
static inline float fast_exp(float x) { return expf(x); }
static inline float fast_rcp(float x) { return 1.0f / x; }
static inline float fast_exp2(float x) { return exp2f(x); }
static inline float fast_log(float x) { return logf(x); }
#else
#define LAS __attribute__((address_space(3)))
DEV unsigned f_as_u(float f) { return __float_as_uint(f); }
DEV float u_as_f(unsigned u) { return __uint_as_float(u); }
DEV float shfl_xor_f(float v, int m) { return __shfl_xor(v, m, 64); }
DEV float shfl_up_f(float v, int d) { return __shfl_up(v, d, 64); }
DEV float shfl_idx_f(float v, int s) { return __shfl(v, s, 64); }
DEV int shfl_idx_i(int v, int s) { return __shfl(v, s, 64); }
DEV int rdlane_i(int v, int s) { return __builtin_amdgcn_readlane(v, s); }
DEV float rdlane_f(float v, int s) { return __uint_as_float((unsigned)__builtin_amdgcn_readlane((int)__float_as_uint(v), s)); }
DEV f32x4 mfma16(bf16x8 a, bf16x8 b, f32x4 c) { return __builtin_amdgcn_mfma_f32_16x16x32_bf16(a, b, c, 0, 0, 0); }
DEV void glds16(const void* g, LAS unsigned char* l) { __builtin_amdgcn_global_load_lds((const unsigned*)g, (LAS unsigned*)l, 16, 0, 0); }
#define S_BARRIER() __builtin_amdgcn_s_barrier()
#define WAIT_V(n) asm volatile("s_waitcnt vmcnt(" #n ")" ::: "memory")
#define WAIT_L(n) asm volatile("s_waitcnt lgkmcnt(" #n ")" ::: "memory")
#define SCHED_BAR() __builtin_amdgcn_sched_barrier(0)
#define SETPRIO(n) __builtin_amdgcn_s_setprio(n)
#define RFL(x) __builtin_amdgcn_readfirstlane(x)
DEV float fast_exp(float x) { return __expf(x); }
DEV float fast_rcp(float x) { return __builtin_amdgcn_rcpf(x); }
DEV float fast_exp2(float x) { return __builtin_amdgcn_exp2f(x); }
DEV float fast_log(float x) { return __logf(x); }
#endif

#ifdef HOST_EMU
DEV int opaque_tid() { return (int)threadIdx.x; }
#else
DEV int opaque_tid() { int t = threadIdx.x; asm volatile("" : "+v"(t)); return t; }
#endif
#ifdef HOST_EMU
typedef const unsigned char* lds_addr_t;
static inline lds_addr_t lds_addr(const void* p) { return (lds_addr_t)p; }
template <int OFF> static inline bf16x4 tr_read4(lds_addr_t vb) {
    const unsigned char* a = vb + OFF; auto t = emu::wave_all(&a, 8); const int l = emu::lane(), G = l >> 4, i = l & 15; bf16x4 r;
    for (int q = 0; q < 4; ++q) { const unsigned char* src; memcpy(&src, t[16 * G + 4 * q + (i >> 2)], 8); short v; memcpy(&v, src + 2 * (i & 3), 2); r[q] = v; }
    return r; }
#define LGKM_WAIT0()
#define LDS_BARRIER() __syncthreads()
#else
typedef unsigned lds_addr_t;
DEV lds_addr_t lds_addr(const LAS void* p) { return (unsigned)(size_t)p; }
template <int OFF> DEV bf16x4 tr_read4(lds_addr_t vb) { bf16x4 r; asm volatile("ds_read_b64_tr_b16 %0, %1 offset:%2" : "=&v"(r) : "v"(vb), "i"(OFF) : "memory"); return r; }
#define LGKM_WAIT0() do { asm volatile("s_waitcnt lgkmcnt(0)" ::: "memory"); __builtin_amdgcn_sched_barrier(0); } while (0)
#define LDS_BARRIER() do { asm volatile("s_waitcnt lgkmcnt(0)" ::: "memory"); __builtin_amdgcn_s_barrier(); asm volatile("" ::: "memory"); } while (0)
#endif
DEV bf16_t f2bf(float f) { unsigned u = f_as_u(f); u += 0x7FFFu + ((u >> 16) & 1u); return (bf16_t)(u >> 16); }
DEV float bf2f(bf16_t b) { return u_as_f((unsigned)b << 16); }
#ifdef HOST_EMU
DEV unsigned pack2(float lo, float hi) { return (unsigned)f2bf(lo) | ((unsigned)f2bf(hi) << 16); }
#else
DEV unsigned pack2(float lo, float hi) { unsigned r; asm volatile("v_cvt_pk_bf16_f32 %0, %1, %2" : "=v"(r) : "v"(lo), "v"(hi)); return r; }
#endif
DEV float bflo(unsigned u) { return u_as_f(u << 16); }
DEV float bfhi(unsigned u) { return u_as_f(u & 0xFFFF0000u); }
DEV float siluf(float x) { return x / (1.0f + expf(-x)); }
DEV float sigmoidf_(float x) { return 1.0f / (1.0f + expf(-x)); }
DEV float logsigf(float x) { return fminf(x, 0.0f) - log1pf(expf(-fabsf(x))); }
#ifdef HOST_EMU
DEV float xrow16_max(float x) { x = fmaxf(x, shfl_xor_f(x, 16)); return fmaxf(x, shfl_xor_f(x, 32)); }
DEV float xrow16_sum(float x) { x += shfl_xor_f(x, 16); return x + shfl_xor_f(x, 32); }
#else
DEV float xrow16_max(float x) {
    auto s = __builtin_amdgcn_permlane16_swap(__float_as_uint(x), __float_as_uint(x), false, false);
    x = fmaxf(__uint_as_float(s[0]), __uint_as_float(s[1]));
    auto t = __builtin_amdgcn_permlane32_swap(__float_as_uint(x), __float_as_uint(x), false, false);
    return fmaxf(__uint_as_float(t[0]), __uint_as_float(t[1])); }
DEV float xrow16_sum(float x) {
    auto s = __builtin_amdgcn_permlane16_swap(__float_as_uint(x), __float_as_uint(x), false, false);
    x = __uint_as_float(s[0]) + __uint_as_float(s[1]);
    auto t = __builtin_amdgcn_permlane32_swap(__float_as_uint(x), __float_as_uint(x), false, false);
    return __uint_as_float(t[0]) + __uint_as_float(t[1]); }
#endif
#if MOE_F8
constexpr float F8_SW1 = 32.0f, F8_SH = 4.0f, F8_SW2 = 128.0f, F8_SY = 16.0f;
DEV float f8clamp(float x) { return fminf(fmaxf(x, -448.0f), 448.0f); }
DEV unsigned pack4_f8(float a, float b, float c, float d) {
    int p_ = __builtin_amdgcn_cvt_pk_fp8_f32(f8clamp(a), f8clamp(b), 0, false);
    p_ = __builtin_amdgcn_cvt_pk_fp8_f32(f8clamp(c), f8clamp(d), p_, true);
    return (unsigned)p_; }
typedef int i32x4 __attribute__((ext_vector_type(4)));
DEV void mfma_f8(f32x4& c, bf16x8 a0, bf16x8 a1, bf16x8 b0, bf16x8 b1, int sc) {
    i32x4 al, ah, bl, bh; __builtin_memcpy(&al, &a0, 16); __builtin_memcpy(&ah, &a1, 16); __builtin_memcpy(&bl, &b0, 16); __builtin_memcpy(&bh, &b1, 16);
    const i32x8 A = __builtin_shufflevector(al, ah, 0, 1, 2, 3, 4, 5, 6, 7), B = __builtin_shufflevector(bl, bh, 0, 1, 2, 3, 4, 5, 6, 7);
    asm volatile("v_mfma_scale_f32_16x16x128_f8f6f4 %0, %1, %2, %0, %3, %3 op_sel_hi:[0,0,0]" : "+v"(c) : "v"(A), "v"(B), "v"(sc)); }
#define MFMA_DRAIN() asm volatile("s_nop 15\n\ts_nop 15" ::: "memory")
#endif
typedef _Float16 h16x8 __attribute__((ext_vector_type(8)));
DEV u32x4 pack8_h(const float (&v)[8]) { h16x8 h; for (int j = 0; j < 8; ++j) h[j] = (_Float16)v[j]; u32x4 o; __builtin_memcpy(&o, &h, 16); return o; }
DEV void unpack8_h(u32x4 u, float (&v)[8]) { h16x8 h; __builtin_memcpy(&h, &u, 16); for (int j = 0; j < 8; ++j) v[j] = (float)h[j]; }
#ifdef HOST_EMU
DEV bool wave_any(bool b) { float v = b ? 1.f : 0.f; for (int m = 32; m >= 1; m >>= 1) v = fmaxf(v, shfl_xor_f(v, m)); return v > 0.f; }
#else
DEV bool wave_any(bool b) { return __builtin_amdgcn_ballot_w64(b) != 0ull; }
#endif
DEV float silu_fast(float x) { return x * fast_rcp(1.0f + fast_exp(-x)); }
DEV float sigmoid_fast(float x) { return fast_rcp(1.0f + fast_exp(-x)); }
DEV float logsig_fast(float x) { return fminf(x, 0.0f) - fast_log(1.0f + fast_exp(-fabsf(x))); }
#ifdef HOST_EMU
DEV float wave_sum(float v) { for (int m = 32; m >= 1; m >>= 1) v += shfl_xor_f(v, m); return v; }
DEV float wave_max(float v) { for (int m = 32; m >= 1; m >>= 1) v = fmaxf(v, shfl_xor_f(v, m)); return v; }
DEV float xsum32(float a, float b) { const float pa = shfl_xor_f(a, 32), pb = shfl_xor_f(b, 32); return (emu::lane() & 32) ? b + pb : a + pa; }
DEV float xsum16(float a, float b) { const float pa = shfl_xor_f(a, 16), pb = shfl_xor_f(b, 16); return (emu::lane() & 16) ? b + pb : a + pa; }
DEV float xsum8(float a, float b, int lane) { const float pa = shfl_xor_f(a, 8), pb = shfl_xor_f(b, 8); return (lane & 8) ? b + pb : a + pa; }
DEV float xsum4(float a, float b, int lane) { const float pa = shfl_xor_f(a, 4), pb = shfl_xor_f(b, 4); return (lane & 4) ? b + pb : a + pa; }
DEV float quad_sum(float v) { v += shfl_xor_f(v, 1); return v + shfl_xor_f(v, 2); }
#else
template <int CTRL> DEV float dpp_f(float x) { return __uint_as_float((unsigned)__builtin_amdgcn_update_dpp(0, (int)__float_as_uint(x), CTRL, 0xF, 0xF, false)); }
DEV float wave_sum(float v) {
    v += dpp_f<0x128>(v); v += dpp_f<0x124>(v); v += dpp_f<0x122>(v); v += dpp_f<0x121>(v);
    return xrow16_sum(v); }
DEV float wave_max(float v) {
    v = fmaxf(v, dpp_f<0x128>(v)); v = fmaxf(v, dpp_f<0x124>(v)); v = fmaxf(v, dpp_f<0x122>(v)); v = fmaxf(v, dpp_f<0x121>(v));
    return xrow16_max(v); }
DEV float xsum32(float a, float b) { auto s_ = __builtin_amdgcn_permlane32_swap(__float_as_uint(a), __float_as_uint(b), false, false); return __uint_as_float(s_[0]) + __uint_as_float(s_[1]); }
DEV float xsum16(float a, float b) { auto s_ = __builtin_amdgcn_permlane16_swap(__float_as_uint(a), __float_as_uint(b), false, false); return __uint_as_float(s_[0]) + __uint_as_float(s_[1]); }
DEV float xsum8(float a, float b, int lane) { const bool hi = (lane & 8) != 0; return (hi ? b : a) + dpp_f<0x128>(hi ? a : b); }
DEV float xsum4(float a, float b, int lane) { const bool hi = (lane & 4) != 0; return (hi ? b : a) + __shfl_xor(hi ? a : b, 4, 64); }
DEV float quad_sum(float v) { v += dpp_f<0xB1>(v); return v + dpp_f<0x4E>(v); }
#endif

#ifdef HOST_EMU
static std::atomic<unsigned> g_emu_bar{0};
struct XcdBarrier { unsigned n; };
static inline XcdBarrier xcd_barrier_post(unsigned*, unsigned*) { XcdBarrier b; b.n = 0; return b; }
static inline void xcd_barrier(XcdBarrier& b) {
    __syncthreads();
    if (threadIdx.x == 0) { b.n++; g_emu_bar.fetch_add(1); while (g_emu_bar.load() < b.n * gridDim.x) std::this_thread::yield(); }
    __syncthreads();
}
#else
#define XB_TMO      128
#define XB_XCNT(j)  (256  + 64 * (j))
#define XB_XSUB(j)  (1280 + 64 * (j))
#define XB_XGEN(j)  (2304 + 64 * (j))
#define XB_TOP      3328
#define XB_TOPGEN   3392
#define XCD_BAR_WORDS 3456
#define XB_QUEUE     3584
#define XB_SPIN_CAP (1u << 22)
DEV unsigned xb_ld(unsigned* p)              { return __hip_atomic_load(p, __ATOMIC_RELAXED, __HIP_MEMORY_SCOPE_AGENT); }
DEV unsigned xb_add(unsigned* p, unsigned v) { return __hip_atomic_fetch_add(p, v, __ATOMIC_RELAXED, __HIP_MEMORY_SCOPE_AGENT); }
DEV unsigned xb_xcc_id() { return (unsigned)__builtin_amdgcn_s_getreg((3 << 11) | 20) & 0xFu; }
#define XB_SPIN(cond, bar) do { unsigned _sp = 0; while (cond) { __builtin_amdgcn_s_sleep(1); \
    if ((++_sp & 255u) == 0u) { if (xb_ld(&(bar)[XB_TMO])) break; if (_sp > XB_SPIN_CAP) { atomicAdd(&(bar)[XB_TMO], 1u); break; } } } } while (0)
struct XcdBarrier { unsigned* bar; unsigned x; volatile LAS unsigned* st; };
DEV XcdBarrier xcd_barrier_post(unsigned* bar, volatile LAS unsigned* st) {
    XcdBarrier b; b.bar = bar; b.x = xb_xcc_id(); b.st = st;
    if (threadIdx.x == 0) (void)xb_add(&bar[XB_XCNT(b.x)], 1u);
    return b;
}
DEV void xcd_barrier_complete(unsigned* bar, unsigned x, unsigned& nloc, unsigned& nx) {
    const unsigned G = gridDim.x * gridDim.y * gridDim.z;
    unsigned sum, cnt, mine, sp = 0u;
    for (;;) {
        sum = 0u; cnt = 0u; mine = 0u;
#pragma unroll
        for (unsigned j = 0; j < 16; ++j) { const unsigned c = xb_ld(&bar[XB_XCNT(j)]); sum += c; cnt += (c > 0u) ? 1u : 0u; mine = (j == x) ? c : mine; }
        if (sum == G) break;
        __builtin_amdgcn_s_sleep(1);
        if ((++sp & 255u) == 0u) { if (xb_ld(&bar[XB_TMO])) break; if (sp > XB_SPIN_CAP) { atomicAdd(&bar[XB_TMO], 1u); break; } }
    }
    nloc = mine > 0u ? mine : 1u; nx = cnt > 0u ? cnt : 1u;
}
DEV void xcd_barrier(const XcdBarrier& b) {
    asm volatile("s_waitcnt vmcnt(0)" ::: "memory");
    __syncthreads();
    if (threadIdx.x == 0) {
        unsigned* bar = b.bar;
        __builtin_amdgcn_s_waitcnt(0);
        unsigned nloc = b.st[0], nx = b.st[1];
        if (nloc == 0u) { xcd_barrier_complete(bar, b.x, nloc, nx); b.st[0] = nloc; b.st[1] = nx; }
        const unsigned old = xb_add(&bar[XB_XSUB(b.x)], 1u);
        const unsigned gen = old / nloc;
        if (old + 1u == (gen + 1u) * nloc) {
            __builtin_amdgcn_fence(__ATOMIC_RELEASE, "agent");
            asm volatile("s_waitcnt vmcnt(0)" ::: "memory");
            const unsigned og = xb_add(&bar[XB_TOP], 1u);
            const unsigned tg = og / nx;
            if (og + 1u == (tg + 1u) * nx) xb_add(&bar[XB_TOPGEN], 1u);
            else XB_SPIN(xb_ld(&bar[XB_TOPGEN]) == tg, bar);
            __builtin_amdgcn_fence(__ATOMIC_ACQUIRE, "agent");
            xb_add(&bar[XB_XGEN(b.x)], 1u);
            asm volatile("s_waitcnt vmcnt(0)" ::: "memory");
        } else {
            XB_SPIN(xb_ld(&bar[XB_XGEN(b.x)]) == gen, bar);
            __builtin_amdgcn_fence(__ATOMIC_ACQUIRE, "agent");
            asm volatile("s_waitcnt vmcnt(0)" ::: "memory");
        }
    }
    __syncthreads();
}
#endif

namespace pg8 {
constexpr int BM = 256, BK = 64, HALF = 128, HTB = HALF * BK * 2, STAGE_BYTES = 8 * HTB, NXCD = 8, WGM = 8;
DEV int lds_byte(int r, int c) { const int st = (r >> 4) * 2 + (c >> 5), rr = r & 15, cc = c & 31, ob = rr * 64 + cc * 2; return st * 1024 + (ob ^ (((ob >> 9) & 1) << 5)); }
DEV void stage_rc(int b, int& R, int& C) { const int st = b / 1024, sb = b % 1024, swz = sb ^ (((sb >> 9) & 1) << 5); R = (st >> 1) * 16 + swz / 64; C = (st & 1) * 32 + (swz % 64) / 2; }
DEV int perm32(int rho) { const int n = rho >> 4, i = rho & 15; return 8 * (i >> 2) + 4 * n + (i & 3); }

struct Unit { int pm, pn, pb; };
struct Gemm { const bf16_t* A; const bf16_t* Bt; int K; const int* rowtab; };

struct Order {
    int nM, nN, nwg, G, c, mt, mts;
    DEV void init(int ngrp, int mt_, int mts_, int nN_, int G_, int c_) { mt = mt_; mts = mts_; nM = ngrp * mt_; nN = nN_; nwg = nM * nN; G = G_; c = c_; }
    DEV bool next(int i, Unit& u) const {
        const long L = (long)i * G + c; if (L >= nwg) return false;
        int wgid = (int)L; { const int q = nwg / NXCD, r = nwg % NXCD, xcd = wgid % NXCD, off = wgid / NXCD; wgid = (xcd < r ? xcd * (q + 1) : r * (q + 1) + (xcd - r) * q) + off; }
        const int nig = WGM * nN, gid = wgid / nig, fm = gid * WGM, gsz = (nM - fm) < WGM ? (nM - fm) : WGM;
        const int pmv = fm + ((wgid % nig) % gsz); u.pn = (wgid % nig) / gsz;
        const int e = pmv / mt, pl = pmv - e * mt; u.pm = e * mts + pl; u.pb = e * nN + u.pn; return true;
    }
};

template <class Epi, bool GATHER, bool F8 = false>
DEV void gemm_phase(LAS unsigned char* lds, const Gemm g, const Order& S, const Epi& E) {
    const int tid = opaque_tid(), wid = RFL(tid >> 6), lane = tid & 63, wr = wid >> 2, wc = wid & 3, fr = lane & 15, fq = lane >> 4;
    const int K = g.K, nt = K / BK;
    unsigned voffA[2], voffB[2];
#pragma unroll
    for (int i = 0; i < 2; ++i) { int R, C; stage_rc(tid * 16 + i * 8192, R, C); const int Rb = Epi::PERM ? ((R & ~31) + perm32(R & 31)) : R;
        voffA[i] = (unsigned)(R * K + C) * 2u; voffB[i] = (unsigned)(Rb * K + C) * 2u; }
    const size_t kstep = (size_t)(BK * 2);
    const size_t hstep = (size_t)HALF * K * 2;
    const size_t tstep = 2 * hstep;
    const unsigned ldsw = (unsigned)wid * 1024u;
    const int aoff = lds_byte(wr * 64 + fr, fq * 8), boff = lds_byte(wc * 32 + fr, fq * 8);
#define PG8_SA(b, h) (((b) * 2 + (h)) * HTB)
#define PG8_SB(b, h) ((4 + (b) * 2 + (h)) * HTB)
#define PG8_STAGE(bufoff, gbase, voff) do { _Pragma("unroll") for (int _i = 0; _i < 2; ++_i) \
        glds16((const char*)(gbase) + (voff)[_i], lds + (bufoff) + ldsw + _i * 8192); } while (0)
#define PG8_STAGE_A(bufoff, gbase, h, nx) do { _Pragma("unroll") for (int _i = 0; _i < 2; ++_i) { \
        if constexpr (GATHER) glds16((const char*)(gbase) + ((nx) ? na[h][_i] : ca[h][_i]), lds + (bufoff) + ldsw + _i * 8192); \
        else glds16((const char*)(gbase) + (size_t)(h) * hstep + voffA[_i], lds + (bufoff) + ldsw + _i * 8192); } } while (0)
#define PG8_LDA(dst, b, h) do { _Pragma("unroll") for (int m = 0; m < 4; ++m) _Pragma("unroll") for (int k = 0; k < 2; ++k) dst[m][k] = *(const LAS bf16x8*)(lds + PG8_SA(b, h) + aoff + m * 2048 + k * 1024); } while (0)
#define PG8_LDB(dst, b, h) do { _Pragma("unroll") for (int n = 0; n < 2; ++n) _Pragma("unroll") for (int k = 0; k < 2; ++k) dst[n][k] = *(const LAS bf16x8*)(lds + PG8_SB(b, h) + boff + n * 2048 + k * 1024); } while (0)
#if MOE_F8
#define PG8_MMA(ai, bj, At, Bt) do { SETPRIO(1); _Pragma("unroll") for (int m = 0; m < 4; ++m) _Pragma("unroll") for (int n = 0; n < 2; ++n) { \
        if constexpr (F8) mfma_f8(acc[ai][bj][m][n], Bt[n][0], Bt[n][1], At[m][0], At[m][1], f8sc); \
        else { _Pragma("unroll") for (int k = 0; k < 2; ++k) acc[ai][bj][m][n] = mfma16(Bt[n][k], At[m][k], acc[ai][bj][m][n]); } } SETPRIO(0); } while (0)
#else
#define PG8_MMA(ai, bj, At, Bt) do { SETPRIO(1); _Pragma("unroll") for (int m = 0; m < 4; ++m) _Pragma("unroll") for (int n = 0; n < 2; ++n) _Pragma("unroll") for (int k = 0; k < 2; ++k) \
        acc[ai][bj][m][n] = mfma16(Bt[n][k], At[m][k], acc[ai][bj][m][n]); SETPRIO(0); } while (0)
#endif
    Unit cur, nxt; int ui = 0;
    if (!S.next(0, cur)) return;
#if MOE_F8
    int f8sc = 0x7F7F7F7F; asm volatile("" : "+v"(f8sc));
#endif
    f32x4 acc[2][2][4][2];
#pragma unroll
    for (int a = 0; a < 2; ++a)
#pragma unroll
        for (int b = 0; b < 2; ++b)
#pragma unroll
            for (int m = 0; m < 4; ++m)
#pragma unroll
                for (int n = 0; n < 2; ++n) acc[a][b][m][n] = (f32x4){0.f, 0.f, 0.f, 0.f};
    bf16x8 At[4][2], B0[2][2], B1[2][2];
    unsigned ca[2][2], na[2][2];
    const char* cA; const char* nA;
    const char* cB = (const char*)g.Bt + (size_t)cur.pb * tstep;
#define PG8_SETA(u, base, off) do { if constexpr (GATHER) { base = (const char*)g.A; \
            _Pragma("unroll") for (int _h = 0; _h < 2; ++_h) _Pragma("unroll") for (int _i = 0; _i < 2; ++_i) { int _R, _C; stage_rc(tid * 16 + _i * 8192, _R, _C); \
                off[_h][_i] = (unsigned)g.rowtab[(u).pm * 256 + _h * 128 + _R] * (unsigned)(K * 2) + (unsigned)_C * 2u; } } \
        else { base = (const char*)g.A + (size_t)(u).pm * tstep; } } while (0)
    PG8_SETA(cur, cA, ca);
    nA = cA;
    if constexpr (GATHER) {
#pragma unroll
        for (int _h = 0; _h < 2; ++_h)
#pragma unroll
            for (int _i = 0; _i < 2; ++_i) na[_h][_i] = ca[_h][_i]; }
    PG8_STAGE(PG8_SB(0, 0), cB, voffB); PG8_STAGE_A(PG8_SA(0, 0), cA, 0, false); PG8_STAGE(PG8_SB(0, 1), cB + hstep, voffB); PG8_STAGE_A(PG8_SA(0, 1), cA, 1, false);
    if (wr == 1) S_BARRIER();
    WAIT_V(4); S_BARRIER();
    PG8_STAGE(PG8_SB(1, 0), cB + kstep, voffB); PG8_STAGE_A(PG8_SA(1, 0), cA + kstep, 0, false); PG8_STAGE(PG8_SB(1, 1), cB + hstep + kstep, voffB);
    WAIT_V(6); S_BARRIER();
    for (;;) {
        const bool has_next = S.next(ui + 1, nxt);
        const char* nB = cB;
        if (has_next) { PG8_SETA(nxt, nA, na); nB = (const char*)g.Bt + (size_t)nxt.pb * tstep; }
        else { nA = cA;
            if constexpr (GATHER) {
#pragma unroll
                for (int _h = 0; _h < 2; ++_h)
#pragma unroll
                    for (int _i = 0; _i < 2; ++_i) na[_h][_i] = ca[_h][_i]; } }
        for (int t = 0; t < nt; t += 2) {
            const bool last = (t == nt - 2);
            const char* a1 = cA + (size_t)(t + 1) * kstep;
            const char* a2 = last ? nA : cA + (size_t)(t + 2) * kstep; const char* b2 = last ? nB : cB + (size_t)(t + 2) * kstep;
            const char* a3 = a2 + kstep; const char* b3 = b2 + kstep;
            PG8_LDB(B0, 0, 0); SCHED_BAR(); PG8_LDA(At, 0, 0); PG8_STAGE_A(PG8_SA(1, 1), a1, 1, false);
            WAIT_L(8); S_BARRIER(); WAIT_L(0); PG8_MMA(0, 0, At, B0); S_BARRIER(); SCHED_BAR();
            PG8_LDB(B1, 0, 1); PG8_STAGE(PG8_SB(0, 0), b2, voffB);
            S_BARRIER(); WAIT_L(0); PG8_MMA(0, 1, At, B1); S_BARRIER();
            PG8_LDA(At, 0, 1); PG8_STAGE_A(PG8_SA(0, 0), a2, 0, last);
            S_BARRIER(); WAIT_L(0); PG8_MMA(1, 0, At, B0); S_BARRIER(); SCHED_BAR();
            PG8_STAGE(PG8_SB(0, 1), b2 + hstep, voffB);
            WAIT_V(6); S_BARRIER(); PG8_MMA(1, 1, At, B1); S_BARRIER();
            PG8_LDB(B0, 1, 0); SCHED_BAR(); PG8_LDA(At, 1, 0); PG8_STAGE_A(PG8_SA(0, 1), a2, 1, last);
            WAIT_L(8); S_BARRIER(); WAIT_L(0); PG8_MMA(0, 0, At, B0); S_BARRIER(); SCHED_BAR();
            PG8_LDB(B1, 1, 1); PG8_STAGE(PG8_SB(1, 0), b3, voffB);
            S_BARRIER(); WAIT_L(0); PG8_MMA(0, 1, At, B1); S_BARRIER();
            PG8_LDA(At, 1, 1); PG8_STAGE_A(PG8_SA(1, 0), a3, 0, last);
            S_BARRIER(); WAIT_L(0); PG8_MMA(1, 0, At, B0); S_BARRIER(); SCHED_BAR();
            PG8_STAGE(PG8_SB(1, 1), b3 + hstep, voffB);
            WAIT_V(6); S_BARRIER(); PG8_MMA(1, 1, At, B1); S_BARRIER();
        }
#if MOE_F8
        if constexpr (F8) MFMA_DRAIN();
#endif
        E(acc, cur, wr, wc, fr, fq);
        if (!has_next) break;
#pragma unroll
        for (int a = 0; a < 2; ++a)
#pragma unroll
            for (int b = 0; b < 2; ++b)
#pragma unroll
                for (int m = 0; m < 4; ++m)
#pragma unroll
                    for (int n = 0; n < 2; ++n) acc[a][b][m][n] = (f32x4){0.f, 0.f, 0.f, 0.f};
        cur = nxt; cA = nA; cB = nB; ++ui;
        if constexpr (GATHER) {
#pragma unroll
            for (int _h = 0; _h < 2; ++_h)
#pragma unroll
                for (int _i = 0; _i < 2; ++_i) ca[_h][_i] = na[_h][_i]; }
    }
    WAIT_V(0);
    if (wr == 0) S_BARRIER();
    S_BARRIER();
#undef PG8_SA
#undef PG8_SB
#undef PG8_STAGE
#undef PG8_STAGE_A
#undef PG8_LDA
#undef PG8_LDB
#undef PG8_MMA
#undef PG8_SETA
}
}
using pg8::Unit;

struct EpiProj {
    static constexpr bool PERM = true;
    bf16_t* proj; float* gates; const float* bias;
    DEV void operator()(const f32x4 (&acc)[2][2][4][2], const Unit& u, int wr, int wc, int fr, int fq) const {
        const int row0 = u.pm * 256 + wr * 64 + fr; const int colt = u.pn * 256, cl = wc * 32 + 8 * fq;
        if (u.pn < PROJ_N / 256) {
#pragma unroll
            for (int bj = 0; bj < 2; ++bj) { const f32x4 b0 = *(const f32x4*)(bias + colt + cl + bj * 128), b1 = *(const f32x4*)(bias + colt + cl + bj * 128 + 4);
#pragma unroll
                for (int ai = 0; ai < 2; ++ai)
#pragma unroll
                    for (int m = 0; m < 4; ++m) { bf16_t* rowp = proj + (size_t)(row0 + ai * 128 + m * 16) * PROJ_N + colt + cl + bj * 128;
                        const f32x4 v0 = acc[ai][bj][m][0] + b0, v1 = acc[ai][bj][m][1] + b1;
                        u32x4 o; o[0] = pack2(v0[0], v0[1]); o[1] = pack2(v0[2], v0[3]); o[2] = pack2(v1[0], v1[1]); o[3] = pack2(v1[2], v1[3]);
                        *(u32x4*)rowp = o; } }
        } else if (cl < NG) {
            const f32x4 b0 = *(const f32x4*)(bias + colt + cl), b1 = *(const f32x4*)(bias + colt + cl + 4);
#pragma unroll
            for (int ai = 0; ai < 2; ++ai)
#pragma unroll
                for (int m = 0; m < 4; ++m) { float* rowp = gates + (size_t)(row0 + ai * 128 + m * 16) * NG + cl;
                    *(f32x4*)(rowp) = acc[ai][0][m][0] + b0; *(f32x4*)(rowp + 4) = acc[ai][0][m][1] + b1; }
        }
    }
};
struct EpiSwiglu {
    static constexpr bool PERM = true;
    bf16_t* h;
    DEV void operator()(const f32x4 (&acc)[2][2][4][2], const Unit& u, int wr, int wc, int fr, int fq) const {
        const int row0 = u.pm * 256 + wr * 64 + fr; const int col0 = u.pn * 128 + wc * 32 + 8 * fq;
#if MOE_F8
        unsigned char* h8 = (unsigned char*)h;
        constexpr float isw = 1.0f / F8_SW1, kd = F8_SW1 * F8_SW1 / F8_SH;
#pragma unroll
        for (int ai = 0; ai < 2; ++ai)
#pragma unroll
            for (int m = 0; m < 4; ++m) { unsigned char* rowp = h8 + (size_t)(row0 + ai * 128 + m * 16) * FF + col0;
                float v[8];
#pragma unroll
                for (int n = 0; n < 2; ++n)
#pragma unroll
                    for (int j = 0; j < 4; ++j) {
                        const float e = fast_exp2(acc[ai][0][m][n][j] * (-isw * 1.44269504f)); v[n * 4 + j] = acc[ai][0][m][n][j] * acc[ai][1][m][n][j] * fast_rcp(e * kd + kd); }
                u32x2 o; o[0] = pack4_f8(v[0], v[1], v[2], v[3]); o[1] = pack4_f8(v[4], v[5], v[6], v[7]);
                *(u32x2*)rowp = o; }
        return;
#endif
#pragma unroll
        for (int ai = 0; ai < 2; ++ai)
#pragma unroll
            for (int m = 0; m < 4; ++m) { bf16_t* rowp = h + (size_t)(row0 + ai * 128 + m * 16) * FF + col0;
                float v[8];
#pragma unroll
                for (int n = 0; n < 2; ++n)
#pragma unroll
                    for (int j = 0; j < 4; ++j) { const float gt = acc[ai][0][m][n][j], up = acc[ai][1][m][n][j]; v[n * 4 + j] = gt * fast_rcp(1.0f + fast_exp(-gt)) * up; }
                u32x4 o; o[0] = pack2(v[0], v[1]); o[1] = pack2(v[2], v[3]); o[2] = pack2(v[4], v[5]); o[3] = pack2(v[6], v[7]);
                *(u32x4*)rowp = o; }
    }
};
template <bool F8OUT>
struct EpiDown {
    static constexpr bool PERM = true;
    bf16_t* y; float sc;
    DEV void operator()(const f32x4 (&acc)[2][2][4][2], const Unit& u, int wr, int wc, int fr, int fq) const {
        const int row0 = u.pm * 256 + wr * 64 + fr; const int col0 = u.pn * 256 + wc * 32 + 8 * fq;
#pragma unroll
        for (int ai = 0; ai < 2; ++ai)
#pragma unroll
            for (int m = 0; m < 4; ++m) {
#pragma unroll
                for (int bj = 0; bj < 2; ++bj) {
                    const f32x4 v0 = acc[ai][bj][m][0] * sc, v1 = acc[ai][bj][m][1] * sc;
#if MOE_F8
                    if constexpr (F8OUT) { unsigned char* rowp = (unsigned char*)y + (size_t)(row0 + ai * 128 + m * 16) * D_ + col0;
                        u32x2 o; o[0] = pack4_f8(v0[0], v0[1], v0[2], v0[3]); o[1] = pack4_f8(v1[0], v1[1], v1[2], v1[3]);
                        *(u32x2*)(rowp + bj * 128) = o; }
                    else
#endif
                    { bf16_t* rowp = y + (size_t)(row0 + ai * 128 + m * 16) * D_ + col0;
                        u32x4 o; o[0] = pack2(v0[0], v0[1]); o[1] = pack2(v0[2], v0[3]); o[2] = pack2(v1[0], v1[1]); o[3] = pack2(v1[2], v1[3]);
                        *(u32x4*)(rowp + bj * 128) = o; } } }
    }
};

DEV void phase_mods(const Params& p, LAS unsigned char* lds) {
    LAS float* sc = (LAS float*)lds;
    const int tid = opaque_tid(), col = tid & 63, ks = tid >> 6;
    float* mods = (float*)(p.ws + WS_MODS);
    constexpr int NB = B_ + 1;
    for (int u = blockIdx.x; u < DEPTH_ * 96; u += gridDim.x) {
        const int l = u / 96, cb = (u % 96) * 64;
        __syncthreads();
        for (int i = tid; i < NB * 1024; i += 512) { const int bb = i >> 10, k = i & 1023; const float cv = bb < B_ ? p.in[1][(size_t)bb * 1024 + k] : p.in[3][k]; sc[i] = siluf(cv); }
        __syncthreads();
        float acc[NB];
#pragma unroll
        for (int bb = 0; bb < NB; ++bb) acc[bb] = 0.f;
        const float* w = p.in[4] + (size_t)l * 1024 * 6144 + cb + col;
        for (int k = ks * 128; k < ks * 128 + 128; ++k) { const float wv = w[(size_t)k * 6144];
#pragma unroll
            for (int bb = 0; bb < NB; ++bb) acc[bb] += sc[bb * 1024 + k] * wv; }
        __syncthreads();
#pragma unroll
        for (int bb = 0; bb < NB; ++bb) sc[(ks * NB + bb) * 64 + col] = acc[bb];
        __syncthreads();
        for (int i = tid; i < NB * 64; i += 512) { const int bb = i >> 6, c2 = i & 63; float s = p.in[5][(size_t)l * 6144 + cb + c2];
            for (int q = 0; q < 8; ++q) s += sc[(q * NB + bb) * 64 + c2];
            mods[((size_t)l * NB + bb) * 6144 + cb + c2] = s; }
    }
    if (blockIdx.x == gridDim.x - 1) {
        float* rope = (float*)(p.ws + WS_ROPE);
        for (int i = tid; i < 64 * 16; i += 512) { const int pos = i >> 4, f = i & 15; const float inv = powf(10000.0f, -(float)f / 16.0f); const float a = (float)pos * inv; rope[i * 2] = cosf(a); rope[i * 2 + 1] = sinf(a); }
        for (int i = tid; i < 64 * 8; i += 512) { const int pos = i >> 3, f = i & 7; const float inv = powf(10000.0f, -(float)f / 8.0f); const float a = (float)pos * inv; rope[2048 + i * 2] = cosf(a); rope[2048 + i * 2 + 1] = sinf(a); }
    }
}

DEV int win_srccol(int n) {
    if (n < 1024) return n; if (n < 1792) return n + 16; if (n < 3328) return n + 48;
    if (n < 3344) return 1024 + (n - 3328); if (n < 3376) return 1808 + (n - 3344); return -1;
}
template <bool WIN>
DEV void conv_tile(const float* src, int ldn, int srcc0, bf16_t* dst, int ldk, int n0, int k0, LAS float* tile) {
    const int tid = opaque_tid(), nn = tid & 63, kk = tid >> 6;
    int sc_ = WIN ? win_srccol(n0 + nn) : srcc0 + nn;
#pragma unroll
    for (int i = 0; i < 8; ++i) { const int k = kk + 8 * i; tile[k * 65 + nn] = sc_ >= 0 ? src[(size_t)(k0 + k) * ldn + sc_] : 0.f; }
    __syncthreads();
    { const int n = tid >> 3, k8 = (tid & 7) * 8; float v[8];
#pragma unroll
      for (int j = 0; j < 8; ++j) v[j] = tile[(k8 + j) * 65 + n];
      u32x4 o; o[0] = pack2(v[0], v[1]); o[1] = pack2(v[2], v[3]); o[2] = pack2(v[4], v[5]); o[3] = pack2(v[6], v[7]);
      *(u32x4*)(dst + (size_t)(n0 + n) * ldk + k0 + k8) = o; }
    __syncthreads();
}
#if MOE_F8
constexpr float F8_SW1_ = F8_SW1, F8_SW2_ = F8_SW2;
#else
constexpr float F8_SW1_ = 0.f, F8_SW2_ = 0.f;
#endif
struct ConvTile { const float* s0; const float* s1; int ld; bf16_t* dst; int ldk; int n0, k0; int kind; };
#ifdef HOST_EMU
template <class T> static inline T* rfl_ptr(T* q) { return q; }
#else
template <class T> DEV T* rfl_ptr(T* q) { const unsigned long long v = (unsigned long long)q; const unsigned lo = (unsigned)RFL((int)(unsigned)v), hi = (unsigned)RFL((int)(unsigned)(v >> 32)); return (T*)(((unsigned long long)hi << 32) | lo); }
#endif
DEV ConvTile conv_desc(const Params& p, int l, int t_) {
    const int t = RFL(t_);
    ConvTile c;
    bf16_t* btin = (bf16_t*)(p.ws + WS_BTIN); bf16_t* btout = (bf16_t*)(p.ws + WS_BTOUT); bf16_t* btgu = (bf16_t*)(p.ws + WS_BTGU); bf16_t* btdn = (bf16_t*)(p.ws + WS_BTDN);
    const float* w_in = p.in[6] + (size_t)l * D_ * PROJ_W0; const float* w_out = p.in[14] + (size_t)l * D_ * D_;
    const float* w_gate = p.in[18] + (size_t)l * NE * D_ * FF; const float* w_up = p.in[19] + (size_t)l * NE * D_ * FF; const float* w_down = p.in[20] + (size_t)l * NE * FF * D_;
    constexpr int T_IN = 13 * 16, T_OUT = 4 * 16, T_GU = NE * 16 * 16;
    if (t < T_IN) { const int nb = t / 16, kt = t % 16; const int sc = win_srccol(nb * 256);
        c.kind = 0; c.s0 = w_in + sc; c.s1 = w_in + sc + 128; c.ld = PROJ_W0; c.dst = btin; c.ldk = D_; c.n0 = nb * 256; c.k0 = kt * 64; }
    else if (t < T_IN + T_OUT) { const int q = t - T_IN, nb = q / 16, kt = q % 16;
        c.kind = 0; c.s0 = w_out + nb * 256; c.s1 = c.s0 + 128; c.ld = D_; c.dst = btout; c.ldk = D_; c.n0 = nb * 256; c.k0 = kt * 64; }
    else if (t < T_IN + T_OUT + T_GU) { const int q = t - T_IN - T_OUT, e = q / 256, r = q % 256, nb = r / 16, kt = r % 16;
        c.kind = MOE_F8 ? 1 : 0; c.s0 = w_gate + (size_t)e * D_ * FF + nb * 128; c.s1 = w_up + (size_t)e * D_ * FF + nb * 128; c.ld = FF; c.dst = btgu + (size_t)e * 2 * FF * D_ / (MOE_F8 ? 2 : 1); c.ldk = D_; c.n0 = nb * 256; c.k0 = kt * 64; }
    else { const int q = t - T_IN - T_OUT - T_GU, e = q / 128, r = q % 128, nb = r / 32, kt = r % 32;
        c.kind = MOE_F8 ? 2 : 0; c.s0 = w_down + (size_t)e * FF * D_ + nb * 256; c.s1 = c.s0 + 128; c.ld = D_; c.dst = btdn + (size_t)e * D_ * FF / (MOE_F8 ? 2 : 1); c.ldk = FF; c.n0 = nb * 256; c.k0 = kt * 64; }
    c.s0 = rfl_ptr(c.s0); c.s1 = rfl_ptr(c.s1); c.dst = rfl_ptr(c.dst); c.ld = RFL(c.ld); c.ldk = RFL(c.ldk); c.n0 = RFL(c.n0); c.k0 = RFL(c.k0); c.kind = RFL(c.kind);
    return c;
}
DEV void conv_issue(const ConvTile& c, f32x4 (&r)[8], int tid) {
    const int nn4 = (tid & 63) * 4; const float* src = (nn4 < 128 ? c.s0 + nn4 : c.s1 + (nn4 - 128)) + (size_t)(c.k0 + (tid >> 6)) * c.ld;
#pragma unroll
    for (int i = 0; i < 8; ++i) r[i] = *(const f32x4*)(src + (size_t)(8 * i) * c.ld);
}
DEV void conv_finish(const ConvTile& c, const f32x4 (&r)[8], LAS float* tile, int tid) {
    const int nn4 = (tid & 63) * 4, kk = tid >> 6;
#pragma unroll
    for (int i = 0; i < 8; ++i) { LAS float* d = tile + (kk + 8 * i) * 257 + nn4; d[0] = r[i][0]; d[1] = r[i][1]; d[2] = r[i][2]; d[3] = r[i][3]; }
    __syncthreads();
#if MOE_F8
    if (c.kind != 0) { const int n = tid >> 1, kh = (tid & 1) * 32; unsigned char* drow = (unsigned char*)c.dst + (size_t)(c.n0 + n) * c.ldk + c.k0 + kh;
#pragma unroll
      for (int q = 0; q < 2; ++q) { float v[16];
          if (c.kind == 1) {
#pragma unroll
              for (int j = 0; j < 16; ++j) v[j] = tile[(kh + 16 * q + j) * 257 + n] * F8_SW1; }
          else {
#pragma unroll
              for (int j = 0; j < 16; ++j) v[j] = tile[(kh + 16 * q + j) * 257 + n] * F8_SW2; }
          u32x4 o; o[0] = pack4_f8(v[0], v[1], v[2], v[3]); o[1] = pack4_f8(v[4], v[5], v[6], v[7]); o[2] = pack4_f8(v[8], v[9], v[10], v[11]); o[3] = pack4_f8(v[12], v[13], v[14], v[15]);
          *(u32x4*)(drow + 16 * q) = o; } }
    else
#endif
    { const int n = tid >> 1, kh = (tid & 1) * 32; bf16_t* drow = c.dst + (size_t)(c.n0 + n) * c.ldk + c.k0 + kh;
#pragma unroll
      for (int q = 0; q < 4; ++q) { float v[8];
#pragma unroll
          for (int j = 0; j < 8; ++j) v[j] = tile[(kh + 8 * q + j) * 257 + n];
          u32x4 o; o[0] = pack2(v[0], v[1]); o[1] = pack2(v[2], v[3]); o[2] = pack2(v[4], v[5]); o[3] = pack2(v[6], v[7]);
          *(u32x4*)(drow + 8 * q) = o; } }
    __syncthreads();
}
DEV void phase_convert(const Params& p, int l, LAS unsigned char* lds) {
    LAS float* tile = (LAS float*)lds;
    const int tid = opaque_tid();
    constexpr int T_MAIN = 13 * 16 + 4 * 16 + NE * 16 * 16 + NE * 4 * 32;
    {
        f32x4 ra[8], rb[8];
        int t = blockIdx.x;
        ConvTile ca, cb;
        if (t < T_MAIN) { ca = conv_desc(p, l, t); conv_issue(ca, ra, tid); }
        while (t < T_MAIN) {
            const int t1 = t + gridDim.x;
            if (t1 < T_MAIN) { cb = conv_desc(p, l, t1); conv_issue(cb, rb, tid); }
            conv_finish(ca, ra, tile, tid);
            const int t2 = t1 + gridDim.x;
            if (t1 < T_MAIN) { if (t2 < T_MAIN) { ca = conv_desc(p, l, t2); conv_issue(ca, ra, tid); } conv_finish(cb, rb, tile, tid); }
            t = t2;
        }
    }
    { bf16_t* btin = (bf16_t*)(p.ws + WS_BTIN); const float* w_in = p.in[6] + (size_t)l * D_ * PROJ_W0;
      for (int t = blockIdx.x; t < 4 * 16; t += gridDim.x) conv_tile<true>(w_in, PROJ_W0, 0, btin, D_, PROJ_N + (t / 16) * 64, (t % 16) * 64, tile); }
    if (blockIdx.x == 0) { float* bias = (float*)(p.ws + WS_BIAS); const float* b_in = p.in[7] + (size_t)l * PROJ_W0;
        for (int i = tid; i < PROJ_NP; i += 512) { const int s = win_srccol(i); bias[i] = s >= 0 ? b_in[s] : 0.f; } }
    if (l == 0) {
        const float* mods = (const float*)(p.ws + WS_MODS); bf16_t* ub = (bf16_t*)(p.ws + WS_U);
        const int lane = tid & 63, gw = blockIdx.x * 8 + (tid >> 6), nw = gridDim.x * 8;
        for (int row = gw; row < NTOK; row += nw) {
            const bool isl = row < NL; const int bb = isl ? row / T_ : B_;
            const float* xr = isl ? p.in[0] + (size_t)row * D_ : p.in[2] + (size_t)(row - NL) * D_;
            const float* md = mods + (size_t)bb * 6144;
#pragma unroll
            for (int i = 0; i < 2; ++i) { const int c = lane * 8 + i * 512;
                const f32x4 x0 = *(const f32x4*)(xr + c), x1 = *(const f32x4*)(xr + c + 4), s0 = *(const f32x4*)(md + 1024 + c), s1 = *(const f32x4*)(md + 1024 + c + 4), h0 = *(const f32x4*)(md + c), h1 = *(const f32x4*)(md + c + 4);
                const f32x4 a = x0 * (s0 + 1.0f) + h0, b = x1 * (s1 + 1.0f) + h1;
                u32x4 o; o[0] = pack2(a[0], a[1]); o[1] = pack2(a[2], a[3]); o[2] = pack2(b[0], b[1]); o[3] = pack2(b[2], b[3]);
                *(u32x4*)(ub + (size_t)row * D_ + c) = o; }
        }
    }
}

DEV int tok_row(bool lat, int b, int pos) { return lat ? b * T_ + pos : NL + b * TC_ + pos; }
DEV bf16x8 lds_frag(const LAS bf16_t* base, int row, int stride, int col) { return *(const LAS bf16x8*)(base + row * stride + col); }

#ifdef HOST_EMU
#define WAVE_SYNC() do { int z_ = 0; (void)emu::wave_all(&z_, 4); } while (0)
#else
#define WAVE_SYNC() __builtin_amdgcn_wave_barrier()
#endif
#ifdef HOST_EMU
DEV void wg_release_acquire() { __syncthreads(); }
#else
DEV void wg_release_acquire() {
    __builtin_amdgcn_fence(__ATOMIC_RELEASE, "workgroup"); asm volatile("s_waitcnt vmcnt(0)" ::: "memory"); __syncthreads();
    __builtin_amdgcn_fence(__ATOMIC_ACQUIRE, "agent"); asm volatile("s_waitcnt vmcnt(0)" ::: "memory"); }
#endif
DEV void merge_head(const Params& p, int l, int b, int part, int h, int tid) {
    const bool need_ctx = l < DEPTH_ - 1;
    const bf16_t* proj = (const bf16_t*)(p.ws + WS_R1 + R1_PROJ); bf16_t* ymix = (bf16_t*)(p.ws + WS_YMIX);
    const bf16_t* o0 = (const bf16_t*)(p.ws + WS_R1 + (part ? R1_OG : R1_OM)); const bf16_t* o1 = o0 + (size_t)NTOK * 256;
    const int ch = h * 64 + (tid & 7) * 8;
    const float* gn = (part ? p.in[12] : p.in[11]) + (size_t)l * 256 + ch;
    const f32x4 g0 = *(const f32x4*)gn, g1 = *(const f32x4*)(gn + 4);
    const int ntk = T_ + (need_ctx ? TC_ : 0);
    for (int i0 = tid >> 3; i0 < ntk; i0 += 256) {
        int rows[4]; u32x4 oa[4], ob[4]; u32x4 gtv[4];
#pragma unroll
        for (int k = 0; k < 4; ++k) { const int i = i0 + 64 * k; const int row = i < T_ ? b * T_ + i : NL + b * TC_ + (i - T_); rows[k] = row;
            oa[k] = *(const u32x4*)(o0 + (size_t)row * 256 + ch); ob[k] = *(const u32x4*)(o1 + (size_t)row * 256 + ch);
            gtv[k] = *(const u32x4*)(proj + (size_t)row * PROJ_N + (part ? C_GR : C_MO) + ch); }
#pragma unroll
        for (int k = 0; k < 4; ++k) {
            const f32x4 x0 = (f32x4){bflo(oa[k][0]) + bflo(ob[k][0]), bfhi(oa[k][0]) + bfhi(ob[k][0]), bflo(oa[k][1]) + bflo(ob[k][1]), bfhi(oa[k][1]) + bfhi(ob[k][1])};
            const f32x4 x1 = (f32x4){bflo(oa[k][2]) + bflo(ob[k][2]), bfhi(oa[k][2]) + bfhi(ob[k][2]), bflo(oa[k][3]) + bflo(ob[k][3]), bfhi(oa[k][3]) + bfhi(ob[k][3])};
            float s = x0[0] + x0[1] + x0[2] + x0[3] + x1[0] + x1[1] + x1[2] + x1[3];
            s += shfl_xor_f(s, 1); s += shfl_xor_f(s, 2); s += shfl_xor_f(s, 4);
            const float mu = s * (1.0f / 64.0f);
            const f32x4 d0 = x0 - mu, d1 = x1 - mu;
            float q = d0[0] * d0[0] + d0[1] * d0[1] + d0[2] * d0[2] + d0[3] * d0[3] + d1[0] * d1[0] + d1[1] * d1[1] + d1[2] * d1[2] + d1[3] * d1[3];
            q += shfl_xor_f(q, 1); q += shfl_xor_f(q, 2); q += shfl_xor_f(q, 4);
            const float rstd = 1.0f / sqrtf(q * (1.0f / 64.0f) + LN_EPS);
            float gv[8];
#pragma unroll
            for (int j = 0; j < 4; ++j) { gv[2 * j] = bflo(gtv[k][j]); gv[2 * j + 1] = bfhi(gtv[k][j]); }
            float y[8];
#pragma unroll
            for (int j = 0; j < 8; ++j) { const float nv = (j < 4 ? d0[j] : d1[j - 4]) * rstd * (j < 4 ? g0[j] : g1[j - 4]); y[j] = nv * (part ? silu_fast(gv[j]) : sigmoid_fast(gv[j])); }
            u32x4 ov; ov[0] = pack2(y[0], y[1]); ov[1] = pack2(y[2], y[3]); ov[2] = pack2(y[4], y[5]); ov[3] = pack2(y[6], y[7]);
            *(u32x4*)(ymix + (size_t)rows[k] * D_ + part * 256 + ch) = ov;
        }
    }
}

struct MlItem { u32x2 q1[3], q2[3], k1[3], k2[3]; };
struct MlChunk { u32x2 q[2][2], k[2][2]; u32x4 v[2]; float gtv, g_pt, cm63; };
DEV void mlstm_unit(const Params& p, int l, int b, int h, LAS unsigned char* lds) {
    constexpr int ST = 72;
    constexpr int DSZ = 4 * 64 * ST * 2 + 2 * 80 * ST * 2 + 3 * 64 * 4 + 3 * 128 * 4;
    static_assert(2 * DSZ <= LDS_BYTES - 32, "mlstm lds");
    const int tid = opaque_tid(), lane = tid & 63, w = tid >> 6, dir = w >> 2, wh = w & 3, t4 = tid & 255, fr = lane & 15, fq = lane >> 4;
    LAS unsigned char* db = lds + dir * DSZ;
    LAS bf16_t* Qs = (LAS bf16_t*)db;
    LAS bf16_t* Ks = Qs + 64 * ST;
    LAS bf16_t* KT = Ks + 64 * ST;
    LAS bf16_t* Ps = KT + 64 * ST;
    LAS bf16_t* VT = Ps + 64 * ST;
    LAS bf16_t* Cs = VT + 80 * ST;
    LAS float* gt = (LAS float*)(Cs + 80 * ST);
    LAS float* cw = gt + 3 * 64;
    const bf16_t* proj = (const bf16_t*)(p.ws + WS_R1 + R1_PROJ); const float* gates = (const float*)(p.ws + WS_R1 + R1_GATES);
    bf16_t* qk2 = (bf16_t*)(p.ws + WS_R1 + R1_QK2);
    bf16_t* om = (bf16_t*)(p.ws + WS_R1 + R1_OM) + (size_t)dir * NTOK * 256;
    float* gbuf = (float*)(p.ws + WS_GSCAN) + (size_t)((b * 4 + h) * 2 + dir) * NCH * 192;
    const float* ropeM = (const float*)(p.ws + WS_ROPE);
    __syncthreads();
    for (int i = t4; i < 3 * 128; i += 256) { const int j = i / 128, c = i % 128; cw[i] = p.in[8][((size_t)l * 3 + j) * 512 + (c < 64 ? h * 64 + c : 256 + h * 64 + (c - 64))]; }
    for (int i = t4; i < 80 * ST; i += 256) Cs[i] = 0;
    for (int i = t4; i < 16 * ST; i += 256) VT[64 * ST + i] = (bf16_t)0x3F80;
    for (int c0 = wh; c0 < NCH; c0 += 12) {
        float ig[3], fg[3];
#pragma unroll
        for (int k = 0; k < 3; ++k) { const int c = c0 + 4 * k; ig[k] = fg[k] = 0.f;
            if (c < NCH) { const bool lat = c >= NCH_C; const int cc = lat ? c - NCH_C : c; const int Ts = lat ? T_ : TC_;
                const int sp = dir == 0 ? cc * 64 + lane : Ts - 1 - (cc * 64 + lane);
                const float* gr = gates + (size_t)tok_row(lat, b, sp) * NG + dir * 8 + h; ig[k] = gr[0]; fg[k] = gr[4]; } }
#pragma unroll
        for (int k = 0; k < 3; ++k) { const int c = c0 + 4 * k;
            if (c < NCH) {
                float bs = logsigf(fg[k]);
                for (int d = 1; d < 64; d <<= 1) { const float o = shfl_up_f(bs, d); if (lane >= d) bs += o; }
                const float g = ig[k] - bs;
                float cm = g;
                for (int d = 1; d < 64; d <<= 1) { const float o = shfl_up_f(cm, d); if (lane >= d) cm = fmaxf(cm, o); }
                gbuf[c * 192 + lane] = bs; gbuf[c * 192 + 64 + lane] = g; gbuf[c * 192 + 128 + lane] = cm; } }
    }
    __syncthreads();
    {
        constexpr int NIT = (TC_ + T_) * 8;
        auto item_load = [&](int it, MlItem& R) {
            const int tk = it >> 3, pg = it & 7; const bool lat = tk >= TC_; const int sp = lat ? tk - TC_ : tk, Ts = lat ? T_ : TC_;
            const int hf = pg >> 2, i0 = 4 * (pg & 3), dA = 32 * hf + i0, dB = dA + 16;
#pragma unroll
            for (int tap = 0; tap < 3; ++tap) { const int sp2 = sp + tap - 1; const bool ok = sp2 >= 0 && sp2 < Ts; const int spc = ok ? sp2 : sp;
                const bf16_t* pr = proj + (size_t)tok_row(lat, b, spc) * PROJ_N + h * 64;
                const u32x2 z = (u32x2){0u, 0u};
                const u32x2 a = *(const u32x2*)(pr + C_MQ + dA), bq = *(const u32x2*)(pr + C_MQ + dB), c = *(const u32x2*)(pr + C_MK + dA), d = *(const u32x2*)(pr + C_MK + dB);
                R.q1[tap] = ok ? a : z; R.q2[tap] = ok ? bq : z; R.k1[tap] = ok ? c : z; R.k2[tap] = ok ? d : z; } };
        auto item_finish = [&](int it, const MlItem& R) {
            const int tk = it >> 3, pg = it & 7; const bool lat = tk >= TC_; const int sp = lat ? tk - TC_ : tk;
            const int hf = pg >> 2, i0 = 4 * (pg & 3), dA = 32 * hf + i0, dB = dA + 16;
            float qa[4], qb[4], ka[4], kb[4];
#pragma unroll
            for (int j = 0; j < 4; ++j) { qa[j] = qb[j] = ka[j] = kb[j] = 0.f; }
#pragma unroll
            for (int tap = 0; tap < 3; ++tap) { const LAS float* wq = cw + tap * 128;
                qa[0] += wq[dA] * bflo(R.q1[tap][0]); qa[1] += wq[dA + 1] * bfhi(R.q1[tap][0]); qa[2] += wq[dA + 2] * bflo(R.q1[tap][1]); qa[3] += wq[dA + 3] * bfhi(R.q1[tap][1]);
                qb[0] += wq[dB] * bflo(R.q2[tap][0]); qb[1] += wq[dB + 1] * bfhi(R.q2[tap][0]); qb[2] += wq[dB + 2] * bflo(R.q2[tap][1]); qb[3] += wq[dB + 3] * bfhi(R.q2[tap][1]);
                ka[0] += wq[64 + dA] * bflo(R.k1[tap][0]); ka[1] += wq[64 + dA + 1] * bfhi(R.k1[tap][0]); ka[2] += wq[64 + dA + 2] * bflo(R.k1[tap][1]); ka[3] += wq[64 + dA + 3] * bfhi(R.k1[tap][1]);
                kb[0] += wq[64 + dB] * bflo(R.k2[tap][0]); kb[1] += wq[64 + dB + 1] * bfhi(R.k2[tap][0]); kb[2] += wq[64 + dB + 2] * bflo(R.k2[tap][1]); kb[3] += wq[64 + dB + 3] * bfhi(R.k2[tap][1]); }
#pragma unroll
            for (int j = 0; j < 4; ++j) { qa[j] = silu_fast(qa[j]); qb[j] = silu_fast(qb[j]); ka[j] = silu_fast(ka[j]) * 0.125f; kb[j] = silu_fast(kb[j]) * 0.125f; }
            if (lat) { const int pos = hf == 0 ? (sp >> 6) : (sp & 63);
#pragma unroll
                for (int j = 0; j < 4; ++j) { const float cs = ropeM[(pos * 16 + i0 + j) * 2], sn = ropeM[(pos * 16 + i0 + j) * 2 + 1];
                    const float q1 = qa[j] * cs - qb[j] * sn, q2 = qa[j] * sn + qb[j] * cs; qa[j] = q1; qb[j] = q2;
                    const float k1 = ka[j] * cs - kb[j] * sn, k2 = ka[j] * sn + kb[j] * cs; ka[j] = k1; kb[j] = k2; } }
            bf16_t* dst = qk2 + (size_t)tok_row(lat, b, sp) * 512 + h * 128;
            u32x2 o;
            o[0] = pack2(qa[0], qa[1]); o[1] = pack2(qa[2], qa[3]); *(u32x2*)(dst + dA) = o;
            o[0] = pack2(qb[0], qb[1]); o[1] = pack2(qb[2], qb[3]); *(u32x2*)(dst + dB) = o;
            o[0] = pack2(ka[0], ka[1]); o[1] = pack2(ka[2], ka[3]); *(u32x2*)(dst + 64 + dA) = o;
            o[0] = pack2(kb[0], kb[1]); o[1] = pack2(kb[2], kb[3]); *(u32x2*)(dst + 64 + dB) = o; };
        for (int it0 = tid; it0 < NIT; it0 += 1024) {
            MlItem A, B; const bool two = it0 + 512 < NIT;
            item_load(it0, A); if (two) item_load(it0 + 512, B);
            item_finish(it0, A); if (two) item_finish(it0 + 512, B);
        }
    }
    wg_release_acquire();
    f32x4 cacc[5];
#pragma unroll
    for (int i = 0; i < 5; ++i) cacc[i] = (f32x4){0.f, 0.f, 0.f, 0.f};
    const int ti = wh;
    const int pt = t4 >> 2, pgq = t4 & 3;
    float m_in = 0.f;
    auto chunk_load = [&](int c, MlChunk& R) {
        const bool lat = c >= NCH_C; const int cc = lat ? c - NCH_C : c; const int Ts = lat ? T_ : TC_;
        const int sp = dir == 0 ? cc * 64 + pt : Ts - 1 - (cc * 64 + pt);
        const size_t row = (size_t)tok_row(lat, b, sp);
#pragma unroll
        for (int sub = 0; sub < 2; ++sub) { const int pg = pgq * 2 + sub; const int hf = pg >> 2, i0 = 4 * (pg & 3), dA = 32 * hf + i0, dB = dA + 16;
            const bf16_t* src = qk2 + row * 512 + h * 128;
            R.q[sub][0] = *(const u32x2*)(src + dA); R.q[sub][1] = *(const u32x2*)(src + dB); R.k[sub][0] = *(const u32x2*)(src + 64 + dA); R.k[sub][1] = *(const u32x2*)(src + 64 + dB);
            R.v[sub] = *(const u32x4*)(proj + row * PROJ_N + C_MV + h * 64 + pg * 8); }
        R.gtv = gbuf[c * 192 + (t4 < 192 ? t4 : 0)]; R.g_pt = gbuf[c * 192 + 64 + pt]; R.cm63 = gbuf[c * 192 + 128 + 63]; };
    MlChunk cur, nxt;
    chunk_load(0, cur); nxt = cur;
    for (int c = 0; c < NCH; ++c) {
        const bool lat = c >= NCH_C; const int cc = lat ? c - NCH_C : c; const int Ts = lat ? T_ : TC_;
        {
            if (t4 < 192) gt[t4] = cur.gtv;
            const float wsc = fast_exp(cur.g_pt - fmaxf(m_in, cur.cm63));
#pragma unroll
            for (int sub = 0; sub < 2; ++sub) { const int pg = pgq * 2 + sub; const int hf = pg >> 2, i0 = 4 * (pg & 3), dA = 32 * hf + i0, dB = dA + 16;
                *(LAS u32x2*)(Qs + pt * ST + dA) = cur.q[sub][0]; *(LAS u32x2*)(Qs + pt * ST + dB) = cur.q[sub][1];
                *(LAS u32x2*)(Ks + pt * ST + dA) = cur.k[sub][0]; *(LAS u32x2*)(Ks + pt * ST + dB) = cur.k[sub][1];
                const float ka[4] = {bflo(cur.k[sub][0][0]), bfhi(cur.k[sub][0][0]), bflo(cur.k[sub][0][1]), bfhi(cur.k[sub][0][1])};
                const float kb[4] = {bflo(cur.k[sub][1][0]), bfhi(cur.k[sub][1][0]), bflo(cur.k[sub][1][1]), bfhi(cur.k[sub][1][1])};
#pragma unroll
                for (int j = 0; j < 4; ++j) { KT[(dA + j) * ST + pt] = f2bf(ka[j] * wsc); KT[(dB + j) * ST + pt] = f2bf(kb[j] * wsc); }
                const u32x4 vv = cur.v[sub];
#pragma unroll
                for (int j = 0; j < 4; ++j) { VT[(pg * 8 + 2 * j) * ST + pt] = (bf16_t)(vv[j] & 0xFFFFu); VT[(pg * 8 + 2 * j + 1) * ST + pt] = (bf16_t)(vv[j] >> 16); } }
        }
        LDS_BARRIER();
        if (c + 1 < NCH) chunk_load(c + 1, nxt);
        const float M63 = fmaxf(m_in, gt[128 + 63]);
        float Mt[4];
#pragma unroll
        for (int r = 0; r < 4; ++r) Mt[r] = fmaxf(m_in, gt[128 + 16 * ti + 4 * fq + r]);
        {
            const bf16x8 a0 = lds_frag(Qs, 16 * ti + fr, ST, 8 * fq), a1 = lds_frag(Qs, 16 * ti + fr, ST, 32 + 8 * fq);
#pragma unroll
            for (int tj = 0; tj < 4; ++tj) {
                f32x4 s = (f32x4){0.f, 0.f, 0.f, 0.f};
                s = mfma16(a0, lds_frag(Ks, 16 * tj + fr, ST, 8 * fq), s);
                s = mfma16(a1, lds_frag(Ks, 16 * tj + fr, ST, 32 + 8 * fq), s);
                const int sc_ = 16 * tj + fr; const float gs = gt[64 + sc_];
#pragma unroll
                for (int r = 0; r < 4; ++r) { const int t = 16 * ti + 4 * fq + r;
                    const float pv = sc_ <= t ? s[r] * fast_exp(gs - Mt[r]) : 0.f; Ps[t * ST + sc_] = f2bf(pv); } }
            const float decay = fast_exp(m_in - M63);
            const bf16x8 v0 = lds_frag(VT, 16 * ti + fr, ST, 8 * fq), v1 = lds_frag(VT, 16 * ti + fr, ST, 32 + 8 * fq);
#pragma unroll
            for (int dj = 0; dj < 4; ++dj) { cacc[dj] = cacc[dj] * decay;
                cacc[dj] = mfma16(v0, lds_frag(KT, 16 * dj + fr, ST, 8 * fq), cacc[dj]);
                cacc[dj] = mfma16(v1, lds_frag(KT, 16 * dj + fr, ST, 32 + 8 * fq), cacc[dj]); }
            cacc[4] = cacc[4] * decay;
            cacc[4] = mfma16(lds_frag(VT, 64 + fr, ST, 8 * fq), lds_frag(KT, 16 * wh + fr, ST, 8 * fq), cacc[4]);
            cacc[4] = mfma16(lds_frag(VT, 64 + fr, ST, 32 + 8 * fq), lds_frag(KT, 16 * wh + fr, ST, 32 + 8 * fq), cacc[4]);
        }
        WAVE_SYNC();
        {
            const bf16x8 p0 = lds_frag(Ps, 16 * ti + fr, ST, 8 * fq), p1 = lds_frag(Ps, 16 * ti + fr, ST, 32 + 8 * fq);
            const bf16x8 q0 = lds_frag(Qs, 16 * ti + fr, ST, 8 * fq), q1 = lds_frag(Qs, 16 * ti + fr, ST, 32 + 8 * fq);
            f32x4 np_[5];
            float ev[4];
#pragma unroll
            for (int r = 0; r < 4; ++r) ev[r] = fast_exp(m_in - Mt[r]);
#pragma unroll
            for (int tj = 0; tj < 5; ++tj) { f32x4 nc = (f32x4){0.f, 0.f, 0.f, 0.f}; np_[tj] = (f32x4){0.f, 0.f, 0.f, 0.f};
                np_[tj] = mfma16(p0, lds_frag(VT, 16 * tj + fr, ST, 8 * fq), np_[tj]);
                np_[tj] = mfma16(p1, lds_frag(VT, 16 * tj + fr, ST, 32 + 8 * fq), np_[tj]);
                nc = mfma16(q0, lds_frag(Cs, 16 * tj + fr, ST, 8 * fq), nc);
                nc = mfma16(q1, lds_frag(Cs, 16 * tj + fr, ST, 32 + 8 * fq), nc);
#pragma unroll
                for (int r = 0; r < 4; ++r) np_[tj][r] += ev[r] * nc[r]; }
#pragma unroll
            for (int r = 0; r < 4; ++r) { const int t = 16 * ti + 4 * fq + r;
                const float dn = fmaxf(fabsf(np_[4][r]), fast_exp(-gt[t] - Mt[r])); const float inv = 1.0f / dn;
                const int sp = dir == 0 ? cc * 64 + t : Ts - 1 - (cc * 64 + t);
                bf16_t* orow = om + (size_t)tok_row(lat, b, sp) * 256 + h * 64;
#pragma unroll
                for (int tj = 0; tj < 4; ++tj) orow[16 * tj + fr] = f2bf(np_[tj][r] * inv); }
        }
        m_in = gt[63] + M63;
        LDS_BARRIER();
#pragma unroll
        for (int dj = 0; dj < 4; ++dj)
#pragma unroll
            for (int r = 0; r < 4; ++r) Cs[(16 * ti + 4 * fq + r) * ST + 16 * dj + fr] = f2bf(cacc[dj][r]);
#pragma unroll
        for (int r = 0; r < 4; ++r) Cs[(64 + 4 * fq + r) * ST + 16 * wh + fr] = f2bf(cacc[4][r]);
        cur = nxt;
    }
    wg_release_acquire();
    merge_head(p, l, b, 0, h, tid);
}

template <int KS, int HALF, int DJ> struct GlaTr { static constexpr int v = ((32 * KS + 4 * HALF) * 40 + 16 * DJ) * 2; };
struct GlChunk { f32x4 lr[4]; unsigned q[2][2], k[2][2]; u32x4 v[2]; };
DEV void gla_unit(const Params& p, int l, int b, int h, LAS unsigned char* lds) {
    constexpr int ST = 72, SQ = 40;
    constexpr int DSZ = 5 * 64 * SQ * 2 + 32 * ST * 2 + 2 * 64 * ST * 2 + 64 * 33 * 4 + 544 * 4;
    static_assert(2 * DSZ <= LDS_BYTES - 32, "gla lds");
    const int tid = opaque_tid(), lane = tid & 63, w = tid >> 6, dir = w >> 2, wh = w & 3, t4 = tid & 255, fr = lane & 15, fq = lane >> 4;
    LAS unsigned char* db = lds + dir * DSZ;
    LAS bf16_t* Qs = (LAS bf16_t*)db;
    LAS bf16_t* Ks = Qs + 64 * SQ;
    LAS bf16_t* Ss = Ks + 64 * SQ;
    LAS bf16_t* Ah = Ss + 64 * SQ;
    LAS bf16_t* Al = Ah + 64 * SQ;
    LAS bf16_t* KT = Al + 64 * SQ;
    LAS bf16_t* VT = KT + 32 * ST;
    LAS bf16_t* Ps = VT + 64 * ST;
    LAS float* bc = (LAS float*)(Ps + 64 * ST);
    LAS float* w2s = bc + 64 * 33;
    const bf16_t* proj = (const bf16_t*)(p.ws + WS_R1 + R1_PROJ); const float* gates = (const float*)(p.ws + WS_R1 + R1_GATES);
    bf16_t* og = (bf16_t*)(p.ws + WS_R1 + R1_OG) + (size_t)dir * NTOK * 256;
    const float* ropeG = (const float*)(p.ws + WS_ROPE) + 2048;
    __syncthreads();
    for (int i = t4; i < 16 * 32; i += 256) { const int r = i >> 5, d = i & 31; w2s[i] = p.in[9][(((size_t)l * 2 + dir) * 16 + r) * 128 + h * 32 + d]; }
    if (t4 < 32) w2s[512 + t4] = p.in[10][((size_t)l * 2 + dir) * 128 + h * 32 + t4];
    for (int i = t4; i < 64 * SQ; i += 256) Ss[i] = 0;
    __syncthreads();
    f32x4 sacc[2];
    sacc[0] = (f32x4){0.f, 0.f, 0.f, 0.f}; sacc[1] = (f32x4){0.f, 0.f, 0.f, 0.f};
    const int ti = wh;
    const int pt = t4 >> 2, pgq = t4 & 3;
    bf16x8 lf_[2];
#pragma unroll
    for (int ks = 0; ks < 2; ++ks)
#pragma unroll
        for (int j = 0; j < 8; ++j) lf_[ks][j] = (32 * ks + 8 * fq + j <= 16 * ti + fr) ? (short)0x3F80 : (short)0;
    auto chunk_load = [&](int c, GlChunk& R) {
        const bool lat = c >= NCH_C; const int cc = lat ? c - NCH_C : c; const int Ts = lat ? T_ : TC_;
        const int sp = dir == 0 ? cc * 64 + pt : Ts - 1 - (cc * 64 + pt);
        const size_t row = (size_t)tok_row(lat, b, sp);
        const float* lr = gates + row * NG + 16 + dir * 16;
#pragma unroll
        for (int r = 0; r < 4; ++r) R.lr[r] = *(const f32x4*)(lr + 4 * r);
        const bf16_t* pr = proj + row * PROJ_N;
#pragma unroll
        for (int sub = 0; sub < 2; ++sub) { const int pg = pgq * 2 + sub; const int hf = pg >> 2, i0 = 2 * (pg & 3), dA = 16 * hf + i0, dB = dA + 8;
            R.q[sub][0] = *(const unsigned*)(pr + C_GQ + h * 32 + dA); R.q[sub][1] = *(const unsigned*)(pr + C_GQ + h * 32 + dB);
            R.k[sub][0] = *(const unsigned*)(pr + C_GK + h * 32 + dA); R.k[sub][1] = *(const unsigned*)(pr + C_GK + h * 32 + dB);
            R.v[sub] = *(const u32x4*)(pr + C_GV + h * 64 + pg * 8); } };
    GlChunk cur, nxt;
    chunk_load(0, cur); nxt = cur;
    for (int c = 0; c < NCH; ++c) {
        const bool lat = c >= NCH_C; const int cc = lat ? c - NCH_C : c; const int Ts = lat ? T_ : TC_;
        const int sp = dir == 0 ? cc * 64 + pt : Ts - 1 - (cc * 64 + pt);
        { float lrv[16];
#pragma unroll
          for (int r = 0; r < 16; r += 4) { lrv[r] = cur.lr[r >> 2][0]; lrv[r + 1] = cur.lr[r >> 2][1]; lrv[r + 2] = cur.lr[r >> 2][2]; lrv[r + 3] = cur.lr[r >> 2][3]; }
          float av[8];
#pragma unroll
          for (int j = 0; j < 8; ++j) { const int d = pgq * 8 + j; float z = w2s[512 + d];
#pragma unroll
              for (int r = 0; r < 16; ++r) z += lrv[r] * w2s[r * 32 + d];
              av[j] = logsig_fast(z) * (1.0f / 16.0f); }
          u32x4 hi, lo;
#pragma unroll
          for (int j = 0; j < 4; ++j) { const bf16_t h0 = f2bf(av[2 * j]), h1 = f2bf(av[2 * j + 1]);
              hi[j] = (unsigned)h0 | ((unsigned)h1 << 16); lo[j] = (unsigned)f2bf(av[2 * j] - bf2f(h0)) | ((unsigned)f2bf(av[2 * j + 1] - bf2f(h1)) << 16); }
          *(LAS u32x4*)(Ah + pt * SQ + pgq * 8) = hi; *(LAS u32x4*)(Al + pt * SQ + pgq * 8) = lo; }
        LDS_BARRIER();
        {
            const lds_addr_t ah = lds_addr(Ah + (8 * fq + (fr >> 2)) * SQ + 4 * (fr & 3)), al = lds_addr(Al + (8 * fq + (fr >> 2)) * SQ + 4 * (fr & 3));
#define GLA_CS(DJ) do { \
            const bf16x4 h00 = tr_read4<GlaTr<0, 0, DJ>::v>(ah), h01 = tr_read4<GlaTr<0, 1, DJ>::v>(ah), h10 = tr_read4<GlaTr<1, 0, DJ>::v>(ah), h11 = tr_read4<GlaTr<1, 1, DJ>::v>(ah); \
            const bf16x4 l00 = tr_read4<GlaTr<0, 0, DJ>::v>(al), l01 = tr_read4<GlaTr<0, 1, DJ>::v>(al), l10 = tr_read4<GlaTr<1, 0, DJ>::v>(al), l11 = tr_read4<GlaTr<1, 1, DJ>::v>(al); \
            LGKM_WAIT0(); \
            f32x4 acc = (f32x4){0.f, 0.f, 0.f, 0.f}; \
            acc = mfma16(lf_[0], (bf16x8){h00[0], h00[1], h00[2], h00[3], h01[0], h01[1], h01[2], h01[3]}, acc); \
            acc = mfma16(lf_[1], (bf16x8){h10[0], h10[1], h10[2], h10[3], h11[0], h11[1], h11[2], h11[3]}, acc); \
            acc = mfma16(lf_[0], (bf16x8){l00[0], l00[1], l00[2], l00[3], l01[0], l01[1], l01[2], l01[3]}, acc); \
            acc = mfma16(lf_[1], (bf16x8){l10[0], l10[1], l10[2], l10[3], l11[0], l11[1], l11[2], l11[3]}, acc); \
            _Pragma("unroll") for (int r = 0; r < 4; ++r) bc[(16 * ti + 4 * fq + r) * 33 + 16 * DJ + fr] = acc[r]; } while (0)
            GLA_CS(0); GLA_CS(1);
#undef GLA_CS
        }
        WAVE_SYNC();
#pragma unroll
        for (int sub = 0; sub < 2; ++sub) {
            const int pg = pgq * 2 + sub;
            const int hf = pg >> 2, i0 = 2 * (pg & 3), dA = 16 * hf + i0, dB = dA + 8;
            const unsigned q1 = cur.q[sub][0], q2 = cur.q[sub][1], k1 = cur.k[sub][0], k2 = cur.k[sub][1];
            const float qs_ = 0.17677669529663687f;
            float qa[2] = {bflo(q1) * qs_, bfhi(q1) * qs_}, qb[2] = {bflo(q2) * qs_, bfhi(q2) * qs_}, ka[2] = {bflo(k1), bfhi(k1)}, kb[2] = {bflo(k2), bfhi(k2)};
            if (lat) { const int pos = hf == 0 ? (sp >> 6) : (sp & 63);
#pragma unroll
                for (int j = 0; j < 2; ++j) { const float cs = ropeG[(pos * 8 + i0 + j) * 2], sn = ropeG[(pos * 8 + i0 + j) * 2 + 1];
                    const float x1 = qa[j] * cs - qb[j] * sn, x2 = qa[j] * sn + qb[j] * cs; qa[j] = x1; qb[j] = x2;
                    const float y1 = ka[j] * cs - kb[j] * sn, y2 = ka[j] * sn + kb[j] * cs; ka[j] = y1; kb[j] = y2; } }
#pragma unroll
            for (int j = 0; j < 2; ++j) { const float bA = bc[pt * 33 + dA + j], bB = bc[pt * 33 + dB + j];
                qa[j] *= fast_exp(bA); qb[j] *= fast_exp(bB); ka[j] *= fast_exp(-bA); kb[j] *= fast_exp(-bB); }
            *(LAS unsigned*)(Qs + pt * SQ + dA) = pack2(qa[0], qa[1]); *(LAS unsigned*)(Qs + pt * SQ + dB) = pack2(qb[0], qb[1]);
            *(LAS unsigned*)(Ks + pt * SQ + dA) = pack2(ka[0], ka[1]); *(LAS unsigned*)(Ks + pt * SQ + dB) = pack2(kb[0], kb[1]);
#pragma unroll
            for (int j = 0; j < 2; ++j) { KT[(dA + j) * ST + pt] = f2bf(ka[j]); KT[(dB + j) * ST + pt] = f2bf(kb[j]); }
            const u32x4 vv = cur.v[sub];
#pragma unroll
            for (int j = 0; j < 4; ++j) { VT[(pg * 8 + 2 * j) * ST + pt] = (bf16_t)(vv[j] & 0xFFFFu); VT[(pg * 8 + 2 * j + 1) * ST + pt] = (bf16_t)(vv[j] >> 16); }
        }
        LDS_BARRIER();
        if (c + 1 < NCH) chunk_load(c + 1, nxt);
        {
            const bf16x8 a0 = lds_frag(Qs, 16 * ti + fr, SQ, 8 * fq);
#pragma unroll
            for (int tj = 0; tj < 4; ++tj) {
                f32x4 s = (f32x4){0.f, 0.f, 0.f, 0.f};
                s = mfma16(a0, lds_frag(Ks, 16 * tj + fr, SQ, 8 * fq), s);
                const int sc_ = 16 * tj + fr;
#pragma unroll
                for (int r = 0; r < 4; ++r) { const int t = 16 * ti + 4 * fq + r; Ps[t * ST + sc_] = f2bf(sc_ <= t ? s[r] : 0.f); } }
        }
        WAVE_SYNC();
        {
            const bf16x8 p0 = lds_frag(Ps, 16 * ti + fr, ST, 8 * fq), p1 = lds_frag(Ps, 16 * ti + fr, ST, 32 + 8 * fq), q0 = lds_frag(Qs, 16 * ti + fr, SQ, 8 * fq);
            f32x4 o[4];
#pragma unroll
            for (int tj = 0; tj < 4; ++tj) { o[tj] = (f32x4){0.f, 0.f, 0.f, 0.f};
                o[tj] = mfma16(p0, lds_frag(VT, 16 * tj + fr, ST, 8 * fq), o[tj]);
                o[tj] = mfma16(p1, lds_frag(VT, 16 * tj + fr, ST, 32 + 8 * fq), o[tj]);
                o[tj] = mfma16(q0, lds_frag(Ss, 16 * tj + fr, SQ, 8 * fq), o[tj]); }
#pragma unroll
            for (int r = 0; r < 4; ++r) { const int t = 16 * ti + 4 * fq + r; const int sp2 = dir == 0 ? cc * 64 + t : Ts - 1 - (cc * 64 + t);
                bf16_t* orow = og + (size_t)tok_row(lat, b, sp2) * 256 + h * 64;
#pragma unroll
                for (int tj = 0; tj < 4; ++tj) orow[16 * tj + fr] = f2bf(o[tj][r]); }
            const bf16x8 v0 = lds_frag(VT, 16 * wh + fr, ST, 8 * fq), v1 = lds_frag(VT, 16 * wh + fr, ST, 32 + 8 * fq);
#pragma unroll
            for (int dj = 0; dj < 2; ++dj) {
                sacc[dj] = mfma16(v0, lds_frag(KT, 16 * dj + fr, ST, 8 * fq), sacc[dj]);
                sacc[dj] = mfma16(v1, lds_frag(KT, 16 * dj + fr, ST, 32 + 8 * fq), sacc[dj]);
                sacc[dj] = sacc[dj] * fast_exp(bc[63 * 33 + 16 * dj + fr]); }
        }
        LDS_BARRIER();
#pragma unroll
        for (int dj = 0; dj < 2; ++dj)
#pragma unroll
            for (int r = 0; r < 4; ++r) Ss[(16 * wh + 4 * fq + r) * SQ + 16 * dj + fr] = f2bf(sacc[dj][r]);
        cur = nxt;
    }
    wg_release_acquire();
    merge_head(p, l, b, 1, h, tid);
}

template <int KS, int T16, int VT> struct TrOff { static constexpr int v = ((32 * KS + 16 * T16) * 72 + 16 * VT) * 2; };
template <int NT>
DEV void attn_ldkv(const LAS bf16_t* Kb, lds_addr_t vb, bf16x8 (&kf)[NT][2], bf16x8 (&vf)[NT / 2][4], int fr, int fq) {
#pragma unroll
    for (int kt = 0; kt < NT; ++kt) { kf[kt][0] = lds_frag(Kb, 16 * kt + fr, 72, 8 * fq); kf[kt][1] = lds_frag(Kb, 16 * kt + fr, 72, 32 + 8 * fq); }
    bf16x4 lo[NT / 2][4], hi[NT / 2][4];
#define ATT_TR(KS) do { lo[KS][0] = tr_read4<TrOff<KS, 0, 0>::v>(vb); hi[KS][0] = tr_read4<TrOff<KS, 1, 0>::v>(vb); lo[KS][1] = tr_read4<TrOff<KS, 0, 1>::v>(vb); hi[KS][1] = tr_read4<TrOff<KS, 1, 1>::v>(vb); \
        lo[KS][2] = tr_read4<TrOff<KS, 0, 2>::v>(vb); hi[KS][2] = tr_read4<TrOff<KS, 1, 2>::v>(vb); lo[KS][3] = tr_read4<TrOff<KS, 0, 3>::v>(vb); hi[KS][3] = tr_read4<TrOff<KS, 1, 3>::v>(vb); } while (0)
    ATT_TR(0);
    if constexpr (NT == 4) { ATT_TR(1); }
#undef ATT_TR
    LGKM_WAIT0();
#pragma unroll
    for (int ks = 0; ks < NT / 2; ++ks)
#pragma unroll
        for (int vt = 0; vt < 4; ++vt) vf[ks][vt] = (bf16x8){lo[ks][vt][0], lo[ks][vt][1], lo[ks][vt][2], lo[ks][vt][3], hi[ks][vt][0], hi[ks][vt][1], hi[ks][vt][2], hi[ks][vt][3]};
}
template <int NT, bool LOC>
DEV void attn_tile(const bf16x8 (&kf)[NT][2], const bf16x8 (&vf)[NT / 2][4], bf16x8 qf0, bf16x8 qf1, f32x4 (&o)[4], float& mrun, float& lrun, const LAS float* rpl, int d0) {
    f32x4 s[NT];
#pragma unroll
    for (int kt = 0; kt < NT; ++kt) { s[kt] = (f32x4){0.f, 0.f, 0.f, 0.f}; s[kt] = mfma16(kf[kt][0], qf0, s[kt]); s[kt] = mfma16(kf[kt][1], qf1, s[kt]); }
    float mx = -INFINITY;
#pragma unroll
    for (int kt = 0; kt < NT; ++kt)
#pragma unroll
        for (int j = 0; j < 4; ++j) { float v;
            if (LOC) { const bool ok = (unsigned)(16 * kt + j - d0) < 16u; v = ok ? s[kt][j] * 0.18033688f + rpl[16 * kt + j] : -INFINITY; }
            else v = s[kt][j] * 0.18033688f;
            s[kt][j] = v; mx = fmaxf(mx, v); }
    mx = xrow16_max(mx);
    if (wave_any(mx > mrun + 8.0f)) {
        const float mnew = fmaxf(mrun, mx);
        const float alpha = fast_exp2(mrun - mnew);
        lrun = lrun * alpha; mrun = mnew;
#pragma unroll
        for (int vt = 0; vt < 4; ++vt) o[vt] = o[vt] * alpha;
    }
    float ps = 0.f;
#pragma unroll
    for (int kt = 0; kt < NT; ++kt)
#pragma unroll
        for (int j = 0; j < 4; ++j) { const float pv = fast_exp2(s[kt][j] - mrun); s[kt][j] = pv; ps += pv; }
    lrun += ps;
#pragma unroll
    for (int ks = 0; ks < NT / 2; ++ks) { u32x4 pu; pu[0] = pack2(s[2 * ks][0], s[2 * ks][1]); pu[1] = pack2(s[2 * ks][2], s[2 * ks][3]); pu[2] = pack2(s[2 * ks + 1][0], s[2 * ks + 1][1]); pu[3] = pack2(s[2 * ks + 1][2], s[2 * ks + 1][3]);
        bf16x8 pf; __builtin_memcpy(&pf, &pu, 16);
#pragma unroll
        for (int vt = 0; vt < 4; ++vt) o[vt] = mfma16(vf[ks][vt], pf, o[vt]); }
}
template <bool LOCAL>
DEV void attn_unit(const Params& p, int l, int b, int head, int r0, LAS unsigned char* lds) {
    constexpr int NQT = 2, ST = 72, HB = 64 * ST, BUF = 2 * HB;
    LAS bf16_t* kv = (LAS bf16_t*)lds;
    LAS float* rp = (LAS float*)(kv + 2 * BUF) + 64;
    const int tid = opaque_tid(), lane = tid & 63, w = tid >> 6, fr = lane & 15, fq = lane >> 4;
    const int qt = w & 3, qc = 16 * qt + fr, rw = r0 + 2 * (w >> 2);
    const bf16_t* proj = (const bf16_t*)(p.ws + WS_R1 + R1_PROJ);
    bf16_t* ymix = (bf16_t*)(p.ws + WS_YMIX);
    const int rs_first = r0 - 4 < 0 ? 0 : (r0 - 4 > GRID_R - 8 ? GRID_R - 8 : r0 - 4);
    const int rl = r0 + 3, rs_last = rl - 4 < 0 ? 0 : (rl - 4 > GRID_R - 8 ? GRID_R - 8 : rl - 4);
    const int kr_lo = rs_first, nloc = LOCAL ? rs_last + 8 - rs_first : 0, nblk = nloc + NCH_C;
    const int skey = tid >> 3, sg8 = (tid & 7) * 8;
    const bf16_t* sbase = proj + (size_t)head * 64 + sg8;
    u32x4 kr0, vr0, kr1, vr1;
#define ATT_KROW(kb) ((kb) < nloc ? tok_row(true, b, (kr_lo + (kb)) * 64) : tok_row(false, b, ((kb) - nloc) * 64))
#define ATT_LOAD(kb, KR, VR) do { const bf16_t* pr_ = sbase + (size_t)(ATT_KROW(kb) + skey) * PROJ_N; KR = *(const u32x4*)(pr_ + C_NK); VR = *(const u32x4*)(pr_ + C_NV); } while (0)
#define ATT_STORE(bi, KR, VR) do { LAS bf16_t* d_ = kv + (bi) * BUF + skey * ST + sg8; *(LAS u32x4*)(d_) = KR; *(LAS u32x4*)(d_ + HB) = VR; } while (0)
    __syncthreads();
    ATT_LOAD(0, kr0, vr0);
    ATT_LOAD(1, kr1, vr1);
    if (LOCAL) for (int i = tid; i < 15 * 31; i += 512) rp[i] = p.in[13][((size_t)l * 8 + head) * 465 + i] * 1.44269504f;
    bf16x8 qf[NQT][2]; f32x4 o[NQT][4]; float mrun[NQT], lrun[NQT];
#pragma unroll
    for (int i = 0; i < NQT; ++i) { const bf16_t* qp = proj + (size_t)tok_row(LOCAL, b, (rw + i) * 64 + qc) * PROJ_N + C_NQ + head * 64;
        qf[i][0] = *(const bf16x8*)(qp + 8 * fq); qf[i][1] = *(const bf16x8*)(qp + 32 + 8 * fq); mrun[i] = -INFINITY; lrun[i] = 0.f;
#pragma unroll
        for (int vt = 0; vt < 4; ++vt) o[i][vt] = (f32x4){0.f, 0.f, 0.f, 0.f}; }
    ATT_STORE(0, kr0, vr0);
    ATT_LOAD(2, kr0, vr0);
    const int cs = qc - 8 < 0 ? 0 : (qc - 8 > 48 ? 48 : qc - 8);
    const int koff = qt == 0 ? 0 : (qt == 1 ? 8 : (qt == 2 ? 24 : 32));
    const int d0 = cs - koff - 4 * fq;
    const LAS float* rpl0 = rp + koff + 4 * fq - qc + 15;
    const int rs0 = rw - 4 < 0 ? 0 : (rw - 4 > GRID_R - 8 ? GRID_R - 8 : rw - 4), rs1 = rw - 3 < 0 ? 0 : (rw - 3 > GRID_R - 8 ? GRID_R - 8 : rw - 3);
    LDS_BARRIER();
#define ATT_ITER(kb, KR, VR) do { const int bi = (kb) & 1; \
        if ((kb) + 1 < nblk) ATT_STORE(bi ^ 1, KR, VR); \
        if ((kb) + 3 < nblk) ATT_LOAD((kb) + 3, KR, VR); \
        const LAS bf16_t* Kb = kv + bi * BUF; \
        const LAS bf16_t* Vl = kv + bi * BUF + HB + (4 * fq + (fr >> 2)) * ST + 4 * (fr & 3); \
        if ((kb) < nloc) { \
            const int krow = kr_lo + (kb); \
            const bool a0 = krow >= rs0 && krow < rs0 + 8, a1 = krow >= rs1 && krow < rs1 + 8; \
            if (a0 || a1) { \
                bf16x8 kf[2][2], vf[1][4]; \
                attn_ldkv<2>(Kb + koff * ST, lds_addr(Vl + koff * ST), kf, vf, fr, fq); \
                if (a0) attn_tile<2, true>(kf, vf, qf[0][0], qf[0][1], o[0], mrun[0], lrun[0], rpl0 + (krow - rw + 7) * 31, d0); \
                if (a1) attn_tile<2, true>(kf, vf, qf[1][0], qf[1][1], o[1], mrun[1], lrun[1], rpl0 + (krow - rw - 1 + 7) * 31, d0); \
            } \
        } else { \
            _Pragma("unroll") for (int hf = 0; hf < 2; ++hf) { \
                bf16x8 kf[2][2], vf[1][4]; \
                attn_ldkv<2>(Kb + 32 * hf * ST, lds_addr(Vl + 32 * hf * ST), kf, vf, fr, fq); \
                _Pragma("unroll") for (int i = 0; i < NQT; ++i) attn_tile<2, false>(kf, vf, qf[i][0], qf[i][1], o[i], mrun[i], lrun[i], rpl0, d0); } \
        } \
        LDS_BARRIER(); } while (0)
#pragma unroll 1
    for (int kb = 0; kb < nblk; kb += 2) {
        ATT_ITER(kb, kr1, vr1);
        if (kb + 1 < nblk) ATT_ITER(kb + 1, kr0, vr0);
    }
#undef ATT_ITER
#undef ATT_KROW
#undef ATT_LOAD
#undef ATT_STORE
#pragma unroll
    for (int i = 0; i < NQT; ++i) { const float lr = xrow16_sum(lrun[i]);
        const float inv = 1.0f / lr;
        bf16_t* yr = ymix + (size_t)tok_row(LOCAL, b, (rw + i) * 64 + qc) * D_ + 512 + head * 64;
#pragma unroll
        for (int vt = 0; vt < 4; ++vt) { u32x2 ov; ov[0] = pack2(o[i][vt][0] * inv, o[i][vt][1] * inv); ov[1] = pack2(o[i][vt][2] * inv, o[i][vt][3] * inv); *(u32x2*)(yr + 16 * vt + 4 * fq) = ov; } }
}

DEV void phase_mixer(const Params& p, int l, LAS unsigned char* lds) {
    const bool need_ctx = l < DEPTH_ - 1;
#ifndef REP_K
#define REP_K -1
#endif
#ifndef NO_SCAN
    for (int rep_ = 0; rep_ < ((REP_K == 20 || REP_K == 99) ? 2 : 1); ++rep_)
    for (int u = blockIdx.x; u < B_ * 8; u += gridDim.x) { if (u < B_ * 4) mlstm_unit(p, l, u >> 2, u & 3, lds); else gla_unit(p, l, (u - B_ * 4) >> 2, u & 3, lds); }
#endif
    static_assert(GRID_R % 4 == 0 && NCH_C == 4, "attention unit grouping");
    const int nloc = B_ * 8 * (GRID_R / 4), nctx = need_ctx ? B_ * 8 : 0;
#ifdef HOST_EMU
    for (int u = blockIdx.x; u < nloc + nctx; u += gridDim.x) {
        if (u < nloc) { const int rg = u % (GRID_R / 4), head = (u / (GRID_R / 4)) & 7, b = u / (GRID_R / 4 * 8); attn_unit<true>(p, l, b, head, rg * 4, lds); }
        else { const int q = u - nloc, head = q & 7, b = q >> 3; attn_unit<false>(p, l, b, head, 0, lds); }
    }
#else
    for (int rep_ = 0; rep_ < ((REP_K == 22 || REP_K == 99) ? 2 : 1); ++rep_) {
        unsigned* ctr = (unsigned*)(p.ws + WS_CTL) + XB_QUEUE + l * 2 + rep_;
        volatile LAS int* qs = (volatile LAS int*)(lds + LDS_BYTES - 32);
        const int tid = opaque_tid();
        __syncthreads();
        if (tid == 0) qs[0] = (int)atomicAdd(ctr, 1u);
        __syncthreads();
        int u = qs[0];
        while (u < nloc + nctx) {
            int pend = 0;
            if (tid == 0) pend = (int)atomicAdd(ctr, 1u);
            if (u < nloc) { const int rg = u % (GRID_R / 4), head = (u / (GRID_R / 4)) & 7, b = u / (GRID_R / 4 * 8); attn_unit<true>(p, l, b, head, rg * 4, lds); }
            else { const int q = u - nloc, head = q & 7, b = q >> 3; attn_unit<false>(p, l, b, head, 0, lds); }
            __syncthreads();
            if (tid == 0) qs[0] = pend;
            __syncthreads();
            u = qs[0];
        }
    }
#endif
}

DEV void ln_stats(const float (&v)[2][8], float& mu, float& rstd) {
    float s = 0.f;
#pragma unroll
    for (int i = 0; i < 2; ++i)
#pragma unroll
        for (int j = 0; j < 8; ++j) s += v[i][j];
    mu = wave_sum(s) * (1.0f / 1024.0f);
    float q = 0.f;
#pragma unroll
    for (int i = 0; i < 2; ++i)
#pragma unroll
        for (int j = 0; j < 8; ++j) { const float d = v[i][j] - mu; q += d * d; }
    rstd = 1.0f / sqrtf(wave_sum(q) * (1.0f / 1024.0f) + LN_EPS);
}
DEV void ln_apply(float (&v)[2][8], float mu, float rstd, const float* g, const float* bta, int lane) {
#pragma unroll
    for (int i = 0; i < 2; ++i) { const int c = lane * 8 + i * 512; const f32x4 ga = *(const f32x4*)(g + c), gb2 = *(const f32x4*)(g + c + 4), ba = *(const f32x4*)(bta + c), bb2 = *(const f32x4*)(bta + c + 4);
#pragma unroll
        for (int j = 0; j < 8; ++j) v[i][j] = (v[i][j] - mu) * rstd * (j < 4 ? ga[j] : gb2[j - 4]) + (j < 4 ? ba[j] : bb2[j - 4]); }
}
DEV void ln_row(float (&v)[2][8], const float* g, const float* bta, int lane) {
    float s = 0.f;
#pragma unroll
    for (int i = 0; i < 2; ++i)
#pragma unroll
        for (int j = 0; j < 8; ++j) s += v[i][j];
    const float mu = wave_sum(s) * (1.0f / 1024.0f);
    float q = 0.f;
#pragma unroll
    for (int i = 0; i < 2; ++i)
#pragma unroll
        for (int j = 0; j < 8; ++j) { v[i][j] -= mu; q += v[i][j] * v[i][j]; }
    const float rstd = 1.0f / sqrtf(wave_sum(q) * (1.0f / 1024.0f) + LN_EPS);
#pragma unroll
    for (int i = 0; i < 2; ++i) { const int c = lane * 8 + i * 512; const f32x4 ga = *(const f32x4*)(g + c), gb2 = *(const f32x4*)(g + c + 4), ba = *(const f32x4*)(bta + c), bb2 = *(const f32x4*)(bta + c + 4);
#pragma unroll
        for (int j = 0; j < 8; ++j) v[i][j] = v[i][j] * rstd * (j < 4 ? ga[j] : gb2[j - 4]) + (j < 4 ? ba[j] : bb2[j - 4]); }
}

DEV void phase_ln1_router(const Params& p, int l, LAS unsigned char* lds) {
    LAS float* wrT = (LAS float*)lds;
    const int tid = opaque_tid(), lane = tid & 63, gw = blockIdx.x * 8 + (tid >> 6), nw = gridDim.x * 8;
    const int ntok = l < DEPTH_ - 1 ? NTOK : NL;
    const float* wr = p.in[17] + (size_t)l * 1024 * 16;
    __syncthreads();
    for (int i = tid; i < 16 * 1024; i += 512) { const int k = i >> 4, e = i & 15; wrT[e * 1024 + k] = wr[i]; }
    __syncthreads();
    const float* mods = (const float*)(p.ws + WS_MODS) + (size_t)l * (B_ + 1) * 6144;
    bf16_t* ub = (bf16_t*)(p.ws + WS_U); float* aff = (float*)(p.ws + WS_AFF);
    const bf16_t* xh = (const bf16_t*)(p.ws + WS_XH); bf16_t* x1h = (bf16_t*)(p.ws + WS_X1H); const bf16_t* yo = (const bf16_t*)(p.ws + WS_YO);
    const float alpha = sqrtf(sqrtf((float)(2 * DEPTH_)));
    const float* lg = p.in[15] + (size_t)l * 1024; const float* lb = p.in[16] + (size_t)l * 1024;
    constexpr int NR = 4;
    for (int row0 = gw; row0 < ntok; row0 += NR * nw) {
        u32x4 xraw[NR][2], yraw[NR][2];
#pragma unroll
        for (int r = 0; r < NR; ++r) { const int row = row0 + r * nw; const int rw = row < ntok ? row : row0;
#pragma unroll
            for (int i = 0; i < 2; ++i) { const int c = lane * 8 + i * 512;
                yraw[r][i] = *(const u32x4*)(yo + (size_t)rw * D_ + c);
                xraw[r][i] = (u32x4){0u, 0u, 0u, 0u}; if (l != 0) xraw[r][i] = *(const u32x4*)(xh + (size_t)rw * D_ + c); } }
        f32x2 up[NR / 2][2][8];
#pragma unroll
        for (int r = 0; r < NR; ++r) {
            const int row = row0 + r * nw;
            float uu[2][8];
            if (row < ntok) {
                const bool isl = row < NL; const int bb = isl ? row / T_ : B_;
                const float* md = mods + (size_t)bb * 6144;
                float v[2][8];
#pragma unroll
                for (int i = 0; i < 2; ++i) { const int c = lane * 8 + i * 512; float xv[8];
                    if (l == 0) { const float* xr = isl ? p.in[0] + (size_t)row * D_ : p.in[2] + (size_t)(row - NL) * D_; const f32x4 a = *(const f32x4*)(xr + c), b2 = *(const f32x4*)(xr + c + 4);
#pragma unroll
                        for (int j = 0; j < 4; ++j) { xv[j] = a[j]; xv[4 + j] = b2[j]; } }
                    else unpack8_h(xraw[r][i], xv);
                    const u32x4 yv = yraw[r][i]; const f32x4 g0 = *(const f32x4*)(md + 2048 + c), g1 = *(const f32x4*)(md + 2048 + c + 4);
#pragma unroll
                    for (int j = 0; j < 4; ++j) { v[i][j] = alpha * xv[j] + g0[j] * ((j & 1) ? bfhi(yv[j >> 1]) : bflo(yv[j >> 1])); v[i][4 + j] = alpha * xv[4 + j] + g1[j] * ((j & 1) ? bfhi(yv[2 + (j >> 1)]) : bflo(yv[2 + (j >> 1)])); } }
                float mu, rstd; ln_stats(v, mu, rstd);
                ln_apply(v, mu, rstd, lg, lb, lane);
#pragma unroll
                for (int i = 0; i < 2; ++i) { const int c = lane * 8 + i * 512;
                    *(u32x4*)(x1h + (size_t)row * D_ + c) = pack8_h(v[i]);
                    const f32x4 s0 = *(const f32x4*)(md + 4096 + c), s1 = *(const f32x4*)(md + 4096 + c + 4), h0 = *(const f32x4*)(md + 3072 + c), h1 = *(const f32x4*)(md + 3072 + c + 4);
#pragma unroll
                    for (int j = 0; j < 8; ++j) uu[i][j] = v[i][j] * ((j < 4 ? s0[j] : s1[j - 4]) + 1.0f) + (j < 4 ? h0[j] : h1[j - 4]);
#if MOE_F8
                    u32x2 o; o[0] = pack4_f8(uu[i][0], uu[i][1], uu[i][2], uu[i][3]); o[1] = pack4_f8(uu[i][4], uu[i][5], uu[i][6], uu[i][7]);
                    *(u32x2*)((unsigned char*)ub + (size_t)row * D_ + c) = o; }
#else
                    u32x4 o; o[0] = pack2(uu[i][0], uu[i][1]); o[1] = pack2(uu[i][2], uu[i][3]); o[2] = pack2(uu[i][4], uu[i][5]); o[3] = pack2(uu[i][6], uu[i][7]);
                    *(u32x4*)(ub + (size_t)row * D_ + c) = o; }
#endif
            } else {
#pragma unroll
                for (int i = 0; i < 2; ++i)
#pragma unroll
                    for (int j = 0; j < 8; ++j) uu[i][j] = 0.f;
            }
#pragma unroll
            for (int i = 0; i < 2; ++i)
#pragma unroll
                for (int j = 0; j < 8; ++j) up[r >> 1][i][j][r & 1] = uu[i][j];
            SCHED_BAR();
        }
#ifndef HOST_EMU
        asm volatile("" ::: "memory");
#endif
        float p8a[NR][8];
#pragma unroll
        for (int j = 0; j < 8; ++j) { f32x2 pe[NR / 2][2];
#pragma unroll
            for (int hh = 0; hh < 2; ++hh) { const int e = j + 8 * hh; f32x2 acc[NR / 2];
#pragma unroll
                for (int q = 0; q < NR / 2; ++q) acc[q] = (f32x2){0.f, 0.f};
#pragma unroll
                for (int i = 0; i < 2; ++i) { const int c = lane * 8 + i * 512; const f32x4 w0 = *(const LAS f32x4*)(wrT + e * 1024 + c), w1 = *(const LAS f32x4*)(wrT + e * 1024 + c + 4);
#pragma unroll
                    for (int q = 0; q < NR / 2; ++q) {
                        acc[q] += up[q][i][0] * w0[0]; acc[q] += up[q][i][1] * w0[1]; acc[q] += up[q][i][2] * w0[2]; acc[q] += up[q][i][3] * w0[3];
                        acc[q] += up[q][i][4] * w1[0]; acc[q] += up[q][i][5] * w1[1]; acc[q] += up[q][i][6] * w1[2]; acc[q] += up[q][i][7] * w1[3]; } }
#pragma unroll
                for (int q = 0; q < NR / 2; ++q) pe[q][hh] = acc[q]; }
#pragma unroll
            for (int q = 0; q < NR / 2; ++q) { p8a[2 * q][j] = xsum32(pe[q][0][0], pe[q][1][0]); p8a[2 * q + 1][j] = xsum32(pe[q][0][1], pe[q][1][1]); } }
#pragma unroll
        for (int r = 0; r < NR; ++r) {
            const int row = row0 + r * nw;
            float p4[4], p2[2];
#pragma unroll
            for (int j = 0; j < 4; ++j) p4[j] = xsum16(p8a[r][j], p8a[r][4 + j]);
#pragma unroll
            for (int j = 0; j < 2; ++j) p2[j] = xsum8(p4[j], p4[2 + j], lane);
            float mine = quad_sum(xsum4(p2[0], p2[1], lane));
            const float mx = wave_max(mine);
            mine = expf(mine - mx);
            const float sm = wave_sum(mine) * 0.25f;
            if (row < ntok && (lane & 3) == 0) aff[(size_t)row * 16 + (lane >> 2)] = mine / sm;
        }
    }
}

#ifdef HOST_EMU
static inline void lds_inc(unsigned* p) { (*p)++; }
#else
DEV void lds_inc(LAS unsigned* p) { __hip_atomic_fetch_add(p, 1u, __ATOMIC_RELAXED, __HIP_MEMORY_SCOPE_WORKGROUP); }
#endif
DEV void phase_topk(const Params& p, int l, LAS unsigned char* lds) {
    LAS unsigned* keys = (LAS unsigned*)lds;
    LAS unsigned* hist = keys + T_;
    LAS unsigned* misc = hist + 256;
    const int tid = opaque_tid(), lane = tid & 63, w = tid >> 6;
    const bool need_ctx = l < DEPTH_ - 1;
    const float* aff = (const float*)(p.ws + WS_AFF); int* slot = (int*)(p.ws + WS_SLOT); int* rowtab = (int*)(p.ws + WS_ROWTAB);
    const int nun = B_ * 16 * (need_ctx ? 2 : 1);
    for (int u = blockIdx.x; u < nun; u += gridDim.x) {
        const bool lat = u < B_ * 16; const int q = lat ? u : u - B_ * 16, b = q >> 4, e = q & 15;
        const int n = lat ? T_ : TC_, cap = lat ? CAP_L : CAP_C, row0 = tok_row(lat, b, 0);
        __syncthreads();
        unsigned kv[4];
#pragma unroll
        for (int j = 0; j < 4; ++j) { const int t = tid * 4 + j; kv[j] = t < n ? f_as_u(aff[(size_t)(row0 + t) * 16 + e]) : 0u; }
        unsigned prefix = 0u, remaining = (unsigned)cap;
#pragma unroll 1
        for (int pass = 0; pass < 4; ++pass) {
            const int shift = 24 - 8 * pass;
            if (tid < 256) hist[tid] = 0u;
            __syncthreads();
#pragma unroll
            for (int j = 0; j < 4; ++j) { const int t = tid * 4 + j;
                if (t < n && (pass == 0 || (kv[j] >> (shift + 8)) == prefix)) lds_inc(&hist[(kv[j] >> shift) & 255u]); }
            __syncthreads();
            if (w == 0) {
                const unsigned h0 = hist[4 * lane], h1 = hist[4 * lane + 1], h2 = hist[4 * lane + 2], h3 = hist[4 * lane + 3];
                const unsigned sl = h0 + h1 + h2 + h3;
                unsigned S = sl;
                for (int d = 1; d < 64; d <<= 1) { const unsigned o = (unsigned)shfl_idx_i((int)S, lane + d < 64 ? lane + d : lane); if (lane + d < 64) S += o; }
                const unsigned above = S - sl;
                if (above < remaining && remaining <= S) {
                    unsigned acc = above; int bin;
                    if (acc + h3 >= remaining) { bin = 3; } else { acc += h3; if (acc + h2 >= remaining) { bin = 2; } else { acc += h2; if (acc + h1 >= remaining) { bin = 1; } else { acc += h1; bin = 0; } } }
                    misc[0] = (unsigned)(4 * lane + bin); misc[1] = remaining - acc; }
            }
            __syncthreads();
            prefix = (prefix << 8) | misc[0]; remaining = misc[1];
        }
        unsigned cnt = 0u;
#pragma unroll
        for (int j = 0; j < 4; ++j) { const int t = tid * 4 + j; if (t < n) cnt += (kv[j] > prefix ? 1u : 0u) + (kv[j] == prefix ? 65536u : 0u); }
        unsigned inc = cnt;
        for (int d = 1; d < 64; d <<= 1) { const unsigned o2 = (unsigned)shfl_idx_i((int)inc, lane >= d ? lane - d : lane); if (lane >= d) inc += o2; }
        if (lane == 63) misc[8 + w] = inc;
        __syncthreads();
        unsigned base = 0u, total = 0u;
#pragma unroll
        for (int ww = 0; ww < 8; ++ww) { const unsigned tw = misc[8 + ww]; if (ww < w) base += tw; total += tw; }
        unsigned run = base + inc - cnt;
        const unsigned ngt = total & 0xFFFFu;
#pragma unroll
        for (int j = 0; j < 4; ++j) { const int t = tid * 4 + j;
            if (t < n) { const bool gt = kv[j] > prefix, eq = kv[j] == prefix; const unsigned rg = run & 0xFFFFu, re = run >> 16;
                int sl = -1;
                if (gt) sl = (int)rg; else if (eq && re < remaining) sl = (int)(ngt + re);
                slot[(size_t)(row0 + t) * 16 + e] = sl;
                if (sl >= 0) rowtab[e * MROWS + (lat ? b * CAP_L + sl : ROWS_L + b * CAP_C + sl)] = row0 + t;
                run += (gt ? 1u : 0u) + (eq ? 65536u : 0u); } }
    }
    { const int used = need_ctx ? ROWS_L + ROWS_C : ROWS_L; const int mr = need_ctx ? MROWS : MROWS_LAST;
      if (blockIdx.x == gridDim.x - 1) for (int i = tid; i < 16 * (mr - used); i += 512) { const int e = i / (mr - used), r = used + i % (mr - used); rowtab[e * MROWS + r] = 0; } }
}

DEV void phase_combine(const Params& p, int l) {
    const int tid = opaque_tid(), lane = tid & 63, gw = blockIdx.x * 8 + (tid >> 6), nw = gridDim.x * 8;
    const bool need_ctx = l < DEPTH_ - 1; const int ntok = need_ctx ? NTOK : NL;
    const float* mods = (const float*)(p.ws + WS_MODS) + (size_t)l * (B_ + 1) * 6144;
    const float* modn = mods + (size_t)(B_ + 1) * 6144;
    const bf16_t* x1h = (const bf16_t*)(p.ws + WS_X1H); bf16_t* xh = (bf16_t*)(p.ws + WS_XH); bf16_t* ub = (bf16_t*)(p.ws + WS_U);
    const float* aff = (const float*)(p.ws + WS_AFF); const int* slot = (const int*)(p.ws + WS_SLOT); const bf16_t* yexp = (const bf16_t*)(p.ws + WS_YEXP);
    const float* lg = p.in[21] + (size_t)l * 1024; const float* lb = p.in[22] + (size_t)l * 1024;
    const float alpha = sqrtf(sqrtf((float)(2 * DEPTH_)));
    int slot_n[2]; float aff_n[2];
#pragma unroll
    for (int r = 0; r < 2; ++r) { const int row = gw + r * nw; slot_n[r] = -1; aff_n[r] = 0.f;
        if (row < ntok && lane < 16) { slot_n[r] = slot[(size_t)row * 16 + lane]; aff_n[r] = aff[(size_t)row * 16 + lane]; } }
    for (int row0 = gw; row0 < ntok; row0 += 2 * nw) {
        int myslot[2]; float myaff[2]; int rbase[2]; unsigned em[2];
        float v[2][2][8], f[2][2][8];
#pragma unroll
        for (int r = 0; r < 2; ++r) { const int row = row0 + r * nw; const bool act = row < ntok; const int rw = act ? row : row0;
            const bool isl = rw < NL; const int bidx = isl ? rw / T_ : (rw - NL) / TC_;
            rbase[r] = isl ? bidx * CAP_L : ROWS_L + bidx * CAP_C;
            myslot[r] = slot_n[r]; myaff[r] = aff_n[r];
            { const int rown = row + 2 * nw; slot_n[r] = -1; aff_n[r] = 0.f; if (rown < ntok && lane < 16) { slot_n[r] = slot[(size_t)rown * 16 + lane]; aff_n[r] = aff[(size_t)rown * 16 + lane]; } }
#pragma unroll
            for (int i = 0; i < 2; ++i) unpack8_h(*(const u32x4*)(x1h + (size_t)rw * D_ + lane * 8 + i * 512), v[r][i]);
#pragma unroll
            for (int i = 0; i < 2; ++i)
#pragma unroll
                for (int j = 0; j < 8; ++j) f[r][i][j] = 0.f;
            unsigned m_ = 0u;
#pragma unroll
            for (int e = 0; e < 16; ++e) m_ |= (rdlane_i(myslot[r], e) >= 0 ? 1u : 0u) << e;
            em[r] = act ? m_ : 0u; }
        while (em[0] | em[1]) {
#if MOE_F8 && YEXP_F8
            u32x2 yv[2][4][2]; float ga[2][4];
#pragma unroll
            for (int r = 0; r < 2; ++r)
#pragma unroll
                for (int k = 0; k < 4; ++k) { const bool ok = em[r] != 0u; const int ee = ok ? __builtin_ctz(em[r]) : 0; em[r] &= em[r] - 1u;
                    const int sl = rdlane_i(myslot[r], ee); ga[r][k] = ok ? rdlane_f(myaff[r], ee) * (1.0f / F8_SY) : 0.f;
                    const unsigned char* yr = (const unsigned char*)yexp + ((size_t)ee * MROWS + rbase[r] + (sl > 0 ? sl : 0)) * D_;
                    yv[r][k][0] = *(const u32x2*)(yr + lane * 8); yv[r][k][1] = *(const u32x2*)(yr + lane * 8 + 512); }
#pragma unroll
            for (int r = 0; r < 2; ++r)
#pragma unroll
                for (int k = 0; k < 4; ++k)
#pragma unroll
                    for (int i = 0; i < 2; ++i)
#pragma unroll
                        for (int j = 0; j < 2; ++j) { const f32x2 lo = __builtin_amdgcn_cvt_pk_f32_fp8((int)yv[r][k][i][j], false), hi = __builtin_amdgcn_cvt_pk_f32_fp8((int)yv[r][k][i][j], true);
                            f[r][i][4 * j] += ga[r][k] * lo[0]; f[r][i][4 * j + 1] += ga[r][k] * lo[1]; f[r][i][4 * j + 2] += ga[r][k] * hi[0]; f[r][i][4 * j + 3] += ga[r][k] * hi[1]; }
#else
            u32x4 yv[2][4][2]; float ga[2][4];
#pragma unroll
            for (int r = 0; r < 2; ++r)
#pragma unroll
                for (int k = 0; k < 4; ++k) { const bool ok = em[r] != 0u; const int ee = ok ? __builtin_ctz(em[r]) : 0; em[r] &= em[r] - 1u;
                    const int sl = rdlane_i(myslot[r], ee); ga[r][k] = ok ? rdlane_f(myaff[r], ee) : 0.f;
                    const bf16_t* yr = yexp + ((size_t)ee * MROWS + rbase[r] + (sl > 0 ? sl : 0)) * D_;
                    yv[r][k][0] = *(const u32x4*)(yr + lane * 8); yv[r][k][1] = *(const u32x4*)(yr + lane * 8 + 512); }
#pragma unroll
            for (int r = 0; r < 2; ++r)
#pragma unroll
                for (int k = 0; k < 4; ++k)
#pragma unroll
                    for (int i = 0; i < 2; ++i)
#pragma unroll
                        for (int j = 0; j < 4; ++j) { f[r][i][2 * j] += ga[r][k] * bflo(yv[r][k][i][j]); f[r][i][2 * j + 1] += ga[r][k] * bfhi(yv[r][k][i][j]); }
#endif
        }
#pragma unroll
        for (int r = 0; r < 2; ++r) { const int row = row0 + r * nw;
            if (row < ntok) {
                const bool isl = row < NL; const int bb = isl ? row / T_ : B_;
                const float* md = mods + (size_t)bb * 6144;
#pragma unroll
                for (int i = 0; i < 2; ++i) { const int c = lane * 8 + i * 512; const f32x4 g0 = *(const f32x4*)(md + 5120 + c), g1 = *(const f32x4*)(md + 5120 + c + 4);
#pragma unroll
                    for (int j = 0; j < 4; ++j) { v[r][i][j] = alpha * v[r][i][j] + g0[j] * f[r][i][j]; v[r][i][4 + j] = alpha * v[r][i][4 + j] + g1[j] * f[r][i][4 + j]; } }
                ln_row(v[r], lg, lb, lane);
#pragma unroll
                for (int i = 0; i < 2; ++i) { const int c = lane * 8 + i * 512;
                    if (!need_ctx) { float* xw = p.out + (size_t)row * D_; *(f32x4*)(xw + c) = (f32x4){v[r][i][0], v[r][i][1], v[r][i][2], v[r][i][3]}; *(f32x4*)(xw + c + 4) = (f32x4){v[r][i][4], v[r][i][5], v[r][i][6], v[r][i][7]}; }
                    else { const float* mn = modn + (size_t)bb * 6144;
                        *(u32x4*)(xh + (size_t)row * D_ + c) = pack8_h(v[r][i]);
                        const f32x4 s0 = *(const f32x4*)(mn + 1024 + c), s1 = *(const f32x4*)(mn + 1024 + c + 4), h0 = *(const f32x4*)(mn + c), h1 = *(const f32x4*)(mn + c + 4);
                        float uu[8];
#pragma unroll
                        for (int j = 0; j < 8; ++j) uu[j] = v[r][i][j] * ((j < 4 ? s0[j] : s1[j - 4]) + 1.0f) + (j < 4 ? h0[j] : h1[j - 4]);
                        u32x4 o; o[0] = pack2(uu[0], uu[1]); o[1] = pack2(uu[2], uu[3]); o[2] = pack2(uu[4], uu[5]); o[3] = pack2(uu[6], uu[7]);
                        *(u32x4*)(ub + (size_t)row * D_ + c) = o; } }
            }
        }
    }
}

__global__ void __launch_bounds__(512, 2) fwd(Params p) {
#ifdef HOST_EMU
    unsigned char* smem = emu::tls.dynsmem;
#else
    extern __shared__ __attribute__((aligned(16))) unsigned char smem_raw[];
    LAS unsigned char* smem = (LAS unsigned char*)smem_raw;
#endif
#ifdef HOST_EMU
    XcdBarrier bar = xcd_barrier_post(nullptr, nullptr);
#else
    volatile LAS unsigned* xbw = (volatile LAS unsigned*)(smem + LDS_BYTES - 16);
    if (threadIdx.x == 0) { xbw[0] = 0u; xbw[1] = 0u; xbw[2] = 0u; xbw[3] = 0u; }
    __syncthreads();
    XcdBarrier bar = xcd_barrier_post((unsigned*)(p.ws + WS_CTL), xbw);
#endif
#define SEAM(id) if ((id) > p.ph_lo && (id) < p.ph_hi) { xcd_barrier(bar); if (REP_K == 30) xcd_barrier(bar); }
#ifndef REP_K
#define REP_K -1
#endif
#define REPEAT(k) for (int rep_ = 0; rep_ < ((REP_K == (k) || REP_K == 99) ? 2 : 1); ++rep_)
#define REPBAR() if (rep_) xcd_barrier(bar)
#ifndef PH_MASK
#define PH_MASK 0xFFFF
#endif
#define RUN(id) if ((id) >= p.ph_lo && (id) < p.ph_hi)
#define RUNK(k) if (((PH_MASK >> (k)) & 1) && (base + (k)) >= p.ph_lo && (base + (k)) < p.ph_hi)
    if ((PH_MASK >> 15) & 1) RUN(0) REPEAT(15) { REPBAR(); phase_mods(p, smem); }
    const float alpha = sqrtf(sqrtf((float)(2 * DEPTH_)));
    for (int l = 0; l < DEPTH_; ++l) {
        const int base = 1 + l * NPH;
        const bool need_ctx = l < DEPTH_ - 1;
        SEAM(base + 0); RUNK(0) REPEAT(0) { REPBAR(); phase_convert(p, l, smem); }
        SEAM(base + 1); RUNK(1) REPEAT(1) { REPBAR();
            pg8::Gemm g; g.A = (const bf16_t*)(p.ws + WS_U); g.Bt = (const bf16_t*)(p.ws + WS_BTIN); g.K = D_; g.rowtab = nullptr;
            pg8::Order S; S.init(1, NTOK / 256, NTOK / 256, PROJ_NP / 256, gridDim.x, blockIdx.x);
            EpiProj E; E.proj = (bf16_t*)(p.ws + WS_R1 + R1_PROJ); E.gates = (float*)(p.ws + WS_R1 + R1_GATES); E.bias = (const float*)(p.ws + WS_BIAS);
            pg8::gemm_phase<EpiProj, false>(smem, g, S, E);
        }
        SEAM(base + 2); RUNK(2) REPEAT(2) { REPBAR(); phase_mixer(p, l, smem); }
        SEAM(base + 4); RUNK(4) REPEAT(4) { REPBAR();
            pg8::Gemm g; g.A = (const bf16_t*)(p.ws + WS_YMIX); g.Bt = (const bf16_t*)(p.ws + WS_BTOUT); g.K = D_; g.rowtab = nullptr;
            const int mt = (need_ctx ? NTOK : NL) / 256;
            pg8::Order S; S.init(1, mt, mt, D_ / 256, gridDim.x, blockIdx.x);
            EpiDown<false> E; E.y = (bf16_t*)(p.ws + WS_YO); E.sc = 1.0f;
            pg8::gemm_phase<EpiDown<false>, false>(smem, g, S, E);
        }
        SEAM(base + 5); RUNK(5) REPEAT(5) { REPBAR(); phase_ln1_router(p, l, smem); }
        SEAM(base + 6); RUNK(6) REPEAT(6) { REPBAR(); phase_topk(p, l, smem); }
        SEAM(base + 7); RUNK(7) REPEAT(7) { REPBAR();
            pg8::Gemm g; g.A = (const bf16_t*)(p.ws + WS_U); g.Bt = (const bf16_t*)(p.ws + WS_BTGU); g.K = MOE_F8 ? D_ / 2 : D_; g.rowtab = (const int*)(p.ws + WS_ROWTAB);
            pg8::Order S; S.init(NE, (need_ctx ? MROWS : MROWS_LAST) / 256, MROWS / 256, 2 * FF / 256, gridDim.x, blockIdx.x);
            EpiSwiglu E; E.h = (bf16_t*)(p.ws + WS_R1);
            pg8::gemm_phase<EpiSwiglu, true, MOE_F8 != 0>(smem, g, S, E);
        }
        SEAM(base + 8); RUNK(8) REPEAT(8) { REPBAR();
            pg8::Gemm g; g.A = (const bf16_t*)(p.ws + WS_R1); g.Bt = (const bf16_t*)(p.ws + WS_BTDN); g.K = MOE_F8 ? FF / 2 : FF; g.rowtab = nullptr;
            pg8::Order S; S.init(NE, (need_ctx ? MROWS : MROWS_LAST) / 256, MROWS / 256, D_ / 256, gridDim.x, blockIdx.x);
            EpiDown<(MOE_F8 && YEXP_F8)> E; E.y = (bf16_t*)(p.ws + WS_YEXP);
#if MOE_F8
            E.sc = (YEXP_F8 ? F8_SY : 1.0f) / (F8_SH * F8_SW2);
#else
            E.sc = 1.0f;
#endif
            pg8::gemm_phase<EpiDown<(MOE_F8 && YEXP_F8)>, false, MOE_F8 != 0>(smem, g, S, E);
        }
        SEAM(base + 9); RUNK(9) REPEAT(9) { REPBAR(); phase_combine(p, l); }
    }
}

extern "C" void kernel_launch(void* const* d_in, const int* in_sizes, int n_in, void* d_out, int out_size, void* d_ws, size_t ws_size, hipStream_t stream) {
    static int grid = 0;
    if (grid == 0) {
        if (n_in != 23 || out_size != NL * D_ || ws_size < WS_END) { fprintf(stderr, "kernel_launch: bad shapes: n_in %d out %d ws %zu (need %zu)\n", n_in, out_size, ws_size, (size_t)WS_END); grid = -1; return; }
        int dev = 0, cus = 0;
        if (hipGetDevice(&dev) != hipSuccess || hipDeviceGetAttribute(&cus, hipDeviceAttributeMultiprocessorCount, dev) != hipSuccess) { grid = -1; return; }
        if (hipFuncSetAttribute((const void*)fwd, hipFuncAttributeMaxDynamicSharedMemorySize, LDS_BYTES) != hipSuccess) { fprintf(stderr, "kernel_launch: hipFuncSetAttribute failed\n"); grid = -1; return; }
        (void)hipGetLastError();
        grid = cus;
    }
    if (grid < 0) return;
#ifdef HOST_EMU
    g_emu_bar.store(0);
#endif
    (void)hipMemsetAsync((char*)d_ws + WS_CTL, 0, WS_CTL_BYTES, stream);
    Params p{};
    for (int i = 0; i < 23; ++i) p.in[i] = (const float*)d_in[i];
    p.out = (float*)d_out; p.ws = (unsigned char*)d_ws;
#if ONE_LAUNCH
    p.ph_lo = 0; p.ph_hi = NPHASES;
#ifdef HOST_EMU
    if (getenv("EMU_PH_HI")) p.ph_hi = atoi(getenv("EMU_PH_HI"));
#endif
    hipLaunchKernelGGL(fwd, dim3(grid), dim3(512), LDS_BYTES, stream, p);
#else
    int nph = NPHASES;
#ifdef HOST_EMU
    if (getenv("EMU_PH_HI")) nph = atoi(getenv("EMU_PH_HI"));
#endif
    for (int ph = 0; ph < nph; ++ph) { p.ph_lo = ph; p.ph_hi = ph + 1; hipLaunchKernelGGL(fwd, dim3(grid), dim3(512), LDS_BYTES, stream, p); }
#endif
}
```

```cpp
#ifdef HOST_EMU
#include "emu.h"
#else
#include <hip/hip_runtime.h>
#include <cstdio>
#include <cstdint>
#endif

#ifndef CFG_BATCH
#define CFG_BATCH 32
#define CFG_SEQ 2048
#define CFG_CTX 256
#define CFG_DEPTH 4
#endif
#ifndef ONE_LAUNCH
#define ONE_LAUNCH 1
#endif
#ifndef MOE_F8
#ifdef HOST_EMU
#define MOE_F8 0
#else
#define MOE_F8 1
#endif
#endif
#ifndef YEXP_F8
#define YEXP_F8 1
#endif

#define DEV __device__ __forceinline__
typedef unsigned short bf16_t;
typedef short bf16x8 __attribute__((ext_vector_type(8)));
typedef short bf16x4 __attribute__((ext_vector_type(4)));
typedef float f32x4 __attribute__((ext_vector_type(4)));
typedef float f32x2 __attribute__((ext_vector_type(2)));
typedef unsigned u32x4 __attribute__((ext_vector_type(4)));
typedef unsigned u32x2 __attribute__((ext_vector_type(2)));
typedef int i32x8 __attribute__((ext_vector_type(8)));

constexpr int B_ = CFG_BATCH, T_ = CFG_SEQ, TC_ = CFG_CTX, DEPTH_ = CFG_DEPTH;
constexpr int D_ = 1024, NL = B_ * T_, NC = B_ * TC_, NTOK = NL + NC;
constexpr int PROJ_W0 = 3376, PROJ_N = 3328, PROJ_NP = 3584, NG = 48;
constexpr int FF = 2048, NE = 16;
constexpr int CAP_L = 2 * T_ / NE, CAP_C = 2 * TC_ / NE;
constexpr int ROWS_L = B_ * CAP_L, ROWS_C = B_ * CAP_C;
constexpr int MROWS = ((ROWS_L + ROWS_C + 255) / 256) * 256;
constexpr int MROWS_LAST = ((ROWS_L + 255) / 256) * 256;
constexpr int NCH_C = TC_ / 64, NCH_L = T_ / 64, NCH = NCH_C + NCH_L;
constexpr int GRID_R = T_ / 64;
constexpr float LN_EPS = 1e-5f;
constexpr int C_MQ = 0, C_MK = 256, C_MV = 512, C_MO = 768, C_GQ = 1024, C_GK = 1152, C_GV = 1280, C_GR = 1536, C_NQ = 1792, C_NK = 2304, C_NV = 2816;
static_assert(T_ % 256 == 0 && TC_ % 256 == 0 && NL % 256 == 0 && NC % 256 == 0, "shape");
static_assert(GRID_R >= 8, "rows");

constexpr size_t al256(size_t x) { return (x + 255) & ~(size_t)255; }
constexpr size_t WS_CTL = 0;
constexpr size_t WS_CTL_BYTES = 16384;
constexpr size_t WS_MODS = WS_CTL + WS_CTL_BYTES;
constexpr size_t WS_ROPE = WS_MODS + al256((size_t)DEPTH_ * (B_ + 1) * 6144 * 4);
constexpr size_t WS_BIAS = WS_ROPE + al256((64 * 16 * 2 + 64 * 8 * 2) * 4);
constexpr size_t WS_BTIN = WS_BIAS + al256(PROJ_NP * 4);
constexpr size_t WS_BTOUT = WS_BTIN + al256((size_t)PROJ_NP * D_ * 2);
constexpr size_t WBYTES = MOE_F8 ? 1 : 2;
constexpr size_t WS_BTGU = WS_BTOUT + al256((size_t)D_ * D_ * 2);
constexpr size_t WS_BTDN = WS_BTGU + al256((size_t)NE * 2 * FF * D_ * WBYTES);
constexpr size_t WS_U = WS_BTDN + al256((size_t)NE * D_ * FF * WBYTES);
constexpr size_t WS_XH = WS_U + al256((size_t)NTOK * D_ * 2);
constexpr size_t WS_AFF = WS_XH + al256((size_t)NTOK * D_ * 2);
constexpr size_t WS_SLOT = WS_AFF + al256((size_t)NTOK * 16 * 4);
constexpr size_t WS_GSCAN = WS_SLOT + al256((size_t)NTOK * 16 * 4);
constexpr size_t WS_ROWTAB = WS_GSCAN + al256((size_t)B_ * 8 * NCH * 192 * 4);
constexpr size_t WS_YMIX = WS_ROWTAB + al256((size_t)NE * MROWS * 4);
constexpr size_t WS_YEXP = WS_YMIX + al256((size_t)NTOK * D_ * 2);
constexpr size_t WS_R1 = WS_YEXP + al256((size_t)NE * MROWS * D_ * 2);
constexpr size_t R1_PROJ = 0;
constexpr size_t R1_GATES = R1_PROJ + al256((size_t)NTOK * PROJ_N * 2);
constexpr size_t R1_OM = R1_GATES + al256((size_t)NTOK * NG * 4);
constexpr size_t R1_OG = R1_OM + al256((size_t)2 * NTOK * 256 * 2);
constexpr size_t R1_QK2 = R1_OG + al256((size_t)2 * NTOK * 256 * 2);
constexpr size_t R1_END = R1_QK2 + al256((size_t)NTOK * 512 * 2);
constexpr size_t R1_H_BYTES = al256((size_t)NE * MROWS * FF * 2);
constexpr size_t WS_YO = WS_R1 + (R1_END > R1_H_BYTES ? R1_END : R1_H_BYTES);
#if MOE_F8 && YEXP_F8
constexpr size_t WS_X1H = WS_YEXP + (size_t)NE * MROWS * D_;
constexpr size_t WS_END = WS_YO + al256((size_t)NTOK * D_ * 2);
#else
constexpr size_t WS_X1H = WS_YO + al256((size_t)NTOK * D_ * 2);
constexpr size_t WS_END = WS_X1H + al256((size_t)NTOK * D_ * 2);
#endif
static_assert((size_t)NE * MROWS * D_ >= (size_t)NTOK * D_ * 2, "x1 alias");

constexpr int LDS_BYTES = 144 * 1024;
constexpr int NPH = 10;
constexpr int NPHASES = 1 + DEPTH_ * NPH;

struct Params {
    const float* in[23];
    float* out;
    unsigned char* ws;
    int ph_lo, ph_hi;
};

#ifdef HOST_EMU
#define LAS
static inline unsigned f_as_u(float f) { unsigned u; memcpy(&u, &f, 4); return u; }
static inline float u_as_f(unsigned u) { float f; memcpy(&f, &u, 4); return f; }
static inline float shfl_xor_f(float v, int m) { auto t = emu::wave_all(&v, 4); float r; memcpy(&r, t[emu::lane() ^ m], 4); return r; }
static inline float shfl_up_f(float v, int d) { auto t = emu::wave_all(&v, 4); int l = emu::lane(); float r; memcpy(&r, t[l >= d ? l - d : l], 4); return r; }
static inline float shfl_idx_f(float v, int s) { auto t = emu::wave_all(&v, 4); float r; memcpy(&r, t[s & 63], 4); return r; }
static inline int shfl_idx_i(int v, int s) { auto t = emu::wave_all(&v, 4); int r; memcpy(&r, t[s & 63], 4); return r; }
static inline int rdlane_i(int v, int s) { return shfl_idx_i(v, s); }
static inline float rdlane_f(float v, int s) { return shfl_idx_f(v, s); }
static inline f32x4 mfma16(bf16x8 a, bf16x8 b, f32x4 c) {
    struct { bf16x8 a, b; } d; d.a = a; d.b = b;
    auto t = emu::wave_all(&d, 32);
    int l = emu::lane(), col = l & 15, g = l >> 4;
    for (int r = 0; r < 4; ++r) {
        int row = 4 * g + r; float s = c[r];
        for (int k = 0; k < 32; ++k) {
            unsigned short av, bv;
            memcpy(&av, t[row + 16 * (k >> 3)] + 2 * (k & 7), 2);
            memcpy(&bv, t[col + 16 * (k >> 3)] + 16 + 2 * (k & 7), 2);
            s += u_as_f((unsigned)av << 16) * u_as_f((unsigned)bv << 16);
        }
        c[r] = s;
    }
    return c;
}
static inline void glds16(const void* g, unsigned char* l) { memcpy(l + 16 * emu::lane(), g, 16); }
#define S_BARRIER() __syncthreads()
#define WAIT_V(n)
#define WAIT_L(n)
#define SCHED_BAR()
#define SETPRIO(n)
#define RFL(x) (x)
static inline float fast_exp(float x) { return expf(x); }
static inline float fast_rcp(float x) { return 1.0f / x; }
static inline float fast_exp2(float x) { return exp2f(x); }
static inline float fast_log(float x) { return logf(x); }
#else
#define LAS __attribute__((address_space(3)))
DEV unsigned f_as_u(float f) { return __float_as_uint(f); }
DEV float u_as_f(unsigned u) { return __uint_as_float(u); }
DEV float shfl_xor_f(float v, int m) { return __shfl_xor(v, m, 64); }
DEV float shfl_up_f(float v, int d) { return __shfl_up(v, d, 64); }
DEV float shfl_idx_f(float v, int s) { return __shfl(v, s, 64); }
DEV int shfl_idx_i(int v, int s) { return __shfl(v, s, 64); }
DEV int rdlane_i(int v, int s) { return __builtin_amdgcn_readlane(v, s); }
DEV float rdlane_f(float v, int s) { return __uint_as_float((unsigned)__builtin_amdgcn_readlane((int)__float_as_uint(v), s)); }
DEV f32x4 mfma16(bf16x8 a, bf16x8 b, f32x4 c) { return __builtin_amdgcn_mfma_f32_16x16x32_bf16(a, b, c, 0, 0, 0); }
DEV void glds16(const void* g, LAS unsigned char* l) { __builtin_amdgcn_global_load_lds((const unsigned*)g, (LAS unsigned*)l, 16, 0, 0); }
#define S_BARRIER() __builtin_amdgcn_s_barrier()
#define WAIT_V(n) asm volatile("s_waitcnt vmcnt(" #n ")" ::: "memory")
#define WAIT_L(n) asm volatile("s_waitcnt lgkmcnt(" #n ")" ::: "memory")
#define SCHED_BAR() __builtin_amdgcn_sched_barrier(0)
#define SETPRIO(n) __builtin_amdgcn_s_setprio(n)
#define RFL(x) __builtin_amdgcn_readfirstlane(x)
DEV float fast_exp(float x) { return __expf(x); }
DEV float fast_rcp(float x) { return __builtin_amdgcn_rcpf(x); }
DEV float fast_exp2(float x) { return __builtin_amdgcn_exp2f(x); }
DEV float fast_log(float x) { return __logf(x); }
#endif

#ifdef HOST_EMU
DEV int opaque_tid() { return (int)threadIdx.x; }
#else
DEV int opaque_tid() { int t = threadIdx.x; asm volatile("" : "+v"(t)); return t; }
#endif
#ifdef HOST_EMU
typedef const unsigned char* lds_addr_t;
static inline lds_addr_t lds_addr(const void* p) { return (lds_addr_t)p; }
template <int OFF> static inline bf16x4 tr_read4(lds_addr_t vb) {
    const unsigned char* a = vb + OFF; auto t = emu::wave_all(&a, 8); const int l = emu::lane(), G = l >> 4, i = l & 15; bf16x4 r;
    for (int q = 0; q < 4; ++q) { const unsigned char* src; memcpy(&src, t[16 * G + 4 * q + (i >> 2)], 8); short v; memcpy(&v, src + 2 * (i & 3), 2); r[q] = v; }
    return r; }
#define LGKM_WAIT0()
#define LDS_BARRIER() __syncthreads()
#else
typedef unsigned lds_addr_t;
DEV lds_addr_t lds_addr(const LAS void* p) { return (unsigned)(size_t)p; }
template <int OFF> DEV bf16x4 tr_read4(lds_addr_t vb) { bf16x4 r; asm volatile("ds_read_b64_tr_b16 %0, %1 offset:%2" : "=&v"(r) : "v"(vb), "i"(OFF) : "memory"); return r; }
#define LGKM_WAIT0() do { asm volatile("s_waitcnt lgkmcnt(0)" ::: "memory"); __builtin_amdgcn_sched_barrier(0); } while (0)
#define LDS_BARRIER() do { asm volatile("s_waitcnt lgkmcnt(0)" ::: "memory"); __builtin_amdgcn_s_barrier(); asm volatile("" ::: "memory"); } while (0)
#endif
DEV bf16_t f2bf(float f) { unsigned u = f_as_u(f); u += 0x7FFFu + ((u >> 16) & 1u); return (bf16_t)(u >> 16); }
DEV float bf2f(bf16_t b) { return u_as_f((unsigned)b << 16); }
#ifdef HOST_EMU
DEV unsigned pack2(float lo, float hi) { return (unsigned)f2bf(lo) | ((unsigned)f2bf(hi) << 16); }
#else
DEV unsigned pack2(float lo, float hi) { unsigned r; asm volatile("v_cvt_pk_bf16_f32 %0, %1, %2" : "=v"(r) : "v"(lo), "v"(hi)); return r; }
#endif
DEV float bflo(unsigned u) { return u_as_f(u << 16); }
DEV float bfhi(unsigned u) { return u_as_f(u & 0xFFFF0000u); }
DEV float siluf(float x) { return x / (1.0f + expf(-x)); }
DEV float sigmoidf_(float x) { return 1.0f / (1.0f + expf(-x)); }
DEV float logsigf(float x) { return fminf(x, 0.0f) - log1pf(expf(-fabsf(x))); }
#ifdef HOST_EMU
DEV float xrow16_max(float x) { x = fmaxf(x, shfl_xor_f(x, 16)); return fmaxf(x, shfl_xor_f(x, 32)); }
DEV float xrow16_sum(float x) { x += shfl_xor_f(x, 16); return x + shfl_xor_f(x, 32); }
#else
DEV float xrow16_max(float x) {
    auto s = __builtin_amdgcn_permlane16_swap(__float_as_uint(x), __float_as_uint(x), false, false);
    x = fmaxf(__uint_as_float(s[0]), __uint_as_float(s[1]));
    auto t = __builtin_amdgcn_permlane32_swap(__float_as_uint(x), __float_as_uint(x), false, false);
    return fmaxf(__uint_as_float(t[0]), __uint_as_float(t[1])); }
DEV float xrow16_sum(float x) {
    auto s = __builtin_amdgcn_permlane16_swap(__float_as_uint(x), __float_as_uint(x), false, false);
    x = __uint_as_float(s[0]) + __uint_as_float(s[1]);
    auto t = __builtin_amdgcn_permlane32_swap(__float_as_uint(x), __float_as_uint(x), false, false);
    return __uint_as_float(t[0]) + __uint_as_float(t[1]); }
#endif
#if MOE_F8
constexpr float F8_SW1 = 32.0f, F8_SH = 4.0f, F8_SW2 = 128.0f, F8_SY = 16.0f;
DEV float f8clamp(float x) { return fminf(fmaxf(x, -448.0f), 448.0f); }
DEV unsigned pack4_f8(float a, float b, float c, float d) {
    int p_ = __builtin_amdgcn_cvt_pk_fp8_f32(f8clamp(a), f8clamp(b), 0, false);
    p_ = __builtin_amdgcn_cvt_pk_fp8_f32(f8clamp(c), f8clamp(d), p_, true);
    return (unsigned)p_; }
typedef int i32x4 __attribute__((ext_vector_type(4)));
DEV void mfma_f8(f32x4& c, bf16x8 a0, bf16x8 a1, bf16x8 b0, bf16x8 b1, int sc) {
    i32x4 al, ah, bl, bh; __builtin_memcpy(&al, &a0, 16); __builtin_memcpy(&ah, &a1, 16); __builtin_memcpy(&bl, &b0, 16); __builtin_memcpy(&bh, &b1, 16);
    const i32x8 A = __builtin_shufflevector(al, ah, 0, 1, 2, 3, 4, 5, 6, 7), B = __builtin_shufflevector(bl, bh, 0, 1, 2, 3, 4, 5, 6, 7);
    asm volatile("v_mfma_scale_f32_16x16x128_f8f6f4 %0, %1, %2, %0, %3, %3 op_sel_hi:[0,0,0]" : "+v"(c) : "v"(A), "v"(B), "v"(sc)); }
#define MFMA_DRAIN() asm volatile("s_nop 15\n\ts_nop 15" ::: "memory")
#endif
typedef _Float16 h16x8 __attribute__((ext_vector_type(8)));
DEV u32x4 pack8_h(const float (&v)[8]) { h16x8 h; for (int j = 0; j < 8; ++j) h[j] = (_Float16)v[j]; u32x4 o; __builtin_memcpy(&o, &h, 16); return o; }
DEV void unpack8_h(u32x4 u, float (&v)[8]) { h16x8 h; __builtin_memcpy(&h, &u, 16); for (int j = 0; j < 8; ++j) v[j] = (float)h[j]; }
#ifdef HOST_EMU
DEV bool wave_any(bool b) { float v = b ? 1.f : 0.f; for (int m = 32; m >= 1; m >>= 1) v = fmaxf(v, shfl_xor_f(v, m)); return v > 0.f; }
#else
DEV bool wave_any(bool b) { return __builtin_amdgcn_ballot_w64(b) != 0ull; }
#endif
#ifdef HOST_EMU
template <class T> static inline void st_stream(T* q, T v) { *q = v; }
#else
template <class T> DEV void st_stream(T* q, T v) { __builtin_nontemporal_store(v, q); }
#endif
#ifdef HOST_EMU
template <class T> static inline T ld_stream(const T* q) { return *q; }
#else
template <class T> DEV T ld_stream(const T* q) { return __builtin_nontemporal_load(q); }
#endif
DEV float silu_fast(float x) { return x * fast_rcp(1.0f + fast_exp(-x)); }
DEV float sigmoid_fast(float x) { return fast_rcp(1.0f + fast_exp(-x)); }
DEV float logsig_fast(float x) { return fminf(x, 0.0f) - fast_log(1.0f + fast_exp(-fabsf(x))); }
#ifdef HOST_EMU
DEV float wave_sum(float v) { for (int m = 32; m >= 1; m >>= 1) v += shfl_xor_f(v, m); return v; }
DEV float wave_max(float v) { for (int m = 32; m >= 1; m >>= 1) v = fmaxf(v, shfl_xor_f(v, m)); return v; }
DEV float xsum32(float a, float b) { const float pa = shfl_xor_f(a, 32), pb = shfl_xor_f(b, 32); return (emu::lane() & 32) ? b + pb : a + pa; }
DEV float xsum16(float a, float b) { const float pa = shfl_xor_f(a, 16), pb = shfl_xor_f(b, 16); return (emu::lane() & 16) ? b + pb : a + pa; }
DEV float xsum8(float a, float b, int lane) { const float pa = shfl_xor_f(a, 8), pb = shfl_xor_f(b, 8); return (lane & 8) ? b + pb : a + pa; }
DEV float xsum4(float a, float b, int lane) { const float pa = shfl_xor_f(a, 4), pb = shfl_xor_f(b, 4); return (lane & 4) ? b + pb : a + pa; }
DEV float quad_sum(float v) { v += shfl_xor_f(v, 1); return v + shfl_xor_f(v, 2); }
#else
template <int CTRL> DEV float dpp_f(float x) { return __uint_as_float((unsigned)__builtin_amdgcn_update_dpp(0, (int)__float_as_uint(x), CTRL, 0xF, 0xF, false)); }
DEV float wave_sum(float v) {
    v += dpp_f<0x128>(v); v += dpp_f<0x124>(v); v += dpp_f<0x122>(v); v += dpp_f<0x121>(v);
    return xrow16_sum(v); }
DEV float wave_max(float v) {
    v = fmaxf(v, dpp_f<0x128>(v)); v = fmaxf(v, dpp_f<0x124>(v)); v = fmaxf(v, dpp_f<0x122>(v)); v = fmaxf(v, dpp_f<0x121>(v));
    return xrow16_max(v); }
DEV float xsum32(float a, float b) { auto s_ = __builtin_amdgcn_permlane32_swap(__float_as_uint(a), __float_as_uint(b), false, false); return __uint_as_float(s_[0]) + __uint_as_float(s_[1]); }
DEV float xsum16(float a, float b) { auto s_ = __builtin_amdgcn_permlane16_swap(__float_as_uint(a), __float_as_uint(b), false, false); return __uint_as_float(s_[0]) + __uint_as_float(s_[1]); }
DEV float xsum8(float a, float b, int lane) { const bool hi = (lane & 8) != 0; return (hi ? b : a) + dpp_f<0x128>(hi ? a : b); }
DEV float xsum4(float a, float b, int lane) { const bool hi = (lane & 4) != 0; return (hi ? b : a) + __shfl_xor(hi ? a : b, 4, 64); }
DEV float quad_sum(float v) { v += dpp_f<0xB1>(v); return v + dpp_f<0x4E>(v); }
#endif

#ifdef HOST_EMU
static std::atomic<unsigned> g_emu_bar{0};
struct XcdBarrier { unsigned n; };
static inline XcdBarrier xcd_barrier_post(unsigned*, unsigned*) { XcdBarrier b; b.n = 0; return b; }
static inline void xcd_barrier(XcdBarrier& b) {
    __syncthreads();
    if (threadIdx.x == 0) { b.n++; g_emu_bar.fetch_add(1); while (g_emu_bar.load() < b.n * gridDim.x) std::this_thread::yield(); }
    __syncthreads();
}
#else
#define XB_TMO      128
#define XB_XCNT(j)  (256  + 64 * (j))
#define XB_XSUB(j)  (1280 + 64 * (j))
#define XB_XGEN(j)  (2304 + 64 * (j))
#define XB_TOP      3328
#define XB_TOPGEN   3392
#define XCD_BAR_WORDS 3456
#define XB_QUEUE     3584
#define XB_SPIN_CAP (1u << 22)
DEV unsigned xb_ld(unsigned* p)              { return __hip_atomic_load(p, __ATOMIC_RELAXED, __HIP_MEMORY_SCOPE_AGENT); }
DEV unsigned xb_add(unsigned* p, unsigned v) { return __hip_atomic_fetch_add(p, v, __ATOMIC_RELAXED, __HIP_MEMORY_SCOPE_AGENT); }
DEV unsigned xb_xcc_id() { return (unsigned)__builtin_amdgcn_s_getreg((3 << 11) | 20) & 0xFu; }
#define XB_SPIN(cond, bar) do { unsigned _sp = 0; while (cond) { __builtin_amdgcn_s_sleep(1); \
    if ((++_sp & 255u) == 0u) { if (xb_ld(&(bar)[XB_TMO])) break; if (_sp > XB_SPIN_CAP) { atomicAdd(&(bar)[XB_TMO], 1u); break; } } } } while (0)
struct XcdBarrier { unsigned* bar; unsigned x; volatile LAS unsigned* st; };
DEV XcdBarrier xcd_barrier_post(unsigned* bar, volatile LAS unsigned* st) {
    XcdBarrier b; b.bar = bar; b.x = xb_xcc_id(); b.st = st;
    if (threadIdx.x == 0) (void)xb_add(&bar[XB_XCNT(b.x)], 1u);
    return b;
}
DEV void xcd_barrier_complete(unsigned* bar, unsigned x, unsigned& nloc, unsigned& nx) {
    const unsigned G = gridDim.x * gridDim.y * gridDim.z;
    unsigned sum, cnt, mine, sp = 0u;
    for (;;) {
        sum = 0u; cnt = 0u; mine = 0u;
#pragma unroll
        for (unsigned j = 0; j < 16; ++j) { const unsigned c = xb_ld(&bar[XB_XCNT(j)]); sum += c; cnt += (c > 0u) ? 1u : 0u; mine = (j == x) ? c : mine; }
        if (sum == G) break;
        __builtin_amdgcn_s_sleep(1);
        if ((++sp & 255u) == 0u) { if (xb_ld(&bar[XB_TMO])) break; if (sp > XB_SPIN_CAP) { atomicAdd(&bar[XB_TMO], 1u); break; } }
    }
    nloc = mine > 0u ? mine : 1u; nx = cnt > 0u ? cnt : 1u;
}
DEV void xcd_barrier(const XcdBarrier& b) {
    asm volatile("s_waitcnt vmcnt(0)" ::: "memory");
    __syncthreads();
    if (threadIdx.x == 0) {
        unsigned* bar = b.bar;
        __builtin_amdgcn_s_waitcnt(0);
        unsigned nloc = b.st[0], nx = b.st[1];
        if (nloc == 0u) { xcd_barrier_complete(bar, b.x, nloc, nx); b.st[0] = nloc; b.st[1] = nx; }
        const unsigned old = xb_add(&bar[XB_XSUB(b.x)], 1u);
        const unsigned gen = old / nloc;
        if (old + 1u == (gen + 1u) * nloc) {
            __builtin_amdgcn_fence(__ATOMIC_RELEASE, "agent");
            asm volatile("s_waitcnt vmcnt(0)" ::: "memory");
            const unsigned og = xb_add(&bar[XB_TOP], 1u);
            const unsigned tg = og / nx;
            if (og + 1u == (tg + 1u) * nx) xb_add(&bar[XB_TOPGEN], 1u);
            else XB_SPIN(xb_ld(&bar[XB_TOPGEN]) == tg, bar);
            __builtin_amdgcn_fence(__ATOMIC_ACQUIRE, "agent");
            xb_add(&bar[XB_XGEN(b.x)], 1u);
            asm volatile("s_waitcnt vmcnt(0)" ::: "memory");
        } else {
            XB_SPIN(xb_ld(&bar[XB_XGEN(b.x)]) == gen, bar);
            __builtin_amdgcn_fence(__ATOMIC_ACQUIRE, "agent");
            asm volatile("s_waitcnt vmcnt(0)" ::: "memory");
        }
    }
    __syncthreads();
}
#endif

namespace pg8 {
constexpr int BM = 256, BK = 64, HALF = 128, HTB = HALF * BK * 2, STAGE_BYTES = 8 * HTB, NXCD = 8, WGM = 8;
DEV int lds_byte(int r, int c) { const int st = (r >> 4) * 2 + (c >> 5), rr = r & 15, cc = c & 31, ob = rr * 64 + cc * 2; return st * 1024 + (ob ^ (((ob >> 9) & 1) << 5)); }
DEV void stage_rc(int b, int& R, int& C) { const int st = b / 1024, sb = b % 1024, swz = sb ^ (((sb >> 9) & 1) << 5); R = (st >> 1) * 16 + swz / 64; C = (st & 1) * 32 + (swz % 64) / 2; }
DEV int perm32(int rho) { const int n = rho >> 4, i = rho & 15; return 8 * (i >> 2) + 4 * n + (i & 3); }

struct Unit { int pm, pn, pb; };
struct Gemm { const bf16_t* A; const bf16_t* Bt; int K; const int* rowtab; };

struct Order {
    int nM, nN, nwg, G, c, mt, mts;
    DEV void init(int ngrp, int mt_, int mts_, int nN_, int G_, int c_) { mt = mt_; mts = mts_; nM = ngrp * mt_; nN = nN_; nwg = nM * nN; G = G_; c = c_; }
    DEV bool next(int i, Unit& u) const {
        const long L = (long)i * G + c; if (L >= nwg) return false;
        int wgid = (int)L; { const int q = nwg / NXCD, r = nwg % NXCD, xcd = wgid % NXCD, off = wgid / NXCD; wgid = (xcd < r ? xcd * (q + 1) : r * (q + 1) + (xcd - r) * q) + off; }
        const int nig = WGM * nN, gid = wgid / nig, fm = gid * WGM, gsz = (nM - fm) < WGM ? (nM - fm) : WGM;
        const int pmv = fm + ((wgid % nig) % gsz); u.pn = (wgid % nig) / gsz;
        const int e = pmv / mt, pl = pmv - e * mt; u.pm = e * mts + pl; u.pb = e * nN + u.pn; return true;
    }
};

template <class Epi, bool GATHER, bool F8 = false>
DEV void gemm_phase(LAS unsigned char* lds, const Gemm g, const Order& S, const Epi& E) {
    const int tid = opaque_tid(), wid = RFL(tid >> 6), lane = tid & 63, wr = wid >> 2, wc = wid & 3, fr = lane & 15, fq = lane >> 4;
    const int K = g.K, nt = K / BK;
    unsigned voffA[2], voffB[2];
#pragma unroll
    for (int i = 0; i < 2; ++i) { int R, C; stage_rc(tid * 16 + i * 8192, R, C); const int Rb = Epi::PERM ? ((R & ~31) + perm32(R & 31)) : R;
        voffA[i] = (unsigned)(R * K + C) * 2u; voffB[i] = (unsigned)(Rb * K + C) * 2u; }
    const size_t kstep = (size_t)(BK * 2);
    const size_t hstep = (size_t)HALF * K * 2;
    const size_t tstep = 2 * hstep;
    const unsigned ldsw = (unsigned)wid * 1024u;
    const int aoff = lds_byte(wr * 64 + fr, fq * 8), boff = lds_byte(wc * 32 + fr, fq * 8);
#define PG8_SA(b, h) (((b) * 2 + (h)) * HTB)
#define PG8_SB(b, h) ((4 + (b) * 2 + (h)) * HTB)
#define PG8_STAGE(bufoff, gbase, voff) do { _Pragma("unroll") for (int _i = 0; _i < 2; ++_i) \
        glds16((const char*)(gbase) + (voff)[_i], lds + (bufoff) + ldsw + _i * 8192); } while (0)
#define PG8_STAGE_A(bufoff, gbase, h, nx) do { _Pragma("unroll") for (int _i = 0; _i < 2; ++_i) { \
        if constexpr (GATHER) glds16((const char*)(gbase) + ((nx) ? na[h][_i] : ca[h][_i]), lds + (bufoff) + ldsw + _i * 8192); \
        else glds16((const char*)(gbase) + (size_t)(h) * hstep + voffA[_i], lds + (bufoff) + ldsw + _i * 8192); } } while (0)
#define PG8_LDA(dst, b, h) do { _Pragma("unroll") for (int m = 0; m < 4; ++m) _Pragma("unroll") for (int k = 0; k < 2; ++k) dst[m][k] = *(const LAS bf16x8*)(lds + PG8_SA(b, h) + aoff + m * 2048 + k * 1024); } while (0)
#define PG8_LDB(dst, b, h) do { _Pragma("unroll") for (int n = 0; n < 2; ++n) _Pragma("unroll") for (int k = 0; k < 2; ++k) dst[n][k] = *(const LAS bf16x8*)(lds + PG8_SB(b, h) + boff + n * 2048 + k * 1024); } while (0)
#if MOE_F8
#define PG8_MMA(ai, bj, At, Bt) do { SETPRIO(1); _Pragma("unroll") for (int m = 0; m < 4; ++m) _Pragma("unroll") for (int n = 0; n < 2; ++n) { \
        if constexpr (F8) mfma_f8(acc[ai][bj][m][n], Bt[n][0], Bt[n][1], At[m][0], At[m][1], f8sc); \
        else { _Pragma("unroll") for (int k = 0; k < 2; ++k) acc[ai][bj][m][n] = mfma16(Bt[n][k], At[m][k], acc[ai][bj][m][n]); } } SETPRIO(0); } while (0)
#else
#define PG8_MMA(ai, bj, At, Bt) do { SETPRIO(1); _Pragma("unroll") for (int m = 0; m < 4; ++m) _Pragma("unroll") for (int n = 0; n < 2; ++n) _Pragma("unroll") for (int k = 0; k < 2; ++k) \
        acc[ai][bj][m][n] = mfma16(Bt[n][k], At[m][k], acc[ai][bj][m][n]); SETPRIO(0); } while (0)
#endif
    Unit cur, nxt; int ui = 0;
    if (!S.next(0, cur)) return;
#if MOE_F8
    int f8sc = 0x7F7F7F7F; asm volatile("" : "+v"(f8sc));
#endif
    f32x4 acc[2][2][4][2];
#pragma unroll
    for (int a = 0; a < 2; ++a)
#pragma unroll
        for (int b = 0; b < 2; ++b)
#pragma unroll
            for (int m = 0; m < 4; ++m)
#pragma unroll
                for (int n = 0; n < 2; ++n) acc[a][b][m][n] = (f32x4){0.f, 0.f, 0.f, 0.f};
    bf16x8 At[4][2], B0[2][2], B1[2][2];
    unsigned ca[2][2], na[2][2];
    const char* cA; const char* nA;
    const char* cB = (const char*)g.Bt + (size_t)cur.pb * tstep;
#define PG8_SETA(u, base, off) do { if constexpr (GATHER) { base = (const char*)g.A; \
            _Pragma("unroll") for (int _h = 0; _h < 2; ++_h) _Pragma("unroll") for (int _i = 0; _i < 2; ++_i) { int _R, _C; stage_rc(tid * 16 + _i * 8192, _R, _C); \
                off[_h][_i] = (unsigned)g.rowtab[(u).pm * 256 + _h * 128 + _R] * (unsigned)(K * 2) + (unsigned)_C * 2u; } } \
        else { base = (const char*)g.A + (size_t)(u).pm * tstep; } } while (0)
    PG8_SETA(cur, cA, ca);
    nA = cA;
    if constexpr (GATHER) {
#pragma unroll
        for (int _h = 0; _h < 2; ++_h)
#pragma unroll
            for (int _i = 0; _i < 2; ++_i) na[_h][_i] = ca[_h][_i]; }
    PG8_STAGE(PG8_SB(0, 0), cB, voffB); PG8_STAGE_A(PG8_SA(0, 0), cA, 0, false); PG8_STAGE(PG8_SB(0, 1), cB + hstep, voffB); PG8_STAGE_A(PG8_SA(0, 1), cA, 1, false);
    if (wr == 1) S_BARRIER();
    WAIT_V(4); S_BARRIER();
    PG8_STAGE(PG8_SB(1, 0), cB + kstep, voffB); PG8_STAGE_A(PG8_SA(1, 0), cA + kstep, 0, false); PG8_STAGE(PG8_SB(1, 1), cB + hstep + kstep, voffB);
    WAIT_V(6); S_BARRIER();
    for (;;) {
        const bool has_next = S.next(ui + 1, nxt);
        const char* nB = cB;
        if (has_next) { PG8_SETA(nxt, nA, na); nB = (const char*)g.Bt + (size_t)nxt.pb * tstep; }
        else { nA = cA;
            if constexpr (GATHER) {
#pragma unroll
                for (int _h = 0; _h < 2; ++_h)
#pragma unroll
                    for (int _i = 0; _i < 2; ++_i) na[_h][_i] = ca[_h][_i]; } }
        for (int t = 0; t < nt; t += 2) {
            const bool last = (t == nt - 2);
            const char* a1 = cA + (size_t)(t + 1) * kstep;
            const char* a2 = last ? nA : cA + (size_t)(t + 2) * kstep; const char* b2 = last ? nB : cB + (size_t)(t + 2) * kstep;
            const char* a3 = a2 + kstep; const char* b3 = b2 + kstep;
            PG8_LDB(B0, 0, 0); SCHED_BAR(); PG8_LDA(At, 0, 0); PG8_STAGE_A(PG8_SA(1, 1), a1, 1, false);
            WAIT_L(8); S_BARRIER(); WAIT_L(0); PG8_MMA(0, 0, At, B0); S_BARRIER(); SCHED_BAR();
            PG8_LDB(B1, 0, 1); PG8_STAGE(PG8_SB(0, 0), b2, voffB);
            S_BARRIER(); WAIT_L(0); PG8_MMA(0, 1, At, B1); S_BARRIER();
            PG8_LDA(At, 0, 1); PG8_STAGE_A(PG8_SA(0, 0), a2, 0, last);
            S_BARRIER(); WAIT_L(0); PG8_MMA(1, 0, At, B0); S_BARRIER(); SCHED_BAR();
            PG8_STAGE(PG8_SB(0, 1), b2 + hstep, voffB);
            WAIT_V(6); S_BARRIER(); PG8_MMA(1, 1, At, B1); S_BARRIER();
            PG8_LDB(B0, 1, 0); SCHED_BAR(); PG8_LDA(At, 1, 0); PG8_STAGE_A(PG8_SA(0, 1), a2, 1, last);
            WAIT_L(8); S_BARRIER(); WAIT_L(0); PG8_MMA(0, 0, At, B0); S_BARRIER(); SCHED_BAR();
            PG8_LDB(B1, 1, 1); PG8_STAGE(PG8_SB(1, 0), b3, voffB);
            S_BARRIER(); WAIT_L(0); PG8_MMA(0, 1, At, B1); S_BARRIER();
            PG8_LDA(At, 1, 1); PG8_STAGE_A(PG8_SA(1, 0), a3, 0, last);
            S_BARRIER(); WAIT_L(0); PG8_MMA(1, 0, At, B0); S_BARRIER(); SCHED_BAR();
            PG8_STAGE(PG8_SB(1, 1), b3 + hstep, voffB);
            WAIT_V(6); S_BARRIER(); PG8_MMA(1, 1, At, B1); S_BARRIER();
        }
#if MOE_F8
        if constexpr (F8) MFMA_DRAIN();
#endif
        E(acc, cur, wr, wc, fr, fq);
        if (!has_next) break;
#pragma unroll
        for (int a = 0; a < 2; ++a)
#pragma unroll
            for (int b = 0; b < 2; ++b)
#pragma unroll
                for (int m = 0; m < 4; ++m)
#pragma unroll
                    for (int n = 0; n < 2; ++n) acc[a][b][m][n] = (f32x4){0.f, 0.f, 0.f, 0.f};
        cur = nxt; cA = nA; cB = nB; ++ui;
        if constexpr (GATHER) {
#pragma unroll
            for (int _h = 0; _h < 2; ++_h)
#pragma unroll
                for (int _i = 0; _i < 2; ++_i) ca[_h][_i] = na[_h][_i]; }
    }
    WAIT_V(0);
    if (wr == 0) S_BARRIER();
    S_BARRIER();
#undef PG8_SA
#undef PG8_SB
#undef PG8_STAGE
#undef PG8_STAGE_A
#undef PG8_LDA
#undef PG8_LDB
#undef PG8_MMA
#undef PG8_SETA
}
}
using pg8::Unit;

struct EpiProj {
    static constexpr bool PERM = true;
    bf16_t* proj; float* gates; const float* bias;
    DEV void operator()(const f32x4 (&acc)[2][2][4][2], const Unit& u, int wr, int wc, int fr, int fq) const {
        const int row0 = u.pm * 256 + wr * 64 + fr; const int colt = u.pn * 256, cl = wc * 32 + 8 * fq;
        if (u.pn < PROJ_N / 256) {
#pragma unroll
            for (int bj = 0; bj < 2; ++bj) { const f32x4 b0 = *(const f32x4*)(bias + colt + cl + bj * 128), b1 = *(const f32x4*)(bias + colt + cl + bj * 128 + 4);
#pragma unroll
                for (int ai = 0; ai < 2; ++ai)
#pragma unroll
                    for (int m = 0; m < 4; ++m) { bf16_t* rowp = proj + (size_t)(row0 + ai * 128 + m * 16) * PROJ_N + colt + cl + bj * 128;
                        const f32x4 v0 = acc[ai][bj][m][0] + b0, v1 = acc[ai][bj][m][1] + b1;
                        u32x4 o; o[0] = pack2(v0[0], v0[1]); o[1] = pack2(v0[2], v0[3]); o[2] = pack2(v1[0], v1[1]); o[3] = pack2(v1[2], v1[3]);
                        *(u32x4*)rowp = o; } }
        } else if (cl < NG) {
            const f32x4 b0 = *(const f32x4*)(bias + colt + cl), b1 = *(const f32x4*)(bias + colt + cl + 4);
#pragma unroll
            for (int ai = 0; ai < 2; ++ai)
#pragma unroll
                for (int m = 0; m < 4; ++m) { float* rowp = gates + (size_t)(row0 + ai * 128 + m * 16) * NG + cl;
                    *(f32x4*)(rowp) = acc[ai][0][m][0] + b0; *(f32x4*)(rowp + 4) = acc[ai][0][m][1] + b1; }
        }
    }
};
struct EpiSwiglu {
    static constexpr bool PERM = true;
    bf16_t* h;
    DEV void operator()(const f32x4 (&acc)[2][2][4][2], const Unit& u, int wr, int wc, int fr, int fq) const {
        const int row0 = u.pm * 256 + wr * 64 + fr; const int col0 = u.pn * 128 + wc * 32 + 8 * fq;
#if MOE_F8
        unsigned char* h8 = (unsigned char*)h;
        constexpr float isw = 1.0f / F8_SW1, kd = F8_SW1 * F8_SW1 / F8_SH;
#pragma unroll
        for (int ai = 0; ai < 2; ++ai)
#pragma unroll
            for (int m = 0; m < 4; ++m) { unsigned char* rowp = h8 + (size_t)(row0 + ai * 128 + m * 16) * FF + col0;
                float v[8];
#pragma unroll
                for (int n = 0; n < 2; ++n)
#pragma unroll
                    for (int j = 0; j < 4; ++j) {
                        const float e = fast_exp2(acc[ai][0][m][n][j] * (-isw * 1.44269504f)); v[n * 4 + j] = acc[ai][0][m][n][j] * acc[ai][1][m][n][j] * fast_rcp(e * kd + kd); }
                u32x2 o; o[0] = pack4_f8(v[0], v[1], v[2], v[3]); o[1] = pack4_f8(v[4], v[5], v[6], v[7]);
                *(u32x2*)rowp = o; }
        return;
#endif
#pragma unroll
        for (int ai = 0; ai < 2; ++ai)
#pragma unroll
            for (int m = 0; m < 4; ++m) { bf16_t* rowp = h + (size_t)(row0 + ai * 128 + m * 16) * FF + col0;
                float v[8];
#pragma unroll
                for (int n = 0; n < 2; ++n)
#pragma unroll
                    for (int j = 0; j < 4; ++j) { const float gt = acc[ai][0][m][n][j], up = acc[ai][1][m][n][j]; v[n * 4 + j] = gt * fast_rcp(1.0f + fast_exp(-gt)) * up; }
                u32x4 o; o[0] = pack2(v[0], v[1]); o[1] = pack2(v[2], v[3]); o[2] = pack2(v[4], v[5]); o[3] = pack2(v[6], v[7]);
                *(u32x4*)rowp = o; }
    }
};
template <bool F8OUT>
struct EpiDown {
    static constexpr bool PERM = true;
    bf16_t* y; float sc;
    DEV void operator()(const f32x4 (&acc)[2][2][4][2], const Unit& u, int wr, int wc, int fr, int fq) const {
        const int row0 = u.pm * 256 + wr * 64 + fr; const int col0 = u.pn * 256 + wc * 32 + 8 * fq;
#pragma unroll
        for (int ai = 0; ai < 2; ++ai)
#pragma unroll
            for (int m = 0; m < 4; ++m) {
#pragma unroll
                for (int bj = 0; bj < 2; ++bj) {
                    const f32x4 v0 = acc[ai][bj][m][0] * sc, v1 = acc[ai][bj][m][1] * sc;
#if MOE_F8
                    if constexpr (F8OUT) { unsigned char* rowp = (unsigned char*)y + (size_t)(row0 + ai * 128 + m * 16) * D_ + col0;
                        u32x2 o; o[0] = pack4_f8(v0[0], v0[1], v0[2], v0[3]); o[1] = pack4_f8(v1[0], v1[1], v1[2], v1[3]);
                        *(u32x2*)(rowp + bj * 128) = o; }
                    else
#endif
                    { bf16_t* rowp = y + (size_t)(row0 + ai * 128 + m * 16) * D_ + col0;
                        u32x4 o; o[0] = pack2(v0[0], v0[1]); o[1] = pack2(v0[2], v0[3]); o[2] = pack2(v1[0], v1[1]); o[3] = pack2(v1[2], v1[3]);
                        *(u32x4*)(rowp + bj * 128) = o; } } }
    }
};

DEV void phase_mods(const Params& p, LAS unsigned char* lds) {
    LAS float* sc = (LAS float*)lds;
    const int tid = opaque_tid(), col = tid & 63, ks = tid >> 6;
    float* mods = (float*)(p.ws + WS_MODS);
    constexpr int NB = B_ + 1;
    for (int u = blockIdx.x; u < DEPTH_ * 96; u += gridDim.x) {
        const int l = u / 96, cb = (u % 96) * 64;
        __syncthreads();
        for (int i = tid; i < NB * 1024; i += 512) { const int bb = i >> 10, k = i & 1023; const float cv = bb < B_ ? p.in[1][(size_t)bb * 1024 + k] : p.in[3][k]; sc[i] = siluf(cv); }
        __syncthreads();
        float acc[NB];
#pragma unroll
        for (int bb = 0; bb < NB; ++bb) acc[bb] = 0.f;
        const float* w = p.in[4] + (size_t)l * 1024 * 6144 + cb + col;
        for (int k = ks * 128; k < ks * 128 + 128; ++k) { const float wv = w[(size_t)k * 6144];
#pragma unroll
            for (int bb = 0; bb < NB; ++bb) acc[bb] += sc[bb * 1024 + k] * wv; }
        __syncthreads();
#pragma unroll
        for (int bb = 0; bb < NB; ++bb) sc[(ks * NB + bb) * 64 + col] = acc[bb];
        __syncthreads();
        for (int i = tid; i < NB * 64; i += 512) { const int bb = i >> 6, c2 = i & 63; float s = p.in[5][(size_t)l * 6144 + cb + c2];
            for (int q = 0; q < 8; ++q) s += sc[(q * NB + bb) * 64 + c2];
            mods[((size_t)l * NB + bb) * 6144 + cb + c2] = s; }
    }
    if (blockIdx.x == gridDim.x - 1) {
        float* rope = (float*)(p.ws + WS_ROPE);
        for (int i = tid; i < 64 * 16; i += 512) { const int pos = i >> 4, f = i & 15; const float inv = powf(10000.0f, -(float)f / 16.0f); const float a = (float)pos * inv; rope[i * 2] = cosf(a); rope[i * 2 + 1] = sinf(a); }
        for (int i = tid; i < 64 * 8; i += 512) { const int pos = i >> 3, f = i & 7; const float inv = powf(10000.0f, -(float)f / 8.0f); const float a = (float)pos * inv; rope[2048 + i * 2] = cosf(a); rope[2048 + i * 2 + 1] = sinf(a); }
    }
}

DEV int win_srccol(int n) {
    if (n < 1024) return n; if (n < 1792) return n + 16; if (n < 3328) return n + 48;
    if (n < 3344) return 1024 + (n - 3328); if (n < 3376) return 1808 + (n - 3344); return -1;
}
template <bool WIN>
DEV void conv_tile(const float* src, int ldn, int srcc0, bf16_t* dst, int ldk, int n0, int k0, LAS float* tile) {
    const int tid = opaque_tid(), nn = tid & 63, kk = tid >> 6;
    int sc_ = WIN ? win_srccol(n0 + nn) : srcc0 + nn;
#pragma unroll
    for (int i = 0; i < 8; ++i) { const int k = kk + 8 * i; tile[k * 65 + nn] = sc_ >= 0 ? src[(size_t)(k0 + k) * ldn + sc_] : 0.f; }
    __syncthreads();
    { const int n = tid >> 3, k8 = (tid & 7) * 8; float v[8];
#pragma unroll
      for (int j = 0; j < 8; ++j) v[j] = tile[(k8 + j) * 65 + n];
      u32x4 o; o[0] = pack2(v[0], v[1]); o[1] = pack2(v[2], v[3]); o[2] = pack2(v[4], v[5]); o[3] = pack2(v[6], v[7]);
      *(u32x4*)(dst + (size_t)(n0 + n) * ldk + k0 + k8) = o; }
    __syncthreads();
}
#if MOE_F8
constexpr float F8_SW1_ = F8_SW1, F8_SW2_ = F8_SW2;
#else
constexpr float F8_SW1_ = 0.f, F8_SW2_ = 0.f;
#endif
struct ConvTile { const float* s0; const float* s1; int ld; bf16_t* dst; int ldk; int n0, k0; int kind; };
#ifdef HOST_EMU
template <class T> static inline T* rfl_ptr(T* q) { return q; }
#else
template <class T> DEV T* rfl_ptr(T* q) { const unsigned long long v = (unsigned long long)q; const unsigned lo = (unsigned)RFL((int)(unsigned)v), hi = (unsigned)RFL((int)(unsigned)(v >> 32)); return (T*)(((unsigned long long)hi << 32) | lo); }
#endif
DEV ConvTile conv_desc(const Params& p, int l, int t_) {
    const int t = RFL(t_);
    ConvTile c;
    bf16_t* btin = (bf16_t*)(p.ws + WS_BTIN); bf16_t* btout = (bf16_t*)(p.ws + WS_BTOUT); bf16_t* btgu = (bf16_t*)(p.ws + WS_BTGU); bf16_t* btdn = (bf16_t*)(p.ws + WS_BTDN);
    const float* w_in = p.in[6] + (size_t)l * D_ * PROJ_W0; const float* w_out = p.in[14] + (size_t)l * D_ * D_;
    const float* w_gate = p.in[18] + (size_t)l * NE * D_ * FF; const float* w_up = p.in[19] + (size_t)l * NE * D_ * FF; const float* w_down = p.in[20] + (size_t)l * NE * FF * D_;
    constexpr int T_IN = 13 * 16, T_OUT = 4 * 16, T_GU = NE * 16 * 16;
    if (t < T_IN) { const int nb = t / 16, kt = t % 16; const int sc = win_srccol(nb * 256);
        c.kind = 0; c.s0 = w_in + sc; c.s1 = w_in + sc + 128; c.ld = PROJ_W0; c.dst = btin; c.ldk = D_; c.n0 = nb * 256; c.k0 = kt * 64; }
    else if (t < T_IN + T_OUT) { const int q = t - T_IN, nb = q / 16, kt = q % 16;
        c.kind = 0; c.s0 = w_out + nb * 256; c.s1 = c.s0 + 128; c.ld = D_; c.dst = btout; c.ldk = D_; c.n0 = nb * 256; c.k0 = kt * 64; }
    else if (t < T_IN + T_OUT + T_GU) { const int q = t - T_IN - T_OUT, e = q / 256, r = q % 256, nb = r / 16, kt = r % 16;
        c.kind = MOE_F8 ? 1 : 0; c.s0 = w_gate + (size_t)e * D_ * FF + nb * 128; c.s1 = w_up + (size_t)e * D_ * FF + nb * 128; c.ld = FF; c.dst = btgu + (size_t)e * 2 * FF * D_ / (MOE_F8 ? 2 : 1); c.ldk = D_; c.n0 = nb * 256; c.k0 = kt * 64; }
    else { const int q = t - T_IN - T_OUT - T_GU, e = q / 128, r = q % 128, nb = r / 32, kt = r % 32;
        c.kind = MOE_F8 ? 2 : 0; c.s0 = w_down + (size_t)e * FF * D_ + nb * 256; c.s1 = c.s0 + 128; c.ld = D_; c.dst = btdn + (size_t)e * D_ * FF / (MOE_F8 ? 2 : 1); c.ldk = FF; c.n0 = nb * 256; c.k0 = kt * 64; }
    c.s0 = rfl_ptr(c.s0); c.s1 = rfl_ptr(c.s1); c.dst = rfl_ptr(c.dst); c.ld = RFL(c.ld); c.ldk = RFL(c.ldk); c.n0 = RFL(c.n0); c.k0 = RFL(c.k0); c.kind = RFL(c.kind);
    return c;
}
DEV void conv_issue(const ConvTile& c, f32x4 (&r)[8], int tid) {
    const int nn4 = (tid & 63) * 4; const float* src = (nn4 < 128 ? c.s0 + nn4 : c.s1 + (nn4 - 128)) + (size_t)(c.k0 + (tid >> 6)) * c.ld;
#pragma unroll
    for (int i = 0; i < 8; ++i) r[i] = ld_stream((const f32x4*)(src + (size_t)(8 * i) * c.ld));
}
DEV void conv_finish(const ConvTile& c, const f32x4 (&r)[8], LAS float* tile, int tid) {
    const int nn4 = (tid & 63) * 4, kk = tid >> 6;
#pragma unroll
    for (int i = 0; i < 8; ++i) { LAS float* d = tile + (kk + 8 * i) * 257 + nn4; d[0] = r[i][0]; d[1] = r[i][1]; d[2] = r[i][2]; d[3] = r[i][3]; }
    __syncthreads();
#if MOE_F8
    if (c.kind != 0) { const int n = tid >> 1, kh = (tid & 1) * 32; unsigned char* drow = (unsigned char*)c.dst + (size_t)(c.n0 + n) * c.ldk + c.k0 + kh;
#pragma unroll
      for (int q = 0; q < 2; ++q) { float v[16];
          if (c.kind == 1) {
#pragma unroll
              for (int j = 0; j < 16; ++j) v[j] = tile[(kh + 16 * q + j) * 257 + n] * F8_SW1; }
          else {
#pragma unroll
              for (int j = 0; j < 16; ++j) v[j] = tile[(kh + 16 * q + j) * 257 + n] * F8_SW2; }
          u32x4 o; o[0] = pack4_f8(v[0], v[1], v[2], v[3]); o[1] = pack4_f8(v[4], v[5], v[6], v[7]); o[2] = pack4_f8(v[8], v[9], v[10], v[11]); o[3] = pack4_f8(v[12], v[13], v[14], v[15]);
          *(u32x4*)(drow + 16 * q) = o; } }
    else
#endif
    { const int n = tid >> 1, kh = (tid & 1) * 32; bf16_t* drow = c.dst + (size_t)(c.n0 + n) * c.ldk + c.k0 + kh;
#pragma unroll
      for (int q = 0; q < 4; ++q) { float v[8];
#pragma unroll
          for (int j = 0; j < 8; ++j) v[j] = tile[(kh + 8 * q + j) * 257 + n];
          u32x4 o; o[0] = pack2(v[0], v[1]); o[1] = pack2(v[2], v[3]); o[2] = pack2(v[4], v[5]); o[3] = pack2(v[6], v[7]);
          *(u32x4*)(drow + 8 * q) = o; } }
    __syncthreads();
}
DEV void phase_convert(const Params& p, int l, LAS unsigned char* lds) {
    LAS float* tile = (LAS float*)lds;
    const int tid = opaque_tid();
    constexpr int T_MAIN = 13 * 16 + 4 * 16 + NE * 16 * 16 + NE * 4 * 32;
    {
        f32x4 ra[8], rb[8];
        int t = blockIdx.x;
        ConvTile ca, cb;
        if (t < T_MAIN) { ca = conv_desc(p, l, t); conv_issue(ca, ra, tid); }
        while (t < T_MAIN) {
            const int t1 = t + gridDim.x;
            if (t1 < T_MAIN) { cb = conv_desc(p, l, t1); conv_issue(cb, rb, tid); }
            conv_finish(ca, ra, tile, tid);
            const int t2 = t1 + gridDim.x;
            if (t1 < T_MAIN) { if (t2 < T_MAIN) { ca = conv_desc(p, l, t2); conv_issue(ca, ra, tid); } conv_finish(cb, rb, tile, tid); }
            t = t2;
        }
    }
    { bf16_t* btin = (bf16_t*)(p.ws + WS_BTIN); const float* w_in = p.in[6] + (size_t)l * D_ * PROJ_W0;
      for (int t = blockIdx.x; t < 4 * 16; t += gridDim.x) conv_tile<true>(w_in, PROJ_W0, 0, btin, D_, PROJ_N + (t / 16) * 64, (t % 16) * 64, tile); }
    if (blockIdx.x == 0) { float* bias = (float*)(p.ws + WS_BIAS); const float* b_in = p.in[7] + (size_t)l * PROJ_W0;
        for (int i = tid; i < PROJ_NP; i += 512) { const int s = win_srccol(i); bias[i] = s >= 0 ? b_in[s] : 0.f; } }
    if (l == 0) {
        const float* mods = (const float*)(p.ws + WS_MODS); bf16_t* ub = (bf16_t*)(p.ws + WS_U);
        const int lane = tid & 63, gw = blockIdx.x * 8 + (tid >> 6), nw = gridDim.x * 8;
        for (int row = gw; row < NTOK; row += nw) {
            const bool isl = row < NL; const int bb = isl ? row / T_ : B_;
            const float* xr = isl ? p.in[0] + (size_t)row * D_ : p.in[2] + (size_t)(row - NL) * D_;
            const float* md = mods + (size_t)bb * 6144;
#pragma unroll
            for (int i = 0; i < 2; ++i) { const int c = lane * 8 + i * 512;
                const f32x4 x0 = *(const f32x4*)(xr + c), x1 = *(const f32x4*)(xr + c + 4), s0 = *(const f32x4*)(md + 1024 + c), s1 = *(const f32x4*)(md + 1024 + c + 4), h0 = *(const f32x4*)(md + c), h1 = *(const f32x4*)(md + c + 4);
                const f32x4 a = x0 * (s0 + 1.0f) + h0, b = x1 * (s1 + 1.0f) + h1;
                u32x4 o; o[0] = pack2(a[0], a[1]); o[1] = pack2(a[2], a[3]); o[2] = pack2(b[0], b[1]); o[3] = pack2(b[2], b[3]);
                *(u32x4*)(ub + (size_t)row * D_ + c) = o; }
        }
    }
}

DEV int tok_row(bool lat, int b, int pos) { return lat ? b * T_ + pos : NL + b * TC_ + pos; }
DEV bf16x8 lds_frag(const LAS bf16_t* base, int row, int stride, int col) { return *(const LAS bf16x8*)(base + row * stride + col); }

#ifdef HOST_EMU
#define WAVE_SYNC() do { int z_ = 0; (void)emu::wave_all(&z_, 4); } while (0)
#else
#define WAVE_SYNC() __builtin_amdgcn_wave_barrier()
#endif
#ifdef HOST_EMU
DEV void wg_release_acquire() { __syncthreads(); }
#else
DEV void wg_release_acquire() {
    __builtin_amdgcn_fence(__ATOMIC_RELEASE, "workgroup"); asm volatile("s_waitcnt vmcnt(0)" ::: "memory"); __syncthreads();
    __builtin_amdgcn_fence(__ATOMIC_ACQUIRE, "agent"); asm volatile("s_waitcnt vmcnt(0)" ::: "memory"); }
#endif
DEV void merge_head(const Params& p, int l, int b, int part, int h, int tid) {
    const bool need_ctx = l < DEPTH_ - 1;
    const bf16_t* proj = (const bf16_t*)(p.ws + WS_R1 + R1_PROJ); bf16_t* ymix = (bf16_t*)(p.ws + WS_YMIX);
    const bf16_t* o0 = (const bf16_t*)(p.ws + WS_R1 + (part ? R1_OG : R1_OM)); const bf16_t* o1 = o0 + (size_t)NTOK * 256;
    const int ch = h * 64 + (tid & 7) * 8;
    const float* gn = (part ? p.in[12] : p.in[11]) + (size_t)l * 256 + ch;
    const f32x4 g0 = *(const f32x4*)gn, g1 = *(const f32x4*)(gn + 4);
    const int ntk = T_ + (need_ctx ? TC_ : 0);
    for (int i0 = tid >> 3; i0 < ntk; i0 += 256) {
        int rows[4]; u32x4 oa[4], ob[4]; u32x4 gtv[4];
#pragma unroll
        for (int k = 0; k < 4; ++k) { const int i = i0 + 64 * k; const int row = i < T_ ? b * T_ + i : NL + b * TC_ + (i - T_); rows[k] = row;
            oa[k] = *(const u32x4*)(o0 + (size_t)row * 256 + ch); ob[k] = *(const u32x4*)(o1 + (size_t)row * 256 + ch);
            gtv[k] = *(const u32x4*)(proj + (size_t)row * PROJ_N + (part ? C_GR : C_MO) + ch); }
#pragma unroll
        for (int k = 0; k < 4; ++k) {
            const f32x4 x0 = (f32x4){bflo(oa[k][0]) + bflo(ob[k][0]), bfhi(oa[k][0]) + bfhi(ob[k][0]), bflo(oa[k][1]) + bflo(ob[k][1]), bfhi(oa[k][1]) + bfhi(ob[k][1])};
            const f32x4 x1 = (f32x4){bflo(oa[k][2]) + bflo(ob[k][2]), bfhi(oa[k][2]) + bfhi(ob[k][2]), bflo(oa[k][3]) + bflo(ob[k][3]), bfhi(oa[k][3]) + bfhi(ob[k][3])};
            float s = x0[0] + x0[1] + x0[2] + x0[3] + x1[0] + x1[1] + x1[2] + x1[3];
            s += shfl_xor_f(s, 1); s += shfl_xor_f(s, 2); s += shfl_xor_f(s, 4);
            const float mu = s * (1.0f / 64.0f);
            const f32x4 d0 = x0 - mu, d1 = x1 - mu;
            float q = d0[0] * d0[0] + d0[1] * d0[1] + d0[2] * d0[2] + d0[3] * d0[3] + d1[0] * d1[0] + d1[1] * d1[1] + d1[2] * d1[2] + d1[3] * d1[3];
            q += shfl_xor_f(q, 1); q += shfl_xor_f(q, 2); q += shfl_xor_f(q, 4);
            const float rstd = 1.0f / sqrtf(q * (1.0f / 64.0f) + LN_EPS);
            float gv[8];
#pragma unroll
            for (int j = 0; j < 4; ++j) { gv[2 * j] = bflo(gtv[k][j]); gv[2 * j + 1] = bfhi(gtv[k][j]); }
            float y[8];
#pragma unroll
            for (int j = 0; j < 8; ++j) { const float nv = (j < 4 ? d0[j] : d1[j - 4]) * rstd * (j < 4 ? g0[j] : g1[j - 4]); y[j] = nv * (part ? silu_fast(gv[j]) : sigmoid_fast(gv[j])); }
            u32x4 ov; ov[0] = pack2(y[0], y[1]); ov[1] = pack2(y[2], y[3]); ov[2] = pack2(y[4], y[5]); ov[3] = pack2(y[6], y[7]);
            *(u32x4*)(ymix + (size_t)rows[k] * D_ + part * 256 + ch) = ov;
        }
    }
}

struct MlItem { u32x2 q1[3], q2[3], k1[3], k2[3]; };
struct MlChunk { u32x2 q[2][2], k[2][2]; u32x4 v[2]; float gtv, g_pt, cm63; };
DEV void mlstm_unit(const Params& p, int l, int b, int h, LAS unsigned char* lds) {
    constexpr int ST = 72;
    constexpr int DSZ = 4 * 64 * ST * 2 + 2 * 80 * ST * 2 + 3 * 64 * 4 + 3 * 128 * 4;
    static_assert(2 * DSZ <= LDS_BYTES - 32, "mlstm lds");
    const int tid = opaque_tid(), lane = tid & 63, w = tid >> 6, dir = w >> 2, wh = w & 3, t4 = tid & 255, fr = lane & 15, fq = lane >> 4;
    LAS unsigned char* db = lds + dir * DSZ;
    LAS bf16_t* Qs = (LAS bf16_t*)db;
    LAS bf16_t* Ks = Qs + 64 * ST;
    LAS bf16_t* KT = Ks + 64 * ST;
    LAS bf16_t* Ps = KT + 64 * ST;
    LAS bf16_t* VT = Ps + 64 * ST;
    LAS bf16_t* Cs = VT + 80 * ST;
    LAS float* gt = (LAS float*)(Cs + 80 * ST);
    LAS float* cw = gt + 3 * 64;
    const bf16_t* proj = (const bf16_t*)(p.ws + WS_R1 + R1_PROJ); const float* gates = (const float*)(p.ws + WS_R1 + R1_GATES);
    bf16_t* qk2 = (bf16_t*)(p.ws + WS_R1 + R1_QK2);
    bf16_t* om = (bf16_t*)(p.ws + WS_R1 + R1_OM) + (size_t)dir * NTOK * 256;
    float* gbuf = (float*)(p.ws + WS_GSCAN) + (size_t)((b * 4 + h) * 2 + dir) * NCH * 192;
    const float* ropeM = (const float*)(p.ws + WS_ROPE);
    __syncthreads();
    for (int i = t4; i < 3 * 128; i += 256) { const int j = i / 128, c = i % 128; cw[i] = p.in[8][((size_t)l * 3 + j) * 512 + (c < 64 ? h * 64 + c : 256 + h * 64 + (c - 64))]; }
    for (int i = t4; i < 80 * ST; i += 256) Cs[i] = 0;
    for (int i = t4; i < 16 * ST; i += 256) VT[64 * ST + i] = (bf16_t)0x3F80;
    for (int c0 = wh; c0 < NCH; c0 += 12) {
        float ig[3], fg[3];
#pragma unroll
        for (int k = 0; k < 3; ++k) { const int c = c0 + 4 * k; ig[k] = fg[k] = 0.f;
            if (c < NCH) { const bool lat = c >= NCH_C; const int cc = lat ? c - NCH_C : c; const int Ts = lat ? T_ : TC_;
                const int sp = dir == 0 ? cc * 64 + lane : Ts - 1 - (cc * 64 + lane);
                const float* gr = gates + (size_t)tok_row(lat, b, sp) * NG + dir * 8 + h; ig[k] = gr[0]; fg[k] = gr[4]; } }
#pragma unroll
        for (int k = 0; k < 3; ++k) { const int c = c0 + 4 * k;
            if (c < NCH) {
                float bs = logsigf(fg[k]);
                for (int d = 1; d < 64; d <<= 1) { const float o = shfl_up_f(bs, d); if (lane >= d) bs += o; }
                const float g = ig[k] - bs;
                float cm = g;
                for (int d = 1; d < 64; d <<= 1) { const float o = shfl_up_f(cm, d); if (lane >= d) cm = fmaxf(cm, o); }
                gbuf[c * 192 + lane] = bs; gbuf[c * 192 + 64 + lane] = g; gbuf[c * 192 + 128 + lane] = cm; } }
    }
    __syncthreads();
    {
        constexpr int NIT = (TC_ + T_) * 8;
        auto item_load = [&](int it, MlItem& R) {
            const int tk = it >> 3, pg = it & 7; const bool lat = tk >= TC_; const int sp = lat ? tk - TC_ : tk, Ts = lat ? T_ : TC_;
            const int hf = pg >> 2, i0 = 4 * (pg & 3), dA = 32 * hf + i0, dB = dA + 16;
#pragma unroll
            for (int tap = 0; tap < 3; ++tap) { const int sp2 = sp + tap - 1; const bool ok = sp2 >= 0 && sp2 < Ts; const int spc = ok ? sp2 : sp;
                const bf16_t* pr = proj + (size_t)tok_row(lat, b, spc) * PROJ_N + h * 64;
                const u32x2 z = (u32x2){0u, 0u};
                const u32x2 a = *(const u32x2*)(pr + C_MQ + dA), bq = *(const u32x2*)(pr + C_MQ + dB), c = *(const u32x2*)(pr + C_MK + dA), d = *(const u32x2*)(pr + C_MK + dB);
                R.q1[tap] = ok ? a : z; R.q2[tap] = ok ? bq : z; R.k1[tap] = ok ? c : z; R.k2[tap] = ok ? d : z; } };
        auto item_finish = [&](int it, const MlItem& R) {
            const int tk = it >> 3, pg = it & 7; const bool lat = tk >= TC_; const int sp = lat ? tk - TC_ : tk;
            const int hf = pg >> 2, i0 = 4 * (pg & 3), dA = 32 * hf + i0, dB = dA + 16;
            float qa[4], qb[4], ka[4], kb[4];
#pragma unroll
            for (int j = 0; j < 4; ++j) { qa[j] = qb[j] = ka[j] = kb[j] = 0.f; }
#pragma unroll
            for (int tap = 0; tap < 3; ++tap) { const LAS float* wq = cw + tap * 128;
                qa[0] += wq[dA] * bflo(R.q1[tap][0]); qa[1] += wq[dA + 1] * bfhi(R.q1[tap][0]); qa[2] += wq[dA + 2] * bflo(R.q1[tap][1]); qa[3] += wq[dA + 3] * bfhi(R.q1[tap][1]);
                qb[0] += wq[dB] * bflo(R.q2[tap][0]); qb[1] += wq[dB + 1] * bfhi(R.q2[tap][0]); qb[2] += wq[dB + 2] * bflo(R.q2[tap][1]); qb[3] += wq[dB + 3] * bfhi(R.q2[tap][1]);
                ka[0] += wq[64 + dA] * bflo(R.k1[tap][0]); ka[1] += wq[64 + dA + 1] * bfhi(R.k1[tap][0]); ka[2] += wq[64 + dA + 2] * bflo(R.k1[tap][1]); ka[3] += wq[64 + dA + 3] * bfhi(R.k1[tap][1]);
                kb[0] += wq[64 + dB] * bflo(R.k2[tap][0]); kb[1] += wq[64 + dB + 1] * bfhi(R.k2[tap][0]); kb[2] += wq[64 + dB + 2] * bflo(R.k2[tap][1]); kb[3] += wq[64 + dB + 3] * bfhi(R.k2[tap][1]); }
#pragma unroll
            for (int j = 0; j < 4; ++j) { qa[j] = silu_fast(qa[j]); qb[j] = silu_fast(qb[j]); ka[j] = silu_fast(ka[j]) * 0.125f; kb[j] = silu_fast(kb[j]) * 0.125f; }
            if (lat) { const int pos = hf == 0 ? (sp >> 6) : (sp & 63);
#pragma unroll
                for (int j = 0; j < 4; ++j) { const float cs = ropeM[(pos * 16 + i0 + j) * 2], sn = ropeM[(pos * 16 + i0 + j) * 2 + 1];
                    const float q1 = qa[j] * cs - qb[j] * sn, q2 = qa[j] * sn + qb[j] * cs; qa[j] = q1; qb[j] = q2;
                    const float k1 = ka[j] * cs - kb[j] * sn, k2 = ka[j] * sn + kb[j] * cs; ka[j] = k1; kb[j] = k2; } }
            bf16_t* dst = qk2 + (size_t)tok_row(lat, b, sp) * 512 + h * 128;
            u32x2 o;
            o[0] = pack2(qa[0], qa[1]); o[1] = pack2(qa[2], qa[3]); *(u32x2*)(dst + dA) = o;
            o[0] = pack2(qb[0], qb[1]); o[1] = pack2(qb[2], qb[3]); *(u32x2*)(dst + dB) = o;
            o[0] = pack2(ka[0], ka[1]); o[1] = pack2(ka[2], ka[3]); *(u32x2*)(dst + 64 + dA) = o;
            o[0] = pack2(kb[0], kb[1]); o[1] = pack2(kb[2], kb[3]); *(u32x2*)(dst + 64 + dB) = o; };
        for (int it0 = tid; it0 < NIT; it0 += 1024) {
            MlItem A, B; const bool two = it0 + 512 < NIT;
            item_load(it0, A); if (two) item_load(it0 + 512, B);
            item_finish(it0, A); if (two) item_finish(it0 + 512, B);
        }
    }
    wg_release_acquire();
    f32x4 cacc[5];
#pragma unroll
    for (int i = 0; i < 5; ++i) cacc[i] = (f32x4){0.f, 0.f, 0.f, 0.f};
    const int ti = wh;
    const int pt = t4 >> 2, pgq = t4 & 3;
    float m_in = 0.f;
    auto chunk_load = [&](int c, MlChunk& R) {
        const bool lat = c >= NCH_C; const int cc = lat ? c - NCH_C : c; const int Ts = lat ? T_ : TC_;
        const int sp = dir == 0 ? cc * 64 + pt : Ts - 1 - (cc * 64 + pt);
        const size_t row = (size_t)tok_row(lat, b, sp);
#pragma unroll
        for (int sub = 0; sub < 2; ++sub) { const int pg = pgq * 2 + sub; const int hf = pg >> 2, i0 = 4 * (pg & 3), dA = 32 * hf + i0, dB = dA + 16;
            const bf16_t* src = qk2 + row * 512 + h * 128;
            R.q[sub][0] = *(const u32x2*)(src + dA); R.q[sub][1] = *(const u32x2*)(src + dB); R.k[sub][0] = *(const u32x2*)(src + 64 + dA); R.k[sub][1] = *(const u32x2*)(src + 64 + dB);
            R.v[sub] = *(const u32x4*)(proj + row * PROJ_N + C_MV + h * 64 + pg * 8); }
        R.gtv = gbuf[c * 192 + (t4 < 192 ? t4 : 0)]; R.g_pt = gbuf[c * 192 + 64 + pt]; R.cm63 = gbuf[c * 192 + 128 + 63]; };
    MlChunk cur, nxt;
    chunk_load(0, cur); nxt = cur;
    for (int c = 0; c < NCH; ++c) {
        const bool lat = c >= NCH_C; const int cc = lat ? c - NCH_C : c; const int Ts = lat ? T_ : TC_;
        {
            if (t4 < 192) gt[t4] = cur.gtv;
            const float wsc = fast_exp(cur.g_pt - fmaxf(m_in, cur.cm63));
#pragma unroll
            for (int sub = 0; sub < 2; ++sub) { const int pg = pgq * 2 + sub; const int hf = pg >> 2, i0 = 4 * (pg & 3), dA = 32 * hf + i0, dB = dA + 16;
                *(LAS u32x2*)(Qs + pt * ST + dA) = cur.q[sub][0]; *(LAS u32x2*)(Qs + pt * ST + dB) = cur.q[sub][1];
                *(LAS u32x2*)(Ks + pt * ST + dA) = cur.k[sub][0]; *(LAS u32x2*)(Ks + pt * ST + dB) = cur.k[sub][1];
                const float ka[4] = {bflo(cur.k[sub][0][0]), bfhi(cur.k[sub][0][0]), bflo(cur.k[sub][0][1]), bfhi(cur.k[sub][0][1])};
                const float kb[4] = {bflo(cur.k[sub][1][0]), bfhi(cur.k[sub][1][0]), bflo(cur.k[sub][1][1]), bfhi(cur.k[sub][1][1])};
#pragma unroll
                for (int j = 0; j < 4; ++j) { KT[(dA + j) * ST + pt] = f2bf(ka[j] * wsc); KT[(dB + j) * ST + pt] = f2bf(kb[j] * wsc); }
                const u32x4 vv = cur.v[sub];
#pragma unroll
                for (int j = 0; j < 4; ++j) { VT[(pg * 8 + 2 * j) * ST + pt] = (bf16_t)(vv[j] & 0xFFFFu); VT[(pg * 8 + 2 * j + 1) * ST + pt] = (bf16_t)(vv[j] >> 16); } }
        }
        LDS_BARRIER();
        if (c + 1 < NCH) chunk_load(c + 1, nxt);
        const float M63 = fmaxf(m_in, gt[128 + 63]);
        float Mt[4];
#pragma unroll
        for (int r = 0; r < 4; ++r) Mt[r] = fmaxf(m_in, gt[128 + 16 * ti + 4 * fq + r]);
        {
            const bf16x8 a0 = lds_frag(Qs, 16 * ti + fr, ST, 8 * fq), a1 = lds_frag(Qs, 16 * ti + fr, ST, 32 + 8 * fq);
#pragma unroll
            for (int tj = 0; tj < 4; ++tj) {
                f32x4 s = (f32x4){0.f, 0.f, 0.f, 0.f};
                s = mfma16(a0, lds_frag(Ks, 16 * tj + fr, ST, 8 * fq), s);
                s = mfma16(a1, lds_frag(Ks, 16 * tj + fr, ST, 32 + 8 * fq), s);
                const int sc_ = 16 * tj + fr; const float gs = gt[64 + sc_];
#pragma unroll
                for (int r = 0; r < 4; ++r) { const int t = 16 * ti + 4 * fq + r;
                    const float pv = sc_ <= t ? s[r] * fast_exp(gs - Mt[r]) : 0.f; Ps[t * ST + sc_] = f2bf(pv); } }
            const float decay = fast_exp(m_in - M63);
            const bf16x8 v0 = lds_frag(VT, 16 * ti + fr, ST, 8 * fq), v1 = lds_frag(VT, 16 * ti + fr, ST, 32 + 8 * fq);
#pragma unroll
            for (int dj = 0; dj < 4; ++dj) { cacc[dj] = cacc[dj] * decay;
                cacc[dj] = mfma16(v0, lds_frag(KT, 16 * dj + fr, ST, 8 * fq), cacc[dj]);
                cacc[dj] = mfma16(v1, lds_frag(KT, 16 * dj + fr, ST, 32 + 8 * fq), cacc[dj]); }
            cacc[4] = cacc[4] * decay;
            cacc[4] = mfma16(lds_frag(VT, 64 + fr, ST, 8 * fq), lds_frag(KT, 16 * wh + fr, ST, 8 * fq), cacc[4]);
            cacc[4] = mfma16(lds_frag(VT, 64 + fr, ST, 32 + 8 * fq), lds_frag(KT, 16 * wh + fr, ST, 32 + 8 * fq), cacc[4]);
        }
        WAVE_SYNC();
        {
            const bf16x8 p0 = lds_frag(Ps, 16 * ti + fr, ST, 8 * fq), p1 = lds_frag(Ps, 16 * ti + fr, ST, 32 + 8 * fq);
            const bf16x8 q0 = lds_frag(Qs, 16 * ti + fr, ST, 8 * fq), q1 = lds_frag(Qs, 16 * ti + fr, ST, 32 + 8 * fq);
            f32x4 np_[5];
            float ev[4];
#pragma unroll
            for (int r = 0; r < 4; ++r) ev[r] = fast_exp(m_in - Mt[r]);
#pragma unroll
            for (int tj = 0; tj < 5; ++tj) { f32x4 nc = (f32x4){0.f, 0.f, 0.f, 0.f}; np_[tj] = (f32x4){0.f, 0.f, 0.f, 0.f};
                np_[tj] = mfma16(p0, lds_frag(VT, 16 * tj + fr, ST, 8 * fq), np_[tj]);
                np_[tj] = mfma16(p1, lds_frag(VT, 16 * tj + fr, ST, 32 + 8 * fq), np_[tj]);
                nc = mfma16(q0, lds_frag(Cs, 16 * tj + fr, ST, 8 * fq), nc);
                nc = mfma16(q1, lds_frag(Cs, 16 * tj + fr, ST, 32 + 8 * fq), nc);
#pragma unroll
                for (int r = 0; r < 4; ++r) np_[tj][r] += ev[r] * nc[r]; }
#pragma unroll
            for (int r = 0; r < 4; ++r) { const int t = 16 * ti + 4 * fq + r;
                const float dn = fmaxf(fabsf(np_[4][r]), fast_exp(-gt[t] - Mt[r])); const float inv = 1.0f / dn;
                const int sp = dir == 0 ? cc * 64 + t : Ts - 1 - (cc * 64 + t);
                bf16_t* orow = om + (size_t)tok_row(lat, b, sp) * 256 + h * 64;
#pragma unroll
                for (int tj = 0; tj < 4; ++tj) orow[16 * tj + fr] = f2bf(np_[tj][r] * inv); }
        }
        m_in = gt[63] + M63;
        LDS_BARRIER();
#pragma unroll
        for (int dj = 0; dj < 4; ++dj)
#pragma unroll
            for (int r = 0; r < 4; ++r) Cs[(16 * ti + 4 * fq + r) * ST + 16 * dj + fr] = f2bf(cacc[dj][r]);
#pragma unroll
        for (int r = 0; r < 4; ++r) Cs[(64 + 4 * fq + r) * ST + 16 * wh + fr] = f2bf(cacc[4][r]);
        cur = nxt;
    }
    wg_release_acquire();
    merge_head(p, l, b, 0, h, tid);
}

template <int KS, int HALF, int DJ> struct GlaTr { static constexpr int v = ((32 * KS + 4 * HALF) * 40 + 16 * DJ) * 2; };
struct GlChunk { f32x4 lr[4]; unsigned q[2][2], k[2][2]; u32x4 v[2]; };
DEV void gla_unit(const Params& p, int l, int b, int h, LAS unsigned char* lds) {
    constexpr int ST = 72, SQ = 40;
    constexpr int DSZ = 5 * 64 * SQ * 2 + 32 * ST * 2 + 2 * 64 * ST * 2 + 64 * 33 * 4 + 544 * 4;
    static_assert(2 * DSZ <= LDS_BYTES - 32, "gla lds");
    const int tid = opaque_tid(), lane = tid & 63, w = tid >> 6, dir = w >> 2, wh = w & 3, t4 = tid & 255, fr = lane & 15, fq = lane >> 4;
    LAS unsigned char* db = lds + dir * DSZ;
    LAS bf16_t* Qs = (LAS bf16_t*)db;
    LAS bf16_t* Ks = Qs + 64 * SQ;
    LAS bf16_t* Ss = Ks + 64 * SQ;
    LAS bf16_t* Ah = Ss + 64 * SQ;
    LAS bf16_t* Al = Ah + 64 * SQ;
    LAS bf16_t* KT = Al + 64 * SQ;
    LAS bf16_t* VT = KT + 32 * ST;
    LAS bf16_t* Ps = VT + 64 * ST;
    LAS float* bc = (LAS float*)(Ps + 64 * ST);
    LAS float* w2s = bc + 64 * 33;
    const bf16_t* proj = (const bf16_t*)(p.ws + WS_R1 + R1_PROJ); const float* gates = (const float*)(p.ws + WS_R1 + R1_GATES);
    bf16_t* og = (bf16_t*)(p.ws + WS_R1 + R1_OG) + (size_t)dir * NTOK * 256;
    const float* ropeG = (const float*)(p.ws + WS_ROPE) + 2048;
    __syncthreads();
    for (int i = t4; i < 16 * 32; i += 256) { const int r = i >> 5, d = i & 31; w2s[i] = p.in[9][(((size_t)l * 2 + dir) * 16 + r) * 128 + h * 32 + d]; }
    if (t4 < 32) w2s[512 + t4] = p.in[10][((size_t)l * 2 + dir) * 128 + h * 32 + t4];
    for (int i = t4; i < 64 * SQ; i += 256) Ss[i] = 0;
    __syncthreads();
    f32x4 sacc[2];
    sacc[0] = (f32x4){0.f, 0.f, 0.f, 0.f}; sacc[1] = (f32x4){0.f, 0.f, 0.f, 0.f};
    const int ti = wh;
    const int pt = t4 >> 2, pgq = t4 & 3;
    bf16x8 lf_[2];
#pragma unroll
    for (int ks = 0; ks < 2; ++ks)
#pragma unroll
        for (int j = 0; j < 8; ++j) lf_[ks][j] = (32 * ks + 8 * fq + j <= 16 * ti + fr) ? (short)0x3F80 : (short)0;
    auto chunk_load = [&](int c, GlChunk& R) {
        const bool lat = c >= NCH_C; const int cc = lat ? c - NCH_C : c; const int Ts = lat ? T_ : TC_;
        const int sp = dir == 0 ? cc * 64 + pt : Ts - 1 - (cc * 64 + pt);
        const size_t row = (size_t)tok_row(lat, b, sp);
        const float* lr = gates + row * NG + 16 + dir * 16;
#pragma unroll
        for (int r = 0; r < 4; ++r) R.lr[r] = *(const f32x4*)(lr + 4 * r);
        const bf16_t* pr = proj + row * PROJ_N;
#pragma unroll
        for (int sub = 0; sub < 2; ++sub) { const int pg = pgq * 2 + sub; const int hf = pg >> 2, i0 = 2 * (pg & 3), dA = 16 * hf + i0, dB = dA + 8;
            R.q[sub][0] = *(const unsigned*)(pr + C_GQ + h * 32 + dA); R.q[sub][1] = *(const unsigned*)(pr + C_GQ + h * 32 + dB);
            R.k[sub][0] = *(const unsigned*)(pr + C_GK + h * 32 + dA); R.k[sub][1] = *(const unsigned*)(pr + C_GK + h * 32 + dB);
            R.v[sub] = *(const u32x4*)(pr + C_GV + h * 64 + pg * 8); } };
    GlChunk cur, nxt;
    chunk_load(0, cur); nxt = cur;
    for (int c = 0; c < NCH; ++c) {
        const bool lat = c >= NCH_C; const int cc = lat ? c - NCH_C : c; const int Ts = lat ? T_ : TC_;
        const int sp = dir == 0 ? cc * 64 + pt : Ts - 1 - (cc * 64 + pt);
        { float lrv[16];
#pragma unroll
          for (int r = 0; r < 16; r += 4) { lrv[r] = cur.lr[r >> 2][0]; lrv[r + 1] = cur.lr[r >> 2][1]; lrv[r + 2] = cur.lr[r >> 2][2]; lrv[r + 3] = cur.lr[r >> 2][3]; }
          float av[8];
#pragma unroll
          for (int j = 0; j < 8; ++j) { const int d = pgq * 8 + j; float z = w2s[512 + d];
#pragma unroll
              for (int r = 0; r < 16; ++r) z += lrv[r] * w2s[r * 32 + d];
              av[j] = logsig_fast(z) * (1.0f / 16.0f); }
          u32x4 hi, lo;
#pragma unroll
          for (int j = 0; j < 4; ++j) { const bf16_t h0 = f2bf(av[2 * j]), h1 = f2bf(av[2 * j + 1]);
              hi[j] = (unsigned)h0 | ((unsigned)h1 << 16); lo[j] = (unsigned)f2bf(av[2 * j] - bf2f(h0)) | ((unsigned)f2bf(av[2 * j + 1] - bf2f(h1)) << 16); }
          *(LAS u32x4*)(Ah + pt * SQ + pgq * 8) = hi; *(LAS u32x4*)(Al + pt * SQ + pgq * 8) = lo; }
        LDS_BARRIER();
        {
            const lds_addr_t ah = lds_addr(Ah + (8 * fq + (fr >> 2)) * SQ + 4 * (fr & 3)), al = lds_addr(Al + (8 * fq + (fr >> 2)) * SQ + 4 * (fr & 3));
#define GLA_CS(DJ) do { \
            const bf16x4 h00 = tr_read4<GlaTr<0, 0, DJ>::v>(ah), h01 = tr_read4<GlaTr<0, 1, DJ>::v>(ah), h10 = tr_read4<GlaTr<1, 0, DJ>::v>(ah), h11 = tr_read4<GlaTr<1, 1, DJ>::v>(ah); \
            const bf16x4 l00 = tr_read4<GlaTr<0, 0, DJ>::v>(al), l01 = tr_read4<GlaTr<0, 1, DJ>::v>(al), l10 = tr_read4<GlaTr<1, 0, DJ>::v>(al), l11 = tr_read4<GlaTr<1, 1, DJ>::v>(al); \
            LGKM_WAIT0(); \
            f32x4 acc = (f32x4){0.f, 0.f, 0.f, 0.f}; \
            acc = mfma16(lf_[0], (bf16x8){h00[0], h00[1], h00[2], h00[3], h01[0], h01[1], h01[2], h01[3]}, acc); \
            acc = mfma16(lf_[1], (bf16x8){h10[0], h10[1], h10[2], h10[3], h11[0], h11[1], h11[2], h11[3]}, acc); \
            acc = mfma16(lf_[0], (bf16x8){l00[0], l00[1], l00[2], l00[3], l01[0], l01[1], l01[2], l01[3]}, acc); \
            acc = mfma16(lf_[1], (bf16x8){l10[0], l10[1], l10[2], l10[3], l11[0], l11[1], l11[2], l11[3]}, acc); \
            _Pragma("unroll") for (int r = 0; r < 4; ++r) bc[(16 * ti + 4 * fq + r) * 33 + 16 * DJ + fr] = acc[r]; } while (0)
            GLA_CS(0); GLA_CS(1);
#undef GLA_CS
        }
        WAVE_SYNC();
#pragma unroll
        for (int sub = 0; sub < 2; ++sub) {
            const int pg = pgq * 2 + sub;
            const int hf = pg >> 2, i0 = 2 * (pg & 3), dA = 16 * hf + i0, dB = dA + 8;
            const unsigned q1 = cur.q[sub][0], q2 = cur.q[sub][1], k1 = cur.k[sub][0], k2 = cur.k[sub][1];
            const float qs_ = 0.17677669529663687f;
            float qa[2] = {bflo(q1) * qs_, bfhi(q1) * qs_}, qb[2] = {bflo(q2) * qs_, bfhi(q2) * qs_}, ka[2] = {bflo(k1), bfhi(k1)}, kb[2] = {bflo(k2), bfhi(k2)};
            if (lat) { const int pos = hf == 0 ? (sp >> 6) : (sp & 63);
#pragma unroll
                for (int j = 0; j < 2; ++j) { const float cs = ropeG[(pos * 8 + i0 + j) * 2], sn = ropeG[(pos * 8 + i0 + j) * 2 + 1];
                    const float x1 = qa[j] * cs - qb[j] * sn, x2 = qa[j] * sn + qb[j] * cs; qa[j] = x1; qb[j] = x2;
                    const float y1 = ka[j] * cs - kb[j] * sn, y2 = ka[j] * sn + kb[j] * cs; ka[j] = y1; kb[j] = y2; } }
#pragma unroll
            for (int j = 0; j < 2; ++j) { const float bA = bc[pt * 33 + dA + j], bB = bc[pt * 33 + dB + j];
                qa[j] *= fast_exp(bA); qb[j] *= fast_exp(bB); ka[j] *= fast_exp(-bA); kb[j] *= fast_exp(-bB); }
            *(LAS unsigned*)(Qs + pt * SQ + dA) = pack2(qa[0], qa[1]); *(LAS unsigned*)(Qs + pt * SQ + dB) = pack2(qb[0], qb[1]);
            *(LAS unsigned*)(Ks + pt * SQ + dA) = pack2(ka[0], ka[1]); *(LAS unsigned*)(Ks + pt * SQ + dB) = pack2(kb[0], kb[1]);
#pragma unroll
            for (int j = 0; j < 2; ++j) { KT[(dA + j) * ST + pt] = f2bf(ka[j]); KT[(dB + j) * ST + pt] = f2bf(kb[j]); }
            const u32x4 vv = cur.v[sub];
#pragma unroll
            for (int j = 0; j < 4; ++j) { VT[(pg * 8 + 2 * j) * ST + pt] = (bf16_t)(vv[j] & 0xFFFFu); VT[(pg * 8 + 2 * j + 1) * ST + pt] = (bf16_t)(vv[j] >> 16); }
        }
        LDS_BARRIER();
        if (c + 1 < NCH) chunk_load(c + 1, nxt);
        {
            const bf16x8 a0 = lds_frag(Qs, 16 * ti + fr, SQ, 8 * fq);
#pragma unroll
            for (int tj = 0; tj < 4; ++tj) {
                f32x4 s = (f32x4){0.f, 0.f, 0.f, 0.f};
                s = mfma16(a0, lds_frag(Ks, 16 * tj + fr, SQ, 8 * fq), s);
                const int sc_ = 16 * tj + fr;
#pragma unroll
                for (int r = 0; r < 4; ++r) { const int t = 16 * ti + 4 * fq + r; Ps[t * ST + sc_] = f2bf(sc_ <= t ? s[r] : 0.f); } }
        }
        WAVE_SYNC();
        {
            const bf16x8 p0 = lds_frag(Ps, 16 * ti + fr, ST, 8 * fq), p1 = lds_frag(Ps, 16 * ti + fr, ST, 32 + 8 * fq), q0 = lds_frag(Qs, 16 * ti + fr, SQ, 8 * fq);
            f32x4 o[4];
#pragma unroll
            for (int tj = 0; tj < 4; ++tj) { o[tj] = (f32x4){0.f, 0.f, 0.f, 0.f};
                o[tj] = mfma16(p0, lds_frag(VT, 16 * tj + fr, ST, 8 * fq), o[tj]);
                o[tj] = mfma16(p1, lds_frag(VT, 16 * tj + fr, ST, 32 + 8 * fq), o[tj]);
                o[tj] = mfma16(q0, lds_frag(Ss, 16 * tj + fr, SQ, 8 * fq), o[tj]); }
#pragma unroll
            for (int r = 0; r < 4; ++r) { const int t = 16 * ti + 4 * fq + r; const int sp2 = dir == 0 ? cc * 64 + t : Ts - 1 - (cc * 64 + t);
                bf16_t* orow = og + (size_t)tok_row(lat, b, sp2) * 256 + h * 64;
#pragma unroll
                for (int tj = 0; tj < 4; ++tj) orow[16 * tj + fr] = f2bf(o[tj][r]); }
            const bf16x8 v0 = lds_frag(VT, 16 * wh + fr, ST, 8 * fq), v1 = lds_frag(VT, 16 * wh + fr, ST, 32 + 8 * fq);
#pragma unroll
            for (int dj = 0; dj < 2; ++dj) {
                sacc[dj] = mfma16(v0, lds_frag(KT, 16 * dj + fr, ST, 8 * fq), sacc[dj]);
                sacc[dj] = mfma16(v1, lds_frag(KT, 16 * dj + fr, ST, 32 + 8 * fq), sacc[dj]);
                sacc[dj] = sacc[dj] * fast_exp(bc[63 * 33 + 16 * dj + fr]); }
        }
        LDS_BARRIER();
#pragma unroll
        for (int dj = 0; dj < 2; ++dj)
#pragma unroll
            for (int r = 0; r < 4; ++r) Ss[(16 * wh + 4 * fq + r) * SQ + 16 * dj + fr] = f2bf(sacc[dj][r]);
        cur = nxt;
    }
    wg_release_acquire();
    merge_head(p, l, b, 1, h, tid);
}

template <int KS, int T16, int VT> struct TrOff { static constexpr int v = ((32 * KS + 16 * T16) * 72 + 16 * VT) * 2; };
template <int NT>
DEV void attn_ldkv(const LAS bf16_t* Kb, lds_addr_t vb, bf16x8 (&kf)[NT][2], bf16x8 (&vf)[NT / 2][4], int fr, int fq) {
#pragma unroll
    for (int kt = 0; kt < NT; ++kt) { kf[kt][0] = lds_frag(Kb, 16 * kt + fr, 72, 8 * fq); kf[kt][1] = lds_frag(Kb, 16 * kt + fr, 72, 32 + 8 * fq); }
    bf16x4 lo[NT / 2][4], hi[NT / 2][4];
#define ATT_TR(KS) do { lo[KS][0] = tr_read4<TrOff<KS, 0, 0>::v>(vb); hi[KS][0] = tr_read4<TrOff<KS, 1, 0>::v>(vb); lo[KS][1] = tr_read4<TrOff<KS, 0, 1>::v>(vb); hi[KS][1] = tr_read4<TrOff<KS, 1, 1>::v>(vb); \
        lo[KS][2] = tr_read4<TrOff<KS, 0, 2>::v>(vb); hi[KS][2] = tr_read4<TrOff<KS, 1, 2>::v>(vb); lo[KS][3] = tr_read4<TrOff<KS, 0, 3>::v>(vb); hi[KS][3] = tr_read4<TrOff<KS, 1, 3>::v>(vb); } while (0)
    ATT_TR(0);
    if constexpr (NT == 4) { ATT_TR(1); }
#undef ATT_TR
    LGKM_WAIT0();
#pragma unroll
    for (int ks = 0; ks < NT / 2; ++ks)
#pragma unroll
        for (int vt = 0; vt < 4; ++vt) vf[ks][vt] = (bf16x8){lo[ks][vt][0], lo[ks][vt][1], lo[ks][vt][2], lo[ks][vt][3], hi[ks][vt][0], hi[ks][vt][1], hi[ks][vt][2], hi[ks][vt][3]};
}
template <int NT, bool LOC>
DEV void attn_tile(const bf16x8 (&kf)[NT][2], const bf16x8 (&vf)[NT / 2][4], bf16x8 qf0, bf16x8 qf1, f32x4 (&o)[4], float& mrun, float& lrun, const LAS float* rpl, int d0) {
    f32x4 s[NT];
#pragma unroll
    for (int kt = 0; kt < NT; ++kt) { s[kt] = (f32x4){0.f, 0.f, 0.f, 0.f}; s[kt] = mfma16(kf[kt][0], qf0, s[kt]); s[kt] = mfma16(kf[kt][1], qf1, s[kt]); }
    float mx = -INFINITY;
#pragma unroll
    for (int kt = 0; kt < NT; ++kt)
#pragma unroll
        for (int j = 0; j < 4; ++j) { float v;
            if (LOC) { const bool ok = (unsigned)(16 * kt + j - d0) < 16u; v = ok ? s[kt][j] * 0.18033688f + rpl[16 * kt + j] : -INFINITY; }
            else v = s[kt][j] * 0.18033688f;
            s[kt][j] = v; mx = fmaxf(mx, v); }
    mx = xrow16_max(mx);
    if (wave_any(mx > mrun + 8.0f)) {
        const float mnew = fmaxf(mrun, mx);
        const float alpha = fast_exp2(mrun - mnew);
        lrun = lrun * alpha; mrun = mnew;
#pragma unroll
        for (int vt = 0; vt < 4; ++vt) o[vt] = o[vt] * alpha;
    }
    float ps = 0.f;
#pragma unroll
    for (int kt = 0; kt < NT; ++kt)
#pragma unroll
        for (int j = 0; j < 4; ++j) { const float pv = fast_exp2(s[kt][j] - mrun); s[kt][j] = pv; ps += pv; }
    lrun += ps;
#pragma unroll
    for (int ks = 0; ks < NT / 2; ++ks) { u32x4 pu; pu[0] = pack2(s[2 * ks][0], s[2 * ks][1]); pu[1] = pack2(s[2 * ks][2], s[2 * ks][3]); pu[2] = pack2(s[2 * ks + 1][0], s[2 * ks + 1][1]); pu[3] = pack2(s[2 * ks + 1][2], s[2 * ks + 1][3]);
        bf16x8 pf; __builtin_memcpy(&pf, &pu, 16);
#pragma unroll
        for (int vt = 0; vt < 4; ++vt) o[vt] = mfma16(vf[ks][vt], pf, o[vt]); }
}
template <bool LOCAL>
DEV void attn_unit(const Params& p, int l, int b, int head, int r0, LAS unsigned char* lds) {
    constexpr int NQT = 2, ST = 72, HB = 64 * ST, BUF = 2 * HB;
    LAS bf16_t* kv = (LAS bf16_t*)lds;
    LAS float* rp = (LAS float*)(kv + 2 * BUF) + 64;
    const int tid = opaque_tid(), lane = tid & 63, w = tid >> 6, fr = lane & 15, fq = lane >> 4;
    const int qt = w & 3, qc = 16 * qt + fr, rw = r0 + 2 * (w >> 2);
    const bf16_t* proj = (const bf16_t*)(p.ws + WS_R1 + R1_PROJ);
    bf16_t* ymix = (bf16_t*)(p.ws + WS_YMIX);
    const int rs_first = r0 - 4 < 0 ? 0 : (r0 - 4 > GRID_R - 8 ? GRID_R - 8 : r0 - 4);
    const int rl = r0 + 3, rs_last = rl - 4 < 0 ? 0 : (rl - 4 > GRID_R - 8 ? GRID_R - 8 : rl - 4);
    const int kr_lo = rs_first, nloc = LOCAL ? rs_last + 8 - rs_first : 0, nblk = nloc + NCH_C;
    const int skey = tid >> 3, sg8 = (tid & 7) * 8;
    const bf16_t* sbase = proj + (size_t)head * 64 + sg8;
    u32x4 kr0, vr0, kr1, vr1;
#define ATT_KROW(kb) ((kb) < nloc ? tok_row(true, b, (kr_lo + (kb)) * 64) : tok_row(false, b, ((kb) - nloc) * 64))
#define ATT_LOAD(kb, KR, VR) do { const bf16_t* pr_ = sbase + (size_t)(ATT_KROW(kb) + skey) * PROJ_N; KR = *(const u32x4*)(pr_ + C_NK); VR = *(const u32x4*)(pr_ + C_NV); } while (0)
#define ATT_STORE(bi, KR, VR) do { LAS bf16_t* d_ = kv + (bi) * BUF + skey * ST + sg8; *(LAS u32x4*)(d_) = KR; *(LAS u32x4*)(d_ + HB) = VR; } while (0)
    __syncthreads();
    ATT_LOAD(0, kr0, vr0);
    ATT_LOAD(1, kr1, vr1);
    if (LOCAL) for (int i = tid; i < 15 * 31; i += 512) rp[i] = p.in[13][((size_t)l * 8 + head) * 465 + i] * 1.44269504f;
    bf16x8 qf[NQT][2]; f32x4 o[NQT][4]; float mrun[NQT], lrun[NQT];
#pragma unroll
    for (int i = 0; i < NQT; ++i) { const bf16_t* qp = proj + (size_t)tok_row(LOCAL, b, (rw + i) * 64 + qc) * PROJ_N + C_NQ + head * 64;
        qf[i][0] = *(const bf16x8*)(qp + 8 * fq); qf[i][1] = *(const bf16x8*)(qp + 32 + 8 * fq); mrun[i] = -INFINITY; lrun[i] = 0.f;
#pragma unroll
        for (int vt = 0; vt < 4; ++vt) o[i][vt] = (f32x4){0.f, 0.f, 0.f, 0.f}; }
    ATT_STORE(0, kr0, vr0);
    ATT_LOAD(2, kr0, vr0);
    const int cs = qc - 8 < 0 ? 0 : (qc - 8 > 48 ? 48 : qc - 8);
    const int koff = qt == 0 ? 0 : (qt == 1 ? 8 : (qt == 2 ? 24 : 32));
    const int d0 = cs - koff - 4 * fq;
    const LAS float* rpl0 = rp + koff + 4 * fq - qc + 15;
    const int rs0 = rw - 4 < 0 ? 0 : (rw - 4 > GRID_R - 8 ? GRID_R - 8 : rw - 4), rs1 = rw - 3 < 0 ? 0 : (rw - 3 > GRID_R - 8 ? GRID_R - 8 : rw - 3);
    LDS_BARRIER();
#define ATT_ITER(kb, KR, VR) do { const int bi = (kb) & 1; \
        if ((kb) + 1 < nblk) ATT_STORE(bi ^ 1, KR, VR); \
        if ((kb) + 3 < nblk) ATT_LOAD((kb) + 3, KR, VR); \
        const LAS bf16_t* Kb = kv + bi * BUF; \
        const LAS bf16_t* Vl = kv + bi * BUF + HB + (4 * fq + (fr >> 2)) * ST + 4 * (fr & 3); \
        if ((kb) < nloc) { \
            const int krow = kr_lo + (kb); \
            const bool a0 = krow >= rs0 && krow < rs0 + 8, a1 = krow >= rs1 && krow < rs1 + 8; \
            if (a0 || a1) { \
                bf16x8 kf[2][2], vf[1][4]; \
                attn_ldkv<2>(Kb + koff * ST, lds_addr(Vl + koff * ST), kf, vf, fr, fq); \
                if (a0) attn_tile<2, true>(kf, vf, qf[0][0], qf[0][1], o[0], mrun[0], lrun[0], rpl0 + (krow - rw + 7) * 31, d0); \
                if (a1) attn_tile<2, true>(kf, vf, qf[1][0], qf[1][1], o[1], mrun[1], lrun[1], rpl0 + (krow - rw - 1 + 7) * 31, d0); \
            } \
        } else { \
            _Pragma("unroll") for (int hf = 0; hf < 2; ++hf) { \
                bf16x8 kf[2][2], vf[1][4]; \
                attn_ldkv<2>(Kb + 32 * hf * ST, lds_addr(Vl + 32 * hf * ST), kf, vf, fr, fq); \
                _Pragma("unroll") for (int i = 0; i < NQT; ++i) attn_tile<2, false>(kf, vf, qf[i][0], qf[i][1], o[i], mrun[i], lrun[i], rpl0, d0); } \
        } \
        LDS_BARRIER(); } while (0)
#pragma unroll 1
    for (int kb = 0; kb < nblk; kb += 2) {
        ATT_ITER(kb, kr1, vr1);
        if (kb + 1 < nblk) ATT_ITER(kb + 1, kr0, vr0);
    }
#undef ATT_ITER
#undef ATT_KROW
#undef ATT_LOAD
#undef ATT_STORE
#pragma unroll
    for (int i = 0; i < NQT; ++i) { const float lr = xrow16_sum(lrun[i]);
        const float inv = 1.0f / lr;
        bf16_t* yr = ymix + (size_t)tok_row(LOCAL, b, (rw + i) * 64 + qc) * D_ + 512 + head * 64;
#pragma unroll
        for (int vt = 0; vt < 4; ++vt) { u32x2 ov; ov[0] = pack2(o[i][vt][0] * inv, o[i][vt][1] * inv); ov[1] = pack2(o[i][vt][2] * inv, o[i][vt][3] * inv); *(u32x2*)(yr + 16 * vt + 4 * fq) = ov; } }
}

DEV void phase_mixer(const Params& p, int l, LAS unsigned char* lds) {
    const bool need_ctx = l < DEPTH_ - 1;
#ifndef REP_K
#define REP_K -1
#endif
#ifndef NO_SCAN
    for (int rep_ = 0; rep_ < ((REP_K == 20 || REP_K == 99) ? 2 : 1); ++rep_)
    for (int u = blockIdx.x; u < B_ * 8; u += gridDim.x) { if (u < B_ * 4) mlstm_unit(p, l, u >> 2, u & 3, lds); else gla_unit(p, l, (u - B_ * 4) >> 2, u & 3, lds); }
#endif
    static_assert(GRID_R % 4 == 0 && NCH_C == 4, "attention unit grouping");
    const int nloc = B_ * 8 * (GRID_R / 4), nctx = need_ctx ? B_ * 8 : 0;
#ifdef HOST_EMU
    for (int u = blockIdx.x; u < nloc + nctx; u += gridDim.x) {
        if (u < nloc) { const int rg = u % (GRID_R / 4), head = (u / (GRID_R / 4)) & 7, b = u / (GRID_R / 4 * 8); attn_unit<true>(p, l, b, head, rg * 4, lds); }
        else { const int q = u - nloc, head = q & 7, b = q >> 3; attn_unit<false>(p, l, b, head, 0, lds); }
    }
#else
    for (int rep_ = 0; rep_ < ((REP_K == 22 || REP_K == 99) ? 2 : 1); ++rep_) {
        unsigned* ctr = (unsigned*)(p.ws + WS_CTL) + XB_QUEUE + l * 2 + rep_;
        volatile LAS int* qs = (volatile LAS int*)(lds + LDS_BYTES - 32);
        const int tid = opaque_tid();
        __syncthreads();
        if (tid == 0) qs[0] = (int)atomicAdd(ctr, 1u);
        __syncthreads();
        int u = qs[0];
        while (u < nloc + nctx) {
            int pend = 0;
            if (tid == 0) pend = (int)atomicAdd(ctr, 1u);
            if (u < nloc) { const int rg = u % (GRID_R / 4), head = (u / (GRID_R / 4)) & 7, b = u / (GRID_R / 4 * 8); attn_unit<true>(p, l, b, head, rg * 4, lds); }
            else { const int q = u - nloc, head = q & 7, b = q >> 3; attn_unit<false>(p, l, b, head, 0, lds); }
            __syncthreads();
            if (tid == 0) qs[0] = pend;
            __syncthreads();
            u = qs[0];
        }
    }
#endif
}

DEV void ln_stats(const float (&v)[2][8], float& mu, float& rstd) {
    float s = 0.f;
#pragma unroll
    for (int i = 0; i < 2; ++i)
#pragma unroll
        for (int j = 0; j < 8; ++j) s += v[i][j];
    mu = wave_sum(s) * (1.0f / 1024.0f);
    float q = 0.f;
#pragma unroll
    for (int i = 0; i < 2; ++i)
#pragma unroll
        for (int j = 0; j < 8; ++j) { const float d = v[i][j] - mu; q += d * d; }
    rstd = 1.0f / sqrtf(wave_sum(q) * (1.0f / 1024.0f) + LN_EPS);
}
DEV void ln_apply(float (&v)[2][8], float mu, float rstd, const float* g, const float* bta, int lane) {
#pragma unroll
    for (int i = 0; i < 2; ++i) { const int c = lane * 8 + i * 512; const f32x4 ga = *(const f32x4*)(g + c), gb2 = *(const f32x4*)(g + c + 4), ba = *(const f32x4*)(bta + c), bb2 = *(const f32x4*)(bta + c + 4);
#pragma unroll
        for (int j = 0; j < 8; ++j) v[i][j] = (v[i][j] - mu) * rstd * (j < 4 ? ga[j] : gb2[j - 4]) + (j < 4 ? ba[j] : bb2[j - 4]); }
}
DEV void ln_row(float (&v)[2][8], const float* g, const float* bta, int lane) {
    float s = 0.f;
#pragma unroll
    for (int i = 0; i < 2; ++i)
#pragma unroll
        for (int j = 0; j < 8; ++j) s += v[i][j];
    const float mu = wave_sum(s) * (1.0f / 1024.0f);
    float q = 0.f;
#pragma unroll
    for (int i = 0; i < 2; ++i)
#pragma unroll
        for (int j = 0; j < 8; ++j) { v[i][j] -= mu; q += v[i][j] * v[i][j]; }
    const float rstd = 1.0f / sqrtf(wave_sum(q) * (1.0f / 1024.0f) + LN_EPS);
#pragma unroll
    for (int i = 0; i < 2; ++i) { const int c = lane * 8 + i * 512; const f32x4 ga = *(const f32x4*)(g + c), gb2 = *(const f32x4*)(g + c + 4), ba = *(const f32x4*)(bta + c), bb2 = *(const f32x4*)(bta + c + 4);
#pragma unroll
        for (int j = 0; j < 8; ++j) v[i][j] = v[i][j] * rstd * (j < 4 ? ga[j] : gb2[j - 4]) + (j < 4 ? ba[j] : bb2[j - 4]); }
}

DEV void phase_ln1_router(const Params& p, int l, LAS unsigned char* lds) {
    LAS float* wrT = (LAS float*)lds;
    const int tid = opaque_tid(), lane = tid & 63, gw = blockIdx.x * 8 + (tid >> 6), nw = gridDim.x * 8;
    const int ntok = l < DEPTH_ - 1 ? NTOK : NL;
    const float* wr = p.in[17] + (size_t)l * 1024 * 16;
    __syncthreads();
    for (int i = tid; i < 16 * 1024; i += 512) { const int k = i >> 4, e = i & 15; wrT[e * 1024 + k] = wr[i]; }
    __syncthreads();
    const float* mods = (const float*)(p.ws + WS_MODS) + (size_t)l * (B_ + 1) * 6144;
    bf16_t* ub = (bf16_t*)(p.ws + WS_U); float* aff = (float*)(p.ws + WS_AFF);
    const bf16_t* xh = (const bf16_t*)(p.ws + WS_XH); bf16_t* x1h = (bf16_t*)(p.ws + WS_X1H); const bf16_t* yo = (const bf16_t*)(p.ws + WS_YO);
    const float alpha = sqrtf(sqrtf((float)(2 * DEPTH_)));
    const float* lg = p.in[15] + (size_t)l * 1024; const float* lb = p.in[16] + (size_t)l * 1024;
    constexpr int NR = 4;
    for (int row0 = gw; row0 < ntok; row0 += NR * nw) {
        u32x4 xraw[NR][2], yraw[NR][2];
#pragma unroll
        for (int r = 0; r < NR; ++r) { const int row = row0 + r * nw; const int rw = row < ntok ? row : row0;
#pragma unroll
            for (int i = 0; i < 2; ++i) { const int c = lane * 8 + i * 512;
                yraw[r][i] = ld_stream((const u32x4*)(yo + (size_t)rw * D_ + c));
                xraw[r][i] = (u32x4){0u, 0u, 0u, 0u}; if (l != 0) xraw[r][i] = ld_stream((const u32x4*)(xh + (size_t)rw * D_ + c)); } }
        f32x2 up[NR / 2][2][8];
#pragma unroll
        for (int r = 0; r < NR; ++r) {
            const int row = row0 + r * nw;
            float uu[2][8];
            if (row < ntok) {
                const bool isl = row < NL; const int bb = isl ? row / T_ : B_;
                const float* md = mods + (size_t)bb * 6144;
                float v[2][8];
#pragma unroll
                for (int i = 0; i < 2; ++i) { const int c = lane * 8 + i * 512; float xv[8];
                    if (l == 0) { const float* xr = isl ? p.in[0] + (size_t)row * D_ : p.in[2] + (size_t)(row - NL) * D_; const f32x4 a = *(const f32x4*)(xr + c), b2 = *(const f32x4*)(xr + c + 4);
#pragma unroll
                        for (int j = 0; j < 4; ++j) { xv[j] = a[j]; xv[4 + j] = b2[j]; } }
                    else unpack8_h(xraw[r][i], xv);
                    const u32x4 yv = yraw[r][i]; const f32x4 g0 = *(const f32x4*)(md + 2048 + c), g1 = *(const f32x4*)(md + 2048 + c + 4);
#pragma unroll
                    for (int j = 0; j < 4; ++j) { v[i][j] = alpha * xv[j] + g0[j] * ((j & 1) ? bfhi(yv[j >> 1]) : bflo(yv[j >> 1])); v[i][4 + j] = alpha * xv[4 + j] + g1[j] * ((j & 1) ? bfhi(yv[2 + (j >> 1)]) : bflo(yv[2 + (j >> 1)])); } }
                float mu, rstd; ln_stats(v, mu, rstd);
                ln_apply(v, mu, rstd, lg, lb, lane);
#pragma unroll
                for (int i = 0; i < 2; ++i) { const int c = lane * 8 + i * 512;
                    st_stream((u32x4*)(x1h + (size_t)row * D_ + c), pack8_h(v[i]));
                    const f32x4 s0 = *(const f32x4*)(md + 4096 + c), s1 = *(const f32x4*)(md + 4096 + c + 4), h0 = *(const f32x4*)(md + 3072 + c), h1 = *(const f32x4*)(md + 3072 + c + 4);
#pragma unroll
                    for (int j = 0; j < 8; ++j) uu[i][j] = v[i][j] * ((j < 4 ? s0[j] : s1[j - 4]) + 1.0f) + (j < 4 ? h0[j] : h1[j - 4]);
#if MOE_F8
                    u32x2 o; o[0] = pack4_f8(uu[i][0], uu[i][1], uu[i][2], uu[i][3]); o[1] = pack4_f8(uu[i][4], uu[i][5], uu[i][6], uu[i][7]);
                    st_stream((u32x2*)((unsigned char*)ub + (size_t)row * D_ + c), o); }
#else
                    u32x4 o; o[0] = pack2(uu[i][0], uu[i][1]); o[1] = pack2(uu[i][2], uu[i][3]); o[2] = pack2(uu[i][4], uu[i][5]); o[3] = pack2(uu[i][6], uu[i][7]);
                    *(u32x4*)(ub + (size_t)row * D_ + c) = o; }
#endif
            } else {
#pragma unroll
                for (int i = 0; i < 2; ++i)
#pragma unroll
                    for (int j = 0; j < 8; ++j) uu[i][j] = 0.f;
            }
#pragma unroll
            for (int i = 0; i < 2; ++i)
#pragma unroll
                for (int j = 0; j < 8; ++j) up[r >> 1][i][j][r & 1] = uu[i][j];
            SCHED_BAR();
        }
#ifndef HOST_EMU
        asm volatile("" ::: "memory");
#endif
        float p8a[NR][8];
#pragma unroll
        for (int j = 0; j < 8; ++j) { f32x2 pe[NR / 2][2];
#pragma unroll
            for (int hh = 0; hh < 2; ++hh) { const int e = j + 8 * hh; f32x2 acc[NR / 2];
#pragma unroll
                for (int q = 0; q < NR / 2; ++q) acc[q] = (f32x2){0.f, 0.f};
#pragma unroll
                for (int i = 0; i < 2; ++i) { const int c = lane * 8 + i * 512; const f32x4 w0 = *(const LAS f32x4*)(wrT + e * 1024 + c), w1 = *(const LAS f32x4*)(wrT + e * 1024 + c + 4);
#pragma unroll
                    for (int q = 0; q < NR / 2; ++q) {
                        acc[q] += up[q][i][0] * w0[0]; acc[q] += up[q][i][1] * w0[1]; acc[q] += up[q][i][2] * w0[2]; acc[q] += up[q][i][3] * w0[3];
                        acc[q] += up[q][i][4] * w1[0]; acc[q] += up[q][i][5] * w1[1]; acc[q] += up[q][i][6] * w1[2]; acc[q] += up[q][i][7] * w1[3]; } }
#pragma unroll
                for (int q = 0; q < NR / 2; ++q) pe[q][hh] = acc[q]; }
#pragma unroll
            for (int q = 0; q < NR / 2; ++q) { p8a[2 * q][j] = xsum32(pe[q][0][0], pe[q][1][0]); p8a[2 * q + 1][j] = xsum32(pe[q][0][1], pe[q][1][1]); } }
#pragma unroll
        for (int r = 0; r < NR; ++r) {
            const int row = row0 + r * nw;
            float p4[4], p2[2];
#pragma unroll
            for (int j = 0; j < 4; ++j) p4[j] = xsum16(p8a[r][j], p8a[r][4 + j]);
#pragma unroll
            for (int j = 0; j < 2; ++j) p2[j] = xsum8(p4[j], p4[2 + j], lane);
            float mine = quad_sum(xsum4(p2[0], p2[1], lane));
            const float mx = wave_max(mine);
            mine = expf(mine - mx);
            const float sm = wave_sum(mine) * 0.25f;
            if (row < ntok && (lane & 3) == 0) aff[(size_t)row * 16 + (lane >> 2)] = mine / sm;
        }
    }
}

#ifdef HOST_EMU
static inline void lds_inc(unsigned* p) { (*p)++; }
#else
DEV void lds_inc(LAS unsigned* p) { __hip_atomic_fetch_add(p, 1u, __ATOMIC_RELAXED, __HIP_MEMORY_SCOPE_WORKGROUP); }
#endif
DEV void phase_topk(const Params& p, int l, LAS unsigned char* lds) {
    LAS unsigned* keys = (LAS unsigned*)lds;
    LAS unsigned* hist = keys + T_;
    LAS unsigned* misc = hist + 256;
    const int tid = opaque_tid(), lane = tid & 63, w = tid >> 6;
    const bool need_ctx = l < DEPTH_ - 1;
    const float* aff = (const float*)(p.ws + WS_AFF); int* slot = (int*)(p.ws + WS_SLOT); int* rowtab = (int*)(p.ws + WS_ROWTAB);
    const int nun = B_ * 16 * (need_ctx ? 2 : 1);
    for (int u = blockIdx.x; u < nun; u += gridDim.x) {
        const bool lat = u < B_ * 16; const int q = lat ? u : u - B_ * 16, b = q >> 4, e = q & 15;
        const int n = lat ? T_ : TC_, cap = lat ? CAP_L : CAP_C, row0 = tok_row(lat, b, 0);
        __syncthreads();
        unsigned kv[4];
#pragma unroll
        for (int j = 0; j < 4; ++j) { const int t = tid * 4 + j; kv[j] = t < n ? f_as_u(aff[(size_t)(row0 + t) * 16 + e]) : 0u; }
        unsigned prefix = 0u, remaining = (unsigned)cap;
#pragma unroll 1
        for (int pass = 0; pass < 4; ++pass) {
            const int shift = 24 - 8 * pass;
            if (tid < 256) hist[tid] = 0u;
            __syncthreads();
#pragma unroll
            for (int j = 0; j < 4; ++j) { const int t = tid * 4 + j;
                if (t < n && (pass == 0 || (kv[j] >> (shift + 8)) == prefix)) lds_inc(&hist[(kv[j] >> shift) & 255u]); }
            __syncthreads();
            if (w == 0) {
                const unsigned h0 = hist[4 * lane], h1 = hist[4 * lane + 1], h2 = hist[4 * lane + 2], h3 = hist[4 * lane + 3];
                const unsigned sl = h0 + h1 + h2 + h3;
                unsigned S = sl;
                for (int d = 1; d < 64; d <<= 1) { const unsigned o = (unsigned)shfl_idx_i((int)S, lane + d < 64 ? lane + d : lane); if (lane + d < 64) S += o; }
                const unsigned above = S - sl;
                if (above < remaining && remaining <= S) {
                    unsigned acc = above; int bin;
                    if (acc + h3 >= remaining) { bin = 3; } else { acc += h3; if (acc + h2 >= remaining) { bin = 2; } else { acc += h2; if (acc + h1 >= remaining) { bin = 1; } else { acc += h1; bin = 0; } } }
                    misc[0] = (unsigned)(4 * lane + bin); misc[1] = remaining - acc; }
            }
            __syncthreads();
            prefix = (prefix << 8) | misc[0]; remaining = misc[1];
        }
        unsigned cnt = 0u;
#pragma unroll
        for (int j = 0; j < 4; ++j) { const int t = tid * 4 + j; if (t < n) cnt += (kv[j] > prefix ? 1u : 0u) + (kv[j] == prefix ? 65536u : 0u); }
        unsigned inc = cnt;
        for (int d = 1; d < 64; d <<= 1) { const unsigned o2 = (unsigned)shfl_idx_i((int)inc, lane >= d ? lane - d : lane); if (lane >= d) inc += o2; }
        if (lane == 63) misc[8 + w] = inc;
        __syncthreads();
        unsigned base = 0u, total = 0u;
#pragma unroll
        for (int ww = 0; ww < 8; ++ww) { const unsigned tw = misc[8 + ww]; if (ww < w) base += tw; total += tw; }
        unsigned run = base + inc - cnt;
        const unsigned ngt = total & 0xFFFFu;
#pragma unroll
        for (int j = 0; j < 4; ++j) { const int t = tid * 4 + j;
            if (t < n) { const bool gt = kv[j] > prefix, eq = kv[j] == prefix; const unsigned rg = run & 0xFFFFu, re = run >> 16;
                int sl = -1;
                if (gt) sl = (int)rg; else if (eq && re < remaining) sl = (int)(ngt + re);
                slot[(size_t)(row0 + t) * 16 + e] = sl;
                if (sl >= 0) rowtab[e * MROWS + (lat ? b * CAP_L + sl : ROWS_L + b * CAP_C + sl)] = row0 + t;
                run += (gt ? 1u : 0u) + (eq ? 65536u : 0u); } }
    }
    { const int used = need_ctx ? ROWS_L + ROWS_C : ROWS_L; const int mr = need_ctx ? MROWS : MROWS_LAST;
      if (blockIdx.x == gridDim.x - 1) for (int i = tid; i < 16 * (mr - used); i += 512) { const int e = i / (mr - used), r = used + i % (mr - used); rowtab[e * MROWS + r] = 0; } }
}

DEV void phase_combine(const Params& p, int l) {
    const int tid = opaque_tid(), lane = tid & 63, gw = blockIdx.x * 8 + (tid >> 6), nw = gridDim.x * 8;
    const bool need_ctx = l < DEPTH_ - 1; const int ntok = need_ctx ? NTOK : NL;
    const float* mods = (const float*)(p.ws + WS_MODS) + (size_t)l * (B_ + 1) * 6144;
    const float* modn = mods + (size_t)(B_ + 1) * 6144;
    const bf16_t* x1h = (const bf16_t*)(p.ws + WS_X1H); bf16_t* xh = (bf16_t*)(p.ws + WS_XH); bf16_t* ub = (bf16_t*)(p.ws + WS_U);
    const float* aff = (const float*)(p.ws + WS_AFF); const int* slot = (const int*)(p.ws + WS_SLOT); const bf16_t* yexp = (const bf16_t*)(p.ws + WS_YEXP);
    const float* lg = p.in[21] + (size_t)l * 1024; const float* lb = p.in[22] + (size_t)l * 1024;
    const float alpha = sqrtf(sqrtf((float)(2 * DEPTH_)));
    int slot_n[2]; float aff_n[2];
#pragma unroll
    for (int r = 0; r < 2; ++r) { const int row = gw + r * nw; slot_n[r] = -1; aff_n[r] = 0.f;
        if (row < ntok && lane < 16) { slot_n[r] = slot[(size_t)row * 16 + lane]; aff_n[r] = aff[(size_t)row * 16 + lane]; } }
    for (int row0 = gw; row0 < ntok; row0 += 2 * nw) {
        int myslot[2]; float myaff[2]; int rbase[2]; unsigned em[2];
        float v[2][2][8], f[2][2][8];
#pragma unroll
        for (int r = 0; r < 2; ++r) { const int row = row0 + r * nw; const bool act = row < ntok; const int rw = act ? row : row0;
            const bool isl = rw < NL; const int bidx = isl ? rw / T_ : (rw - NL) / TC_;
            rbase[r] = isl ? bidx * CAP_L : ROWS_L + bidx * CAP_C;
            myslot[r] = slot_n[r]; myaff[r] = aff_n[r];
            { const int rown = row + 2 * nw; slot_n[r] = -1; aff_n[r] = 0.f; if (rown < ntok && lane < 16) { slot_n[r] = slot[(size_t)rown * 16 + lane]; aff_n[r] = aff[(size_t)rown * 16 + lane]; } }
#pragma unroll
            for (int i = 0; i < 2; ++i) unpack8_h(ld_stream((const u32x4*)(x1h + (size_t)rw * D_ + lane * 8 + i * 512)), v[r][i]);
#pragma unroll
            for (int i = 0; i < 2; ++i)
#pragma unroll
                for (int j = 0; j < 8; ++j) f[r][i][j] = 0.f;
            unsigned m_ = 0u;
#pragma unroll
            for (int e = 0; e < 16; ++e) m_ |= (rdlane_i(myslot[r], e) >= 0 ? 1u : 0u) << e;
            em[r] = act ? m_ : 0u; }
        while (em[0] | em[1]) {
#if MOE_F8 && YEXP_F8
            u32x2 yv[2][4][2]; float ga[2][4];
#pragma unroll
            for (int r = 0; r < 2; ++r)
#pragma unroll
                for (int k = 0; k < 4; ++k) { const bool ok = em[r] != 0u; const int ee = ok ? __builtin_ctz(em[r]) : 0; em[r] &= em[r] - 1u;
                    const int sl = rdlane_i(myslot[r], ee); ga[r][k] = ok ? rdlane_f(myaff[r], ee) * (1.0f / F8_SY) : 0.f;
                    const unsigned char* yr = (const unsigned char*)yexp + ((size_t)ee * MROWS + rbase[r] + (sl > 0 ? sl : 0)) * D_;
                    yv[r][k][0] = ld_stream((const u32x2*)(yr + lane * 8)); yv[r][k][1] = ld_stream((const u32x2*)(yr + lane * 8 + 512)); }
#pragma unroll
            for (int r = 0; r < 2; ++r)
#pragma unroll
                for (int k = 0; k < 4; ++k)
#pragma unroll
                    for (int i = 0; i < 2; ++i)
#pragma unroll
                        for (int j = 0; j < 2; ++j) { const f32x2 lo = __builtin_amdgcn_cvt_pk_f32_fp8((int)yv[r][k][i][j], false), hi = __builtin_amdgcn_cvt_pk_f32_fp8((int)yv[r][k][i][j], true);
                            f[r][i][4 * j] += ga[r][k] * lo[0]; f[r][i][4 * j + 1] += ga[r][k] * lo[1]; f[r][i][4 * j + 2] += ga[r][k] * hi[0]; f[r][i][4 * j + 3] += ga[r][k] * hi[1]; }
#else
            u32x4 yv[2][4][2]; float ga[2][4];
#pragma unroll
            for (int r = 0; r < 2; ++r)
#pragma unroll
                for (int k = 0; k < 4; ++k) { const bool ok = em[r] != 0u; const int ee = ok ? __builtin_ctz(em[r]) : 0; em[r] &= em[r] - 1u;
                    const int sl = rdlane_i(myslot[r], ee); ga[r][k] = ok ? rdlane_f(myaff[r], ee) : 0.f;
                    const bf16_t* yr = yexp + ((size_t)ee * MROWS + rbase[r] + (sl > 0 ? sl : 0)) * D_;
                    yv[r][k][0] = *(const u32x4*)(yr + lane * 8); yv[r][k][1] = *(const u32x4*)(yr + lane * 8 + 512); }
#pragma unroll
            for (int r = 0; r < 2; ++r)
#pragma unroll
                for (int k = 0; k < 4; ++k)
#pragma unroll
                    for (int i = 0; i < 2; ++i)
#pragma unroll
                        for (int j = 0; j < 4; ++j) { f[r][i][2 * j] += ga[r][k] * bflo(yv[r][k][i][j]); f[r][i][2 * j + 1] += ga[r][k] * bfhi(yv[r][k][i][j]); }
#endif
        }
#pragma unroll
        for (int r = 0; r < 2; ++r) { const int row = row0 + r * nw;
            if (row < ntok) {
                const bool isl = row < NL; const int bb = isl ? row / T_ : B_;
                const float* md = mods + (size_t)bb * 6144;
#pragma unroll
                for (int i = 0; i < 2; ++i) { const int c = lane * 8 + i * 512; const f32x4 g0 = *(const f32x4*)(md + 5120 + c), g1 = *(const f32x4*)(md + 5120 + c + 4);
#pragma unroll
                    for (int j = 0; j < 4; ++j) { v[r][i][j] = alpha * v[r][i][j] + g0[j] * f[r][i][j]; v[r][i][4 + j] = alpha * v[r][i][4 + j] + g1[j] * f[r][i][4 + j]; } }
                ln_row(v[r], lg, lb, lane);
#pragma unroll
                for (int i = 0; i < 2; ++i) { const int c = lane * 8 + i * 512;
                    if (!need_ctx) { float* xw = p.out + (size_t)row * D_; *(f32x4*)(xw + c) = (f32x4){v[r][i][0], v[r][i][1], v[r][i][2], v[r][i][3]}; *(f32x4*)(xw + c + 4) = (f32x4){v[r][i][4], v[r][i][5], v[r][i][6], v[r][i][7]}; }
                    else { const float* mn = modn + (size_t)bb * 6144;
                        st_stream((u32x4*)(xh + (size_t)row * D_ + c), pack8_h(v[r][i]));
                        const f32x4 s0 = *(const f32x4*)(mn + 1024 + c), s1 = *(const f32x4*)(mn + 1024 + c + 4), h0 = *(const f32x4*)(mn + c), h1 = *(const f32x4*)(mn + c + 4);
                        float uu[8];
#pragma unroll
                        for (int j = 0; j < 8; ++j) uu[j] = v[r][i][j] * ((j < 4 ? s0[j] : s1[j - 4]) + 1.0f) + (j < 4 ? h0[j] : h1[j - 4]);
                        u32x4 o; o[0] = pack2(uu[0], uu[1]); o[1] = pack2(uu[2], uu[3]); o[2] = pack2(uu[4], uu[5]); o[3] = pack2(uu[6], uu[7]);
                        *(u32x4*)(ub + (size_t)row * D_ + c) = o; } }
            }
        }
    }
}

__global__ void __launch_bounds__(512, 2) fwd(Params p) {
#ifdef HOST_EMU
    unsigned char* smem = emu::tls.dynsmem;
#else
    extern __shared__ __attribute__((aligned(16))) unsigned char smem_raw[];
    LAS unsigned char* smem = (LAS unsigned char*)smem_raw;
#endif
#ifdef HOST_EMU
    XcdBarrier bar = xcd_barrier_post(nullptr, nullptr);
#else
    volatile LAS unsigned* xbw = (volatile LAS unsigned*)(smem + LDS_BYTES - 16);
    if (threadIdx.x == 0) { xbw[0] = 0u; xbw[1] = 0u; xbw[2] = 0u; xbw[3] = 0u; }
    __syncthreads();
    XcdBarrier bar = xcd_barrier_post((unsigned*)(p.ws + WS_CTL), xbw);
#endif
#define SEAM(id) if ((id) > p.ph_lo && (id) < p.ph_hi) { xcd_barrier(bar); if (REP_K == 30) xcd_barrier(bar); }
#ifndef REP_K
#define REP_K -1
#endif
#define REPEAT(k) for (int rep_ = 0; rep_ < ((REP_K == (k) || REP_K == 99) ? 2 : 1); ++rep_)
#define REPBAR() if (rep_) xcd_barrier(bar)
#ifndef PH_MASK
#define PH_MASK 0xFFFF
#endif
#define RUN(id) if ((id) >= p.ph_lo && (id) < p.ph_hi)
#define RUNK(k) if (((PH_MASK >> (k)) & 1) && (base + (k)) >= p.ph_lo && (base + (k)) < p.ph_hi)
    if ((PH_MASK >> 15) & 1) RUN(0) REPEAT(15) { REPBAR(); phase_mods(p, smem); }
    const float alpha = sqrtf(sqrtf((float)(2 * DEPTH_)));
    for (int l = 0; l < DEPTH_; ++l) {
        const int base = 1 + l * NPH;
        const bool need_ctx = l < DEPTH_ - 1;
        SEAM(base + 0); RUNK(0) REPEAT(0) { REPBAR(); phase_convert(p, l, smem); }
        SEAM(base + 1); RUNK(1) REPEAT(1) { REPBAR();
            pg8::Gemm g; g.A = (const bf16_t*)(p.ws + WS_U); g.Bt = (const bf16_t*)(p.ws + WS_BTIN); g.K = D_; g.rowtab = nullptr;
            pg8::Order S; S.init(1, NTOK / 256, NTOK / 256, PROJ_NP / 256, gridDim.x, blockIdx.x);
            EpiProj E; E.proj = (bf16_t*)(p.ws + WS_R1 + R1_PROJ); E.gates = (float*)(p.ws + WS_R1 + R1_GATES); E.bias = (const float*)(p.ws + WS_BIAS);
            pg8::gemm_phase<EpiProj, false>(smem, g, S, E);
        }
        SEAM(base + 2); RUNK(2) REPEAT(2) { REPBAR(); phase_mixer(p, l, smem); }
        SEAM(base + 4); RUNK(4) REPEAT(4) { REPBAR();
            pg8::Gemm g; g.A = (const bf16_t*)(p.ws + WS_YMIX); g.Bt = (const bf16_t*)(p.ws + WS_BTOUT); g.K = D_; g.rowtab = nullptr;
            const int mt = (need_ctx ? NTOK : NL) / 256;
            pg8::Order S; S.init(1, mt, mt, D_ / 256, gridDim.x, blockIdx.x);
            EpiDown<false> E; E.y = (bf16_t*)(p.ws + WS_YO); E.sc = 1.0f;
            pg8::gemm_phase<EpiDown<false>, false>(smem, g, S, E);
        }
        SEAM(base + 5); RUNK(5) REPEAT(5) { REPBAR(); phase_ln1_router(p, l, smem); }
        SEAM(base + 6); RUNK(6) REPEAT(6) { REPBAR(); phase_topk(p, l, smem); }
        SEAM(base + 7); RUNK(7) REPEAT(7) { REPBAR();
            pg8::Gemm g; g.A = (const bf16_t*)(p.ws + WS_U); g.Bt = (const bf16_t*)(p.ws + WS_BTGU); g.K = MOE_F8 ? D_ / 2 : D_; g.rowtab = (const int*)(p.ws + WS_ROWTAB);
            pg8::Order S; S.init(NE, (need_ctx ? MROWS : MROWS_LAST) / 256, MROWS / 256, 2 * FF / 256, gridDim.x, blockIdx.x);
            EpiSwiglu E; E.h = (bf16_t*)(p.ws + WS_R1);
            pg8::gemm_phase<EpiSwiglu, true, MOE_F8 != 0>(smem, g, S, E);
        }
        SEAM(base + 8); RUNK(8) REPEAT(8) { REPBAR();
            pg8::Gemm g; g.A = (const bf16_t*)(p.ws + WS_R1); g.Bt = (const bf16_t*)(p.ws + WS_BTDN); g.K = MOE_F8 ? FF / 2 : FF; g.rowtab = nullptr;
            pg8::Order S; S.init(NE, (need_ctx ? MROWS : MROWS_LAST) / 256, MROWS / 256, D_ / 256, gridDim.x, blockIdx.x);
            EpiDown<(MOE_F8 && YEXP_F8)> E; E.y = (bf16_t*)(p.ws + WS_YEXP);
#if MOE_F8
            E.sc = (YEXP_F8 ? F8_SY : 1.0f) / (F8_SH * F8_SW2);
#else
            E.sc = 1.0f;
#endif
            pg8::gemm_phase<EpiDown<(MOE_F8 && YEXP_F8)>, false, MOE_F8 != 0>(smem, g, S, E);
        }
        SEAM(base + 9); RUNK(9) REPEAT(9) { REPBAR(); phase_combine(p, l); }
    }
}

extern "C" void kernel_launch(void* const* d_in, const int* in_sizes, int n_in, void* d_out, int out_size, void* d_ws, size_t ws_size, hipStream_t stream) {
    static int grid = 0;
    if (grid == 0) {
        if (n_in != 23 || out_size != NL * D_ || ws_size < WS_END) { fprintf(stderr, "kernel_launch: bad shapes: n_in %d out %d ws %zu (need %zu)\n", n_in, out_size, ws_size, (size_t)WS_END); grid = -1; return; }
        int dev = 0, cus = 0;
        if (hipGetDevice(&dev) != hipSuccess || hipDeviceGetAttribute(&cus, hipDeviceAttributeMultiprocessorCount, dev) != hipSuccess) { grid = -1; return; }
        if (hipFuncSetAttribute((const void*)fwd, hipFuncAttributeMaxDynamicSharedMemorySize, LDS_BYTES) != hipSuccess) { fprintf(stderr, "kernel_launch: hipFuncSetAttribute failed\n"); grid = -1; return; }
        (void)hipGetLastError();
        grid = cus;
    }
    if (grid < 0) return;
#ifdef HOST_EMU
    g_emu_bar.store(0);
#endif
    (void)hipMemsetAsync((char*)d_ws + WS_CTL, 0, WS_CTL_BYTES, stream);
    Params p{};
    for (int i = 0; i < 23; ++i) p.in[i] = (const float*)d_in[i];
    p.out = (float*)d_out; p.ws = (unsigned char*)d_ws;
#if ONE_LAUNCH
    p.ph_lo = 0; p.ph_hi = NPHASES;
#ifdef HOST_EMU
    if (getenv("EMU_PH_HI")) p.ph_hi = atoi(getenv("EMU_PH_HI"));
#endif
    hipLaunchKernelGGL(fwd, dim3(grid), dim3(512), LDS_BYTES, stream, p);
#else
    int nph = NPHASES;
#ifdef HOST_EMU
    if (getenv("EMU_PH_HI")) nph = atoi(getenv("EMU_PH_HI"));
#endif
    for (int ph = 0; ph < nph; ++ph) { p.ph_lo = ph; p.ph_hi = ph + 1; hipLaunchKernelGGL(fwd, dim3(grid), dim3(512), LDS_BYTES, stream, p); }
#endif
}
```

```cpp
#ifdef HOST_EMU
#include "emu.h"
#else
#include <hip/hip_runtime.h>
#include <cstdio>
#include <cstdint>
#endif

#ifndef CFG_BATCH
#define CFG_BATCH 32
#define CFG_SEQ 2048
#define CFG_CTX 256
#define CFG_DEPTH 4
#endif
#ifndef ONE_LAUNCH
#define ONE_LAUNCH 1
#endif
#ifndef MOE_F8
#ifdef HOST_EMU
#define MOE_F8 0
#else
#define MOE_F8 1
#endif
#endif
#ifndef YEXP_F8
#define YEXP_F8 1
#endif

#define DEV __device__ __forceinline__
typedef unsigned short bf16_t;
typedef short bf16x8 __attribute__((ext_vector_type(8)));
typedef short bf16x4 __attribute__((ext_vector_type(4)));
typedef float f32x4 __attribute__((ext_vector_type(4)));
typedef float f32x2 __attribute__((ext_vector_type(2)));
typedef unsigned u32x4 __attribute__((ext_vector_type(4)));
typedef unsigned u32x2 __attribute__((ext_vector_type(2)));
typedef int i32x8 __attribute__((ext_vector_type(8)));

constexpr int B_ = CFG_BATCH, T_ = CFG_SEQ, TC_ = CFG_CTX, DEPTH_ = CFG_DEPTH;
constexpr int D_ = 1024, NL = B_ * T_, NC = B_ * TC_, NTOK = NL + NC;
constexpr int PROJ_W0 = 3376, PROJ_N = 3328, PROJ_NP = 3584, NG = 48;
constexpr int FF = 2048, NE = 16;
constexpr int CAP_L = 2 * T_ / NE, CAP_C = 2 * TC_ / NE;
constexpr int ROWS_L = B_ * CAP_L, ROWS_C = B_ * CAP_C;
constexpr int MROWS = ((ROWS_L + ROWS_C + 255) / 256) * 256;
constexpr int MROWS_LAST = ((ROWS_L + 255) / 256) * 256;
constexpr int NCH_C = TC_ / 64, NCH_L = T_ / 64, NCH = NCH_C + NCH_L;
constexpr int GRID_R = T_ / 64;
constexpr float LN_EPS = 1e-5f;
constexpr int C_MQ = 0, C_MK = 256, C_MV = 512, C_MO = 768, C_GQ = 1024, C_GK = 1152, C_GV = 1280, C_GR = 1536, C_NQ = 1792, C_NK = 2304, C_NV = 2816;
static_assert(T_ % 256 == 0 && TC_ % 256 == 0 && NL % 256 == 0 && NC % 256 == 0, "shape");
static_assert(GRID_R >= 8, "rows");

constexpr size_t al256(size_t x) { return (x + 255) & ~(size_t)255; }
constexpr size_t WS_CTL = 0;
constexpr size_t WS_CTL_BYTES = 16384;
constexpr size_t WS_MODS = WS_CTL + WS_CTL_BYTES;
constexpr size_t WS_ROPE = WS_MODS + al256((size_t)DEPTH_ * (B_ + 1) * 6144 * 4);
constexpr size_t WS_BIAS = WS_ROPE + al256((64 * 16 * 2 + 64 * 8 * 2) * 4);
constexpr size_t WS_BTIN = WS_BIAS + al256(PROJ_NP * 4);
constexpr size_t WS_BTOUT = WS_BTIN + al256((size_t)PROJ_NP * D_ * 2);
constexpr size_t WBYTES = MOE_F8 ? 1 : 2;
constexpr size_t WS_BTGU = WS_BTOUT + al256((size_t)D_ * D_ * 2);
constexpr size_t WS_BTDN = WS_BTGU + al256((size_t)NE * 2 * FF * D_ * WBYTES);
constexpr size_t WS_U = WS_BTDN + al256((size_t)NE * D_ * FF * WBYTES);
constexpr size_t WS_XH = WS_U + al256((size_t)NTOK * D_ * 2);
constexpr size_t WS_AFF = WS_XH + al256((size_t)NTOK * D_ * 2);
constexpr size_t WS_SLOT = WS_AFF + al256((size_t)NTOK * 16 * 4);
constexpr size_t WS_GSCAN = WS_SLOT + al256((size_t)NTOK * 16 * 4);
constexpr size_t WS_ROWTAB = WS_GSCAN + al256((size_t)B_ * 8 * NCH * 192 * 4);
constexpr size_t WS_YMIX = WS_ROWTAB + al256((size_t)NE * MROWS * 4);
constexpr size_t WS_YEXP = WS_YMIX + al256((size_t)NTOK * D_ * 2);
constexpr size_t WS_R1 = WS_YEXP + al256((size_t)NE * MROWS * D_ * 2);
constexpr size_t R1_PROJ = 0;
constexpr size_t R1_GATES = R1_PROJ + al256((size_t)NTOK * PROJ_N * 2);
constexpr size_t R1_OM = R1_GATES + al256((size_t)NTOK * NG * 4);
constexpr size_t R1_OG = R1_OM + al256((size_t)2 * NTOK * 256 * 2);
constexpr size_t R1_QK2 = R1_OG + al256((size_t)2 * NTOK * 256 * 2);
constexpr size_t R1_END = R1_QK2 + al256((size_t)NTOK * 512 * 2);
constexpr size_t R1_H_BYTES = al256((size_t)NE * MROWS * FF * 2);
constexpr size_t WS_YO = WS_R1 + (R1_END > R1_H_BYTES ? R1_END : R1_H_BYTES);
#if MOE_F8 && YEXP_F8
constexpr size_t WS_X1H = WS_YEXP + (size_t)NE * MROWS * D_;
constexpr size_t WS_END = WS_YO + al256((size_t)NTOK * D_ * 2);
#else
constexpr size_t WS_X1H = WS_YO + al256((size_t)NTOK * D_ * 2);
constexpr size_t WS_END = WS_X1H + al256((size_t)NTOK * D_ * 2);
#endif
static_assert((size_t)NE * MROWS * D_ >= (size_t)NTOK * D_ * 2, "x1 alias");

constexpr int LDS_BYTES = 144 * 1024;
constexpr int NPH = 10;
constexpr int NPHASES = 1 + DEPTH_ * NPH;

struct Params {
    const float* in[23];
    float* out;
    unsigned char* ws;
    int ph_lo, ph_hi;
};

#ifdef HOST_EMU
#define LAS
static inline unsigned f_as_u(float f) { unsigned u; memcpy(&u, &f, 4); return u; }
static inline float u_as_f(unsigned u) { float f; memcpy(&f, &u, 4); return f; }
static inline float shfl_xor_f(float v, int m) { auto t = emu::wave_all(&v, 4); float r; memcpy(&r, t[emu::lane() ^ m], 4); return r; }
static inline float shfl_up_f(float v, int d) { auto t = emu::wave_all(&v, 4); int l = emu::lane(); float r; memcpy(&r, t[l >= d ? l - d : l], 4); return r; }
static inline float shfl_idx_f(float v, int s) { auto t = emu::wave_all(&v, 4); float r; memcpy(&r, t[s & 63], 4); return r; }
static inline int shfl_idx_i(int v, int s) { auto t = emu::wave_all(&v, 4); int r; memcpy(&r, t[s & 63], 4); return r; }
static inline int rdlane_i(int v, int s) { return shfl_idx_i(v, s); }
static inline float rdlane_f(float v, int s) { return shfl_idx_f(v, s); }
static inline f32x4 mfma16(bf16x8 a, bf16x8 b, f32x4 c) {
    struct { bf16x8 a, b; } d; d.a = a; d.b = b;
    auto t = emu::wave_all(&d, 32);
    int l = emu::lane(), col = l & 15, g = l >> 4;
    for (int r = 0; r < 4; ++r) {
        int row = 4 * g + r; float s = c[r];
        for (int k = 0; k < 32; ++k) {
            unsigned short av, bv;
            memcpy(&av, t[row + 16 * (k >> 3)] + 2 * (k & 7), 2);
            memcpy(&bv, t[col + 16 * (k >> 3)] + 16 + 2 * (k & 7), 2);
            s += u_as_f((unsigned)av << 16) * u_as_f((unsigned)bv << 16);
        }
        c[r] = s;
    }
    return c;
}
static inline void glds16(const void* g, unsigned char* l) { memcpy(l + 16 * emu::lane(), g, 16); }
#define S_BARRIER() __syncthreads()
#define WAIT_V(n)
#define WAIT_L(n)
#define SCHED_BAR()
#define SETPRIO(n)
#define RFL(x) (x)
static inline float fast_exp(float x) { return expf(x); }
static inline float fast_rcp(float x) { return 1.0f / x; }
static inline float fast_exp2(float x) { return exp2f(x); }
static inline float fast_log(float x) { return logf(x); }
#else
#define LAS __attribute__((address_space(3)))
DEV unsigned f_as_u(float f) { return __float_as_uint(f); }
DEV float u_as_f(unsigned u) { return __uint_as_float(u); }
DEV float shfl_xor_f(float v, int m) { return __shfl_xor(v, m, 64); }
DEV float shfl_up_f(float v, int d) { return __shfl_up(v, d, 64); }
DEV float shfl_idx_f(float v, int s) { return __shfl(v, s, 64); }
DEV int shfl_idx_i(int v, int s) { return __shfl(v, s, 64); }
DEV int rdlane_i(int v, int s) { return __builtin_amdgcn_readlane(v, s); }
DEV float rdlane_f(float v, int s) { return __uint_as_float((unsigned)__builtin_amdgcn_readlane((int)__float_as_uint(v), s)); }
DEV f32x4 mfma16(bf16x8 a, bf16x8 b, f32x4 c) { return __builtin_amdgcn_mfma_f32_16x16x32_bf16(a, b, c, 0, 0, 0); }
DEV void glds16(const void* g, LAS unsigned char* l) { __builtin_amdgcn_global_load_lds((const unsigned*)g, (LAS unsigned*)l, 16, 0, 0); }
#define S_BARRIER() __builtin_amdgcn_s_barrier()
#define WAIT_V(n) asm volatile("s_waitcnt vmcnt(" #n ")" ::: "memory")
#define WAIT_L(n) asm volatile("s_waitcnt lgkmcnt(" #n ")" ::: "memory")
#define SCHED_BAR() __builtin_amdgcn_sched_barrier(0)
#define SETPRIO(n) __builtin_amdgcn_s_setprio(n)
#define RFL(x) __builtin_amdgcn_readfirstlane(x)
DEV float fast_exp(float x) { return __expf(x); }
DEV float fast_rcp(float x) { return __builtin_amdgcn_rcpf(x); }
DEV float fast_exp2(float x) { return __builtin_amdgcn_exp2f(x); }
DEV float fast_log(float x) { return __logf(x); }
#endif

#ifdef HOST_EMU
DEV int opaque_tid() { return (int)threadIdx.x; }
#else
DEV int opaque_tid() { int t = threadIdx.x; asm volatile("" : "+v"(t)); return t; }
#endif
#ifdef HOST_EMU
typedef const unsigned char* lds_addr_t;
static inline lds_addr_t lds_addr(const void* p) { return (lds_addr_t)p; }
template <int OFF> static inline bf16x4 tr_read4(lds_addr_t vb) {
    const unsigned char* a = vb + OFF; auto t = emu::wave_all(&a, 8); const int l = emu::lane(), G = l >> 4, i = l & 15; bf16x4 r;
    for (int q = 0; q < 4; ++q) { const unsigned char* src; memcpy(&src, t[16 * G + 4 * q + (i >> 2)], 8); short v; memcpy(&v, src + 2 * (i & 3), 2); r[q] = v; }
    return r; }
#define LGKM_WAIT0()
#define LDS_BARRIER() __syncthreads()
#else
typedef unsigned lds_addr_t;
DEV lds_addr_t lds_addr(const LAS void* p) { return (unsigned)(size_t)p; }
template <int OFF> DEV bf16x4 tr_read4(lds_addr_t vb) { bf16x4 r; asm volatile("ds_read_b64_tr_b16 %0, %1 offset:%2" : "=&v"(r) : "v"(vb), "i"(OFF) : "memory"); return r; }
#define LGKM_WAIT0() do { asm volatile("s_waitcnt lgkmcnt(0)" ::: "memory"); __builtin_amdgcn_sched_barrier(0); } while (0)
#define LDS_BARRIER() do { asm volatile("s_waitcnt lgkmcnt(0)" ::: "memory"); __builtin_amdgcn_s_barrier(); asm volatile("" ::: "memory"); } while (0)
#endif
DEV bf16_t f2bf(float f) { unsigned u = f_as_u(f); u += 0x7FFFu + ((u >> 16) & 1u); return (bf16_t)(u >> 16); }
DEV float bf2f(bf16_t b) { return u_as_f((unsigned)b << 16); }
#ifdef HOST_EMU
DEV unsigned pack2(float lo, float hi) { return (unsigned)f2bf(lo) | ((unsigned)f2bf(hi) << 16); }
#else
DEV unsigned pack2(float lo, float hi) { unsigned r; asm volatile("v_cvt_pk_bf16_f32 %0, %1, %2" : "=v"(r) : "v"(lo), "v"(hi)); return r; }
#endif
DEV float bflo(unsigned u) { return u_as_f(u << 16); }
DEV float bfhi(unsigned u) { return u_as_f(u & 0xFFFF0000u); }
DEV float siluf(float x) { return x / (1.0f + expf(-x)); }
DEV float sigmoidf_(float x) { return 1.0f / (1.0f + expf(-x)); }
DEV float logsigf(float x) { return fminf(x, 0.0f) - log1pf(expf(-fabsf(x))); }
#ifdef HOST_EMU
DEV float xrow16_max(float x) { x = fmaxf(x, shfl_xor_f(x, 16)); return fmaxf(x, shfl_xor_f(x, 32)); }
DEV float xrow16_sum(float x) { x += shfl_xor_f(x, 16); return x + shfl_xor_f(x, 32); }
#else
DEV float xrow16_max(float x) {
    auto s = __builtin_amdgcn_permlane16_swap(__float_as_uint(x), __float_as_uint(x), false, false);
    x = fmaxf(__uint_as_float(s[0]), __uint_as_float(s[1]));
    auto t = __builtin_amdgcn_permlane32_swap(__float_as_uint(x), __float_as_uint(x), false, false);
    return fmaxf(__uint_as_float(t[0]), __uint_as_float(t[1])); }
DEV float xrow16_sum(float x) {
    auto s = __builtin_amdgcn_permlane16_swap(__float_as_uint(x), __float_as_uint(x), false, false);
    x = __uint_as_float(s[0]) + __uint_as_float(s[1]);
    auto t = __builtin_amdgcn_permlane32_swap(__float_as_uint(x), __float_as_uint(x), false, false);
    return __uint_as_float(t[0]) + __uint_as_float(t[1]); }
#endif
#if MOE_F8
constexpr float F8_SW1 = 32.0f, F8_SH = 4.0f, F8_SW2 = 128.0f, F8_SY = 16.0f;
DEV float f8clamp(float x) { return fminf(fmaxf(x, -448.0f), 448.0f); }
DEV unsigned pack4_f8(float a, float b, float c, float d) {
    int p_ = __builtin_amdgcn_cvt_pk_fp8_f32(f8clamp(a), f8clamp(b), 0, false);
    p_ = __builtin_amdgcn_cvt_pk_fp8_f32(f8clamp(c), f8clamp(d), p_, true);
    return (unsigned)p_; }
typedef int i32x4 __attribute__((ext_vector_type(4)));
DEV void mfma_f8(f32x4& c, bf16x8 a0, bf16x8 a1, bf16x8 b0, bf16x8 b1, int sc) {
    i32x4 al, ah, bl, bh; __builtin_memcpy(&al, &a0, 16); __builtin_memcpy(&ah, &a1, 16); __builtin_memcpy(&bl, &b0, 16); __builtin_memcpy(&bh, &b1, 16);
    const i32x8 A = __builtin_shufflevector(al, ah, 0, 1, 2, 3, 4, 5, 6, 7), B = __builtin_shufflevector(bl, bh, 0, 1, 2, 3, 4, 5, 6, 7);
    asm volatile("v_mfma_scale_f32_16x16x128_f8f6f4 %0, %1, %2, %0, %3, %3 op_sel_hi:[0,0,0]" : "+v"(c) : "v"(A), "v"(B), "v"(sc)); }
#define MFMA_DRAIN() asm volatile("s_nop 15\n\ts_nop 15" ::: "memory")
#endif
typedef _Float16 h16x8 __attribute__((ext_vector_type(8)));
DEV u32x4 pack8_h(const float (&v)[8]) { h16x8 h; for (int j = 0; j < 8; ++j) h[j] = (_Float16)v[j]; u32x4 o; __builtin_memcpy(&o, &h, 16); return o; }
DEV void unpack8_h(u32x4 u, float (&v)[8]) { h16x8 h; __builtin_memcpy(&h, &u, 16); for (int j = 0; j < 8; ++j) v[j] = (float)h[j]; }
#ifdef HOST_EMU
DEV bool wave_any(bool b) { float v = b ? 1.f : 0.f; for (int m = 32; m >= 1; m >>= 1) v = fmaxf(v, shfl_xor_f(v, m)); return v > 0.f; }
#else
DEV bool wave_any(bool b) { return __builtin_amdgcn_ballot_w64(b) != 0ull; }
#endif
#ifdef HOST_EMU
template <class T> static inline void st_stream(T* q, T v) { *q = v; }
#else
template <class T> DEV void st_stream(T* q, T v) { __builtin_nontemporal_store(v, q); }
#endif
#ifdef HOST_EMU
template <class T> static inline T ld_stream(const T* q) { return *q; }
#else
template <class T> DEV T ld_stream(const T* q) { return __builtin_nontemporal_load(q); }
#endif
DEV float silu_fast(float x) { return x * fast_rcp(1.0f + fast_exp(-x)); }
DEV float sigmoid_fast(float x) { return fast_rcp(1.0f + fast_exp(-x)); }
DEV float logsig_fast(float x) { return fminf(x, 0.0f) - fast_log(1.0f + fast_exp(-fabsf(x))); }
#ifdef HOST_EMU
DEV float wave_sum(float v) { for (int m = 32; m >= 1; m >>= 1) v += shfl_xor_f(v, m); return v; }
DEV float wave_max(float v) { for (int m = 32; m >= 1; m >>= 1) v = fmaxf(v, shfl_xor_f(v, m)); return v; }
DEV float xsum32(float a, float b) { const float pa = shfl_xor_f(a, 32), pb = shfl_xor_f(b, 32); return (emu::lane() & 32) ? b + pb : a + pa; }
DEV float xsum16(float a, float b) { const float pa = shfl_xor_f(a, 16), pb = shfl_xor_f(b, 16); return (emu::lane() & 16) ? b + pb : a + pa; }
DEV float xsum8(float a, float b, int lane) { const float pa = shfl_xor_f(a, 8), pb = shfl_xor_f(b, 8); return (lane & 8) ? b + pb : a + pa; }
DEV float xsum4(float a, float b, int lane) { const float pa = shfl_xor_f(a, 4), pb = shfl_xor_f(b, 4); return (lane & 4) ? b + pb : a + pa; }
DEV float quad_sum(float v) { v += shfl_xor_f(v, 1); return v + shfl_xor_f(v, 2); }
#else
template <int CTRL> DEV float dpp_f(float x) { return __uint_as_float((unsigned)__builtin_amdgcn_update_dpp(0, (int)__float_as_uint(x), CTRL, 0xF, 0xF, false)); }
DEV float wave_sum(float v) {
    v += dpp_f<0x128>(v); v += dpp_f<0x124>(v); v += dpp_f<0x122>(v); v += dpp_f<0x121>(v);
    return xrow16_sum(v); }
DEV float wave_max(float v) {
    v = fmaxf(v, dpp_f<0x128>(v)); v = fmaxf(v, dpp_f<0x124>(v)); v = fmaxf(v, dpp_f<0x122>(v)); v = fmaxf(v, dpp_f<0x121>(v));
    return xrow16_max(v); }
DEV float xsum32(float a, float b) { auto s_ = __builtin_amdgcn_permlane32_swap(__float_as_uint(a), __float_as_uint(b), false, false); return __uint_as_float(s_[0]) + __uint_as_float(s_[1]); }
DEV float xsum16(float a, float b) { auto s_ = __builtin_amdgcn_permlane16_swap(__float_as_uint(a), __float_as_uint(b), false, false); return __uint_as_float(s_[0]) + __uint_as_float(s_[1]); }
DEV float xsum8(float a, float b, int lane) { const bool hi = (lane & 8) != 0; return (hi ? b : a) + dpp_f<0x128>(hi ? a : b); }
DEV float xsum4(float a, float b, int lane) { const bool hi = (lane & 4) != 0; return (hi ? b : a) + __shfl_xor(hi ? a : b, 4, 64); }
DEV float quad_sum(float v) { v += dpp_f<0xB1>(v); return v + dpp_f<0x4E>(v); }
#endif

#ifdef HOST_EMU
static std::atomic<unsigned> g_emu_bar{0};
struct XcdBarrier { unsigned n; };
static inline XcdBarrier xcd_barrier_post(unsigned*, unsigned*) { XcdBarrier b; b.n = 0; return b; }
static inline void xcd_barrier(XcdBarrier& b) {
    __syncthreads();
    if (threadIdx.x == 0) { b.n++; g_emu_bar.fetch_add(1); while (g_emu_bar.load() < b.n * gridDim.x) std::this_thread::yield(); }
    __syncthreads();
}
#else
#define XB_TMO      128
#define XB_XCNT(j)  (256  + 64 * (j))
#define XB_XSUB(j)  (1280 + 64 * (j))
#define XB_XGEN(j)  (2304 + 64 * (j))
#define XB_TOP      3328
#define XB_TOPGEN   3392
#define XCD_BAR_WORDS 3456
#define XB_QUEUE     3584
#define XB_SPIN_CAP (1u << 22)
DEV unsigned xb_ld(unsigned* p)              { return __hip_atomic_load(p, __ATOMIC_RELAXED, __HIP_MEMORY_SCOPE_AGENT); }
DEV unsigned xb_add(unsigned* p, unsigned v) { return __hip_atomic_fetch_add(p, v, __ATOMIC_RELAXED, __HIP_MEMORY_SCOPE_AGENT); }
DEV unsigned xb_xcc_id() { return (unsigned)__builtin_amdgcn_s_getreg((3 << 11) | 20) & 0xFu; }
#define XB_SPIN(cond, bar) do { unsigned _sp = 0; while (cond) { __builtin_amdgcn_s_sleep(1); \
    if ((++_sp & 255u) == 0u) { if (xb_ld(&(bar)[XB_TMO])) break; if (_sp > XB_SPIN_CAP) { atomicAdd(&(bar)[XB_TMO], 1u); break; } } } } while (0)
struct XcdBarrier { unsigned* bar; unsigned x; volatile LAS unsigned* st; };
DEV XcdBarrier xcd_barrier_post(unsigned* bar, volatile LAS unsigned* st) {
    XcdBarrier b; b.bar = bar; b.x = xb_xcc_id(); b.st = st;
    if (threadIdx.x == 0) (void)xb_add(&bar[XB_XCNT(b.x)], 1u);
    return b;
}
DEV void xcd_barrier_complete(unsigned* bar, unsigned x, unsigned& nloc, unsigned& nx) {
    const unsigned G = gridDim.x * gridDim.y * gridDim.z;
    unsigned sum, cnt, mine, sp = 0u;
    for (;;) {
        sum = 0u; cnt = 0u; mine = 0u;
#pragma unroll
        for (unsigned j = 0; j < 16; ++j) { const unsigned c = xb_ld(&bar[XB_XCNT(j)]); sum += c; cnt += (c > 0u) ? 1u : 0u; mine = (j == x) ? c : mine; }
        if (sum == G) break;
        __builtin_amdgcn_s_sleep(1);
        if ((++sp & 255u) == 0u) { if (xb_ld(&bar[XB_TMO])) break; if (sp > XB_SPIN_CAP) { atomicAdd(&bar[XB_TMO], 1u); break; } }
    }
    nloc = mine > 0u ? mine : 1u; nx = cnt > 0u ? cnt : 1u;
}
DEV void xcd_barrier(const XcdBarrier& b) {
    asm volatile("s_waitcnt vmcnt(0)" ::: "memory");
    __syncthreads();
    if (threadIdx.x == 0) {
        unsigned* bar = b.bar;
        __builtin_amdgcn_s_waitcnt(0);
        unsigned nloc = b.st[0], nx = b.st[1];
        if (nloc == 0u) { xcd_barrier_complete(bar, b.x, nloc, nx); b.st[0] = nloc; b.st[1] = nx; }
        const unsigned old = xb_add(&bar[XB_XSUB(b.x)], 1u);
        const unsigned gen = old / nloc;
        if (old + 1u == (gen + 1u) * nloc) {
            __builtin_amdgcn_fence(__ATOMIC_RELEASE, "agent");
            asm volatile("s_waitcnt vmcnt(0)" ::: "memory");
            const unsigned og = xb_add(&bar[XB_TOP], 1u);
            const unsigned tg = og / nx;
            if (og + 1u == (tg + 1u) * nx) xb_add(&bar[XB_TOPGEN], 1u);
            else XB_SPIN(xb_ld(&bar[XB_TOPGEN]) == tg, bar);
            __builtin_amdgcn_fence(__ATOMIC_ACQUIRE, "agent");
            xb_add(&bar[XB_XGEN(b.x)], 1u);
            asm volatile("s_waitcnt vmcnt(0)" ::: "memory");
        } else {
            XB_SPIN(xb_ld(&bar[XB_XGEN(b.x)]) == gen, bar);
            __builtin_amdgcn_fence(__ATOMIC_ACQUIRE, "agent");
            asm volatile("s_waitcnt vmcnt(0)" ::: "memory");
        }
    }
    __syncthreads();
}
#endif

namespace pg8 {
constexpr int BM = 256, BK = 64, HALF = 128, HTB = HALF * BK * 2, STAGE_BYTES = 8 * HTB, NXCD = 8, WGM = 8;
DEV int lds_byte(int r, int c) { const int st = (r >> 4) * 2 + (c >> 5), rr = r & 15, cc = c & 31, ob = rr * 64 + cc * 2; return st * 1024 + (ob ^ (((ob >> 9) & 1) << 5)); }
DEV void stage_rc(int b, int& R, int& C) { const int st = b / 1024, sb = b % 1024, swz = sb ^ (((sb >> 9) & 1) << 5); R = (st >> 1) * 16 + swz / 64; C = (st & 1) * 32 + (swz % 64) / 2; }
DEV int perm32(int rho) { const int n = rho >> 4, i = rho & 15; return 8 * (i >> 2) + 4 * n + (i & 3); }

struct Unit { int pm, pn, pb; };
struct Gemm { const bf16_t* A; const bf16_t* Bt; int K; const int* rowtab; };

struct Order {
    int nM, nN, nwg, G, c, mt, mts;
    DEV void init(int ngrp, int mt_, int mts_, int nN_, int G_, int c_) { mt = mt_; mts = mts_; nM = ngrp * mt_; nN = nN_; nwg = nM * nN; G = G_; c = c_; }
    DEV bool next(int i, Unit& u) const {
        const long L = (long)i * G + c; if (L >= nwg) return false;
        int wgid = (int)L; { const int q = nwg / NXCD, r = nwg % NXCD, xcd = wgid % NXCD, off = wgid / NXCD; wgid = (xcd < r ? xcd * (q + 1) : r * (q + 1) + (xcd - r) * q) + off; }
        const int nig = WGM * nN, gid = wgid / nig, fm = gid * WGM, gsz = (nM - fm) < WGM ? (nM - fm) : WGM;
        const int pmv = fm + ((wgid % nig) % gsz); u.pn = (wgid % nig) / gsz;
        const int e = pmv / mt, pl = pmv - e * mt; u.pm = e * mts + pl; u.pb = e * nN + u.pn; return true;
    }
};

template <class Epi, bool GATHER, bool F8 = false>
DEV void gemm_phase(LAS unsigned char* lds, const Gemm g, const Order& S, const Epi& E) {
    const int tid = opaque_tid(), wid = RFL(tid >> 6), lane = tid & 63, wr = wid >> 2, wc = wid & 3, fr = lane & 15, fq = lane >> 4;
    const int K = g.K, nt = K / BK;
    unsigned voffA[2], voffB[2];
#pragma unroll
    for (int i = 0; i < 2; ++i) { int R, C; stage_rc(tid * 16 + i * 8192, R, C); const int Rb = Epi::PERM ? ((R & ~31) + perm32(R & 31)) : R;
        voffA[i] = (unsigned)(R * K + C) * 2u; voffB[i] = (unsigned)(Rb * K + C) * 2u; }
    const size_t kstep = (size_t)(BK * 2);
    const size_t hstep = (size_t)HALF * K * 2;
    const size_t tstep = 2 * hstep;
    const unsigned ldsw = (unsigned)wid * 1024u;
    const int aoff = lds_byte(wr * 64 + fr, fq * 8), boff = lds_byte(wc * 32 + fr, fq * 8);
#define PG8_SA(b, h) (((b) * 2 + (h)) * HTB)
#define PG8_SB(b, h) ((4 + (b) * 2 + (h)) * HTB)
#define PG8_STAGE(bufoff, gbase, voff) do { _Pragma("unroll") for (int _i = 0; _i < 2; ++_i) \
        glds16((const char*)(gbase) + (voff)[_i], lds + (bufoff) + ldsw + _i * 8192); } while (0)
#define PG8_STAGE_A(bufoff, gbase, h, nx) do { _Pragma("unroll") for (int _i = 0; _i < 2; ++_i) { \
        if constexpr (GATHER) glds16((const char*)(gbase) + ((nx) ? na[h][_i] : ca[h][_i]), lds + (bufoff) + ldsw + _i * 8192); \
        else glds16((const char*)(gbase) + (size_t)(h) * hstep + voffA[_i], lds + (bufoff) + ldsw + _i * 8192); } } while (0)
#define PG8_LDA(dst, b, h) do { _Pragma("unroll") for (int m = 0; m < 4; ++m) _Pragma("unroll") for (int k = 0; k < 2; ++k) dst[m][k] = *(const LAS bf16x8*)(lds + PG8_SA(b, h) + aoff + m * 2048 + k * 1024); } while (0)
#define PG8_LDB(dst, b, h) do { _Pragma("unroll") for (int n = 0; n < 2; ++n) _Pragma("unroll") for (int k = 0; k < 2; ++k) dst[n][k] = *(const LAS bf16x8*)(lds + PG8_SB(b, h) + boff + n * 2048 + k * 1024); } while (0)
#if MOE_F8
#define PG8_MMA(ai, bj, At, Bt) do { SETPRIO(1); _Pragma("unroll") for (int m = 0; m < 4; ++m) _Pragma("unroll") for (int n = 0; n < 2; ++n) { \
        if constexpr (F8) mfma_f8(acc[ai][bj][m][n], Bt[n][0], Bt[n][1], At[m][0], At[m][1], f8sc); \
        else { _Pragma("unroll") for (int k = 0; k < 2; ++k) acc[ai][bj][m][n] = mfma16(Bt[n][k], At[m][k], acc[ai][bj][m][n]); } } SETPRIO(0); } while (0)
#else
#define PG8_MMA(ai, bj, At, Bt) do { SETPRIO(1); _Pragma("unroll") for (int m = 0; m < 4; ++m) _Pragma("unroll") for (int n = 0; n < 2; ++n) _Pragma("unroll") for (int k = 0; k < 2; ++k) \
        acc[ai][bj][m][n] = mfma16(Bt[n][k], At[m][k], acc[ai][bj][m][n]); SETPRIO(0); } while (0)
#endif
    Unit cur, nxt; int ui = 0;
    if (!S.next(0, cur)) return;
#if MOE_F8
    int f8sc = 0x7F7F7F7F; asm volatile("" : "+v"(f8sc));
#endif
    f32x4 acc[2][2][4][2];
#pragma unroll
    for (int a = 0; a < 2; ++a)
#pragma unroll
        for (int b = 0; b < 2; ++b)
#pragma unroll
            for (int m = 0; m < 4; ++m)
#pragma unroll
                for (int n = 0; n < 2; ++n) acc[a][b][m][n] = (f32x4){0.f, 0.f, 0.f, 0.f};
    bf16x8 At[4][2], B0[2][2], B1[2][2];
    unsigned ca[2][2], na[2][2];
    const char* cA; const char* nA;
    const char* cB = (const char*)g.Bt + (size_t)cur.pb * tstep;
#define PG8_SETA(u, base, off) do { if constexpr (GATHER) { base = (const char*)g.A; \
            _Pragma("unroll") for (int _h = 0; _h < 2; ++_h) _Pragma("unroll") for (int _i = 0; _i < 2; ++_i) { int _R, _C; stage_rc(tid * 16 + _i * 8192, _R, _C); \
                off[_h][_i] = (unsigned)g.rowtab[(u).pm * 256 + _h * 128 + _R] * (unsigned)(K * 2) + (unsigned)_C * 2u; } } \
        else { base = (const char*)g.A + (size_t)(u).pm * tstep; } } while (0)
    PG8_SETA(cur, cA, ca);
    nA = cA;
    if constexpr (GATHER) {
#pragma unroll
        for (int _h = 0; _h < 2; ++_h)
#pragma unroll
            for (int _i = 0; _i < 2; ++_i) na[_h][_i] = ca[_h][_i]; }
    PG8_STAGE(PG8_SB(0, 0), cB, voffB); PG8_STAGE_A(PG8_SA(0, 0), cA, 0, false); PG8_STAGE(PG8_SB(0, 1), cB + hstep, voffB); PG8_STAGE_A(PG8_SA(0, 1), cA, 1, false);
    if (wr == 1) S_BARRIER();
    WAIT_V(4); S_BARRIER();
    PG8_STAGE(PG8_SB(1, 0), cB + kstep, voffB); PG8_STAGE_A(PG8_SA(1, 0), cA + kstep, 0, false); PG8_STAGE(PG8_SB(1, 1), cB + hstep + kstep, voffB);
    WAIT_V(6); S_BARRIER();
    for (;;) {
        const bool has_next = S.next(ui + 1, nxt);
        const char* nB = cB;
        if (has_next) { PG8_SETA(nxt, nA, na); nB = (const char*)g.Bt + (size_t)nxt.pb * tstep; }
        else { nA = cA;
            if constexpr (GATHER) {
#pragma unroll
                for (int _h = 0; _h < 2; ++_h)
#pragma unroll
                    for (int _i = 0; _i < 2; ++_i) na[_h][_i] = ca[_h][_i]; } }
        for (int t = 0; t < nt; t += 2) {
            const bool last = (t == nt - 2);
            const char* a1 = cA + (size_t)(t + 1) * kstep;
            const char* a2 = last ? nA : cA + (size_t)(t + 2) * kstep; const char* b2 = last ? nB : cB + (size_t)(t + 2) * kstep;
            const char* a3 = a2 + kstep; const char* b3 = b2 + kstep;
            PG8_LDB(B0, 0, 0); SCHED_BAR(); PG8_LDA(At, 0, 0); PG8_STAGE_A(PG8_SA(1, 1), a1, 1, false);
            WAIT_L(8); S_BARRIER(); WAIT_L(0); PG8_MMA(0, 0, At, B0); S_BARRIER(); SCHED_BAR();
            PG8_LDB(B1, 0, 1); PG8_STAGE(PG8_SB(0, 0), b2, voffB);
            S_BARRIER(); WAIT_L(0); PG8_MMA(0, 1, At, B1); S_BARRIER();
            PG8_LDA(At, 0, 1); PG8_STAGE_A(PG8_SA(0, 0), a2, 0, last);
            S_BARRIER(); WAIT_L(0); PG8_MMA(1, 0, At, B0); S_BARRIER(); SCHED_BAR();
            PG8_STAGE(PG8_SB(0, 1), b2 + hstep, voffB);
            WAIT_V(6); S_BARRIER(); PG8_MMA(1, 1, At, B1); S_BARRIER();
            PG8_LDB(B0, 1, 0); SCHED_BAR(); PG8_LDA(At, 1, 0); PG8_STAGE_A(PG8_SA(0, 1), a2, 1, last);
            WAIT_L(8); S_BARRIER(); WAIT_L(0); PG8_MMA(0, 0, At, B0); S_BARRIER(); SCHED_BAR();
            PG8_LDB(B1, 1, 1); PG8_STAGE(PG8_SB(1, 0), b3, voffB);
            S_BARRIER(); WAIT_L(0); PG8_MMA(0, 1, At, B1); S_BARRIER();
            PG8_LDA(At, 1, 1); PG8_STAGE_A(PG8_SA(1, 0), a3, 0, last);
            S_BARRIER(); WAIT_L(0); PG8_MMA(1, 0, At, B0); S_BARRIER(); SCHED_BAR();
            PG8_STAGE(PG8_SB(1, 1), b3 + hstep, voffB);
            WAIT_V(6); S_BARRIER(); PG8_MMA(1, 1, At, B1); S_BARRIER();
        }
#if MOE_F8
        if constexpr (F8) MFMA_DRAIN();
#endif
        E(acc, cur, wr, wc, fr, fq);
        if (!has_next) break;
#pragma unroll
        for (int a = 0; a < 2; ++a)
#pragma unroll
            for (int b = 0; b < 2; ++b)
#pragma unroll
                for (int m = 0; m < 4; ++m)
#pragma unroll
                    for (int n = 0; n < 2; ++n) acc[a][b][m][n] = (f32x4){0.f, 0.f, 0.f, 0.f};
        cur = nxt; cA = nA; cB = nB; ++ui;
        if constexpr (GATHER) {
#pragma unroll
            for (int _h = 0; _h < 2; ++_h)
#pragma unroll
                for (int _i = 0; _i < 2; ++_i) ca[_h][_i] = na[_h][_i]; }
    }
    WAIT_V(0);
    if (wr == 0) S_BARRIER();
    S_BARRIER();
#undef PG8_SA
#undef PG8_SB
#undef PG8_STAGE
#undef PG8_STAGE_A
#undef PG8_LDA
#undef PG8_LDB
#undef PG8_MMA
#undef PG8_SETA
}
}
using pg8::Unit;

struct EpiProj {
    static constexpr bool PERM = true;
    bf16_t* proj; float* gates; const float* bias;
    DEV void operator()(const f32x4 (&acc)[2][2][4][2], const Unit& u, int wr, int wc, int fr, int fq) const {
        const int row0 = u.pm * 256 + wr * 64 + fr; const int colt = u.pn * 256, cl = wc * 32 + 8 * fq;
        if (u.pn < PROJ_N / 256) {
#pragma unroll
            for (int bj = 0; bj < 2; ++bj) { const f32x4 b0 = *(const f32x4*)(bias + colt + cl + bj * 128), b1 = *(const f32x4*)(bias + colt + cl + bj * 128 + 4);
#pragma unroll
                for (int ai = 0; ai < 2; ++ai)
#pragma unroll
                    for (int m = 0; m < 4; ++m) { bf16_t* rowp = proj + (size_t)(row0 + ai * 128 + m * 16) * PROJ_N + colt + cl + bj * 128;
                        const f32x4 v0 = acc[ai][bj][m][0] + b0, v1 = acc[ai][bj][m][1] + b1;
                        u32x4 o; o[0] = pack2(v0[0], v0[1]); o[1] = pack2(v0[2], v0[3]); o[2] = pack2(v1[0], v1[1]); o[3] = pack2(v1[2], v1[3]);
                        *(u32x4*)rowp = o; } }
        } else if (cl < NG) {
            const f32x4 b0 = *(const f32x4*)(bias + colt + cl), b1 = *(const f32x4*)(bias + colt + cl + 4);
#pragma unroll
            for (int ai = 0; ai < 2; ++ai)
#pragma unroll
                for (int m = 0; m < 4; ++m) { float* rowp = gates + (size_t)(row0 + ai * 128 + m * 16) * NG + cl;
                    *(f32x4*)(rowp) = acc[ai][0][m][0] + b0; *(f32x4*)(rowp + 4) = acc[ai][0][m][1] + b1; }
        }
    }
};
struct EpiSwiglu {
    static constexpr bool PERM = true;
    bf16_t* h;
    DEV void operator()(const f32x4 (&acc)[2][2][4][2], const Unit& u, int wr, int wc, int fr, int fq) const {
        const int row0 = u.pm * 256 + wr * 64 + fr; const int col0 = u.pn * 128 + wc * 32 + 8 * fq;
#if MOE_F8
        unsigned char* h8 = (unsigned char*)h;
        constexpr float isw = 1.0f / F8_SW1, kd = F8_SW1 * F8_SW1 / F8_SH;
#pragma unroll
        for (int ai = 0; ai < 2; ++ai)
#pragma unroll
            for (int m = 0; m < 4; ++m) { unsigned char* rowp = h8 + (size_t)(row0 + ai * 128 + m * 16) * FF + col0;
                float v[8];
#pragma unroll
                for (int n = 0; n < 2; ++n)
#pragma unroll
                    for (int j = 0; j < 4; ++j) {
                        const float e = fast_exp2(acc[ai][0][m][n][j] * (-isw * 1.44269504f)); v[n * 4 + j] = acc[ai][0][m][n][j] * acc[ai][1][m][n][j] * fast_rcp(e * kd + kd); }
                u32x2 o; o[0] = pack4_f8(v[0], v[1], v[2], v[3]); o[1] = pack4_f8(v[4], v[5], v[6], v[7]);
                *(u32x2*)rowp = o; }
        return;
#endif
#pragma unroll
        for (int ai = 0; ai < 2; ++ai)
#pragma unroll
            for (int m = 0; m < 4; ++m) { bf16_t* rowp = h + (size_t)(row0 + ai * 128 + m * 16) * FF + col0;
                float v[8];
#pragma unroll
                for (int n = 0; n < 2; ++n)
#pragma unroll
                    for (int j = 0; j < 4; ++j) { const float gt = acc[ai][0][m][n][j], up = acc[ai][1][m][n][j]; v[n * 4 + j] = gt * fast_rcp(1.0f + fast_exp(-gt)) * up; }
                u32x4 o; o[0] = pack2(v[0], v[1]); o[1] = pack2(v[2], v[3]); o[2] = pack2(v[4], v[5]); o[3] = pack2(v[6], v[7]);
                *(u32x4*)rowp = o; }
    }
};
template <bool F8OUT>
struct EpiDown {
    static constexpr bool PERM = true;
    bf16_t* y; float sc;
    DEV void operator()(const f32x4 (&acc)[2][2][4][2], const Unit& u, int wr, int wc, int fr, int fq) const {
        const int row0 = u.pm * 256 + wr * 64 + fr; const int col0 = u.pn * 256 + wc * 32 + 8 * fq;
#pragma unroll
        for (int ai = 0; ai < 2; ++ai)
#pragma unroll
            for (int m = 0; m < 4; ++m) {
#pragma unroll
                for (int bj = 0; bj < 2; ++bj) {
                    const f32x4 v0 = acc[ai][bj][m][0] * sc, v1 = acc[ai][bj][m][1] * sc;
#if MOE_F8
                    if constexpr (F8OUT) { unsigned char* rowp = (unsigned char*)y + (size_t)(row0 + ai * 128 + m * 16) * D_ + col0;
                        u32x2 o; o[0] = pack4_f8(v0[0], v0[1], v0[2], v0[3]); o[1] = pack4_f8(v1[0], v1[1], v1[2], v1[3]);
                        *(u32x2*)(rowp + bj * 128) = o; }
                    else
#endif
                    { bf16_t* rowp = y + (size_t)(row0 + ai * 128 + m * 16) * D_ + col0;
                        u32x4 o; o[0] = pack2(v0[0], v0[1]); o[1] = pack2(v0[2], v0[3]); o[2] = pack2(v1[0], v1[1]); o[3] = pack2(v1[2], v1[3]);
                        *(u32x4*)(rowp + bj * 128) = o; } } }
    }
};

DEV void phase_mods(const Params& p, LAS unsigned char* lds) {
    LAS float* sc = (LAS float*)lds;
    const int tid = opaque_tid(), col = tid & 63, ks = tid >> 6;
    float* mods = (float*)(p.ws + WS_MODS);
    constexpr int NB = B_ + 1;
    for (int u = blockIdx.x; u < DEPTH_ * 96; u += gridDim.x) {
        const int l = u / 96, cb = (u % 96) * 64;
        __syncthreads();
        for (int i = tid; i < NB * 1024; i += 512) { const int bb = i >> 10, k = i & 1023; const float cv = bb < B_ ? p.in[1][(size_t)bb * 1024 + k] : p.in[3][k]; sc[i] = siluf(cv); }
        __syncthreads();
        float acc[NB];
#pragma unroll
        for (int bb = 0; bb < NB; ++bb) acc[bb] = 0.f;
        const float* w = p.in[4] + (size_t)l * 1024 * 6144 + cb + col;
        for (int k = ks * 128; k < ks * 128 + 128; ++k) { const float wv = w[(size_t)k * 6144];
#pragma unroll
            for (int bb = 0; bb < NB; ++bb) acc[bb] += sc[bb * 1024 + k] * wv; }
        __syncthreads();
#pragma unroll
        for (int bb = 0; bb < NB; ++bb) sc[(ks * NB + bb) * 64 + col] = acc[bb];
        __syncthreads();
        for (int i = tid; i < NB * 64; i += 512) { const int bb = i >> 6, c2 = i & 63; float s = p.in[5][(size_t)l * 6144 + cb + c2];
            for (int q = 0; q < 8; ++q) s += sc[(q * NB + bb) * 64 + c2];
            mods[((size_t)l * NB + bb) * 6144 + cb + c2] = s; }
    }
    if (blockIdx.x == gridDim.x - 1) {
        float* rope = (float*)(p.ws + WS_ROPE);
        for (int i = tid; i < 64 * 16; i += 512) { const int pos = i >> 4, f = i & 15; const float inv = powf(10000.0f, -(float)f / 16.0f); const float a = (float)pos * inv; rope[i * 2] = cosf(a); rope[i * 2 + 1] = sinf(a); }
        for (int i = tid; i < 64 * 8; i += 512) { const int pos = i >> 3, f = i & 7; const float inv = powf(10000.0f, -(float)f / 8.0f); const float a = (float)pos * inv; rope[2048 + i * 2] = cosf(a); rope[2048 + i * 2 + 1] = sinf(a); }
    }
}

DEV int win_srccol(int n) {
    if (n < 1024) return n; if (n < 1792) return n + 16; if (n < 3328) return n + 48;
    if (n < 3344) return 1024 + (n - 3328); if (n < 3376) return 1808 + (n - 3344); return -1;
}
template <bool WIN>
DEV void conv_tile(const float* src, int ldn, int srcc0, bf16_t* dst, int ldk, int n0, int k0, LAS float* tile) {
    const int tid = opaque_tid(), nn = tid & 63, kk = tid >> 6;
    int sc_ = WIN ? win_srccol(n0 + nn) : srcc0 + nn;
#pragma unroll
    for (int i = 0; i < 8; ++i) { const int k = kk + 8 * i; tile[k * 65 + nn] = sc_ >= 0 ? src[(size_t)(k0 + k) * ldn + sc_] : 0.f; }
    __syncthreads();
    { const int n = tid >> 3, k8 = (tid & 7) * 8; float v[8];
#pragma unroll
      for (int j = 0; j < 8; ++j) v[j] = tile[(k8 + j) * 65 + n];
      u32x4 o; o[0] = pack2(v[0], v[1]); o[1] = pack2(v[2], v[3]); o[2] = pack2(v[4], v[5]); o[3] = pack2(v[6], v[7]);
      *(u32x4*)(dst + (size_t)(n0 + n) * ldk + k0 + k8) = o; }
    __syncthreads();
}
#if MOE_F8
constexpr float F8_SW1_ = F8_SW1, F8_SW2_ = F8_SW2;
#else
constexpr float F8_SW1_ = 0.f, F8_SW2_ = 0.f;
#endif
struct ConvTile { const float* s0; const float* s1; int ld; bf16_t* dst; int ldk; int n0, k0; int kind; };
#ifdef HOST_EMU
template <class T> static inline T* rfl_ptr(T* q) { return q; }
#else
template <class T> DEV T* rfl_ptr(T* q) { const unsigned long long v = (unsigned long long)q; const unsigned lo = (unsigned)RFL((int)(unsigned)v), hi = (unsigned)RFL((int)(unsigned)(v >> 32)); return (T*)(((unsigned long long)hi << 32) | lo); }
#endif
DEV ConvTile conv_desc(const Params& p, int l, int t_) {
    const int t = RFL(t_);
    ConvTile c;
    bf16_t* btin = (bf16_t*)(p.ws + WS_BTIN); bf16_t* btout = (bf16_t*)(p.ws + WS_BTOUT); bf16_t* btgu = (bf16_t*)(p.ws + WS_BTGU); bf16_t* btdn = (bf16_t*)(p.ws + WS_BTDN);
    const float* w_in = p.in[6] + (size_t)l * D_ * PROJ_W0; const float* w_out = p.in[14] + (size_t)l * D_ * D_;
    const float* w_gate = p.in[18] + (size_t)l * NE * D_ * FF; const float* w_up = p.in[19] + (size_t)l * NE * D_ * FF; const float* w_down = p.in[20] + (size_t)l * NE * FF * D_;
    constexpr int T_IN = 13 * 16, T_OUT = 4 * 16, T_GU = NE * 16 * 16;
    if (t < T_IN) { const int nb = t / 16, kt = t % 16; const int sc = win_srccol(nb * 256);
        c.kind = 0; c.s0 = w_in + sc; c.s1 = w_in + sc + 128; c.ld = PROJ_W0; c.dst = btin; c.ldk = D_; c.n0 = nb * 256; c.k0 = kt * 64; }
    else if (t < T_IN + T_OUT) { const int q = t - T_IN, nb = q / 16, kt = q % 16;
        c.kind = 0; c.s0 = w_out + nb * 256; c.s1 = c.s0 + 128; c.ld = D_; c.dst = btout; c.ldk = D_; c.n0 = nb * 256; c.k0 = kt * 64; }
    else if (t < T_IN + T_OUT + T_GU) { const int q = t - T_IN - T_OUT, e = q / 256, r = q % 256, nb = r / 16, kt = r % 16;
        c.kind = MOE_F8 ? 1 : 0; c.s0 = w_gate + (size_t)e * D_ * FF + nb * 128; c.s1 = w_up + (size_t)e * D_ * FF + nb * 128; c.ld = FF; c.dst = btgu + (size_t)e * 2 * FF * D_ / (MOE_F8 ? 2 : 1); c.ldk = D_; c.n0 = nb * 256; c.k0 = kt * 64; }
    else { const int q = t - T_IN - T_OUT - T_GU, e = q / 128, r = q % 128, nb = r / 32, kt = r % 32;
        c.kind = MOE_F8 ? 2 : 0; c.s0 = w_down + (size_t)e * FF * D_ + nb * 256; c.s1 = c.s0 + 128; c.ld = D_; c.dst = btdn + (size_t)e * D_ * FF / (MOE_F8 ? 2 : 1); c.ldk = FF; c.n0 = nb * 256; c.k0 = kt * 64; }
    c.s0 = rfl_ptr(c.s0); c.s1 = rfl_ptr(c.s1); c.dst = rfl_ptr(c.dst); c.ld = RFL(c.ld); c.ldk = RFL(c.ldk); c.n0 = RFL(c.n0); c.k0 = RFL(c.k0); c.kind = RFL(c.kind);
    return c;
}
DEV void conv_issue(const ConvTile& c, f32x4 (&r)[8], int tid) {
    const int nn4 = (tid & 63) * 4; const float* src = (nn4 < 128 ? c.s0 + nn4 : c.s1 + (nn4 - 128)) + (size_t)(c.k0 + (tid >> 6)) * c.ld;
#pragma unroll
    for (int i = 0; i < 8; ++i) r[i] = ld_stream((const f32x4*)(src + (size_t)(8 * i) * c.ld));
}
DEV void conv_finish(const ConvTile& c, const f32x4 (&r)[8], LAS float* tile, int tid) {
    const int nn4 = (tid & 63) * 4, kk = tid >> 6;
#pragma unroll
    for (int i = 0; i < 8; ++i) { LAS float* d = tile + (kk + 8 * i) * 257 + nn4; d[0] = r[i][0]; d[1] = r[i][1]; d[2] = r[i][2]; d[3] = r[i][3]; }
    __syncthreads();
#if MOE_F8
    if (c.kind != 0) { const int n = tid >> 1, kh = (tid & 1) * 32; unsigned char* drow = (unsigned char*)c.dst + (size_t)(c.n0 + n) * c.ldk + c.k0 + kh;
#pragma unroll
      for (int q = 0; q < 2; ++q) { float v[16];
          if (c.kind == 1) {
#pragma unroll
              for (int j = 0; j < 16; ++j) v[j] = tile[(kh + 16 * q + j) * 257 + n] * F8_SW1; }
          else {
#pragma unroll
              for (int j = 0; j < 16; ++j) v[j] = tile[(kh + 16 * q + j) * 257 + n] * F8_SW2; }
          u32x4 o; o[0] = pack4_f8(v[0], v[1], v[2], v[3]); o[1] = pack4_f8(v[4], v[5], v[6], v[7]); o[2] = pack4_f8(v[8], v[9], v[10], v[11]); o[3] = pack4_f8(v[12], v[13], v[14], v[15]);
          *(u32x4*)(drow + 16 * q) = o; } }
    else
#endif
    { const int n = tid >> 1, kh = (tid & 1) * 32; bf16_t* drow = c.dst + (size_t)(c.n0 + n) * c.ldk + c.k0 + kh;
#pragma unroll
      for (int q = 0; q < 4; ++q) { float v[8];
#pragma unroll
          for (int j = 0; j < 8; ++j) v[j] = tile[(kh + 8 * q + j) * 257 + n];
          u32x4 o; o[0] = pack2(v[0], v[1]); o[1] = pack2(v[2], v[3]); o[2] = pack2(v[4], v[5]); o[3] = pack2(v[6], v[7]);
          *(u32x4*)(drow + 8 * q) = o; } }
    __syncthreads();
}
DEV void phase_convert(const Params& p, int l, LAS unsigned char* lds) {
    LAS float* tile = (LAS float*)lds;
    const int tid = opaque_tid();
    constexpr int T_MAIN = 13 * 16 + 4 * 16 + NE * 16 * 16 + NE * 4 * 32;
    {
        f32x4 ra[8], rb[8];
        int t = blockIdx.x;
        ConvTile ca, cb;
        if (t < T_MAIN) { ca = conv_desc(p, l, t); conv_issue(ca, ra, tid); }
        while (t < T_MAIN) {
            const int t1 = t + gridDim.x;
            if (t1 < T_MAIN) { cb = conv_desc(p, l, t1); conv_issue(cb, rb, tid); }
            conv_finish(ca, ra, tile, tid);
            const int t2 = t1 + gridDim.x;
            if (t1 < T_MAIN) { if (t2 < T_MAIN) { ca = conv_desc(p, l, t2); conv_issue(ca, ra, tid); } conv_finish(cb, rb, tile, tid); }
            t = t2;
        }
    }
    { bf16_t* btin = (bf16_t*)(p.ws + WS_BTIN); const float* w_in = p.in[6] + (size_t)l * D_ * PROJ_W0;
      for (int t = blockIdx.x; t < 4 * 16; t += gridDim.x) conv_tile<true>(w_in, PROJ_W0, 0, btin, D_, PROJ_N + (t / 16) * 64, (t % 16) * 64, tile); }
    if (blockIdx.x == 0) { float* bias = (float*)(p.ws + WS_BIAS); const float* b_in = p.in[7] + (size_t)l * PROJ_W0;
        for (int i = tid; i < PROJ_NP; i += 512) { const int s = win_srccol(i); bias[i] = s >= 0 ? b_in[s] : 0.f; } }
    if (l == 0) {
        const float* mods = (const float*)(p.ws + WS_MODS); bf16_t* ub = (bf16_t*)(p.ws + WS_U);
        const int lane = tid & 63, gw = blockIdx.x * 8 + (tid >> 6), nw = gridDim.x * 8;
        for (int row = gw; row < NTOK; row += nw) {
            const bool isl = row < NL; const int bb = isl ? row / T_ : B_;
            const float* xr = isl ? p.in[0] + (size_t)row * D_ : p.in[2] + (size_t)(row - NL) * D_;
            const float* md = mods + (size_t)bb * 6144;
#pragma unroll
            for (int i = 0; i < 2; ++i) { const int c = lane * 8 + i * 512;
                const f32x4 x0 = *(const f32x4*)(xr + c), x1 = *(const f32x4*)(xr + c + 4), s0 = *(const f32x4*)(md + 1024 + c), s1 = *(const f32x4*)(md + 1024 + c + 4), h0 = *(const f32x4*)(md + c), h1 = *(const f32x4*)(md + c + 4);
                const f32x4 a = x0 * (s0 + 1.0f) + h0, b = x1 * (s1 + 1.0f) + h1;
                u32x4 o; o[0] = pack2(a[0], a[1]); o[1] = pack2(a[2], a[3]); o[2] = pack2(b[0], b[1]); o[3] = pack2(b[2], b[3]);
                *(u32x4*)(ub + (size_t)row * D_ + c) = o; }
        }
    }
}

DEV int tok_row(bool lat, int b, int pos) { return lat ? b * T_ + pos : NL + b * TC_ + pos; }
DEV bf16x8 lds_frag(const LAS bf16_t* base, int row, int stride, int col) { return *(const LAS bf16x8*)(base + row * stride + col); }

#ifdef HOST_EMU
#define WAVE_SYNC() do { int z_ = 0; (void)emu::wave_all(&z_, 4); } while (0)
#else
#define WAVE_SYNC() __builtin_amdgcn_wave_barrier()
#endif
#ifdef HOST_EMU
DEV void wg_release_acquire() { __syncthreads(); }
#else
DEV void wg_release_acquire() {
    __builtin_amdgcn_fence(__ATOMIC_RELEASE, "workgroup"); asm volatile("s_waitcnt vmcnt(0)" ::: "memory"); __syncthreads();
    __builtin_amdgcn_fence(__ATOMIC_ACQUIRE, "agent"); asm volatile("s_waitcnt vmcnt(0)" ::: "memory"); }
#endif
DEV void merge_head(const Params& p, int l, int b, int part, int h, int tid) {
    const bool need_ctx = l < DEPTH_ - 1;
    const bf16_t* proj = (const bf16_t*)(p.ws + WS_R1 + R1_PROJ); bf16_t* ymix = (bf16_t*)(p.ws + WS_YMIX);
    const bf16_t* o0 = (const bf16_t*)(p.ws + WS_R1 + (part ? R1_OG : R1_OM)); const bf16_t* o1 = o0 + (size_t)NTOK * 256;
    const int ch = h * 64 + (tid & 7) * 8;
    const float* gn = (part ? p.in[12] : p.in[11]) + (size_t)l * 256 + ch;
    const f32x4 g0 = *(const f32x4*)gn, g1 = *(const f32x4*)(gn + 4);
    const int ntk = T_ + (need_ctx ? TC_ : 0);
    for (int i0 = tid >> 3; i0 < ntk; i0 += 256) {
        int rows[4]; u32x4 oa[4], ob[4]; u32x4 gtv[4];
#pragma unroll
        for (int k = 0; k < 4; ++k) { const int i = i0 + 64 * k; const int row = i < T_ ? b * T_ + i : NL + b * TC_ + (i - T_); rows[k] = row;
            oa[k] = *(const u32x4*)(o0 + (size_t)row * 256 + ch); ob[k] = *(const u32x4*)(o1 + (size_t)row * 256 + ch);
            gtv[k] = *(const u32x4*)(proj + (size_t)row * PROJ_N + (part ? C_GR : C_MO) + ch); }
#pragma unroll
        for (int k = 0; k < 4; ++k) {
            const f32x4 x0 = (f32x4){bflo(oa[k][0]) + bflo(ob[k][0]), bfhi(oa[k][0]) + bfhi(ob[k][0]), bflo(oa[k][1]) + bflo(ob[k][1]), bfhi(oa[k][1]) + bfhi(ob[k][1])};
            const f32x4 x1 = (f32x4){bflo(oa[k][2]) + bflo(ob[k][2]), bfhi(oa[k][2]) + bfhi(ob[k][2]), bflo(oa[k][3]) + bflo(ob[k][3]), bfhi(oa[k][3]) + bfhi(ob[k][3])};
            float s = x0[0] + x0[1] + x0[2] + x0[3] + x1[0] + x1[1] + x1[2] + x1[3];
            s += shfl_xor_f(s, 1); s += shfl_xor_f(s, 2); s += shfl_xor_f(s, 4);
            const float mu = s * (1.0f / 64.0f);
            const f32x4 d0 = x0 - mu, d1 = x1 - mu;
            float q = d0[0] * d0[0] + d0[1] * d0[1] + d0[2] * d0[2] + d0[3] * d0[3] + d1[0] * d1[0] + d1[1] * d1[1] + d1[2] * d1[2] + d1[3] * d1[3];
            q += shfl_xor_f(q, 1); q += shfl_xor_f(q, 2); q += shfl_xor_f(q, 4);
            const float rstd = 1.0f / sqrtf(q * (1.0f / 64.0f) + LN_EPS);
            float gv[8];
#pragma unroll
            for (int j = 0; j < 4; ++j) { gv[2 * j] = bflo(gtv[k][j]); gv[2 * j + 1] = bfhi(gtv[k][j]); }
            float y[8];
#pragma unroll
            for (int j = 0; j < 8; ++j) { const float nv = (j < 4 ? d0[j] : d1[j - 4]) * rstd * (j < 4 ? g0[j] : g1[j - 4]); y[j] = nv * (part ? silu_fast(gv[j]) : sigmoid_fast(gv[j])); }
            u32x4 ov; ov[0] = pack2(y[0], y[1]); ov[1] = pack2(y[2], y[3]); ov[2] = pack2(y[4], y[5]); ov[3] = pack2(y[6], y[7]);
            *(u32x4*)(ymix + (size_t)rows[k] * D_ + part * 256 + ch) = ov;
        }
    }
}

struct MlItem { u32x2 q1[3], q2[3], k1[3], k2[3]; };
struct MlChunk { u32x2 q[2][2], k[2][2]; u32x4 v[2]; float gtv, g_pt, cm63; };
DEV void mlstm_unit(const Params& p, int l, int b, int h, LAS unsigned char* lds) {
    constexpr int ST = 72;
    constexpr int DSZ = 4 * 64 * ST * 2 + 2 * 80 * ST * 2 + 3 * 64 * 4 + 3 * 128 * 4;
    static_assert(2 * DSZ <= LDS_BYTES - 32, "mlstm lds");
    const int tid = opaque_tid(), lane = tid & 63, w = tid >> 6, dir = w >> 2, wh = w & 3, t4 = tid & 255, fr = lane & 15, fq = lane >> 4;
    LAS unsigned char* db = lds + dir * DSZ;
    LAS bf16_t* Qs = (LAS bf16_t*)db;
    LAS bf16_t* Ks = Qs + 64 * ST;
    LAS bf16_t* KT = Ks + 64 * ST;
    LAS bf16_t* Ps = KT + 64 * ST;
    LAS bf16_t* VT = Ps + 64 * ST;
    LAS bf16_t* Cs = VT + 80 * ST;
    LAS float* gt = (LAS float*)(Cs + 80 * ST);
    LAS float* cw = gt + 3 * 64;
    const bf16_t* proj = (const bf16_t*)(p.ws + WS_R1 + R1_PROJ); const float* gates = (const float*)(p.ws + WS_R1 + R1_GATES);
    bf16_t* qk2 = (bf16_t*)(p.ws + WS_R1 + R1_QK2);
    bf16_t* om = (bf16_t*)(p.ws + WS_R1 + R1_OM) + (size_t)dir * NTOK * 256;
    float* gbuf = (float*)(p.ws + WS_GSCAN) + (size_t)((b * 4 + h) * 2 + dir) * NCH * 192;
    const float* ropeM = (const float*)(p.ws + WS_ROPE);
    __syncthreads();
    for (int i = t4; i < 3 * 128; i += 256) { const int j = i / 128, c = i % 128; cw[i] = p.in[8][((size_t)l * 3 + j) * 512 + (c < 64 ? h * 64 + c : 256 + h * 64 + (c - 64))]; }
    for (int i = t4; i < 80 * ST; i += 256) Cs[i] = 0;
    for (int i = t4; i < 16 * ST; i += 256) VT[64 * ST + i] = (bf16_t)0x3F80;
    for (int c0 = wh; c0 < NCH; c0 += 12) {
        float ig[3], fg[3];
#pragma unroll
        for (int k = 0; k < 3; ++k) { const int c = c0 + 4 * k; ig[k] = fg[k] = 0.f;
            if (c < NCH) { const bool lat = c >= NCH_C; const int cc = lat ? c - NCH_C : c; const int Ts = lat ? T_ : TC_;
                const int sp = dir == 0 ? cc * 64 + lane : Ts - 1 - (cc * 64 + lane);
                const float* gr = gates + (size_t)tok_row(lat, b, sp) * NG + dir * 8 + h; ig[k] = gr[0]; fg[k] = gr[4]; } }
#pragma unroll
        for (int k = 0; k < 3; ++k) { const int c = c0 + 4 * k;
            if (c < NCH) {
                float bs = logsigf(fg[k]);
                for (int d = 1; d < 64; d <<= 1) { const float o = shfl_up_f(bs, d); if (lane >= d) bs += o; }
                const float g = ig[k] - bs;
                float cm = g;
                for (int d = 1; d < 64; d <<= 1) { const float o = shfl_up_f(cm, d); if (lane >= d) cm = fmaxf(cm, o); }
                gbuf[c * 192 + lane] = bs; gbuf[c * 192 + 64 + lane] = g; gbuf[c * 192 + 128 + lane] = cm; } }
    }
    __syncthreads();
    {
        constexpr int NIT = (TC_ + T_) * 8;
        auto item_load = [&](int it, MlItem& R) {
            const int tk = it >> 3, pg = it & 7; const bool lat = tk >= TC_; const int sp = lat ? tk - TC_ : tk, Ts = lat ? T_ : TC_;
            const int hf = pg >> 2, i0 = 4 * (pg & 3), dA = 32 * hf + i0, dB = dA + 16;
#pragma unroll
            for (int tap = 0; tap < 3; ++tap) { const int sp2 = sp + tap - 1; const bool ok = sp2 >= 0 && sp2 < Ts; const int spc = ok ? sp2 : sp;
                const bf16_t* pr = proj + (size_t)tok_row(lat, b, spc) * PROJ_N + h * 64;
                const u32x2 z = (u32x2){0u, 0u};
                const u32x2 a = *(const u32x2*)(pr + C_MQ + dA), bq = *(const u32x2*)(pr + C_MQ + dB), c = *(const u32x2*)(pr + C_MK + dA), d = *(const u32x2*)(pr + C_MK + dB);
                R.q1[tap] = ok ? a : z; R.q2[tap] = ok ? bq : z; R.k1[tap] = ok ? c : z; R.k2[tap] = ok ? d : z; } };
        auto item_finish = [&](int it, const MlItem& R) {
            const int tk = it >> 3, pg = it & 7; const bool lat = tk >= TC_; const int sp = lat ? tk - TC_ : tk;
            const int hf = pg >> 2, i0 = 4 * (pg & 3), dA = 32 * hf + i0, dB = dA + 16;
            float qa[4], qb[4], ka[4], kb[4];
#pragma unroll
            for (int j = 0; j < 4; ++j) { qa[j] = qb[j] = ka[j] = kb[j] = 0.f; }
#pragma unroll
            for (int tap = 0; tap < 3; ++tap) { const LAS float* wq = cw + tap * 128;
                qa[0] += wq[dA] * bflo(R.q1[tap][0]); qa[1] += wq[dA + 1] * bfhi(R.q1[tap][0]); qa[2] += wq[dA + 2] * bflo(R.q1[tap][1]); qa[3] += wq[dA + 3] * bfhi(R.q1[tap][1]);
                qb[0] += wq[dB] * bflo(R.q2[tap][0]); qb[1] += wq[dB + 1] * bfhi(R.q2[tap][0]); qb[2] += wq[dB + 2] * bflo(R.q2[tap][1]); qb[3] += wq[dB + 3] * bfhi(R.q2[tap][1]);
                ka[0] += wq[64 + dA] * bflo(R.k1[tap][0]); ka[1] += wq[64 + dA + 1] * bfhi(R.k1[tap][0]); ka[2] += wq[64 + dA + 2] * bflo(R.k1[tap][1]); ka[3] += wq[64 + dA + 3] * bfhi(R.k1[tap][1]);
                kb[0] += wq[64 + dB] * bflo(R.k2[tap][0]); kb[1] += wq[64 + dB + 1] * bfhi(R.k2[tap][0]); kb[2] += wq[64 + dB + 2] * bflo(R.k2[tap][1]); kb[3] += wq[64 + dB + 3] * bfhi(R.k2[tap][1]); }
#pragma unroll
            for (int j = 0; j < 4; ++j) { qa[j] = silu_fast(qa[j]); qb[j] = silu_fast(qb[j]); ka[j] = silu_fast(ka[j]) * 0.125f; kb[j] = silu_fast(kb[j]) * 0.125f; }
            if (lat) { const int pos = hf == 0 ? (sp >> 6) : (sp & 63);
#pragma unroll
                for (int j = 0; j < 4; ++j) { const float cs = ropeM[(pos * 16 + i0 + j) * 2], sn = ropeM[(pos * 16 + i0 + j) * 2 + 1];
                    const float q1 = qa[j] * cs - qb[j] * sn, q2 = qa[j] * sn + qb[j] * cs; qa[j] = q1; qb[j] = q2;
                    const float k1 = ka[j] * cs - kb[j] * sn, k2 = ka[j] * sn + kb[j] * cs; ka[j] = k1; kb[j] = k2; } }
            bf16_t* dst = qk2 + (size_t)tok_row(lat, b, sp) * 512 + h * 128;
            u32x2 o;
            o[0] = pack2(qa[0], qa[1]); o[1] = pack2(qa[2], qa[3]); *(u32x2*)(dst + dA) = o;
            o[0] = pack2(qb[0], qb[1]); o[1] = pack2(qb[2], qb[3]); *(u32x2*)(dst + dB) = o;
            o[0] = pack2(ka[0], ka[1]); o[1] = pack2(ka[2], ka[3]); *(u32x2*)(dst + 64 + dA) = o;
            o[0] = pack2(kb[0], kb[1]); o[1] = pack2(kb[2], kb[3]); *(u32x2*)(dst + 64 + dB) = o; };
        for (int it0 = tid; it0 < NIT; it0 += 1024) {
            MlItem A, B; const bool two = it0 + 512 < NIT;
            item_load(it0, A); if (two) item_load(it0 + 512, B);
            item_finish(it0, A); if (two) item_finish(it0 + 512, B);
        }
    }
    wg_release_acquire();
    f32x4 cacc[5];
#pragma unroll
    for (int i = 0; i < 5; ++i) cacc[i] = (f32x4){0.f, 0.f, 0.f, 0.f};
    const int ti = wh;
    const int pt = t4 >> 2, pgq = t4 & 3;
    float m_in = 0.f;
    auto chunk_load = [&](int c, MlChunk& R) {
        const bool lat = c >= NCH_C; const int cc = lat ? c - NCH_C : c; const int Ts = lat ? T_ : TC_;
        const int sp = dir == 0 ? cc * 64 + pt : Ts - 1 - (cc * 64 + pt);
        const size_t row = (size_t)tok_row(lat, b, sp);
#pragma unroll
        for (int sub = 0; sub < 2; ++sub) { const int pg = pgq * 2 + sub; const int hf = pg >> 2, i0 = 4 * (pg & 3), dA = 32 * hf + i0, dB = dA + 16;
            const bf16_t* src = qk2 + row * 512 + h * 128;
            R.q[sub][0] = *(const u32x2*)(src + dA); R.q[sub][1] = *(const u32x2*)(src + dB); R.k[sub][0] = *(const u32x2*)(src + 64 + dA); R.k[sub][1] = *(const u32x2*)(src + 64 + dB);
            R.v[sub] = *(const u32x4*)(proj + row * PROJ_N + C_MV + h * 64 + pg * 8); }
        R.gtv = gbuf[c * 192 + (t4 < 192 ? t4 : 0)]; R.g_pt = gbuf[c * 192 + 64 + pt]; R.cm63 = gbuf[c * 192 + 128 + 63]; };
    MlChunk cur, nxt;
    chunk_load(0, cur); nxt = cur;
    for (int c = 0; c < NCH; ++c) {
        const bool lat = c >= NCH_C; const int cc = lat ? c - NCH_C : c; const int Ts = lat ? T_ : TC_;
        {
            if (t4 < 192) gt[t4] = cur.gtv;
            const float wsc = fast_exp(cur.g_pt - fmaxf(m_in, cur.cm63));
#pragma unroll
            for (int sub = 0; sub < 2; ++sub) { const int pg = pgq * 2 + sub; const int hf = pg >> 2, i0 = 4 * (pg & 3), dA = 32 * hf + i0, dB = dA + 16;
                *(LAS u32x2*)(Qs + pt * ST + dA) = cur.q[sub][0]; *(LAS u32x2*)(Qs + pt * ST + dB) = cur.q[sub][1];
                *(LAS u32x2*)(Ks + pt * ST + dA) = cur.k[sub][0]; *(LAS u32x2*)(Ks + pt * ST + dB) = cur.k[sub][1];
                const float ka[4] = {bflo(cur.k[sub][0][0]), bfhi(cur.k[sub][0][0]), bflo(cur.k[sub][0][1]), bfhi(cur.k[sub][0][1])};
                const float kb[4] = {bflo(cur.k[sub][1][0]), bfhi(cur.k[sub][1][0]), bflo(cur.k[sub][1][1]), bfhi(cur.k[sub][1][1])};
#pragma unroll
                for (int j = 0; j < 4; ++j) { KT[(dA + j) * ST + pt] = f2bf(ka[j] * wsc); KT[(dB + j) * ST + pt] = f2bf(kb[j] * wsc); }
                const u32x4 vv = cur.v[sub];
#pragma unroll
                for (int j = 0; j < 4; ++j) { VT[(pg * 8 + 2 * j) * ST + pt] = (bf16_t)(vv[j] & 0xFFFFu); VT[(pg * 8 + 2 * j + 1) * ST + pt] = (bf16_t)(vv[j] >> 16); } }
        }
        LDS_BARRIER();
        if (c + 1 < NCH) chunk_load(c + 1, nxt);
        const float M63 = fmaxf(m_in, gt[128 + 63]);
        float Mt[4];
#pragma unroll
        for (int r = 0; r < 4; ++r) Mt[r] = fmaxf(m_in, gt[128 + 16 * ti + 4 * fq + r]);
        {
            const bf16x8 a0 = lds_frag(Qs, 16 * ti + fr, ST, 8 * fq), a1 = lds_frag(Qs, 16 * ti + fr, ST, 32 + 8 * fq);
#pragma unroll
            for (int tj = 0; tj < 4; ++tj) {
                f32x4 s = (f32x4){0.f, 0.f, 0.f, 0.f};
                s = mfma16(a0, lds_frag(Ks, 16 * tj + fr, ST, 8 * fq), s);
                s = mfma16(a1, lds_frag(Ks, 16 * tj + fr, ST, 32 + 8 * fq), s);
                const int sc_ = 16 * tj + fr; const float gs = gt[64 + sc_];
#pragma unroll
                for (int r = 0; r < 4; ++r) { const int t = 16 * ti + 4 * fq + r;
                    const float pv = sc_ <= t ? s[r] * fast_exp(gs - Mt[r]) : 0.f; Ps[t * ST + sc_] = f2bf(pv); } }
            const float decay = fast_exp(m_in - M63);
            const bf16x8 v0 = lds_frag(VT, 16 * ti + fr, ST, 8 * fq), v1 = lds_frag(VT, 16 * ti + fr, ST, 32 + 8 * fq);
#pragma unroll
            for (int dj = 0; dj < 4; ++dj) { cacc[dj] = cacc[dj] * decay;
                cacc[dj] = mfma16(v0, lds_frag(KT, 16 * dj + fr, ST, 8 * fq), cacc[dj]);
                cacc[dj] = mfma16(v1, lds_frag(KT, 16 * dj + fr, ST, 32 + 8 * fq), cacc[dj]); }
            cacc[4] = cacc[4] * decay;
            cacc[4] = mfma16(lds_frag(VT, 64 + fr, ST, 8 * fq), lds_frag(KT, 16 * wh + fr, ST, 8 * fq), cacc[4]);
            cacc[4] = mfma16(lds_frag(VT, 64 + fr, ST, 32 + 8 * fq), lds_frag(KT, 16 * wh + fr, ST, 32 + 8 * fq), cacc[4]);
        }
        WAVE_SYNC();
        {
            const bf16x8 p0 = lds_frag(Ps, 16 * ti + fr, ST, 8 * fq), p1 = lds_frag(Ps, 16 * ti + fr, ST, 32 + 8 * fq);
            const bf16x8 q0 = lds_frag(Qs, 16 * ti + fr, ST, 8 * fq), q1 = lds_frag(Qs, 16 * ti + fr, ST, 32 + 8 * fq);
            f32x4 np_[5];
            float ev[4];
#pragma unroll
            for (int r = 0; r < 4; ++r) ev[r] = fast_exp(m_in - Mt[r]);
#pragma unroll
            for (int tj = 0; tj < 5; ++tj) { f32x4 nc = (f32x4){0.f, 0.f, 0.f, 0.f}; np_[tj] = (f32x4){0.f, 0.f, 0.f, 0.f};
                np_[tj] = mfma16(p0, lds_frag(VT, 16 * tj + fr, ST, 8 * fq), np_[tj]);
                np_[tj] = mfma16(p1, lds_frag(VT, 16 * tj + fr, ST, 32 + 8 * fq), np_[tj]);
                nc = mfma16(q0, lds_frag(Cs, 16 * tj + fr, ST, 8 * fq), nc);
                nc = mfma16(q1, lds_frag(Cs, 16 * tj + fr, ST, 32 + 8 * fq), nc);
#pragma unroll
                for (int r = 0; r < 4; ++r) np_[tj][r] += ev[r] * nc[r]; }
#pragma unroll
            for (int r = 0; r < 4; ++r) { const int t = 16 * ti + 4 * fq + r;
                const float dn = fmaxf(fabsf(np_[4][r]), fast_exp(-gt[t] - Mt[r])); const float inv = 1.0f / dn;
                const int sp = dir == 0 ? cc * 64 + t : Ts - 1 - (cc * 64 + t);
                bf16_t* orow = om + (size_t)tok_row(lat, b, sp) * 256 + h * 64;
#pragma unroll
                for (int tj = 0; tj < 4; ++tj) orow[16 * tj + fr] = f2bf(np_[tj][r] * inv); }
        }
        m_in = gt[63] + M63;
        LDS_BARRIER();
#pragma unroll
        for (int dj = 0; dj < 4; ++dj)
#pragma unroll
            for (int r = 0; r < 4; ++r) Cs[(16 * ti + 4 * fq + r) * ST + 16 * dj + fr] = f2bf(cacc[dj][r]);
#pragma unroll
        for (int r = 0; r < 4; ++r) Cs[(64 + 4 * fq + r) * ST + 16 * wh + fr] = f2bf(cacc[4][r]);
        cur = nxt;
    }
    wg_release_acquire();
    merge_head(p, l, b, 0, h, tid);
}

template <int KS, int HALF, int DJ> struct GlaTr { static constexpr int v = ((32 * KS + 4 * HALF) * 40 + 16 * DJ) * 2; };
struct GlChunk { f32x4 lr[4]; unsigned q[2][2], k[2][2]; u32x4 v[2]; };
DEV void gla_unit(const Params& p, int l, int b, int h, LAS unsigned char* lds) {
    constexpr int ST = 72, SQ = 40;
    constexpr int DSZ = 5 * 64 * SQ * 2 + 32 * ST * 2 + 2 * 64 * ST * 2 + 64 * 33 * 4 + 544 * 4;
    static_assert(2 * DSZ <= LDS_BYTES - 32, "gla lds");
    const int tid = opaque_tid(), lane = tid & 63, w = tid >> 6, dir = w >> 2, wh = w & 3, t4 = tid & 255, fr = lane & 15, fq = lane >> 4;
    LAS unsigned char* db = lds + dir * DSZ;
    LAS bf16_t* Qs = (LAS bf16_t*)db;
    LAS bf16_t* Ks = Qs + 64 * SQ;
    LAS bf16_t* Ss = Ks + 64 * SQ;
    LAS bf16_t* Ah = Ss + 64 * SQ;
    LAS bf16_t* Al = Ah + 64 * SQ;
    LAS bf16_t* KT = Al + 64 * SQ;
    LAS bf16_t* VT = KT + 32 * ST;
    LAS bf16_t* Ps = VT + 64 * ST;
    LAS float* bc = (LAS float*)(Ps + 64 * ST);
    LAS float* w2s = bc + 64 * 33;
    const bf16_t* proj = (const bf16_t*)(p.ws + WS_R1 + R1_PROJ); const float* gates = (const float*)(p.ws + WS_R1 + R1_GATES);
    bf16_t* og = (bf16_t*)(p.ws + WS_R1 + R1_OG) + (size_t)dir * NTOK * 256;
    const float* ropeG = (const float*)(p.ws + WS_ROPE) + 2048;
    __syncthreads();
    for (int i = t4; i < 16 * 32; i += 256) { const int r = i >> 5, d = i & 31; w2s[i] = p.in[9][(((size_t)l * 2 + dir) * 16 + r) * 128 + h * 32 + d]; }
    if (t4 < 32) w2s[512 + t4] = p.in[10][((size_t)l * 2 + dir) * 128 + h * 32 + t4];
    for (int i = t4; i < 64 * SQ; i += 256) Ss[i] = 0;
    __syncthreads();
    f32x4 sacc[2];
    sacc[0] = (f32x4){0.f, 0.f, 0.f, 0.f}; sacc[1] = (f32x4){0.f, 0.f, 0.f, 0.f};
    const int ti = wh;
    const int pt = t4 >> 2, pgq = t4 & 3;
    bf16x8 lf_[2];
#pragma unroll
    for (int ks = 0; ks < 2; ++ks)
#pragma unroll
        for (int j = 0; j < 8; ++j) lf_[ks][j] = (32 * ks + 8 * fq + j <= 16 * ti + fr) ? (short)0x3F80 : (short)0;
    auto chunk_load = [&](int c, GlChunk& R) {
        const bool lat = c >= NCH_C; const int cc = lat ? c - NCH_C : c; const int Ts = lat ? T_ : TC_;
        const int sp = dir == 0 ? cc * 64 + pt : Ts - 1 - (cc * 64 + pt);
        const size_t row = (size_t)tok_row(lat, b, sp);
        const float* lr = gates + row * NG + 16 + dir * 16;
#pragma unroll
        for (int r = 0; r < 4; ++r) R.lr[r] = *(const f32x4*)(lr + 4 * r);
        const bf16_t* pr = proj + row * PROJ_N;
#pragma unroll
        for (int sub = 0; sub < 2; ++sub) { const int pg = pgq * 2 + sub; const int hf = pg >> 2, i0 = 2 * (pg & 3), dA = 16 * hf + i0, dB = dA + 8;
            R.q[sub][0] = *(const unsigned*)(pr + C_GQ + h * 32 + dA); R.q[sub][1] = *(const unsigned*)(pr + C_GQ + h * 32 + dB);
            R.k[sub][0] = *(const unsigned*)(pr + C_GK + h * 32 + dA); R.k[sub][1] = *(const unsigned*)(pr + C_GK + h * 32 + dB);
            R.v[sub] = *(const u32x4*)(pr + C_GV + h * 64 + pg * 8); } };
    GlChunk cur, nxt;
    chunk_load(0, cur); nxt = cur;
    for (int c = 0; c < NCH; ++c) {
        const bool lat = c >= NCH_C; const int cc = lat ? c - NCH_C : c; const int Ts = lat ? T_ : TC_;
        const int sp = dir == 0 ? cc * 64 + pt : Ts - 1 - (cc * 64 + pt);
        { float lrv[16];
#pragma unroll
          for (int r = 0; r < 16; r += 4) { lrv[r] = cur.lr[r >> 2][0]; lrv[r + 1] = cur.lr[r >> 2][1]; lrv[r + 2] = cur.lr[r >> 2][2]; lrv[r + 3] = cur.lr[r >> 2][3]; }
          float av[8];
#pragma unroll
          for (int j = 0; j < 8; ++j) { const int d = pgq * 8 + j; float z = w2s[512 + d];
#pragma unroll
              for (int r = 0; r < 16; ++r) z += lrv[r] * w2s[r * 32 + d];
              av[j] = logsig_fast(z) * (1.0f / 16.0f); }
          u32x4 hi, lo;
#pragma unroll
          for (int j = 0; j < 4; ++j) { const bf16_t h0 = f2bf(av[2 * j]), h1 = f2bf(av[2 * j + 1]);
              hi[j] = (unsigned)h0 | ((unsigned)h1 << 16); lo[j] = (unsigned)f2bf(av[2 * j] - bf2f(h0)) | ((unsigned)f2bf(av[2 * j + 1] - bf2f(h1)) << 16); }
          *(LAS u32x4*)(Ah + pt * SQ + pgq * 8) = hi; *(LAS u32x4*)(Al + pt * SQ + pgq * 8) = lo; }
        LDS_BARRIER();
        {
            const lds_addr_t ah = lds_addr(Ah + (8 * fq + (fr >> 2)) * SQ + 4 * (fr & 3)), al = lds_addr(Al + (8 * fq + (fr >> 2)) * SQ + 4 * (fr & 3));
#define GLA_CS(DJ) do { \
            const bf16x4 h00 = tr_read4<GlaTr<0, 0, DJ>::v>(ah), h01 = tr_read4<GlaTr<0, 1, DJ>::v>(ah), h10 = tr_read4<GlaTr<1, 0, DJ>::v>(ah), h11 = tr_read4<GlaTr<1, 1, DJ>::v>(ah); \
            const bf16x4 l00 = tr_read4<GlaTr<0, 0, DJ>::v>(al), l01 = tr_read4<GlaTr<0, 1, DJ>::v>(al), l10 = tr_read4<GlaTr<1, 0, DJ>::v>(al), l11 = tr_read4<GlaTr<1, 1, DJ>::v>(al); \
            LGKM_WAIT0(); \
            f32x4 acc = (f32x4){0.f, 0.f, 0.f, 0.f}; \
            acc = mfma16(lf_[0], (bf16x8){h00[0], h00[1], h00[2], h00[3], h01[0], h01[1], h01[2], h01[3]}, acc); \
            acc = mfma16(lf_[1], (bf16x8){h10[0], h10[1], h10[2], h10[3], h11[0], h11[1], h11[2], h11[3]}, acc); \
            acc = mfma16(lf_[0], (bf16x8){l00[0], l00[1], l00[2], l00[3], l01[0], l01[1], l01[2], l01[3]}, acc); \
            acc = mfma16(lf_[1], (bf16x8){l10[0], l10[1], l10[2], l10[3], l11[0], l11[1], l11[2], l11[3]}, acc); \
            _Pragma("unroll") for (int r = 0; r < 4; ++r) bc[(16 * ti + 4 * fq + r) * 33 + 16 * DJ + fr] = acc[r]; } while (0)
            GLA_CS(0); GLA_CS(1);
#undef GLA_CS
        }
        WAVE_SYNC();
#pragma unroll
        for (int sub = 0; sub < 2; ++sub) {
            const int pg = pgq * 2 + sub;
            const int hf = pg >> 2, i0 = 2 * (pg & 3), dA = 16 * hf + i0, dB = dA + 8;
            const unsigned q1 = cur.q[sub][0], q2 = cur.q[sub][1], k1 = cur.k[sub][0], k2 = cur.k[sub][1];
            const float qs_ = 0.17677669529663687f;
            float qa[2] = {bflo(q1) * qs_, bfhi(q1) * qs_}, qb[2] = {bflo(q2) * qs_, bfhi(q2) * qs_}, ka[2] = {bflo(k1), bfhi(k1)}, kb[2] = {bflo(k2), bfhi(k2)};
            if (lat) { const int pos = hf == 0 ? (sp >> 6) : (sp & 63);
#pragma unroll
                for (int j = 0; j < 2; ++j) { const float cs = ropeG[(pos * 8 + i0 + j) * 2], sn = ropeG[(pos * 8 + i0 + j) * 2 + 1];
                    const float x1 = qa[j] * cs - qb[j] * sn, x2 = qa[j] * sn + qb[j] * cs; qa[j] = x1; qb[j] = x2;
                    const float y1 = ka[j] * cs - kb[j] * sn, y2 = ka[j] * sn + kb[j] * cs; ka[j] = y1; kb[j] = y2; } }
#pragma unroll
            for (int j = 0; j < 2; ++j) { const float bA = bc[pt * 33 + dA + j], bB = bc[pt * 33 + dB + j];
                qa[j] *= fast_exp(bA); qb[j] *= fast_exp(bB); ka[j] *= fast_exp(-bA); kb[j] *= fast_exp(-bB); }
            *(LAS unsigned*)(Qs + pt * SQ + dA) = pack2(qa[0], qa[1]); *(LAS unsigned*)(Qs + pt * SQ + dB) = pack2(qb[0], qb[1]);
            *(LAS unsigned*)(Ks + pt * SQ + dA) = pack2(ka[0], ka[1]); *(LAS unsigned*)(Ks + pt * SQ + dB) = pack2(kb[0], kb[1]);
#pragma unroll
            for (int j = 0; j < 2; ++j) { KT[(dA + j) * ST + pt] = f2bf(ka[j]); KT[(dB + j) * ST + pt] = f2bf(kb[j]); }
            const u32x4 vv = cur.v[sub];
#pragma unroll
            for (int j = 0; j < 4; ++j) { VT[(pg * 8 + 2 * j) * ST + pt] = (bf16_t)(vv[j] & 0xFFFFu); VT[(pg * 8 + 2 * j + 1) * ST + pt] = (bf16_t)(vv[j] >> 16); }
        }
        LDS_BARRIER();
        if (c + 1 < NCH) chunk_load(c + 1, nxt);
        {
            const bf16x8 a0 = lds_frag(Qs, 16 * ti + fr, SQ, 8 * fq);
#pragma unroll
            for (int tj = 0; tj < 4; ++tj) {
                f32x4 s = (f32x4){0.f, 0.f, 0.f, 0.f};
                s = mfma16(a0, lds_frag(Ks, 16 * tj + fr, SQ, 8 * fq), s);
                const int sc_ = 16 * tj + fr;
#pragma unroll
                for (int r = 0; r < 4; ++r) { const int t = 16 * ti + 4 * fq + r; Ps[t * ST + sc_] = f2bf(sc_ <= t ? s[r] : 0.f); } }
        }
        WAVE_SYNC();
        {
            const bf16x8 p0 = lds_frag(Ps, 16 * ti + fr, ST, 8 * fq), p1 = lds_frag(Ps, 16 * ti + fr, ST, 32 + 8 * fq), q0 = lds_frag(Qs, 16 * ti + fr, SQ, 8 * fq);
            f32x4 o[4];
#pragma unroll
            for (int tj = 0; tj < 4; ++tj) { o[tj] = (f32x4){0.f, 0.f, 0.f, 0.f};
                o[tj] = mfma16(p0, lds_frag(VT, 16 * tj + fr, ST, 8 * fq), o[tj]);
                o[tj] = mfma16(p1, lds_frag(VT, 16 * tj + fr, ST, 32 + 8 * fq), o[tj]);
                o[tj] = mfma16(q0, lds_frag(Ss, 16 * tj + fr, SQ, 8 * fq), o[tj]); }
#pragma unroll
            for (int r = 0; r < 4; ++r) { const int t = 16 * ti + 4 * fq + r; const int sp2 = dir == 0 ? cc * 64 + t : Ts - 1 - (cc * 64 + t);
                bf16_t* orow = og + (size_t)tok_row(lat, b, sp2) * 256 + h * 64;
#pragma unroll
                for (int tj = 0; tj < 4; ++tj) orow[16 * tj + fr] = f2bf(o[tj][r]); }
            const bf16x8 v0 = lds_frag(VT, 16 * wh + fr, ST, 8 * fq), v1 = lds_frag(VT, 16 * wh + fr, ST, 32 + 8 * fq);
#pragma unroll
            for (int dj = 0; dj < 2; ++dj) {
                sacc[dj] = mfma16(v0, lds_frag(KT, 16 * dj + fr, ST, 8 * fq), sacc[dj]);
                sacc[dj] = mfma16(v1, lds_frag(KT, 16 * dj + fr, ST, 32 + 8 * fq), sacc[dj]);
                sacc[dj] = sacc[dj] * fast_exp(bc[63 * 33 + 16 * dj + fr]); }
        }
        LDS_BARRIER();
#pragma unroll
        for (int dj = 0; dj < 2; ++dj)
#pragma unroll
            for (int r = 0; r < 4; ++r) Ss[(16 * wh + 4 * fq + r) * SQ + 16 * dj + fr] = f2bf(sacc[dj][r]);
        cur = nxt;
    }
    wg_release_acquire();
    merge_head(p, l, b, 1, h, tid);
}

template <int KS, int T16, int VT> struct TrOff { static constexpr int v = ((32 * KS + 16 * T16) * 72 + 16 * VT) * 2; };
template <int NT>
DEV void attn_ldkv(const LAS bf16_t* Kb, lds_addr_t vb, bf16x8 (&kf)[NT][2], bf16x8 (&vf)[NT / 2][4], int fr, int fq) {
#pragma unroll
    for (int kt = 0; kt < NT; ++kt) { kf[kt][0] = lds_frag(Kb, 16 * kt + fr, 72, 8 * fq); kf[kt][1] = lds_frag(Kb, 16 * kt + fr, 72, 32 + 8 * fq); }
    bf16x4 lo[NT / 2][4], hi[NT / 2][4];
#define ATT_TR(KS) do { lo[KS][0] = tr_read4<TrOff<KS, 0, 0>::v>(vb); hi[KS][0] = tr_read4<TrOff<KS, 1, 0>::v>(vb); lo[KS][1] = tr_read4<TrOff<KS, 0, 1>::v>(vb); hi[KS][1] = tr_read4<TrOff<KS, 1, 1>::v>(vb); \
        lo[KS][2] = tr_read4<TrOff<KS, 0, 2>::v>(vb); hi[KS][2] = tr_read4<TrOff<KS, 1, 2>::v>(vb); lo[KS][3] = tr_read4<TrOff<KS, 0, 3>::v>(vb); hi[KS][3] = tr_read4<TrOff<KS, 1, 3>::v>(vb); } while (0)
    ATT_TR(0);
    if constexpr (NT == 4) { ATT_TR(1); }
#undef ATT_TR
    LGKM_WAIT0();
#pragma unroll
    for (int ks = 0; ks < NT / 2; ++ks)
#pragma unroll
        for (int vt = 0; vt < 4; ++vt) vf[ks][vt] = (bf16x8){lo[ks][vt][0], lo[ks][vt][1], lo[ks][vt][2], lo[ks][vt][3], hi[ks][vt][0], hi[ks][vt][1], hi[ks][vt][2], hi[ks][vt][3]};
}
template <int NT, bool LOC>
DEV void attn_tile(const bf16x8 (&kf)[NT][2], const bf16x8 (&vf)[NT / 2][4], bf16x8 qf0, bf16x8 qf1, f32x4 (&o)[4], float& mrun, float& lrun, const LAS float* rpl, int d0) {
    f32x4 s[NT];
#pragma unroll
    for (int kt = 0; kt < NT; ++kt) { s[kt] = (f32x4){0.f, 0.f, 0.f, 0.f}; s[kt] = mfma16(kf[kt][0], qf0, s[kt]); s[kt] = mfma16(kf[kt][1], qf1, s[kt]); }
    float mx = -INFINITY;
#pragma unroll
    for (int kt = 0; kt < NT; ++kt)
#pragma unroll
        for (int j = 0; j < 4; ++j) { float v;
            if (LOC) { const bool ok = (unsigned)(16 * kt + j - d0) < 16u; v = ok ? s[kt][j] * 0.18033688f + rpl[16 * kt + j] : -INFINITY; }
            else v = s[kt][j] * 0.18033688f;
            s[kt][j] = v; mx = fmaxf(mx, v); }
    mx = xrow16_max(mx);
    if (wave_any(mx > mrun + 8.0f)) {
        const float mnew = fmaxf(mrun, mx);
        const float alpha = fast_exp2(mrun - mnew);
        lrun = lrun * alpha; mrun = mnew;
#pragma unroll
        for (int vt = 0; vt < 4; ++vt) o[vt] = o[vt] * alpha;
    }
    float ps = 0.f;
#pragma unroll
    for (int kt = 0; kt < NT; ++kt)
#pragma unroll
        for (int j = 0; j < 4; ++j) { const float pv = fast_exp2(s[kt][j] - mrun); s[kt][j] = pv; ps += pv; }
    lrun += ps;
#pragma unroll
    for (int ks = 0; ks < NT / 2; ++ks) { u32x4 pu; pu[0] = pack2(s[2 * ks][0], s[2 * ks][1]); pu[1] = pack2(s[2 * ks][2], s[2 * ks][3]); pu[2] = pack2(s[2 * ks + 1][0], s[2 * ks + 1][1]); pu[3] = pack2(s[2 * ks + 1][2], s[2 * ks + 1][3]);
        bf16x8 pf; __builtin_memcpy(&pf, &pu, 16);
#pragma unroll
        for (int vt = 0; vt < 4; ++vt) o[vt] = mfma16(vf[ks][vt], pf, o[vt]); }
}
template <bool LOCAL>
DEV void attn_unit(const Params& p, int l, int b, int head, int r0, LAS unsigned char* lds) {
    constexpr int NQT = 2, ST = 72, HB = 64 * ST, BUF = 2 * HB;
    LAS bf16_t* kv = (LAS bf16_t*)lds;
    LAS float* rp = (LAS float*)(kv + 2 * BUF) + 64;
    const int tid = opaque_tid(), lane = tid & 63, w = tid >> 6, fr = lane & 15, fq = lane >> 4;
    const int qt = w & 3, qc = 16 * qt + fr, rw = r0 + 2 * (w >> 2);
    const bf16_t* proj = (const bf16_t*)(p.ws + WS_R1 + R1_PROJ);
    bf16_t* ymix = (bf16_t*)(p.ws + WS_YMIX);
    const int rs_first = r0 - 4 < 0 ? 0 : (r0 - 4 > GRID_R - 8 ? GRID_R - 8 : r0 - 4);
    const int rl = r0 + 3, rs_last = rl - 4 < 0 ? 0 : (rl - 4 > GRID_R - 8 ? GRID_R - 8 : rl - 4);
    const int kr_lo = rs_first, nloc = LOCAL ? rs_last + 8 - rs_first : 0, nblk = nloc + NCH_C;
    const int skey = tid >> 3, sg8 = (tid & 7) * 8;
    const bf16_t* sbase = proj + (size_t)head * 64 + sg8;
    u32x4 kr0, vr0, kr1, vr1;
#define ATT_KROW(kb) ((kb) < nloc ? tok_row(true, b, (kr_lo + (kb)) * 64) : tok_row(false, b, ((kb) - nloc) * 64))
#define ATT_LOAD(kb, KR, VR) do { const bf16_t* pr_ = sbase + (size_t)(ATT_KROW(kb) + skey) * PROJ_N; KR = *(const u32x4*)(pr_ + C_NK); VR = *(const u32x4*)(pr_ + C_NV); } while (0)
#define ATT_STORE(bi, KR, VR) do { LAS bf16_t* d_ = kv + (bi) * BUF + skey * ST + sg8; *(LAS u32x4*)(d_) = KR; *(LAS u32x4*)(d_ + HB) = VR; } while (0)
    __syncthreads();
    ATT_LOAD(0, kr0, vr0);
    ATT_LOAD(1, kr1, vr1);
    if (LOCAL) for (int i = tid; i < 15 * 31; i += 512) rp[i] = p.in[13][((size_t)l * 8 + head) * 465 + i] * 1.44269504f;
    bf16x8 qf[NQT][2]; f32x4 o[NQT][4]; float mrun[NQT], lrun[NQT];
#pragma unroll
    for (int i = 0; i < NQT; ++i) { const bf16_t* qp = proj + (size_t)tok_row(LOCAL, b, (rw + i) * 64 + qc) * PROJ_N + C_NQ + head * 64;
        qf[i][0] = *(const bf16x8*)(qp + 8 * fq); qf[i][1] = *(const bf16x8*)(qp + 32 + 8 * fq); mrun[i] = -INFINITY; lrun[i] = 0.f;
#pragma unroll
        for (int vt = 0; vt < 4; ++vt) o[i][vt] = (f32x4){0.f, 0.f, 0.f, 0.f}; }
    ATT_STORE(0, kr0, vr0);
    ATT_LOAD(2, kr0, vr0);
    const int cs = qc - 8 < 0 ? 0 : (qc - 8 > 48 ? 48 : qc - 8);
    const int koff = qt == 0 ? 0 : (qt == 1 ? 8 : (qt == 2 ? 24 : 32));
    const int d0 = cs - koff - 4 * fq;
    const LAS float* rpl0 = rp + koff + 4 * fq - qc + 15;
    const int rs0 = rw - 4 < 0 ? 0 : (rw - 4 > GRID_R - 8 ? GRID_R - 8 : rw - 4), rs1 = rw - 3 < 0 ? 0 : (rw - 3 > GRID_R - 8 ? GRID_R - 8 : rw - 3);
    LDS_BARRIER();
#define ATT_ITER(kb, KR, VR) do { const int bi = (kb) & 1; \
        if ((kb) + 1 < nblk) ATT_STORE(bi ^ 1, KR, VR); \
        if ((kb) + 3 < nblk) ATT_LOAD((kb) + 3, KR, VR); \
        const LAS bf16_t* Kb = kv + bi * BUF; \
        const LAS bf16_t* Vl = kv + bi * BUF + HB + (4 * fq + (fr >> 2)) * ST + 4 * (fr & 3); \
        if ((kb) < nloc) { \
            const int krow = kr_lo + (kb); \
            const bool a0 = krow >= rs0 && krow < rs0 + 8, a1 = krow >= rs1 && krow < rs1 + 8; \
            if (a0 || a1) { \
                bf16x8 kf[2][2], vf[1][4]; \
                attn_ldkv<2>(Kb + koff * ST, lds_addr(Vl + koff * ST), kf, vf, fr, fq); \
                if (a0) attn_tile<2, true>(kf, vf, qf[0][0], qf[0][1], o[0], mrun[0], lrun[0], rpl0 + (krow - rw + 7) * 31, d0); \
                if (a1) attn_tile<2, true>(kf, vf, qf[1][0], qf[1][1], o[1], mrun[1], lrun[1], rpl0 + (krow - rw - 1 + 7) * 31, d0); \
            } \
        } else { \
            _Pragma("unroll") for (int hf = 0; hf < 2; ++hf) { \
                bf16x8 kf[2][2], vf[1][4]; \
                attn_ldkv<2>(Kb + 32 * hf * ST, lds_addr(Vl + 32 * hf * ST), kf, vf, fr, fq); \
                _Pragma("unroll") for (int i = 0; i < NQT; ++i) attn_tile<2, false>(kf, vf, qf[i][0], qf[i][1], o[i], mrun[i], lrun[i], rpl0, d0); } \
        } \
        LDS_BARRIER(); } while (0)
#pragma unroll 1
    for (int kb = 0; kb < nblk; kb += 2) {
        ATT_ITER(kb, kr1, vr1);
        if (kb + 1 < nblk) ATT_ITER(kb + 1, kr0, vr0);
    }
#undef ATT_ITER
#undef ATT_KROW
#undef ATT_LOAD
#undef ATT_STORE
#pragma unroll
    for (int i = 0; i < NQT; ++i) { const float lr = xrow16_sum(lrun[i]);
        const float inv = 1.0f / lr;
        bf16_t* yr = ymix + (size_t)tok_row(LOCAL, b, (rw + i) * 64 + qc) * D_ + 512 + head * 64;
#pragma unroll
        for (int vt = 0; vt < 4; ++vt) { u32x2 ov; ov[0] = pack2(o[i][vt][0] * inv, o[i][vt][1] * inv); ov[1] = pack2(o[i][vt][2] * inv, o[i][vt][3] * inv); *(u32x2*)(yr + 16 * vt + 4 * fq) = ov; } }
}

DEV void phase_mixer(const Params& p, int l, LAS unsigned char* lds) {
    const bool need_ctx = l < DEPTH_ - 1;
#ifndef REP_K
#define REP_K -1
#endif
#ifndef NO_SCAN
    for (int rep_ = 0; rep_ < ((REP_K == 20 || REP_K == 99) ? 2 : 1); ++rep_)
    for (int u = blockIdx.x; u < B_ * 8; u += gridDim.x) { if (u < B_ * 4) mlstm_unit(p, l, u >> 2, u & 3, lds); else gla_unit(p, l, (u - B_ * 4) >> 2, u & 3, lds); }
#endif
    static_assert(GRID_R % 4 == 0 && NCH_C == 4, "attention unit grouping");
    const int nloc = B_ * 8 * (GRID_R / 4), nctx = need_ctx ? B_ * 8 : 0;
#ifdef HOST_EMU
    for (int u = blockIdx.x; u < nloc + nctx; u += gridDim.x) {
        if (u < nloc) { const int rg = u % (GRID_R / 4), head = (u / (GRID_R / 4)) & 7, b = u / (GRID_R / 4 * 8); attn_unit<true>(p, l, b, head, rg * 4, lds); }
        else { const int q = u - nloc, head = q & 7, b = q >> 3; attn_unit<false>(p, l, b, head, 0, lds); }
    }
#else
    for (int rep_ = 0; rep_ < ((REP_K == 22 || REP_K == 99) ? 2 : 1); ++rep_) {
        unsigned* ctr = (unsigned*)(p.ws + WS_CTL) + XB_QUEUE + l * 2 + rep_;
        volatile LAS int* qs = (volatile LAS int*)(lds + LDS_BYTES - 32);
        const int tid = opaque_tid();
        __syncthreads();
        if (tid == 0) qs[0] = (int)atomicAdd(ctr, 1u);
        __syncthreads();
        int u = qs[0];
        while (u < nloc + nctx) {
            int pend = 0;
            if (tid == 0) pend = (int)atomicAdd(ctr, 1u);
            if (u < nloc) { const int rg = u % (GRID_R / 4), head = (u / (GRID_R / 4)) & 7, b = u / (GRID_R / 4 * 8); attn_unit<true>(p, l, b, head, rg * 4, lds); }
            else { const int q = u - nloc, head = q & 7, b = q >> 3; attn_unit<false>(p, l, b, head, 0, lds); }
            __syncthreads();
            if (tid == 0) qs[0] = pend;
            __syncthreads();
            u = qs[0];
        }
    }
#endif
}

DEV void ln_stats(const float (&v)[2][8], float& mu, float& rstd) {
    float s = 0.f;
#pragma unroll
    for (int i = 0; i < 2; ++i)
#pragma unroll
        for (int j = 0; j < 8; ++j) s += v[i][j];
    mu = wave_sum(s) * (1.0f / 1024.0f);
    float q = 0.f;
#pragma unroll
    for (int i = 0; i < 2; ++i)
#pragma unroll
        for (int j = 0; j < 8; ++j) { const float d = v[i][j] - mu; q += d * d; }
    rstd = 1.0f / sqrtf(wave_sum(q) * (1.0f / 1024.0f) + LN_EPS);
}
DEV void ln_apply(float (&v)[2][8], float mu, float rstd, const float* g, const float* bta, int lane) {
#pragma unroll
    for (int i = 0; i < 2; ++i) { const int c = lane * 8 + i * 512; const f32x4 ga = *(const f32x4*)(g + c), gb2 = *(const f32x4*)(g + c + 4), ba = *(const f32x4*)(bta + c), bb2 = *(const f32x4*)(bta + c + 4);
#pragma unroll
        for (int j = 0; j < 8; ++j) v[i][j] = (v[i][j] - mu) * rstd * (j < 4 ? ga[j] : gb2[j - 4]) + (j < 4 ? ba[j] : bb2[j - 4]); }
}
DEV void ln_row(float (&v)[2][8], const float* g, const float* bta, int lane) {
    float s = 0.f;
#pragma unroll
    for (int i = 0; i < 2; ++i)
#pragma unroll
        for (int j = 0; j < 8; ++j) s += v[i][j];
    const float mu = wave_sum(s) * (1.0f / 1024.0f);
    float q = 0.f;
#pragma unroll
    for (int i = 0; i < 2; ++i)
#pragma unroll
        for (int j = 0; j < 8; ++j) { v[i][j] -= mu; q += v[i][j] * v[i][j]; }
    const float rstd = 1.0f / sqrtf(wave_sum(q) * (1.0f / 1024.0f) + LN_EPS);
#pragma unroll
    for (int i = 0; i < 2; ++i) { const int c = lane * 8 + i * 512; const f32x4 ga = *(const f32x4*)(g + c), gb2 = *(const f32x4*)(g + c + 4), ba = *(const f32x4*)(bta + c), bb2 = *(const f32x4*)(bta + c + 4);
#pragma unroll
        for (int j = 0; j < 8; ++j) v[i][j] = v[i][j] * rstd * (j < 4 ? ga[j] : gb2[j - 4]) + (j < 4 ? ba[j] : bb2[j - 4]); }
}

DEV void phase_ln1_router(const Params& p, int l, LAS unsigned char* lds) {
    LAS float* wrT = (LAS float*)lds;
    const int tid = opaque_tid(), lane = tid & 63, gw = blockIdx.x * 8 + (tid >> 6), nw = gridDim.x * 8;
    const int ntok = l < DEPTH_ - 1 ? NTOK : NL;
    const float* wr = p.in[17] + (size_t)l * 1024 * 16;
    __syncthreads();
    for (int i = tid; i < 16 * 1024; i += 512) { const int k = i >> 4, e = i & 15; wrT[e * 1024 + k] = wr[i]; }
    __syncthreads();
    const float* mods = (const float*)(p.ws + WS_MODS) + (size_t)l * (B_ + 1) * 6144;
    bf16_t* ub = (bf16_t*)(p.ws + WS_U); float* aff = (float*)(p.ws + WS_AFF);
    const bf16_t* xh = (const bf16_t*)(p.ws + WS_XH); bf16_t* x1h = (bf16_t*)(p.ws + WS_X1H); const bf16_t* yo = (const bf16_t*)(p.ws + WS_YO);
    const float alpha = sqrtf(sqrtf((float)(2 * DEPTH_)));
    const float* lg = p.in[15] + (size_t)l * 1024; const float* lb = p.in[16] + (size_t)l * 1024;
    constexpr int NR = 4;
    static_assert(T_ % NR == 0 && TC_ % NR == 0, "row groups stay inside one sample");
    for (int grp = gw; grp * NR < ntok; grp += nw) {
        const int row0 = grp * NR;
        u32x4 xraw[NR][2], yraw[NR][2];
#pragma unroll
        for (int r = 0; r < NR; ++r) { const int rw = row0 + r;
#pragma unroll
            for (int i = 0; i < 2; ++i) { const int c = lane * 8 + i * 512;
                yraw[r][i] = ld_stream((const u32x4*)(yo + (size_t)rw * D_ + c));
                xraw[r][i] = (u32x4){0u, 0u, 0u, 0u}; if (l != 0) xraw[r][i] = ld_stream((const u32x4*)(xh + (size_t)rw * D_ + c)); } }
        const bool isl = row0 < NL; const int bb = isl ? row0 / T_ : B_;
        const float* md = mods + (size_t)bb * 6144;
        f32x4 mg[2][2], msc[2][2], msh[2][2];
#pragma unroll
        for (int i = 0; i < 2; ++i) { const int c = lane * 8 + i * 512;
            mg[i][0] = *(const f32x4*)(md + 2048 + c); mg[i][1] = *(const f32x4*)(md + 2048 + c + 4);
            msc[i][0] = *(const f32x4*)(md + 4096 + c) + 1.0f; msc[i][1] = *(const f32x4*)(md + 4096 + c + 4) + 1.0f;
            msh[i][0] = *(const f32x4*)(md + 3072 + c); msh[i][1] = *(const f32x4*)(md + 3072 + c + 4); }
        f32x2 up[NR / 2][2][8];
#pragma unroll
        for (int r = 0; r < NR; ++r) {
            const int row = row0 + r;
            float uu[2][8];
            {
                float v[2][8];
#pragma unroll
                for (int i = 0; i < 2; ++i) { const int c = lane * 8 + i * 512; float xv[8];
                    if (l == 0) { const float* xr = isl ? p.in[0] + (size_t)row * D_ : p.in[2] + (size_t)(row - NL) * D_; const f32x4 a = *(const f32x4*)(xr + c), b2 = *(const f32x4*)(xr + c + 4);
#pragma unroll
                        for (int j = 0; j < 4; ++j) { xv[j] = a[j]; xv[4 + j] = b2[j]; } }
                    else unpack8_h(xraw[r][i], xv);
                    const u32x4 yv = yraw[r][i];
#pragma unroll
                    for (int j = 0; j < 4; ++j) { v[i][j] = alpha * xv[j] + mg[i][0][j] * ((j & 1) ? bfhi(yv[j >> 1]) : bflo(yv[j >> 1])); v[i][4 + j] = alpha * xv[4 + j] + mg[i][1][j] * ((j & 1) ? bfhi(yv[2 + (j >> 1)]) : bflo(yv[2 + (j >> 1)])); } }
                float mu, rstd; ln_stats(v, mu, rstd);
                ln_apply(v, mu, rstd, lg, lb, lane);
#pragma unroll
                for (int i = 0; i < 2; ++i) { const int c = lane * 8 + i * 512;
                    st_stream((u32x4*)(x1h + (size_t)row * D_ + c), pack8_h(v[i]));
#pragma unroll
                    for (int j = 0; j < 8; ++j) uu[i][j] = v[i][j] * (j < 4 ? msc[i][0][j] : msc[i][1][j - 4]) + (j < 4 ? msh[i][0][j] : msh[i][1][j - 4]);
#if MOE_F8
                    u32x2 o; o[0] = pack4_f8(uu[i][0], uu[i][1], uu[i][2], uu[i][3]); o[1] = pack4_f8(uu[i][4], uu[i][5], uu[i][6], uu[i][7]);
                    st_stream((u32x2*)((unsigned char*)ub + (size_t)row * D_ + c), o); }
#else
                    u32x4 o; o[0] = pack2(uu[i][0], uu[i][1]); o[1] = pack2(uu[i][2], uu[i][3]); o[2] = pack2(uu[i][4], uu[i][5]); o[3] = pack2(uu[i][6], uu[i][7]);
                    *(u32x4*)(ub + (size_t)row * D_ + c) = o; }
#endif
            }
#pragma unroll
            for (int i = 0; i < 2; ++i)
#pragma unroll
                for (int j = 0; j < 8; ++j) up[r >> 1][i][j][r & 1] = uu[i][j];
            SCHED_BAR();
        }
#ifndef HOST_EMU
        asm volatile("" ::: "memory");
#endif
        float p8a[NR][8];
#pragma unroll
        for (int j = 0; j < 8; ++j) { f32x2 pe[NR / 2][2];
#pragma unroll
            for (int hh = 0; hh < 2; ++hh) { const int e = j + 8 * hh; f32x2 acc[NR / 2];
#pragma unroll
                for (int q = 0; q < NR / 2; ++q) acc[q] = (f32x2){0.f, 0.f};
#pragma unroll
                for (int i = 0; i < 2; ++i) { const int c = lane * 8 + i * 512; const f32x4 w0 = *(const LAS f32x4*)(wrT + e * 1024 + c), w1 = *(const LAS f32x4*)(wrT + e * 1024 + c + 4);
#pragma unroll
                    for (int q = 0; q < NR / 2; ++q) {
                        acc[q] += up[q][i][0] * w0[0]; acc[q] += up[q][i][1] * w0[1]; acc[q] += up[q][i][2] * w0[2]; acc[q] += up[q][i][3] * w0[3];
                        acc[q] += up[q][i][4] * w1[0]; acc[q] += up[q][i][5] * w1[1]; acc[q] += up[q][i][6] * w1[2]; acc[q] += up[q][i][7] * w1[3]; } }
#pragma unroll
                for (int q = 0; q < NR / 2; ++q) pe[q][hh] = acc[q]; }
#pragma unroll
            for (int q = 0; q < NR / 2; ++q) { p8a[2 * q][j] = xsum32(pe[q][0][0], pe[q][1][0]); p8a[2 * q + 1][j] = xsum32(pe[q][0][1], pe[q][1][1]); } }
#pragma unroll
        for (int r = 0; r < NR; ++r) {
            const int row = row0 + r;
            float p4[4], p2[2];
#pragma unroll
            for (int j = 0; j < 4; ++j) p4[j] = xsum16(p8a[r][j], p8a[r][4 + j]);
#pragma unroll
            for (int j = 0; j < 2; ++j) p2[j] = xsum8(p4[j], p4[2 + j], lane);
            float mine = quad_sum(xsum4(p2[0], p2[1], lane));
            const float mx = wave_max(mine);
            mine = expf(mine - mx);
            const float sm = wave_sum(mine) * 0.25f;
            if (row < ntok && (lane & 3) == 0) aff[(size_t)row * 16 + (lane >> 2)] = mine / sm;
        }
    }
}

#ifdef HOST_EMU
static inline void lds_inc(unsigned* p) { (*p)++; }
#else
DEV void lds_inc(LAS unsigned* p) { __hip_atomic_fetch_add(p, 1u, __ATOMIC_RELAXED, __HIP_MEMORY_SCOPE_WORKGROUP); }
#endif
DEV void phase_topk(const Params& p, int l, LAS unsigned char* lds) {
    LAS unsigned* keys = (LAS unsigned*)lds;
    LAS unsigned* hist = keys + T_;
    LAS unsigned* misc = hist + 256;
    const int tid = opaque_tid(), lane = tid & 63, w = tid >> 6;
    const bool need_ctx = l < DEPTH_ - 1;
    const float* aff = (const float*)(p.ws + WS_AFF); int* slot = (int*)(p.ws + WS_SLOT); int* rowtab = (int*)(p.ws + WS_ROWTAB);
    const int nun = B_ * 16 * (need_ctx ? 2 : 1);
    for (int u = blockIdx.x; u < nun; u += gridDim.x) {
        const bool lat = u < B_ * 16; const int q = lat ? u : u - B_ * 16, b = q >> 4, e = q & 15;
        const int n = lat ? T_ : TC_, cap = lat ? CAP_L : CAP_C, row0 = tok_row(lat, b, 0);
        __syncthreads();
        unsigned kv[4];
#pragma unroll
        for (int j = 0; j < 4; ++j) { const int t = tid * 4 + j; kv[j] = t < n ? f_as_u(aff[(size_t)(row0 + t) * 16 + e]) : 0u; }
        unsigned prefix = 0u, remaining = (unsigned)cap;
#pragma unroll 1
        for (int pass = 0; pass < 4; ++pass) {
            const int shift = 24 - 8 * pass;
            if (tid < 256) hist[tid] = 0u;
            __syncthreads();
#pragma unroll
            for (int j = 0; j < 4; ++j) { const int t = tid * 4 + j;
                if (t < n && (pass == 0 || (kv[j] >> (shift + 8)) == prefix)) lds_inc(&hist[(kv[j] >> shift) & 255u]); }
            __syncthreads();
            if (w == 0) {
                const unsigned h0 = hist[4 * lane], h1 = hist[4 * lane + 1], h2 = hist[4 * lane + 2], h3 = hist[4 * lane + 3];
                const unsigned sl = h0 + h1 + h2 + h3;
                unsigned S = sl;
                for (int d = 1; d < 64; d <<= 1) { const unsigned o = (unsigned)shfl_idx_i((int)S, lane + d < 64 ? lane + d : lane); if (lane + d < 64) S += o; }
                const unsigned above = S - sl;
                if (above < remaining && remaining <= S) {
                    unsigned acc = above; int bin;
                    if (acc + h3 >= remaining) { bin = 3; } else { acc += h3; if (acc + h2 >= remaining) { bin = 2; } else { acc += h2; if (acc + h1 >= remaining) { bin = 1; } else { acc += h1; bin = 0; } } }
                    misc[0] = (unsigned)(4 * lane + bin); misc[1] = remaining - acc; }
            }
            __syncthreads();
            prefix = (prefix << 8) | misc[0]; remaining = misc[1];
        }
        unsigned cnt = 0u;
#pragma unroll
        for (int j = 0; j < 4; ++j) { const int t = tid * 4 + j; if (t < n) cnt += (kv[j] > prefix ? 1u : 0u) + (kv[j] == prefix ? 65536u : 0u); }
        unsigned inc = cnt;
        for (int d = 1; d < 64; d <<= 1) { const unsigned o2 = (unsigned)shfl_idx_i((int)inc, lane >= d ? lane - d : lane); if (lane >= d) inc += o2; }
        if (lane == 63) misc[8 + w] = inc;
        __syncthreads();
        unsigned base = 0u, total = 0u;
#pragma unroll
        for (int ww = 0; ww < 8; ++ww) { const unsigned tw = misc[8 + ww]; if (ww < w) base += tw; total += tw; }
        unsigned run = base + inc - cnt;
        const unsigned ngt = total & 0xFFFFu;
#pragma unroll
        for (int j = 0; j < 4; ++j) { const int t = tid * 4 + j;
            if (t < n) { const bool gt = kv[j] > prefix, eq = kv[j] == prefix; const unsigned rg = run & 0xFFFFu, re = run >> 16;
                int sl = -1;
                if (gt) sl = (int)rg; else if (eq && re < remaining) sl = (int)(ngt + re);
                slot[(size_t)(row0 + t) * 16 + e] = sl;
                if (sl >= 0) rowtab[e * MROWS + (lat ? b * CAP_L + sl : ROWS_L + b * CAP_C + sl)] = row0 + t;
                run += (gt ? 1u : 0u) + (eq ? 65536u : 0u); } }
    }
    { const int used = need_ctx ? ROWS_L + ROWS_C : ROWS_L; const int mr = need_ctx ? MROWS : MROWS_LAST;
      if (blockIdx.x == gridDim.x - 1) for (int i = tid; i < 16 * (mr - used); i += 512) { const int e = i / (mr - used), r = used + i % (mr - used); rowtab[e * MROWS + r] = 0; } }
}

DEV void phase_combine(const Params& p, int l) {
    const int tid = opaque_tid(), lane = tid & 63, gw = blockIdx.x * 8 + (tid >> 6), nw = gridDim.x * 8;
    const bool need_ctx = l < DEPTH_ - 1; const int ntok = need_ctx ? NTOK : NL;
    const float* mods = (const float*)(p.ws + WS_MODS) + (size_t)l * (B_ + 1) * 6144;
    const float* modn = mods + (size_t)(B_ + 1) * 6144;
    const bf16_t* x1h = (const bf16_t*)(p.ws + WS_X1H); bf16_t* xh = (bf16_t*)(p.ws + WS_XH); bf16_t* ub = (bf16_t*)(p.ws + WS_U);
    const float* aff = (const float*)(p.ws + WS_AFF); const int* slot = (const int*)(p.ws + WS_SLOT); const bf16_t* yexp = (const bf16_t*)(p.ws + WS_YEXP);
    const float* lg = p.in[21] + (size_t)l * 1024; const float* lb = p.in[22] + (size_t)l * 1024;
    const float alpha = sqrtf(sqrtf((float)(2 * DEPTH_)));
    static_assert(T_ % 2 == 0 && TC_ % 2 == 0 && NL % 2 == 0, "row pairs stay inside one sample");
    int slot_n[2]; float aff_n[2];
#pragma unroll
    for (int r = 0; r < 2; ++r) { const int row = 2 * gw + r; slot_n[r] = -1; aff_n[r] = 0.f;
        if (row < ntok && lane < 16) { slot_n[r] = slot[(size_t)row * 16 + lane]; aff_n[r] = aff[(size_t)row * 16 + lane]; } }
    for (int row0 = 2 * gw; row0 < ntok; row0 += 2 * nw) {
        int myslot[2]; float myaff[2]; int rbase[2]; unsigned em[2];
        float v[2][2][8], f[2][2][8];
#pragma unroll
        for (int r = 0; r < 2; ++r) { const int row = row0 + r; const bool act = row < ntok; const int rw = act ? row : row0;
            const bool isl = rw < NL; const int bidx = isl ? rw / T_ : (rw - NL) / TC_;
            rbase[r] = isl ? bidx * CAP_L : ROWS_L + bidx * CAP_C;
            myslot[r] = slot_n[r]; myaff[r] = aff_n[r];
            { const int rown = row + 2 * nw; slot_n[r] = -1; aff_n[r] = 0.f; if (rown < ntok && lane < 16) { slot_n[r] = slot[(size_t)rown * 16 + lane]; aff_n[r] = aff[(size_t)rown * 16 + lane]; } }
#pragma unroll
            for (int i = 0; i < 2; ++i) unpack8_h(ld_stream((const u32x4*)(x1h + (size_t)rw * D_ + lane * 8 + i * 512)), v[r][i]);
#pragma unroll
            for (int i = 0; i < 2; ++i)
#pragma unroll
                for (int j = 0; j < 8; ++j) f[r][i][j] = 0.f;
            unsigned m_ = 0u;
#pragma unroll
            for (int e = 0; e < 16; ++e) m_ |= (rdlane_i(myslot[r], e) >= 0 ? 1u : 0u) << e;
            em[r] = act ? m_ : 0u; }
        while (em[0] | em[1]) {
#if MOE_F8 && YEXP_F8
            u32x2 yv[2][4][2]; float ga[2][4];
#pragma unroll
            for (int r = 0; r < 2; ++r)
#pragma unroll
                for (int k = 0; k < 4; ++k) { const bool ok = em[r] != 0u; const int ee = ok ? __builtin_ctz(em[r]) : 0; em[r] &= em[r] - 1u;
                    const int sl = rdlane_i(myslot[r], ee); ga[r][k] = ok ? rdlane_f(myaff[r], ee) * (1.0f / F8_SY) : 0.f;
                    const unsigned char* yr = (const unsigned char*)yexp + ((size_t)ee * MROWS + rbase[r] + (sl > 0 ? sl : 0)) * D_;
                    yv[r][k][0] = ld_stream((const u32x2*)(yr + lane * 8)); yv[r][k][1] = ld_stream((const u32x2*)(yr + lane * 8 + 512)); }
#pragma unroll
            for (int r = 0; r < 2; ++r)
#pragma unroll
                for (int k = 0; k < 4; ++k)
#pragma unroll
                    for (int i = 0; i < 2; ++i)
#pragma unroll
                        for (int j = 0; j < 2; ++j) { const f32x2 lo = __builtin_amdgcn_cvt_pk_f32_fp8((int)yv[r][k][i][j], false), hi = __builtin_amdgcn_cvt_pk_f32_fp8((int)yv[r][k][i][j], true);
                            f[r][i][4 * j] += ga[r][k] * lo[0]; f[r][i][4 * j + 1] += ga[r][k] * lo[1]; f[r][i][4 * j + 2] += ga[r][k] * hi[0]; f[r][i][4 * j + 3] += ga[r][k] * hi[1]; }
#else
            u32x4 yv[2][4][2]; float ga[2][4];
#pragma unroll
            for (int r = 0; r < 2; ++r)
#pragma unroll
                for (int k = 0; k < 4; ++k) { const bool ok = em[r] != 0u; const int ee = ok ? __builtin_ctz(em[r]) : 0; em[r] &= em[r] - 1u;
                    const int sl = rdlane_i(myslot[r], ee); ga[r][k] = ok ? rdlane_f(myaff[r], ee) : 0.f;
                    const bf16_t* yr = yexp + ((size_t)ee * MROWS + rbase[r] + (sl > 0 ? sl : 0)) * D_;
                    yv[r][k][0] = *(const u32x4*)(yr + lane * 8); yv[r][k][1] = *(const u32x4*)(yr + lane * 8 + 512); }
#pragma unroll
            for (int r = 0; r < 2; ++r)
#pragma unroll
                for (int k = 0; k < 4; ++k)
#pragma unroll
                    for (int i = 0; i < 2; ++i)
#pragma unroll
                        for (int j = 0; j < 4; ++j) { f[r][i][2 * j] += ga[r][k] * bflo(yv[r][k][i][j]); f[r][i][2 * j + 1] += ga[r][k] * bfhi(yv[r][k][i][j]); }
#endif
        }
        {
            const bool isl0 = row0 < NL; const int bb0 = isl0 ? row0 / T_ : B_;
            const float* md = mods + (size_t)bb0 * 6144; const float* mn = modn + (size_t)bb0 * 6144;
            f32x4 mg2[2][2], nsc[2][2], nsh[2][2];
#pragma unroll
            for (int i = 0; i < 2; ++i) { const int c = lane * 8 + i * 512;
                mg2[i][0] = *(const f32x4*)(md + 5120 + c); mg2[i][1] = *(const f32x4*)(md + 5120 + c + 4);
                if (need_ctx) { nsc[i][0] = *(const f32x4*)(mn + 1024 + c) + 1.0f; nsc[i][1] = *(const f32x4*)(mn + 1024 + c + 4) + 1.0f; nsh[i][0] = *(const f32x4*)(mn + c); nsh[i][1] = *(const f32x4*)(mn + c + 4); }
                else { nsc[i][0] = nsc[i][1] = nsh[i][0] = nsh[i][1] = (f32x4){0.f, 0.f, 0.f, 0.f}; } }
#pragma unroll
            for (int r = 0; r < 2; ++r) { const int row = row0 + r;
                if (row < ntok) {
#pragma unroll
                    for (int i = 0; i < 2; ++i)
#pragma unroll
                        for (int j = 0; j < 4; ++j) { v[r][i][j] = alpha * v[r][i][j] + mg2[i][0][j] * f[r][i][j]; v[r][i][4 + j] = alpha * v[r][i][4 + j] + mg2[i][1][j] * f[r][i][4 + j]; }
                    ln_row(v[r], lg, lb, lane);
#pragma unroll
                    for (int i = 0; i < 2; ++i) { const int c = lane * 8 + i * 512;
                        if (!need_ctx) { float* xw = p.out + (size_t)row * D_; *(f32x4*)(xw + c) = (f32x4){v[r][i][0], v[r][i][1], v[r][i][2], v[r][i][3]}; *(f32x4*)(xw + c + 4) = (f32x4){v[r][i][4], v[r][i][5], v[r][i][6], v[r][i][7]}; }
                        else {
                            st_stream((u32x4*)(xh + (size_t)row * D_ + c), pack8_h(v[r][i]));
                            float uu[8];
#pragma unroll
                            for (int j = 0; j < 8; ++j) uu[j] = v[r][i][j] * (j < 4 ? nsc[i][0][j] : nsc[i][1][j - 4]) + (j < 4 ? nsh[i][0][j] : nsh[i][1][j - 4]);
                            u32x4 o; o[0] = pack2(uu[0], uu[1]); o[1] = pack2(uu[2], uu[3]); o[2] = pack2(uu[4], uu[5]); o[3] = pack2(uu[6], uu[7]);
                            *(u32x4*)(ub + (size_t)row * D_ + c) = o; } }
                }
            }
        }
    }
}

__global__ void __launch_bounds__(512, 2) fwd(Params p) {
#ifdef HOST_EMU
    unsigned char* smem = emu::tls.dynsmem;
#else
    extern __shared__ __attribute__((aligned(16))) unsigned char smem_raw[];
    LAS unsigned char* smem = (LAS unsigned char*)smem_raw;
#endif
#ifdef HOST_EMU
    XcdBarrier bar = xcd_barrier_post(nullptr, nullptr);
#else
    volatile LAS unsigned* xbw = (volatile LAS unsigned*)(smem + LDS_BYTES - 16);
    if (threadIdx.x == 0) { xbw[0] = 0u; xbw[1] = 0u; xbw[2] = 0u; xbw[3] = 0u; }
    __syncthreads();
    XcdBarrier bar = xcd_barrier_post((unsigned*)(p.ws + WS_CTL), xbw);
#endif
#define SEAM(id) if ((id) > p.ph_lo && (id) < p.ph_hi) { xcd_barrier(bar); if (REP_K == 30) xcd_barrier(bar); }
#ifndef REP_K
#define REP_K -1
#endif
#define REPEAT(k) for (int rep_ = 0; rep_ < ((REP_K == (k) || REP_K == 99) ? 2 : 1); ++rep_)
#define REPBAR() if (rep_) xcd_barrier(bar)
#ifndef PH_MASK
#define PH_MASK 0xFFFF
#endif
#define RUN(id) if ((id) >= p.ph_lo && (id) < p.ph_hi)
#define RUNK(k) if (((PH_MASK >> (k)) & 1) && (base + (k)) >= p.ph_lo && (base + (k)) < p.ph_hi)
    if ((PH_MASK >> 15) & 1) RUN(0) REPEAT(15) { REPBAR(); phase_mods(p, smem); }
    const float alpha = sqrtf(sqrtf((float)(2 * DEPTH_)));
    for (int l = 0; l < DEPTH_; ++l) {
        const int base = 1 + l * NPH;
        const bool need_ctx = l < DEPTH_ - 1;
        SEAM(base + 0); RUNK(0) REPEAT(0) { REPBAR(); phase_convert(p, l, smem); }
        SEAM(base + 1); RUNK(1) REPEAT(1) { REPBAR();
            pg8::Gemm g; g.A = (const bf16_t*)(p.ws + WS_U); g.Bt = (const bf16_t*)(p.ws + WS_BTIN); g.K = D_; g.rowtab = nullptr;
            pg8::Order S; S.init(1, NTOK / 256, NTOK / 256, PROJ_NP / 256, gridDim.x, blockIdx.x);
            EpiProj E; E.proj = (bf16_t*)(p.ws + WS_R1 + R1_PROJ); E.gates = (float*)(p.ws + WS_R1 + R1_GATES); E.bias = (const float*)(p.ws + WS_BIAS);
            pg8::gemm_phase<EpiProj, false>(smem, g, S, E);
        }
        SEAM(base + 2); RUNK(2) REPEAT(2) { REPBAR(); phase_mixer(p, l, smem); }
        SEAM(base + 4); RUNK(4) REPEAT(4) { REPBAR();
            pg8::Gemm g; g.A = (const bf16_t*)(p.ws + WS_YMIX); g.Bt = (const bf16_t*)(p.ws + WS_BTOUT); g.K = D_; g.rowtab = nullptr;
            const int mt = (need_ctx ? NTOK : NL) / 256;
            pg8::Order S; S.init(1, mt, mt, D_ / 256, gridDim.x, blockIdx.x);
            EpiDown<false> E; E.y = (bf16_t*)(p.ws + WS_YO); E.sc = 1.0f;
            pg8::gemm_phase<EpiDown<false>, false>(smem, g, S, E);
        }
        SEAM(base + 5); RUNK(5) REPEAT(5) { REPBAR(); phase_ln1_router(p, l, smem); }
        SEAM(base + 6); RUNK(6) REPEAT(6) { REPBAR(); phase_topk(p, l, smem); }
        SEAM(base + 7); RUNK(7) REPEAT(7) { REPBAR();
            pg8::Gemm g; g.A = (const bf16_t*)(p.ws + WS_U); g.Bt = (const bf16_t*)(p.ws + WS_BTGU); g.K = MOE_F8 ? D_ / 2 : D_; g.rowtab = (const int*)(p.ws + WS_ROWTAB);
            pg8::Order S; S.init(NE, (need_ctx ? MROWS : MROWS_LAST) / 256, MROWS / 256, 2 * FF / 256, gridDim.x, blockIdx.x);
            EpiSwiglu E; E.h = (bf16_t*)(p.ws + WS_R1);
            pg8::gemm_phase<EpiSwiglu, true, MOE_F8 != 0>(smem, g, S, E);
        }
        SEAM(base + 8); RUNK(8) REPEAT(8) { REPBAR();
            pg8::Gemm g; g.A = (const bf16_t*)(p.ws + WS_R1); g.Bt = (const bf16_t*)(p.ws + WS_BTDN); g.K = MOE_F8 ? FF / 2 : FF; g.rowtab = nullptr;
            pg8::Order S; S.init(NE, (need_ctx ? MROWS : MROWS_LAST) / 256, MROWS / 256, D_ / 256, gridDim.x, blockIdx.x);
            EpiDown<(MOE_F8 && YEXP_F8)> E; E.y = (bf16_t*)(p.ws + WS_YEXP);
#if MOE_F8
            E.sc = (YEXP_F8 ? F8_SY : 1.0f) / (F8_SH * F8_SW2);
#else
            E.sc = 1.0f;
#endif
            pg8::gemm_phase<EpiDown<(MOE_F8 && YEXP_F8)>, false, MOE_F8 != 0>(smem, g, S, E);
        }
        SEAM(base + 9); RUNK(9) REPEAT(9) { REPBAR(); phase_combine(p, l); }
    }
}

extern "C" void kernel_launch(void* const* d_in, const int* in_sizes, int n_in, void* d_out, int out_size, void* d_ws, size_t ws_size, hipStream_t stream) {
    static int grid = 0;
    if (grid == 0) {
        if (n_in != 23 || out_size != NL * D_ || ws_size < WS_END) { fprintf(stderr, "kernel_launch: bad shapes: n_in %d out %d ws %zu (need %zu)\n", n_in, out_size, ws_size, (size_t)WS_END); grid = -1; return; }
        int dev = 0, cus = 0;
        if (hipGetDevice(&dev) != hipSuccess || hipDeviceGetAttribute(&cus, hipDeviceAttributeMultiprocessorCount, dev) != hipSuccess) { grid = -1; return; }
        if (hipFuncSetAttribute((const void*)fwd, hipFuncAttributeMaxDynamicSharedMemorySize, LDS_BYTES) != hipSuccess) { fprintf(stderr, "kernel_launch: hipFuncSetAttribute failed\n"); grid = -1; return; }
        (void)hipGetLastError();
        grid = cus;
    }
    if (grid < 0) return;
#ifdef HOST_EMU
    g_emu_bar.store(0);
#endif
    (void)hipMemsetAsync((char*)d_ws + WS_CTL, 0, WS_CTL_BYTES, stream);
    Params p{};
    for (int i = 0; i < 23; ++i) p.in[i] = (const float*)d_in[i];
    p.out = (float*)d_out; p.ws = (unsigned char*)d_ws;
#if ONE_LAUNCH
    p.ph_lo = 0; p.ph_hi = NPHASES;
#ifdef HOST_EMU
    if (getenv("EMU_PH_HI")) p.ph_hi = atoi(getenv("EMU_PH_HI"));
#endif
    hipLaunchKernelGGL(fwd, dim3(grid), dim3(512), LDS_BYTES, stream, p);
#else
    int nph = NPHASES;
#ifdef HOST_EMU
    if (getenv("EMU_PH_HI")) nph = atoi(getenv("EMU_PH_HI"));
#endif
    for (int ph = 0; ph < nph; ++ph) { p.ph_lo = ph; p.ph_hi = ph + 1; hipLaunchKernelGGL(fwd, dim3(grid), dim3(512), LDS_BYTES, stream, p); }
#endif
}
```

```cpp
#ifdef HOST_EMU
#include "emu.h"
#else
#include <hip/hip_runtime.h>
#include <cstdio>
#include <cstdint>
#endif

#ifndef CFG_BATCH
#define CFG_BATCH 32
#define CFG_SEQ 2048
#define CFG_CTX 256
#define CFG_DEPTH 4
#endif
#ifndef ONE_LAUNCH
#define ONE_LAUNCH 1
#endif
#ifndef MOE_F8
#ifdef HOST_EMU
#define MOE_F8 0
#else
#define MOE_F8 1
#endif
#endif
#ifndef YEXP_F8
#define YEXP_F8 1
#endif

#define DEV __device__ __forceinline__
typedef unsigned short bf16_t;
typedef short bf16x8 __attribute__((ext_vector_type(8)));
typedef short bf16x4 __attribute__((ext_vector_type(4)));
typedef float f32x4 __attribute__((ext_vector_type(4)));
typedef float f32x2 __attribute__((ext_vector_type(2)));
typedef unsigned u32x4 __attribute__((ext_vector_type(4)));
typedef unsigned u32x2 __attribute__((ext_vector_type(2)));
typedef int i32x8 __attribute__((ext_vector_type(8)));

constexpr int B_ = CFG_BATCH, T_ = CFG_SEQ, TC_ = CFG_CTX, DEPTH_ = CFG_DEPTH;
constexpr int D_ = 1024, NL = B_ * T_, NC = B_ * TC_, NTOK = NL + NC;
constexpr int PROJ_W0 = 3376, PROJ_N = 3328, PROJ_NP = 3584, NG = 48;
constexpr int FF = 2048, NE = 16;
constexpr int CAP_L = 2 * T_ / NE, CAP_C = 2 * TC_ / NE;
constexpr int ROWS_L = B_ * CAP_L, ROWS_C = B_ * CAP_C;
constexpr int MROWS = ((ROWS_L + ROWS_C + 255) / 256) * 256;
constexpr int MROWS_LAST = ((ROWS_L + 255) / 256) * 256;
constexpr int NCH_C = TC_ / 64, NCH_L = T_ / 64, NCH = NCH_C + NCH_L;
constexpr int GRID_R = T_ / 64;
constexpr float LN_EPS = 1e-5f;
constexpr int C_MQ = 0, C_MK = 256, C_MV = 512, C_MO = 768, C_GQ = 1024, C_GK = 1152, C_GV = 1280, C_GR = 1536, C_NQ = 1792, C_NK = 2304, C_NV = 2816;
static_assert(T_ % 256 == 0 && TC_ % 256 == 0 && NL % 256 == 0 && NC % 256 == 0, "shape");
static_assert(GRID_R >= 8, "rows");

constexpr size_t al256(size_t x) { return (x + 255) & ~(size_t)255; }
constexpr size_t WS_CTL = 0;
constexpr size_t WS_CTL_BYTES = 16384;
constexpr size_t WS_MODS = WS_CTL + WS_CTL_BYTES;
constexpr size_t WS_ROPE = WS_MODS + al256((size_t)DEPTH_ * (B_ + 1) * 6144 * 4);
constexpr size_t WS_BIAS = WS_ROPE + al256((64 * 16 * 2 + 64 * 8 * 2) * 4);
constexpr size_t WS_BTIN = WS_BIAS + al256(PROJ_NP * 4);
constexpr size_t WS_BTOUT = WS_BTIN + al256((size_t)PROJ_NP * D_ * 2);
constexpr size_t WBYTES = MOE_F8 ? 1 : 2;
constexpr size_t WS_BTGU = WS_BTOUT + al256((size_t)D_ * D_ * 2);
constexpr size_t WS_BTDN = WS_BTGU + al256((size_t)NE * 2 * FF * D_ * WBYTES);
constexpr size_t WS_U = WS_BTDN + al256((size_t)NE * D_ * FF * WBYTES);
constexpr size_t WS_XH = WS_U + al256((size_t)NTOK * D_ * 2);
constexpr size_t WS_AFF = WS_XH + al256((size_t)NTOK * D_ * 2);
constexpr size_t WS_SLOT = WS_AFF + al256((size_t)NTOK * 16 * 4);
constexpr size_t WS_GSCAN = WS_SLOT + al256((size_t)NTOK * 16 * 4);
constexpr size_t WS_ROWTAB = WS_GSCAN + al256((size_t)B_ * 8 * NCH * 192 * 4);
constexpr size_t WS_YMIX = WS_ROWTAB + al256((size_t)NE * MROWS * 4);
constexpr size_t WS_YEXP = WS_YMIX + al256((size_t)NTOK * D_ * 2);
constexpr size_t WS_R1 = WS_YEXP + al256((size_t)NE * MROWS * D_ * 2);
constexpr size_t R1_PROJ = 0;
constexpr size_t R1_GATES = R1_PROJ + al256((size_t)NTOK * PROJ_N * 2);
constexpr size_t R1_OM = R1_GATES + al256((size_t)NTOK * NG * 4);
constexpr size_t R1_OG = R1_OM + al256((size_t)2 * NTOK * 256 * 2);
constexpr size_t R1_QK2 = R1_OG + al256((size_t)2 * NTOK * 256 * 2);
constexpr size_t R1_END = R1_QK2 + al256((size_t)NTOK * 512 * 2);
constexpr size_t R1_H_BYTES = al256((size_t)NE * MROWS * FF * 2);
constexpr size_t WS_YO = WS_R1 + (R1_END > R1_H_BYTES ? R1_END : R1_H_BYTES);
#if MOE_F8 && YEXP_F8
constexpr size_t WS_X1H = WS_YEXP + (size_t)NE * MROWS * D_;
constexpr size_t WS_END = WS_YO + al256((size_t)NTOK * D_ * 2);
#else
constexpr size_t WS_X1H = WS_YO + al256((size_t)NTOK * D_ * 2);
constexpr size_t WS_END = WS_X1H + al256((size_t)NTOK * D_ * 2);
#endif
static_assert((size_t)NE * MROWS * D_ >= (size_t)NTOK * D_ * 2, "x1 alias");

constexpr int LDS_BYTES = 144 * 1024;
constexpr int NPH = 10;
constexpr int NPHASES = 1 + DEPTH_ * NPH;

struct Params {
    const float* in[23];
    float* out;
    unsigned char* ws;
    int ph_lo, ph_hi;
};

#ifdef HOST_EMU
#define LAS
static inline unsigned f_as_u(float f) { unsigned u; memcpy(&u, &f, 4); return u; }
static inline float u_as_f(unsigned u) { float f; memcpy(&f, &u, 4); return f; }
static inline float shfl_xor_f(float v, int m) { auto t = emu::wave_all(&v, 4); float r; memcpy(&r, t[emu::lane() ^ m], 4); return r; }
static inline float shfl_up_f(float v, int d) { auto t = emu::wave_all(&v, 4); int l = emu::lane(); float r; memcpy(&r, t[l >= d ? l - d : l], 4); return r; }
static inline float shfl_idx_f(float v, int s) { auto t = emu::wave_all(&v, 4); float r; memcpy(&r, t[s & 63], 4); return r; }
static inline int shfl_idx_i(int v, int s) { auto t = emu::wave_all(&v, 4); int r; memcpy(&r, t[s & 63], 4); return r; }
static inline int rdlane_i(int v, int s) { return shfl_idx_i(v, s); }
static inline float rdlane_f(float v, int s) { return shfl_idx_f(v, s); }
static inline f32x4 mfma16(bf16x8 a, bf16x8 b, f32x4 c) {
    struct { bf16x8 a, b; } d; d.a = a; d.b = b;
    auto t = emu::wave_all(&d, 32);
    int l = emu::lane(), col = l & 15, g = l >> 4;
    for (int r = 0; r < 4; ++r) {
        int row = 4 * g + r; float s = c[r];
        for (int k = 0; k < 32; ++k) {
            unsigned short av, bv;
            memcpy(&av, t[row + 16 * (k >> 3)] + 2 * (k & 7), 2);
            memcpy(&bv, t[col + 16 * (k >> 3)] + 16 + 2 * (k & 7), 2);
            s += u_as_f((unsigned)av << 16) * u_as_f((unsigned)bv << 16);
        }
        c[r] = s;
    }
    return c;
}
static inline void glds16(const void* g, unsigned char* l) { memcpy(l + 16 * emu::lane(), g, 16); }
#define S_BARRIER() __syncthreads()
#define WAIT_V(n)
#define WAIT_L(n)
#define SCHED_BAR()
#define SETPRIO(n)
#define RFL(x) (x)
static inline float fast_exp(float x) { return expf(x); }
static inline float fast_rcp(float x) { return 1.0f / x; }
static inline float fast_exp2(float x) { return exp2f(x); }
static inline float fast_log(float x) { return logf(x); }
#else
#define LAS __attribute__((address_space(3)))
DEV unsigned f_as_u(float f) { return __float_as_uint(f); }
DEV float u_as_f(unsigned u) { return __uint_as_float(u); }
DEV float shfl_xor_f(float v, int m) { return __shfl_xor(v, m, 64); }
DEV float shfl_up_f(float v, int d) { return __shfl_up(v, d, 64); }
DEV float shfl_idx_f(float v, int s) { return __shfl(v, s, 64); }
DEV int shfl_idx_i(int v, int s) { return __shfl(v, s, 64); }
DEV int rdlane_i(int v, int s) { return __builtin_amdgcn_readlane(v, s); }
DEV float rdlane_f(float v, int s) { return __uint_as_float((unsigned)__builtin_amdgcn_readlane((int)__float_as_uint(v), s)); }
DEV f32x4 mfma16(bf16x8 a, bf16x8 b, f32x4 c) { return __builtin_amdgcn_mfma_f32_16x16x32_bf16(a, b, c, 0, 0, 0); }
DEV void glds16(const void* g, LAS unsigned char* l) { __builtin_amdgcn_global_load_lds((const unsigned*)g, (LAS unsigned*)l, 16, 0, 0); }
#define S_BARRIER() __builtin_amdgcn_s_barrier()
#define WAIT_V(n) asm volatile("s_waitcnt vmcnt(" #n ")" ::: "memory")
#define WAIT_L(n) asm volatile("s_waitcnt lgkmcnt(" #n ")" ::: "memory")
#define SCHED_BAR() __builtin_amdgcn_sched_barrier(0)
#define SETPRIO(n) __builtin_amdgcn_s_setprio(n)
#define RFL(x) __builtin_amdgcn_readfirstlane(x)
DEV float fast_exp(float x) { return __expf(x); }
DEV float fast_rcp(float x) { return __builtin_amdgcn_rcpf(x); }
DEV float fast_exp2(float x) { return __builtin_amdgcn_exp2f(x); }
DEV float fast_log(float x) { return __logf(x); }
#endif

#ifdef HOST_EMU
DEV int opaque_tid() { return (int)threadIdx.x; }
#else
DEV int opaque_tid() { int t = threadIdx.x; asm volatile("" : "+v"(t)); return t; }
#endif
#ifdef HOST_EMU
typedef const unsigned char* lds_addr_t;
static inline lds_addr_t lds_addr(const void* p) { return (lds_addr_t)p; }
template <int OFF> static inline bf16x4 tr_read4(lds_addr_t vb) {
    const unsigned char* a = vb + OFF; auto t = emu::wave_all(&a, 8); const int l = emu::lane(), G = l >> 4, i = l & 15; bf16x4 r;
    for (int q = 0; q < 4; ++q) { const unsigned char* src; memcpy(&src, t[16 * G + 4 * q + (i >> 2)], 8); short v; memcpy(&v, src + 2 * (i & 3), 2); r[q] = v; }
    return r; }
#define LGKM_WAIT0()
#define LDS_BARRIER() __syncthreads()
#else
typedef unsigned lds_addr_t;
DEV lds_addr_t lds_addr(const LAS void* p) { return (unsigned)(size_t)p; }
template <int OFF> DEV bf16x4 tr_read4(lds_addr_t vb) { bf16x4 r; asm volatile("ds_read_b64_tr_b16 %0, %1 offset:%2" : "=&v"(r) : "v"(vb), "i"(OFF) : "memory"); return r; }
#define LGKM_WAIT0() do { asm volatile("s_waitcnt lgkmcnt(0)" ::: "memory"); __builtin_amdgcn_sched_barrier(0); } while (0)
#define LDS_BARRIER() do { asm volatile("s_waitcnt lgkmcnt(0)" ::: "memory"); __builtin_amdgcn_s_barrier(); asm volatile("" ::: "memory"); } while (0)
#endif
DEV bf16_t f2bf(float f) { unsigned u = f_as_u(f); u += 0x7FFFu + ((u >> 16) & 1u); return (bf16_t)(u >> 16); }
DEV float bf2f(bf16_t b) { return u_as_f((unsigned)b << 16); }
#ifdef HOST_EMU
DEV unsigned pack2(float lo, float hi) { return (unsigned)f2bf(lo) | ((unsigned)f2bf(hi) << 16); }
#else
DEV unsigned pack2(float lo, float hi) { unsigned r; asm volatile("v_cvt_pk_bf16_f32 %0, %1, %2" : "=v"(r) : "v"(lo), "v"(hi)); return r; }
#endif
DEV float bflo(unsigned u) { return u_as_f(u << 16); }
DEV float bfhi(unsigned u) { return u_as_f(u & 0xFFFF0000u); }
DEV float siluf(float x) { return x / (1.0f + expf(-x)); }
DEV float sigmoidf_(float x) { return 1.0f / (1.0f + expf(-x)); }
DEV float logsigf(float x) { return fminf(x, 0.0f) - log1pf(expf(-fabsf(x))); }
#ifdef HOST_EMU
DEV float xrow16_max(float x) { x = fmaxf(x, shfl_xor_f(x, 16)); return fmaxf(x, shfl_xor_f(x, 32)); }
DEV float xrow16_sum(float x) { x += shfl_xor_f(x, 16); return x + shfl_xor_f(x, 32); }
#else
DEV float xrow16_max(float x) {
    auto s = __builtin_amdgcn_permlane16_swap(__float_as_uint(x), __float_as_uint(x), false, false);
    x = fmaxf(__uint_as_float(s[0]), __uint_as_float(s[1]));
    auto t = __builtin_amdgcn_permlane32_swap(__float_as_uint(x), __float_as_uint(x), false, false);
    return fmaxf(__uint_as_float(t[0]), __uint_as_float(t[1])); }
DEV float xrow16_sum(float x) {
    auto s = __builtin_amdgcn_permlane16_swap(__float_as_uint(x), __float_as_uint(x), false, false);
    x = __uint_as_float(s[0]) + __uint_as_float(s[1]);
    auto t = __builtin_amdgcn_permlane32_swap(__float_as_uint(x), __float_as_uint(x), false, false);
    return __uint_as_float(t[0]) + __uint_as_float(t[1]); }
#endif
#if MOE_F8
constexpr float F8_SW1 = 32.0f, F8_SH = 4.0f, F8_SW2 = 128.0f, F8_SY = 16.0f;
DEV float f8clamp(float x) { return fminf(fmaxf(x, -448.0f), 448.0f); }
DEV unsigned pack4_f8(float a, float b, float c, float d) {
    int p_ = __builtin_amdgcn_cvt_pk_fp8_f32(f8clamp(a), f8clamp(b), 0, false);
    p_ = __builtin_amdgcn_cvt_pk_fp8_f32(f8clamp(c), f8clamp(d), p_, true);
    return (unsigned)p_; }
typedef int i32x4 __attribute__((ext_vector_type(4)));
DEV void mfma_f8(f32x4& c, bf16x8 a0, bf16x8 a1, bf16x8 b0, bf16x8 b1, int sc) {
    i32x4 al, ah, bl, bh; __builtin_memcpy(&al, &a0, 16); __builtin_memcpy(&ah, &a1, 16); __builtin_memcpy(&bl, &b0, 16); __builtin_memcpy(&bh, &b1, 16);
    const i32x8 A = __builtin_shufflevector(al, ah, 0, 1, 2, 3, 4, 5, 6, 7), B = __builtin_shufflevector(bl, bh, 0, 1, 2, 3, 4, 5, 6, 7);
    asm volatile("v_mfma_scale_f32_16x16x128_f8f6f4 %0, %1, %2, %0, %3, %3 op_sel_hi:[0,0,0]" : "+v"(c) : "v"(A), "v"(B), "v"(sc)); }
#define MFMA_DRAIN() asm volatile("s_nop 15\n\ts_nop 15" ::: "memory")
#endif
typedef _Float16 h16x8 __attribute__((ext_vector_type(8)));
DEV u32x4 pack8_h(const float (&v)[8]) { h16x8 h; for (int j = 0; j < 8; ++j) h[j] = (_Float16)v[j]; u32x4 o; __builtin_memcpy(&o, &h, 16); return o; }
DEV void unpack8_h(u32x4 u, float (&v)[8]) { h16x8 h; __builtin_memcpy(&h, &u, 16); for (int j = 0; j < 8; ++j) v[j] = (float)h[j]; }
#ifdef HOST_EMU
DEV bool wave_any(bool b) { float v = b ? 1.f : 0.f; for (int m = 32; m >= 1; m >>= 1) v = fmaxf(v, shfl_xor_f(v, m)); return v > 0.f; }
#else
DEV bool wave_any(bool b) { return __builtin_amdgcn_ballot_w64(b) != 0ull; }
#endif
#ifdef HOST_EMU
template <class T> static inline void st_stream(T* q, T v) { *q = v; }
#else
template <class T> DEV void st_stream(T* q, T v) { __builtin_nontemporal_store(v, q); }
#endif
#ifdef HOST_EMU
template <class T> static inline T ld_stream(const T* q) { return *q; }
#else
template <class T> DEV T ld_stream(const T* q) { return __builtin_nontemporal_load(q); }
#endif
DEV float silu_fast(float x) { return x * fast_rcp(1.0f + fast_exp(-x)); }
DEV float sigmoid_fast(float x) { return fast_rcp(1.0f + fast_exp(-x)); }
DEV float logsig_fast(float x) { return fminf(x, 0.0f) - fast_log(1.0f + fast_exp(-fabsf(x))); }
#ifdef HOST_EMU
DEV float wave_sum(float v) { for (int m = 32; m >= 1; m >>= 1) v += shfl_xor_f(v, m); return v; }
DEV float wave_max(float v) { for (int m = 32; m >= 1; m >>= 1) v = fmaxf(v, shfl_xor_f(v, m)); return v; }
DEV float xsum32(float a, float b) { const float pa = shfl_xor_f(a, 32), pb = shfl_xor_f(b, 32); return (emu::lane() & 32) ? b + pb : a + pa; }
DEV float xsum16(float a, float b) { const float pa = shfl_xor_f(a, 16), pb = shfl_xor_f(b, 16); return (emu::lane() & 16) ? b + pb : a + pa; }
DEV float xsum8(float a, float b, int lane) { const float pa = shfl_xor_f(a, 8), pb = shfl_xor_f(b, 8); return (lane & 8) ? b + pb : a + pa; }
DEV float xsum4(float a, float b, int lane) { const float pa = shfl_xor_f(a, 4), pb = shfl_xor_f(b, 4); return (lane & 4) ? b + pb : a + pa; }
DEV float quad_sum(float v) { v += shfl_xor_f(v, 1); return v + shfl_xor_f(v, 2); }
#else
template <int CTRL> DEV float dpp_f(float x) { return __uint_as_float((unsigned)__builtin_amdgcn_update_dpp(0, (int)__float_as_uint(x), CTRL, 0xF, 0xF, false)); }
DEV float wave_sum(float v) {
    v += dpp_f<0x128>(v); v += dpp_f<0x124>(v); v += dpp_f<0x122>(v); v += dpp_f<0x121>(v);
    return xrow16_sum(v); }
DEV float wave_max(float v) {
    v = fmaxf(v, dpp_f<0x128>(v)); v = fmaxf(v, dpp_f<0x124>(v)); v = fmaxf(v, dpp_f<0x122>(v)); v = fmaxf(v, dpp_f<0x121>(v));
    return xrow16_max(v); }
DEV float xsum32(float a, float b) { auto s_ = __builtin_amdgcn_permlane32_swap(__float_as_uint(a), __float_as_uint(b), false, false); return __uint_as_float(s_[0]) + __uint_as_float(s_[1]); }
DEV float xsum16(float a, float b) { auto s_ = __builtin_amdgcn_permlane16_swap(__float_as_uint(a), __float_as_uint(b), false, false); return __uint_as_float(s_[0]) + __uint_as_float(s_[1]); }
DEV float xsum8(float a, float b, int lane) { const bool hi = (lane & 8) != 0; return (hi ? b : a) + dpp_f<0x128>(hi ? a : b); }
DEV float xsum4(float a, float b, int lane) { const bool hi = (lane & 4) != 0; return (hi ? b : a) + __shfl_xor(hi ? a : b, 4, 64); }
DEV float quad_sum(float v) { v += dpp_f<0xB1>(v); return v + dpp_f<0x4E>(v); }
#endif

#ifdef HOST_EMU
static std::atomic<unsigned> g_emu_bar{0};
struct XcdBarrier { unsigned n; };
static inline XcdBarrier xcd_barrier_post(unsigned*, unsigned*) { XcdBarrier b; b.n = 0; return b; }
static inline void xcd_barrier(XcdBarrier& b) {
    __syncthreads();
    if (threadIdx.x == 0) { b.n++; g_emu_bar.fetch_add(1); while (g_emu_bar.load() < b.n * gridDim.x) std::this_thread::yield(); }
    __syncthreads();
}
#else
#define XB_TMO      128
#define XB_XCNT(j)  (256  + 64 * (j))
#define XB_XSUB(j)  (1280 + 64 * (j))
#define XB_XGEN(j)  (2304 + 64 * (j))
#define XB_TOP      3328
#define XB_TOPGEN   3392
#define XCD_BAR_WORDS 3456
#define XB_QUEUE     3584
#define XB_SPIN_CAP (1u << 22)
DEV unsigned xb_ld(unsigned* p)              { return __hip_atomic_load(p, __ATOMIC_RELAXED, __HIP_MEMORY_SCOPE_AGENT); }
DEV unsigned xb_add(unsigned* p, unsigned v) { return __hip_atomic_fetch_add(p, v, __ATOMIC_RELAXED, __HIP_MEMORY_SCOPE_AGENT); }
DEV unsigned xb_xcc_id() { return (unsigned)__builtin_amdgcn_s_getreg((3 << 11) | 20) & 0xFu; }
#define XB_SPIN(cond, bar) do { unsigned _sp = 0; while (cond) { __builtin_amdgcn_s_sleep(1); \
    if ((++_sp & 255u) == 0u) { if (xb_ld(&(bar)[XB_TMO])) break; if (_sp > XB_SPIN_CAP) { atomicAdd(&(bar)[XB_TMO], 1u); break; } } } } while (0)
struct XcdBarrier { unsigned* bar; unsigned x; volatile LAS unsigned* st; };
DEV XcdBarrier xcd_barrier_post(unsigned* bar, volatile LAS unsigned* st) {
    XcdBarrier b; b.bar = bar; b.x = xb_xcc_id(); b.st = st;
    if (threadIdx.x == 0) (void)xb_add(&bar[XB_XCNT(b.x)], 1u);
    return b;
}
DEV void xcd_barrier_complete(unsigned* bar, unsigned x, unsigned& nloc, unsigned& nx) {
    const unsigned G = gridDim.x * gridDim.y * gridDim.z;
    unsigned sum, cnt, mine, sp = 0u;
    for (;;) {
        sum = 0u; cnt = 0u; mine = 0u;
#pragma unroll
        for (unsigned j = 0; j < 16; ++j) { const unsigned c = xb_ld(&bar[XB_XCNT(j)]); sum += c; cnt += (c > 0u) ? 1u : 0u; mine = (j == x) ? c : mine; }
        if (sum == G) break;
        __builtin_amdgcn_s_sleep(1);
        if ((++sp & 255u) == 0u) { if (xb_ld(&bar[XB_TMO])) break; if (sp > XB_SPIN_CAP) { atomicAdd(&bar[XB_TMO], 1u); break; } }
    }
    nloc = mine > 0u ? mine : 1u; nx = cnt > 0u ? cnt : 1u;
}
DEV void xcd_barrier(const XcdBarrier& b) {
    asm volatile("s_waitcnt vmcnt(0)" ::: "memory");
    __syncthreads();
    if (threadIdx.x == 0) {
        unsigned* bar = b.bar;
        __builtin_amdgcn_s_waitcnt(0);
        unsigned nloc = b.st[0], nx = b.st[1];
        if (nloc == 0u) { xcd_barrier_complete(bar, b.x, nloc, nx); b.st[0] = nloc; b.st[1] = nx; }
        const unsigned old = xb_add(&bar[XB_XSUB(b.x)], 1u);
        const unsigned gen = old / nloc;
        if (old + 1u == (gen + 1u) * nloc) {
            __builtin_amdgcn_fence(__ATOMIC_RELEASE, "agent");
            asm volatile("s_waitcnt vmcnt(0)" ::: "memory");
            const unsigned og = xb_add(&bar[XB_TOP], 1u);
            const unsigned tg = og / nx;
            if (og + 1u == (tg + 1u) * nx) xb_add(&bar[XB_TOPGEN], 1u);
            else XB_SPIN(xb_ld(&bar[XB_TOPGEN]) == tg, bar);
            __builtin_amdgcn_fence(__ATOMIC_ACQUIRE, "agent");
            xb_add(&bar[XB_XGEN(b.x)], 1u);
            asm volatile("s_waitcnt vmcnt(0)" ::: "memory");
        } else {
            XB_SPIN(xb_ld(&bar[XB_XGEN(b.x)]) == gen, bar);
            __builtin_amdgcn_fence(__ATOMIC_ACQUIRE, "agent");
            asm volatile("s_waitcnt vmcnt(0)" ::: "memory");
        }
    }
    __syncthreads();
}
#endif

namespace pg8 {
constexpr int BM = 256, BK = 64, HALF = 128, HTB = HALF * BK * 2, STAGE_BYTES = 8 * HTB, NXCD = 8, WGM = 8;
DEV int lds_byte(int r, int c) { const int st = (r >> 4) * 2 + (c >> 5), rr = r & 15, cc = c & 31, ob = rr * 64 + cc * 2; return st * 1024 + (ob ^ (((ob >> 9) & 1) << 5)); }
DEV void stage_rc(int b, int& R, int& C) { const int st = b / 1024, sb = b % 1024, swz = sb ^ (((sb >> 9) & 1) << 5); R = (st >> 1) * 16 + swz / 64; C = (st & 1) * 32 + (swz % 64) / 2; }
DEV int perm32(int rho) { const int n = rho >> 4, i = rho & 15; return 8 * (i >> 2) + 4 * n + (i & 3); }

struct Unit { int pm, pn, pb; };
struct Gemm { const bf16_t* A; const bf16_t* Bt; int K; const int* rowtab; };

struct Order {
    int nM, nN, nwg, G, c, mt, mts;
    DEV void init(int ngrp, int mt_, int mts_, int nN_, int G_, int c_) { mt = mt_; mts = mts_; nM = ngrp * mt_; nN = nN_; nwg = nM * nN; G = G_; c = c_; }
    DEV bool next(int i, Unit& u) const {
        const long L = (long)i * G + c; if (L >= nwg) return false;
        int wgid = (int)L; { const int q = nwg / NXCD, r = nwg % NXCD, xcd = wgid % NXCD, off = wgid / NXCD; wgid = (xcd < r ? xcd * (q + 1) : r * (q + 1) + (xcd - r) * q) + off; }
        const int nig = WGM * nN, gid = wgid / nig, fm = gid * WGM, gsz = (nM - fm) < WGM ? (nM - fm) : WGM;
        const int pmv = fm + ((wgid % nig) % gsz); u.pn = (wgid % nig) / gsz;
        const int e = pmv / mt, pl = pmv - e * mt; u.pm = e * mts + pl; u.pb = e * nN + u.pn; return true;
    }
};

template <class Epi, bool GATHER, bool F8 = false>
DEV void gemm_phase(LAS unsigned char* lds, const Gemm g, const Order& S, const Epi& E) {
    const int tid = opaque_tid(), wid = RFL(tid >> 6), lane = tid & 63, wr = wid >> 2, wc = wid & 3, fr = lane & 15, fq = lane >> 4;
    const int K = g.K, nt = K / BK;
    unsigned voffA[2], voffB[2];
#pragma unroll
    for (int i = 0; i < 2; ++i) { int R, C; stage_rc(tid * 16 + i * 8192, R, C); const int Rb = Epi::PERM ? ((R & ~31) + perm32(R & 31)) : R;
        voffA[i] = (unsigned)(R * K + C) * 2u; voffB[i] = (unsigned)(Rb * K + C) * 2u; }
    const size_t kstep = (size_t)(BK * 2);
    const size_t hstep = (size_t)HALF * K * 2;
    const size_t tstep = 2 * hstep;
    const unsigned ldsw = (unsigned)wid * 1024u;
    const int aoff = lds_byte(wr * 64 + fr, fq * 8), boff = lds_byte(wc * 32 + fr, fq * 8);
#define PG8_SA(b, h) (((b) * 2 + (h)) * HTB)
#define PG8_SB(b, h) ((4 + (b) * 2 + (h)) * HTB)
#define PG8_STAGE(bufoff, gbase, voff) do { _Pragma("unroll") for (int _i = 0; _i < 2; ++_i) \
        glds16((const char*)(gbase) + (voff)[_i], lds + (bufoff) + ldsw + _i * 8192); } while (0)
#define PG8_STAGE_A(bufoff, gbase, h, nx) do { _Pragma("unroll") for (int _i = 0; _i < 2; ++_i) { \
        if constexpr (GATHER) glds16((const char*)(gbase) + ((nx) ? na[h][_i] : ca[h][_i]), lds + (bufoff) + ldsw + _i * 8192); \
        else glds16((const char*)(gbase) + (size_t)(h) * hstep + voffA[_i], lds + (bufoff) + ldsw + _i * 8192); } } while (0)
#define PG8_LDA(dst, b, h) do { _Pragma("unroll") for (int m = 0; m < 4; ++m) _Pragma("unroll") for (int k = 0; k < 2; ++k) dst[m][k] = *(const LAS bf16x8*)(lds + PG8_SA(b, h) + aoff + m * 2048 + k * 1024); } while (0)
#define PG8_LDB(dst, b, h) do { _Pragma("unroll") for (int n = 0; n < 2; ++n) _Pragma("unroll") for (int k = 0; k < 2; ++k) dst[n][k] = *(const LAS bf16x8*)(lds + PG8_SB(b, h) + boff + n * 2048 + k * 1024); } while (0)
#if MOE_F8
#define PG8_MMA(ai, bj, At, Bt) do { SETPRIO(1); _Pragma("unroll") for (int m = 0; m < 4; ++m) _Pragma("unroll") for (int n = 0; n < 2; ++n) { \
        if constexpr (F8) mfma_f8(acc[ai][bj][m][n], Bt[n][0], Bt[n][1], At[m][0], At[m][1], f8sc); \
        else { _Pragma("unroll") for (int k = 0; k < 2; ++k) acc[ai][bj][m][n] = mfma16(Bt[n][k], At[m][k], acc[ai][bj][m][n]); } } SETPRIO(0); } while (0)
#else
#define PG8_MMA(ai, bj, At, Bt) do { SETPRIO(1); _Pragma("unroll") for (int m = 0; m < 4; ++m) _Pragma("unroll") for (int n = 0; n < 2; ++n) _Pragma("unroll") for (int k = 0; k < 2; ++k) \
        acc[ai][bj][m][n] = mfma16(Bt[n][k], At[m][k], acc[ai][bj][m][n]); SETPRIO(0); } while (0)
#endif
    Unit cur, nxt; int ui = 0;
    if (!S.next(0, cur)) return;
#if MOE_F8
    int f8sc = 0x7F7F7F7F; asm volatile("" : "+v"(f8sc));
#endif
    f32x4 acc[2][2][4][2];
#pragma unroll
    for (int a = 0; a < 2; ++a)
#pragma unroll
        for (int b = 0; b < 2; ++b)
#pragma unroll
            for (int m = 0; m < 4; ++m)
#pragma unroll
                for (int n = 0; n < 2; ++n) acc[a][b][m][n] = (f32x4){0.f, 0.f, 0.f, 0.f};
    bf16x8 At[4][2], B0[2][2], B1[2][2];
    unsigned ca[2][2], na[2][2];
    const char* cA; const char* nA;
    const char* cB = (const char*)g.Bt + (size_t)cur.pb * tstep;
#define PG8_SETA(u, base, off) do { if constexpr (GATHER) { base = (const char*)g.A; \
            _Pragma("unroll") for (int _h = 0; _h < 2; ++_h) _Pragma("unroll") for (int _i = 0; _i < 2; ++_i) { int _R, _C; stage_rc(tid * 16 + _i * 8192, _R, _C); \
                off[_h][_i] = (unsigned)g.rowtab[(u).pm * 256 + _h * 128 + _R] * (unsigned)(K * 2) + (unsigned)_C * 2u; } } \
        else { base = (const char*)g.A + (size_t)(u).pm * tstep; } } while (0)
    PG8_SETA(cur, cA, ca);
    nA = cA;
    if constexpr (GATHER) {
#pragma unroll
        for (int _h = 0; _h < 2; ++_h)
#pragma unroll
            for (int _i = 0; _i < 2; ++_i) na[_h][_i] = ca[_h][_i]; }
    PG8_STAGE(PG8_SB(0, 0), cB, voffB); PG8_STAGE_A(PG8_SA(0, 0), cA, 0, false); PG8_STAGE(PG8_SB(0, 1), cB + hstep, voffB); PG8_STAGE_A(PG8_SA(0, 1), cA, 1, false);
    if (wr == 1) S_BARRIER();
    WAIT_V(4); S_BARRIER();
    PG8_STAGE(PG8_SB(1, 0), cB + kstep, voffB); PG8_STAGE_A(PG8_SA(1, 0), cA + kstep, 0, false); PG8_STAGE(PG8_SB(1, 1), cB + hstep + kstep, voffB);
    WAIT_V(6); S_BARRIER();
    for (;;) {
        const bool has_next = S.next(ui + 1, nxt);
        const char* nB = cB;
        if (has_next) { PG8_SETA(nxt, nA, na); nB = (const char*)g.Bt + (size_t)nxt.pb * tstep; }
        else { nA = cA;
            if constexpr (GATHER) {
#pragma unroll
                for (int _h = 0; _h < 2; ++_h)
#pragma unroll
                    for (int _i = 0; _i < 2; ++_i) na[_h][_i] = ca[_h][_i]; } }
        for (int t = 0; t < nt; t += 2) {
            const bool last = (t == nt - 2);
            const char* a1 = cA + (size_t)(t + 1) * kstep;
            const char* a2 = last ? nA : cA + (size_t)(t + 2) * kstep; const char* b2 = last ? nB : cB + (size_t)(t + 2) * kstep;
            const char* a3 = a2 + kstep; const char* b3 = b2 + kstep;
            PG8_LDB(B0, 0, 0); SCHED_BAR(); PG8_LDA(At, 0, 0); PG8_STAGE_A(PG8_SA(1, 1), a1, 1, false);
            WAIT_L(8); S_BARRIER(); WAIT_L(0); PG8_MMA(0, 0, At, B0); S_BARRIER(); SCHED_BAR();
            PG8_LDB(B1, 0, 1); PG8_STAGE(PG8_SB(0, 0), b2, voffB);
            S_BARRIER(); WAIT_L(0); PG8_MMA(0, 1, At, B1); S_BARRIER();
            PG8_LDA(At, 0, 1); PG8_STAGE_A(PG8_SA(0, 0), a2, 0, last);
            S_BARRIER(); WAIT_L(0); PG8_MMA(1, 0, At, B0); S_BARRIER(); SCHED_BAR();
            PG8_STAGE(PG8_SB(0, 1), b2 + hstep, voffB);
            WAIT_V(6); S_BARRIER(); PG8_MMA(1, 1, At, B1); S_BARRIER();
            PG8_LDB(B0, 1, 0); SCHED_BAR(); PG8_LDA(At, 1, 0); PG8_STAGE_A(PG8_SA(0, 1), a2, 1, last);
            WAIT_L(8); S_BARRIER(); WAIT_L(0); PG8_MMA(0, 0, At, B0); S_BARRIER(); SCHED_BAR();
            PG8_LDB(B1, 1, 1); PG8_STAGE(PG8_SB(1, 0), b3, voffB);
            S_BARRIER(); WAIT_L(0); PG8_MMA(0, 1, At, B1); S_BARRIER();
            PG8_LDA(At, 1, 1); PG8_STAGE_A(PG8_SA(1, 0), a3, 0, last);
            S_BARRIER(); WAIT_L(0); PG8_MMA(1, 0, At, B0); S_BARRIER(); SCHED_BAR();
            PG8_STAGE(PG8_SB(1, 1), b3 + hstep, voffB);
            WAIT_V(6); S_BARRIER(); PG8_MMA(1, 1, At, B1); S_BARRIER();
        }
#if MOE_F8
        if constexpr (F8) MFMA_DRAIN();
#endif
        E(acc, cur, wr, wc, fr, fq);
        if (!has_next) break;
#pragma unroll
        for (int a = 0; a < 2; ++a)
#pragma unroll
            for (int b = 0; b < 2; ++b)
#pragma unroll
                for (int m = 0; m < 4; ++m)
#pragma unroll
                    for (int n = 0; n < 2; ++n) acc[a][b][m][n] = (f32x4){0.f, 0.f, 0.f, 0.f};
        cur = nxt; cA = nA; cB = nB; ++ui;
        if constexpr (GATHER) {
#pragma unroll
            for (int _h = 0; _h < 2; ++_h)
#pragma unroll
                for (int _i = 0; _i < 2; ++_i) ca[_h][_i] = na[_h][_i]; }
    }
    WAIT_V(0);
    if (wr == 0) S_BARRIER();
    S_BARRIER();
#undef PG8_SA
#undef PG8_SB
#undef PG8_STAGE
#undef PG8_STAGE_A
#undef PG8_LDA
#undef PG8_LDB
#undef PG8_MMA
#undef PG8_SETA
}
}
using pg8::Unit;

struct EpiProj {
    static constexpr bool PERM = true;
    bf16_t* proj; float* gates; const float* bias;
    DEV void operator()(const f32x4 (&acc)[2][2][4][2], const Unit& u, int wr, int wc, int fr, int fq) const {
        const int row0 = u.pm * 256 + wr * 64 + fr; const int colt = u.pn * 256, cl = wc * 32 + 8 * fq;
        if (u.pn < PROJ_N / 256) {
#pragma unroll
            for (int bj = 0; bj < 2; ++bj) { const f32x4 b0 = *(const f32x4*)(bias + colt + cl + bj * 128), b1 = *(const f32x4*)(bias + colt + cl + bj * 128 + 4);
#pragma unroll
                for (int ai = 0; ai < 2; ++ai)
#pragma unroll
                    for (int m = 0; m < 4; ++m) { bf16_t* rowp = proj + (size_t)(row0 + ai * 128 + m * 16) * PROJ_N + colt + cl + bj * 128;
                        const f32x4 v0 = acc[ai][bj][m][0] + b0, v1 = acc[ai][bj][m][1] + b1;
                        u32x4 o; o[0] = pack2(v0[0], v0[1]); o[1] = pack2(v0[2], v0[3]); o[2] = pack2(v1[0], v1[1]); o[3] = pack2(v1[2], v1[3]);
                        *(u32x4*)rowp = o; } }
        } else if (cl < NG) {
            const f32x4 b0 = *(const f32x4*)(bias + colt + cl), b1 = *(const f32x4*)(bias + colt + cl + 4);
#pragma unroll
            for (int ai = 0; ai < 2; ++ai)
#pragma unroll
                for (int m = 0; m < 4; ++m) { float* rowp = gates + (size_t)(row0 + ai * 128 + m * 16) * NG + cl;
                    *(f32x4*)(rowp) = acc[ai][0][m][0] + b0; *(f32x4*)(rowp + 4) = acc[ai][0][m][1] + b1; }
        }
    }
};
struct EpiSwiglu {
    static constexpr bool PERM = true;
    bf16_t* h;
    DEV void operator()(const f32x4 (&acc)[2][2][4][2], const Unit& u, int wr, int wc, int fr, int fq) const {
        const int row0 = u.pm * 256 + wr * 64 + fr; const int col0 = u.pn * 128 + wc * 32 + 8 * fq;
#if MOE_F8
        unsigned char* h8 = (unsigned char*)h;
        constexpr float isw = 1.0f / F8_SW1, kd = F8_SW1 * F8_SW1 / F8_SH;
#pragma unroll
        for (int ai = 0; ai < 2; ++ai)
#pragma unroll
            for (int m = 0; m < 4; ++m) { unsigned char* rowp = h8 + (size_t)(row0 + ai * 128 + m * 16) * FF + col0;
                float v[8];
#pragma unroll
                for (int n = 0; n < 2; ++n)
#pragma unroll
                    for (int j = 0; j < 4; ++j) {
                        const float e = fast_exp2(acc[ai][0][m][n][j] * (-isw * 1.44269504f)); v[n * 4 + j] = acc[ai][0][m][n][j] * acc[ai][1][m][n][j] * fast_rcp(e * kd + kd); }
                u32x2 o; o[0] = pack4_f8(v[0], v[1], v[2], v[3]); o[1] = pack4_f8(v[4], v[5], v[6], v[7]);
                *(u32x2*)rowp = o; }
        return;
#endif
#pragma unroll
        for (int ai = 0; ai < 2; ++ai)
#pragma unroll
            for (int m = 0; m < 4; ++m) { bf16_t* rowp = h + (size_t)(row0 + ai * 128 + m * 16) * FF + col0;
                float v[8];
#pragma unroll
                for (int n = 0; n < 2; ++n)
#pragma unroll
                    for (int j = 0; j < 4; ++j) { const float gt = acc[ai][0][m][n][j], up = acc[ai][1][m][n][j]; v[n * 4 + j] = gt * fast_rcp(1.0f + fast_exp(-gt)) * up; }
                u32x4 o; o[0] = pack2(v[0], v[1]); o[1] = pack2(v[2], v[3]); o[2] = pack2(v[4], v[5]); o[3] = pack2(v[6], v[7]);
                *(u32x4*)rowp = o; }
    }
};
template <bool F8OUT>
struct EpiDown {
    static constexpr bool PERM = true;
    bf16_t* y; float sc;
    DEV void operator()(const f32x4 (&acc)[2][2][4][2], const Unit& u, int wr, int wc, int fr, int fq) const {
        const int row0 = u.pm * 256 + wr * 64 + fr; const int col0 = u.pn * 256 + wc * 32 + 8 * fq;
#pragma unroll
        for (int ai = 0; ai < 2; ++ai)
#pragma unroll
            for (int m = 0; m < 4; ++m) {
#pragma unroll
                for (int bj = 0; bj < 2; ++bj) {
                    const f32x4 v0 = acc[ai][bj][m][0] * sc, v1 = acc[ai][bj][m][1] * sc;
#if MOE_F8
                    if constexpr (F8OUT) { unsigned char* rowp = (unsigned char*)y + (size_t)(row0 + ai * 128 + m * 16) * D_ + col0;
                        u32x2 o; o[0] = pack4_f8(v0[0], v0[1], v0[2], v0[3]); o[1] = pack4_f8(v1[0], v1[1], v1[2], v1[3]);
                        *(u32x2*)(rowp + bj * 128) = o; }
                    else
#endif
                    { bf16_t* rowp = y + (size_t)(row0 + ai * 128 + m * 16) * D_ + col0;
                        u32x4 o; o[0] = pack2(v0[0], v0[1]); o[1] = pack2(v0[2], v0[3]); o[2] = pack2(v1[0], v1[1]); o[3] = pack2(v1[2], v1[3]);
                        *(u32x4*)(rowp + bj * 128) = o; } } }
    }
};

DEV void phase_mods(const Params& p, LAS unsigned char* lds) {
    LAS float* sc = (LAS float*)lds;
    const int tid = opaque_tid(), col = tid & 63, ks = tid >> 6;
    float* mods = (float*)(p.ws + WS_MODS);
    constexpr int NB = B_ + 1;
    for (int u = blockIdx.x; u < DEPTH_ * 96; u += gridDim.x) {
        const int l = u / 96, cb = (u % 96) * 64;
        __syncthreads();
        for (int i = tid; i < NB * 1024; i += 512) { const int bb = i >> 10, k = i & 1023; const float cv = bb < B_ ? p.in[1][(size_t)bb * 1024 + k] : p.in[3][k]; sc[i] = siluf(cv); }
        __syncthreads();
        float acc[NB];
#pragma unroll
        for (int bb = 0; bb < NB; ++bb) acc[bb] = 0.f;
        const float* w = p.in[4] + (size_t)l * 1024 * 6144 + cb + col;
        for (int k = ks * 128; k < ks * 128 + 128; ++k) { const float wv = w[(size_t)k * 6144];
#pragma unroll
            for (int bb = 0; bb < NB; ++bb) acc[bb] += sc[bb * 1024 + k] * wv; }
        __syncthreads();
#pragma unroll
        for (int bb = 0; bb < NB; ++bb) sc[(ks * NB + bb) * 64 + col] = acc[bb];
        __syncthreads();
        for (int i = tid; i < NB * 64; i += 512) { const int bb = i >> 6, c2 = i & 63; float s = p.in[5][(size_t)l * 6144 + cb + c2];
            for (int q = 0; q < 8; ++q) s += sc[(q * NB + bb) * 64 + c2];
            mods[((size_t)l * NB + bb) * 6144 + cb + c2] = s; }
    }
    if (blockIdx.x == gridDim.x - 1) {
        float* rope = (float*)(p.ws + WS_ROPE);
        for (int i = tid; i < 64 * 16; i += 512) { const int pos = i >> 4, f = i & 15; const float inv = powf(10000.0f, -(float)f / 16.0f); const float a = (float)pos * inv; rope[i * 2] = cosf(a); rope[i * 2 + 1] = sinf(a); }
        for (int i = tid; i < 64 * 8; i += 512) { const int pos = i >> 3, f = i & 7; const float inv = powf(10000.0f, -(float)f / 8.0f); const float a = (float)pos * inv; rope[2048 + i * 2] = cosf(a); rope[2048 + i * 2 + 1] = sinf(a); }
    }
}

DEV int win_srccol(int n) {
    if (n < 1024) return n; if (n < 1792) return n + 16; if (n < 3328) return n + 48;
    if (n < 3344) return 1024 + (n - 3328); if (n < 3376) return 1808 + (n - 3344); return -1;
}
template <bool WIN>
DEV void conv_tile(const float* src, int ldn, int srcc0, bf16_t* dst, int ldk, int n0, int k0, LAS float* tile) {
    const int tid = opaque_tid(), nn = tid & 63, kk = tid >> 6;
    int sc_ = WIN ? win_srccol(n0 + nn) : srcc0 + nn;
#pragma unroll
    for (int i = 0; i < 8; ++i) { const int k = kk + 8 * i; tile[k * 65 + nn] = sc_ >= 0 ? src[(size_t)(k0 + k) * ldn + sc_] : 0.f; }
    __syncthreads();
    { const int n = tid >> 3, k8 = (tid & 7) * 8; float v[8];
#pragma unroll
      for (int j = 0; j < 8; ++j) v[j] = tile[(k8 + j) * 65 + n];
      u32x4 o; o[0] = pack2(v[0], v[1]); o[1] = pack2(v[2], v[3]); o[2] = pack2(v[4], v[5]); o[3] = pack2(v[6], v[7]);
      *(u32x4*)(dst + (size_t)(n0 + n) * ldk + k0 + k8) = o; }
    __syncthreads();
}
#if MOE_F8
constexpr float F8_SW1_ = F8_SW1, F8_SW2_ = F8_SW2;
#else
constexpr float F8_SW1_ = 0.f, F8_SW2_ = 0.f;
#endif
struct ConvTile { const float* s0; const float* s1; int ld; bf16_t* dst; int ldk; int n0, k0; int kind; };
#ifdef HOST_EMU
template <class T> static inline T* rfl_ptr(T* q) { return q; }
#else
template <class T> DEV T* rfl_ptr(T* q) { const unsigned long long v = (unsigned long long)q; const unsigned lo = (unsigned)RFL((int)(unsigned)v), hi = (unsigned)RFL((int)(unsigned)(v >> 32)); return (T*)(((unsigned long long)hi << 32) | lo); }
#endif
DEV ConvTile conv_desc(const Params& p, int l, int t_) {
    const int t = RFL(t_);
    ConvTile c;
    bf16_t* btin = (bf16_t*)(p.ws + WS_BTIN); bf16_t* btout = (bf16_t*)(p.ws + WS_BTOUT); bf16_t* btgu = (bf16_t*)(p.ws + WS_BTGU); bf16_t* btdn = (bf16_t*)(p.ws + WS_BTDN);
    const float* w_in = p.in[6] + (size_t)l * D_ * PROJ_W0; const float* w_out = p.in[14] + (size_t)l * D_ * D_;
    const float* w_gate = p.in[18] + (size_t)l * NE * D_ * FF; const float* w_up = p.in[19] + (size_t)l * NE * D_ * FF; const float* w_down = p.in[20] + (size_t)l * NE * FF * D_;
    constexpr int T_IN = 13 * 16, T_OUT = 4 * 16, T_GU = NE * 16 * 16;
    if (t < T_IN) { const int nb = t / 16, kt = t % 16; const int sc = win_srccol(nb * 256);
        c.kind = 0; c.s0 = w_in + sc; c.s1 = w_in + sc + 128; c.ld = PROJ_W0; c.dst = btin; c.ldk = D_; c.n0 = nb * 256; c.k0 = kt * 64; }
    else if (t < T_IN + T_OUT) { const int q = t - T_IN, nb = q / 16, kt = q % 16;
        c.kind = 0; c.s0 = w_out + nb * 256; c.s1 = c.s0 + 128; c.ld = D_; c.dst = btout; c.ldk = D_; c.n0 = nb * 256; c.k0 = kt * 64; }
    else if (t < T_IN + T_OUT + T_GU) { const int q = t - T_IN - T_OUT, e = q / 256, r = q % 256, nb = r / 16, kt = r % 16;
        c.kind = MOE_F8 ? 1 : 0; c.s0 = w_gate + (size_t)e * D_ * FF + nb * 128; c.s1 = w_up + (size_t)e * D_ * FF + nb * 128; c.ld = FF; c.dst = btgu + (size_t)e * 2 * FF * D_ / (MOE_F8 ? 2 : 1); c.ldk = D_; c.n0 = nb * 256; c.k0 = kt * 64; }
    else { const int q = t - T_IN - T_OUT - T_GU, e = q / 128, r = q % 128, nb = r / 32, kt = r % 32;
        c.kind = MOE_F8 ? 2 : 0; c.s0 = w_down + (size_t)e * FF * D_ + nb * 256; c.s1 = c.s0 + 128; c.ld = D_; c.dst = btdn + (size_t)e * D_ * FF / (MOE_F8 ? 2 : 1); c.ldk = FF; c.n0 = nb * 256; c.k0 = kt * 64; }
    c.s0 = rfl_ptr(c.s0); c.s1 = rfl_ptr(c.s1); c.dst = rfl_ptr(c.dst); c.ld = RFL(c.ld); c.ldk = RFL(c.ldk); c.n0 = RFL(c.n0); c.k0 = RFL(c.k0); c.kind = RFL(c.kind);
    return c;
}
DEV void conv_issue(const ConvTile& c, f32x4 (&r)[8], int tid) {
    const int nn4 = (tid & 63) * 4; const float* src = (nn4 < 128 ? c.s0 + nn4 : c.s1 + (nn4 - 128)) + (size_t)(c.k0 + (tid >> 6)) * c.ld;
#pragma unroll
    for (int i = 0; i < 8; ++i) r[i] = ld_stream((const f32x4*)(src + (size_t)(8 * i) * c.ld));
}
DEV void conv_finish(const ConvTile& c, const f32x4 (&r)[8], LAS float* tile, int tid) {
    const int nn4 = (tid & 63) * 4, kk = tid >> 6;
#pragma unroll
    for (int i = 0; i < 8; ++i) { LAS float* d = tile + (kk + 8 * i) * 257 + nn4; d[0] = r[i][0]; d[1] = r[i][1]; d[2] = r[i][2]; d[3] = r[i][3]; }
    __syncthreads();
#if MOE_F8
    if (c.kind != 0) { const int n = tid >> 1, kh = (tid & 1) * 32; unsigned char* drow = (unsigned char*)c.dst + (size_t)(c.n0 + n) * c.ldk + c.k0 + kh;
#pragma unroll
      for (int q = 0; q < 2; ++q) { float v[16];
          if (c.kind == 1) {
#pragma unroll
              for (int j = 0; j < 16; ++j) v[j] = tile[(kh + 16 * q + j) * 257 + n] * F8_SW1; }
          else {
#pragma unroll
              for (int j = 0; j < 16; ++j) v[j] = tile[(kh + 16 * q + j) * 257 + n] * F8_SW2; }
          u32x4 o; o[0] = pack4_f8(v[0], v[1], v[2], v[3]); o[1] = pack4_f8(v[4], v[5], v[6], v[7]); o[2] = pack4_f8(v[8], v[9], v[10], v[11]); o[3] = pack4_f8(v[12], v[13], v[14], v[15]);
          *(u32x4*)(drow + 16 * q) = o; } }
    else
#endif
    { const int n = tid >> 1, kh = (tid & 1) * 32; bf16_t* drow = c.dst + (size_t)(c.n0 + n) * c.ldk + c.k0 + kh;
#pragma unroll
      for (int q = 0; q < 4; ++q) { float v[8];
#pragma unroll
          for (int j = 0; j < 8; ++j) v[j] = tile[(kh + 8 * q + j) * 257 + n];
          u32x4 o; o[0] = pack2(v[0], v[1]); o[1] = pack2(v[2], v[3]); o[2] = pack2(v[4], v[5]); o[3] = pack2(v[6], v[7]);
          *(u32x4*)(drow + 8 * q) = o; } }
    __syncthreads();
}
DEV void phase_convert(const Params& p, int l, LAS unsigned char* lds) {
    LAS float* tile = (LAS float*)lds;
    const int tid = opaque_tid();
    constexpr int T_MAIN = 13 * 16 + 4 * 16 + NE * 16 * 16 + NE * 4 * 32;
    {
        f32x4 ra[8], rb[8];
        int t = blockIdx.x;
        ConvTile ca, cb;
        if (t < T_MAIN) { ca = conv_desc(p, l, t); conv_issue(ca, ra, tid); }
        while (t < T_MAIN) {
            const int t1 = t + gridDim.x;
            if (t1 < T_MAIN) { cb = conv_desc(p, l, t1); conv_issue(cb, rb, tid); }
            conv_finish(ca, ra, tile, tid);
            const int t2 = t1 + gridDim.x;
            if (t1 < T_MAIN) { if (t2 < T_MAIN) { ca = conv_desc(p, l, t2); conv_issue(ca, ra, tid); } conv_finish(cb, rb, tile, tid); }
            t = t2;
        }
    }
    { bf16_t* btin = (bf16_t*)(p.ws + WS_BTIN); const float* w_in = p.in[6] + (size_t)l * D_ * PROJ_W0;
      for (int t = blockIdx.x; t < 4 * 16; t += gridDim.x) conv_tile<true>(w_in, PROJ_W0, 0, btin, D_, PROJ_N + (t / 16) * 64, (t % 16) * 64, tile); }
    if (blockIdx.x == 0) { float* bias = (float*)(p.ws + WS_BIAS); const float* b_in = p.in[7] + (size_t)l * PROJ_W0;
        for (int i = tid; i < PROJ_NP; i += 512) { const int s = win_srccol(i); bias[i] = s >= 0 ? b_in[s] : 0.f; } }
    if (l == 0) {
        const float* mods = (const float*)(p.ws + WS_MODS); bf16_t* ub = (bf16_t*)(p.ws + WS_U);
        const int lane = tid & 63, gw = blockIdx.x * 8 + (tid >> 6), nw = gridDim.x * 8;
        for (int row = gw; row < NTOK; row += nw) {
            const bool isl = row < NL; const int bb = isl ? row / T_ : B_;
            const float* xr = isl ? p.in[0] + (size_t)row * D_ : p.in[2] + (size_t)(row - NL) * D_;
            const float* md = mods + (size_t)bb * 6144;
#pragma unroll
            for (int i = 0; i < 2; ++i) { const int c = lane * 8 + i * 512;
                const f32x4 x0 = *(const f32x4*)(xr + c), x1 = *(const f32x4*)(xr + c + 4), s0 = *(const f32x4*)(md + 1024 + c), s1 = *(const f32x4*)(md + 1024 + c + 4), h0 = *(const f32x4*)(md + c), h1 = *(const f32x4*)(md + c + 4);
                const f32x4 a = x0 * (s0 + 1.0f) + h0, b = x1 * (s1 + 1.0f) + h1;
                u32x4 o; o[0] = pack2(a[0], a[1]); o[1] = pack2(a[2], a[3]); o[2] = pack2(b[0], b[1]); o[3] = pack2(b[2], b[3]);
                *(u32x4*)(ub + (size_t)row * D_ + c) = o; }
        }
    }
}

DEV int tok_row(bool lat, int b, int pos) { return lat ? b * T_ + pos : NL + b * TC_ + pos; }
DEV bf16x8 lds_frag(const LAS bf16_t* base, int row, int stride, int col) { return *(const LAS bf16x8*)(base + row * stride + col); }

#ifdef HOST_EMU
#define WAVE_SYNC() do { int z_ = 0; (void)emu::wave_all(&z_, 4); } while (0)
#else
#define WAVE_SYNC() __builtin_amdgcn_wave_barrier()
#endif
#ifdef HOST_EMU
DEV void wg_release_acquire() { __syncthreads(); }
#else
DEV void wg_release_acquire() {
    __builtin_amdgcn_fence(__ATOMIC_RELEASE, "workgroup"); asm volatile("s_waitcnt vmcnt(0)" ::: "memory"); __syncthreads();
    __builtin_amdgcn_fence(__ATOMIC_ACQUIRE, "agent"); asm volatile("s_waitcnt vmcnt(0)" ::: "memory"); }
#endif
DEV void merge_head(const Params& p, int l, int b, int part, int h, int tid) {
    const bool need_ctx = l < DEPTH_ - 1;
    const bf16_t* proj = (const bf16_t*)(p.ws + WS_R1 + R1_PROJ); bf16_t* ymix = (bf16_t*)(p.ws + WS_YMIX);
    const bf16_t* o0 = (const bf16_t*)(p.ws + WS_R1 + (part ? R1_OG : R1_OM)); const bf16_t* o1 = o0 + (size_t)NTOK * 256;
    const int ch = h * 64 + (tid & 7) * 8;
    const float* gn = (part ? p.in[12] : p.in[11]) + (size_t)l * 256 + ch;
    const f32x4 g0 = *(const f32x4*)gn, g1 = *(const f32x4*)(gn + 4);
    const int ntk = T_ + (need_ctx ? TC_ : 0);
    for (int i0 = tid >> 3; i0 < ntk; i0 += 256) {
        int rows[4]; u32x4 oa[4], ob[4]; u32x4 gtv[4];
#pragma unroll
        for (int k = 0; k < 4; ++k) { const int i = i0 + 64 * k; const int row = i < T_ ? b * T_ + i : NL + b * TC_ + (i - T_); rows[k] = row;
            oa[k] = *(const u32x4*)(o0 + (size_t)row * 256 + ch); ob[k] = *(const u32x4*)(o1 + (size_t)row * 256 + ch);
            gtv[k] = *(const u32x4*)(proj + (size_t)row * PROJ_N + (part ? C_GR : C_MO) + ch); }
#pragma unroll
        for (int k = 0; k < 4; ++k) {
            const f32x4 x0 = (f32x4){bflo(oa[k][0]) + bflo(ob[k][0]), bfhi(oa[k][0]) + bfhi(ob[k][0]), bflo(oa[k][1]) + bflo(ob[k][1]), bfhi(oa[k][1]) + bfhi(ob[k][1])};
            const f32x4 x1 = (f32x4){bflo(oa[k][2]) + bflo(ob[k][2]), bfhi(oa[k][2]) + bfhi(ob[k][2]), bflo(oa[k][3]) + bflo(ob[k][3]), bfhi(oa[k][3]) + bfhi(ob[k][3])};
            float s = x0[0] + x0[1] + x0[2] + x0[3] + x1[0] + x1[1] + x1[2] + x1[3];
            s += shfl_xor_f(s, 1); s += shfl_xor_f(s, 2); s += shfl_xor_f(s, 4);
            const float mu = s * (1.0f / 64.0f);
            const f32x4 d0 = x0 - mu, d1 = x1 - mu;
            float q = d0[0] * d0[0] + d0[1] * d0[1] + d0[2] * d0[2] + d0[3] * d0[3] + d1[0] * d1[0] + d1[1] * d1[1] + d1[2] * d1[2] + d1[3] * d1[3];
            q += shfl_xor_f(q, 1); q += shfl_xor_f(q, 2); q += shfl_xor_f(q, 4);
            const float rstd = 1.0f / sqrtf(q * (1.0f / 64.0f) + LN_EPS);
            float gv[8];
#pragma unroll
            for (int j = 0; j < 4; ++j) { gv[2 * j] = bflo(gtv[k][j]); gv[2 * j + 1] = bfhi(gtv[k][j]); }
            float y[8];
#pragma unroll
            for (int j = 0; j < 8; ++j) { const float nv = (j < 4 ? d0[j] : d1[j - 4]) * rstd * (j < 4 ? g0[j] : g1[j - 4]); y[j] = nv * (part ? silu_fast(gv[j]) : sigmoid_fast(gv[j])); }
            u32x4 ov; ov[0] = pack2(y[0], y[1]); ov[1] = pack2(y[2], y[3]); ov[2] = pack2(y[4], y[5]); ov[3] = pack2(y[6], y[7]);
            *(u32x4*)(ymix + (size_t)rows[k] * D_ + part * 256 + ch) = ov;
        }
    }
}

struct MlItem { u32x2 q1[3], q2[3], k1[3], k2[3]; };
struct MlChunk { u32x2 q[2][2], k[2][2]; u32x4 v[2]; float gtv, g_pt, cm63; };
DEV void mlstm_unit(const Params& p, int l, int b, int h, LAS unsigned char* lds) {
    constexpr int ST = 72;
    constexpr int DSZ = 4 * 64 * ST * 2 + 2 * 80 * ST * 2 + 3 * 64 * 4 + 3 * 128 * 4;
    static_assert(2 * DSZ <= LDS_BYTES - 32, "mlstm lds");
    const int tid = opaque_tid(), lane = tid & 63, w = tid >> 6, dir = w >> 2, wh = w & 3, t4 = tid & 255, fr = lane & 15, fq = lane >> 4;
    LAS unsigned char* db = lds + dir * DSZ;
    LAS bf16_t* Qs = (LAS bf16_t*)db;
    LAS bf16_t* Ks = Qs + 64 * ST;
    LAS bf16_t* KT = Ks + 64 * ST;
    LAS bf16_t* Ps = KT + 64 * ST;
    LAS bf16_t* VT = Ps + 64 * ST;
    LAS bf16_t* Cs = VT + 80 * ST;
    LAS float* gt = (LAS float*)(Cs + 80 * ST);
    LAS float* cw = gt + 3 * 64;
    const bf16_t* proj = (const bf16_t*)(p.ws + WS_R1 + R1_PROJ); const float* gates = (const float*)(p.ws + WS_R1 + R1_GATES);
    bf16_t* qk2 = (bf16_t*)(p.ws + WS_R1 + R1_QK2);
    bf16_t* om = (bf16_t*)(p.ws + WS_R1 + R1_OM) + (size_t)dir * NTOK * 256;
    float* gbuf = (float*)(p.ws + WS_GSCAN) + (size_t)((b * 4 + h) * 2 + dir) * NCH * 192;
    const float* ropeM = (const float*)(p.ws + WS_ROPE);
    __syncthreads();
    for (int i = t4; i < 3 * 128; i += 256) { const int j = i / 128, c = i % 128; cw[i] = p.in[8][((size_t)l * 3 + j) * 512 + (c < 64 ? h * 64 + c : 256 + h * 64 + (c - 64))]; }
    for (int i = t4; i < 80 * ST; i += 256) Cs[i] = 0;
    for (int i = t4; i < 16 * ST; i += 256) VT[64 * ST + i] = (bf16_t)0x3F80;
    for (int c0 = wh; c0 < NCH; c0 += 12) {
        float ig[3], fg[3];
#pragma unroll
        for (int k = 0; k < 3; ++k) { const int c = c0 + 4 * k; ig[k] = fg[k] = 0.f;
            if (c < NCH) { const bool lat = c >= NCH_C; const int cc = lat ? c - NCH_C : c; const int Ts = lat ? T_ : TC_;
                const int sp = dir == 0 ? cc * 64 + lane : Ts - 1 - (cc * 64 + lane);
                const float* gr = gates + (size_t)tok_row(lat, b, sp) * NG + dir * 8 + h; ig[k] = gr[0]; fg[k] = gr[4]; } }
#pragma unroll
        for (int k = 0; k < 3; ++k) { const int c = c0 + 4 * k;
            if (c < NCH) {
                float bs = logsigf(fg[k]);
                for (int d = 1; d < 64; d <<= 1) { const float o = shfl_up_f(bs, d); if (lane >= d) bs += o; }
                const float g = ig[k] - bs;
                float cm = g;
                for (int d = 1; d < 64; d <<= 1) { const float o = shfl_up_f(cm, d); if (lane >= d) cm = fmaxf(cm, o); }
                gbuf[c * 192 + lane] = bs; gbuf[c * 192 + 64 + lane] = g; gbuf[c * 192 + 128 + lane] = cm; } }
    }
    __syncthreads();
    {
        constexpr int NIT = (TC_ + T_) * 8;
        auto item_load = [&](int it, MlItem& R) {
            const int tk = it >> 3, pg = it & 7; const bool lat = tk >= TC_; const int sp = lat ? tk - TC_ : tk, Ts = lat ? T_ : TC_;
            const int hf = pg >> 2, i0 = 4 * (pg & 3), dA = 32 * hf + i0, dB = dA + 16;
#pragma unroll
            for (int tap = 0; tap < 3; ++tap) { const int sp2 = sp + tap - 1; const bool ok = sp2 >= 0 && sp2 < Ts; const int spc = ok ? sp2 : sp;
                const bf16_t* pr = proj + (size_t)tok_row(lat, b, spc) * PROJ_N + h * 64;
                const u32x2 z = (u32x2){0u, 0u};
                const u32x2 a = *(const u32x2*)(pr + C_MQ + dA), bq = *(const u32x2*)(pr + C_MQ + dB), c = *(const u32x2*)(pr + C_MK + dA), d = *(const u32x2*)(pr + C_MK + dB);
                R.q1[tap] = ok ? a : z; R.q2[tap] = ok ? bq : z; R.k1[tap] = ok ? c : z; R.k2[tap] = ok ? d : z; } };
        auto item_finish = [&](int it, const MlItem& R) {
            const int tk = it >> 3, pg = it & 7; const bool lat = tk >= TC_; const int sp = lat ? tk - TC_ : tk;
            const int hf = pg >> 2, i0 = 4 * (pg & 3), dA = 32 * hf + i0, dB = dA + 16;
            float qa[4], qb[4], ka[4], kb[4];
#pragma unroll
            for (int j = 0; j < 4; ++j) { qa[j] = qb[j] = ka[j] = kb[j] = 0.f; }
#pragma unroll
            for (int tap = 0; tap < 3; ++tap) { const LAS float* wq = cw + tap * 128;
                qa[0] += wq[dA] * bflo(R.q1[tap][0]); qa[1] += wq[dA + 1] * bfhi(R.q1[tap][0]); qa[2] += wq[dA + 2] * bflo(R.q1[tap][1]); qa[3] += wq[dA + 3] * bfhi(R.q1[tap][1]);
                qb[0] += wq[dB] * bflo(R.q2[tap][0]); qb[1] += wq[dB + 1] * bfhi(R.q2[tap][0]); qb[2] += wq[dB + 2] * bflo(R.q2[tap][1]); qb[3] += wq[dB + 3] * bfhi(R.q2[tap][1]);
                ka[0] += wq[64 + dA] * bflo(R.k1[tap][0]); ka[1] += wq[64 + dA + 1] * bfhi(R.k1[tap][0]); ka[2] += wq[64 + dA + 2] * bflo(R.k1[tap][1]); ka[3] += wq[64 + dA + 3] * bfhi(R.k1[tap][1]);
                kb[0] += wq[64 + dB] * bflo(R.k2[tap][0]); kb[1] += wq[64 + dB + 1] * bfhi(R.k2[tap][0]); kb[2] += wq[64 + dB + 2] * bflo(R.k2[tap][1]); kb[3] += wq[64 + dB + 3] * bfhi(R.k2[tap][1]); }
#pragma unroll
            for (int j = 0; j < 4; ++j) { qa[j] = silu_fast(qa[j]); qb[j] = silu_fast(qb[j]); ka[j] = silu_fast(ka[j]) * 0.125f; kb[j] = silu_fast(kb[j]) * 0.125f; }
            if (lat) { const int pos = hf == 0 ? (sp >> 6) : (sp & 63);
#pragma unroll
                for (int j = 0; j < 4; ++j) { const float cs = ropeM[(pos * 16 + i0 + j) * 2], sn = ropeM[(pos * 16 + i0 + j) * 2 + 1];
                    const float q1 = qa[j] * cs - qb[j] * sn, q2 = qa[j] * sn + qb[j] * cs; qa[j] = q1; qb[j] = q2;
                    const float k1 = ka[j] * cs - kb[j] * sn, k2 = ka[j] * sn + kb[j] * cs; ka[j] = k1; kb[j] = k2; } }
            bf16_t* dst = qk2 + (size_t)tok_row(lat, b, sp) * 512 + h * 128;
            u32x2 o;
            o[0] = pack2(qa[0], qa[1]); o[1] = pack2(qa[2], qa[3]); *(u32x2*)(dst + dA) = o;
            o[0] = pack2(qb[0], qb[1]); o[1] = pack2(qb[2], qb[3]); *(u32x2*)(dst + dB) = o;
            o[0] = pack2(ka[0], ka[1]); o[1] = pack2(ka[2], ka[3]); *(u32x2*)(dst + 64 + dA) = o;
            o[0] = pack2(kb[0], kb[1]); o[1] = pack2(kb[2], kb[3]); *(u32x2*)(dst + 64 + dB) = o; };
        for (int it0 = tid; it0 < NIT; it0 += 1024) {
            MlItem A, B; const bool two = it0 + 512 < NIT;
            item_load(it0, A); if (two) item_load(it0 + 512, B);
            item_finish(it0, A); if (two) item_finish(it0 + 512, B);
        }
    }
    wg_release_acquire();
    f32x4 cacc[5];
#pragma unroll
    for (int i = 0; i < 5; ++i) cacc[i] = (f32x4){0.f, 0.f, 0.f, 0.f};
    const int ti = wh;
    const int pt = t4 >> 2, pgq = t4 & 3;
    float m_in = 0.f;
    auto chunk_load = [&](int c, MlChunk& R) {
        const bool lat = c >= NCH_C; const int cc = lat ? c - NCH_C : c; const int Ts = lat ? T_ : TC_;
        const int sp = dir == 0 ? cc * 64 + pt : Ts - 1 - (cc * 64 + pt);
        const size_t row = (size_t)tok_row(lat, b, sp);
#pragma unroll
        for (int sub = 0; sub < 2; ++sub) { const int pg = pgq * 2 + sub; const int hf = pg >> 2, i0 = 4 * (pg & 3), dA = 32 * hf + i0, dB = dA + 16;
            const bf16_t* src = qk2 + row * 512 + h * 128;
            R.q[sub][0] = *(const u32x2*)(src + dA); R.q[sub][1] = *(const u32x2*)(src + dB); R.k[sub][0] = *(const u32x2*)(src + 64 + dA); R.k[sub][1] = *(const u32x2*)(src + 64 + dB);
            R.v[sub] = *(const u32x4*)(proj + row * PROJ_N + C_MV + h * 64 + pg * 8); }
        R.gtv = gbuf[c * 192 + (t4 < 192 ? t4 : 0)]; R.g_pt = gbuf[c * 192 + 64 + pt]; R.cm63 = gbuf[c * 192 + 128 + 63]; };
    MlChunk cur, nxt;
    chunk_load(0, cur); nxt = cur;
    for (int c = 0; c < NCH; ++c) {
        const bool lat = c >= NCH_C; const int cc = lat ? c - NCH_C : c; const int Ts = lat ? T_ : TC_;
        {
            if (t4 < 192) gt[t4] = cur.gtv;
            const float wsc = fast_exp(cur.g_pt - fmaxf(m_in, cur.cm63));
#pragma unroll
            for (int sub = 0; sub < 2; ++sub) { const int pg = pgq * 2 + sub; const int hf = pg >> 2, i0 = 4 * (pg & 3), dA = 32 * hf + i0, dB = dA + 16;
                *(LAS u32x2*)(Qs + pt * ST + dA) = cur.q[sub][0]; *(LAS u32x2*)(Qs + pt * ST + dB) = cur.q[sub][1];
                *(LAS u32x2*)(Ks + pt * ST + dA) = cur.k[sub][0]; *(LAS u32x2*)(Ks + pt * ST + dB) = cur.k[sub][1];
                const float ka[4] = {bflo(cur.k[sub][0][0]), bfhi(cur.k[sub][0][0]), bflo(cur.k[sub][0][1]), bfhi(cur.k[sub][0][1])};
                const float kb[4] = {bflo(cur.k[sub][1][0]), bfhi(cur.k[sub][1][0]), bflo(cur.k[sub][1][1]), bfhi(cur.k[sub][1][1])};
#pragma unroll
                for (int j = 0; j < 4; ++j) { KT[(dA + j) * ST + pt] = f2bf(ka[j] * wsc); KT[(dB + j) * ST + pt] = f2bf(kb[j] * wsc); }
                const u32x4 vv = cur.v[sub];
#pragma unroll
                for (int j = 0; j < 4; ++j) { VT[(pg * 8 + 2 * j) * ST + pt] = (bf16_t)(vv[j] & 0xFFFFu); VT[(pg * 8 + 2 * j + 1) * ST + pt] = (bf16_t)(vv[j] >> 16); } }
        }
        LDS_BARRIER();
        if (c + 1 < NCH) chunk_load(c + 1, nxt);
        const float M63 = fmaxf(m_in, gt[128 + 63]);
        float Mt[4];
#pragma unroll
        for (int r = 0; r < 4; ++r) Mt[r] = fmaxf(m_in, gt[128 + 16 * ti + 4 * fq + r]);
        {
            const bf16x8 a0 = lds_frag(Qs, 16 * ti + fr, ST, 8 * fq), a1 = lds_frag(Qs, 16 * ti + fr, ST, 32 + 8 * fq);
#pragma unroll
            for (int tj = 0; tj < 4; ++tj) {
                f32x4 s = (f32x4){0.f, 0.f, 0.f, 0.f};
                s = mfma16(a0, lds_frag(Ks, 16 * tj + fr, ST, 8 * fq), s);
                s = mfma16(a1, lds_frag(Ks, 16 * tj + fr, ST, 32 + 8 * fq), s);
                const int sc_ = 16 * tj + fr; const float gs = gt[64 + sc_];
#pragma unroll
                for (int r = 0; r < 4; ++r) { const int t = 16 * ti + 4 * fq + r;
                    const float pv = sc_ <= t ? s[r] * fast_exp(gs - Mt[r]) : 0.f; Ps[t * ST + sc_] = f2bf(pv); } }
            const float decay = fast_exp(m_in - M63);
            const bf16x8 v0 = lds_frag(VT, 16 * ti + fr, ST, 8 * fq), v1 = lds_frag(VT, 16 * ti + fr, ST, 32 + 8 * fq);
#pragma unroll
            for (int dj = 0; dj < 4; ++dj) { cacc[dj] = cacc[dj] * decay;
                cacc[dj] = mfma16(v0, lds_frag(KT, 16 * dj + fr, ST, 8 * fq), cacc[dj]);
                cacc[dj] = mfma16(v1, lds_frag(KT, 16 * dj + fr, ST, 32 + 8 * fq), cacc[dj]); }
            cacc[4] = cacc[4] * decay;
            cacc[4] = mfma16(lds_frag(VT, 64 + fr, ST, 8 * fq), lds_frag(KT, 16 * wh + fr, ST, 8 * fq), cacc[4]);
            cacc[4] = mfma16(lds_frag(VT, 64 + fr, ST, 32 + 8 * fq), lds_frag(KT, 16 * wh + fr, ST, 32 + 8 * fq), cacc[4]);
        }
        WAVE_SYNC();
        {
            const bf16x8 p0 = lds_frag(Ps, 16 * ti + fr, ST, 8 * fq), p1 = lds_frag(Ps, 16 * ti + fr, ST, 32 + 8 * fq);
            const bf16x8 q0 = lds_frag(Qs, 16 * ti + fr, ST, 8 * fq), q1 = lds_frag(Qs, 16 * ti + fr, ST, 32 + 8 * fq);
            f32x4 np_[5];
            float ev[4];
#pragma unroll
            for (int r = 0; r < 4; ++r) ev[r] = fast_exp(m_in - Mt[r]);
#pragma unroll
            for (int tj = 0; tj < 5; ++tj) { f32x4 nc = (f32x4){0.f, 0.f, 0.f, 0.f}; np_[tj] = (f32x4){0.f, 0.f, 0.f, 0.f};
                np_[tj] = mfma16(p0, lds_frag(VT, 16 * tj + fr, ST, 8 * fq), np_[tj]);
                np_[tj] = mfma16(p1, lds_frag(VT, 16 * tj + fr, ST, 32 + 8 * fq), np_[tj]);
                nc = mfma16(q0, lds_frag(Cs, 16 * tj + fr, ST, 8 * fq), nc);
                nc = mfma16(q1, lds_frag(Cs, 16 * tj + fr, ST, 32 + 8 * fq), nc);
#pragma unroll
                for (int r = 0; r < 4; ++r) np_[tj][r] += ev[r] * nc[r]; }
#pragma unroll
            for (int r = 0; r < 4; ++r) { const int t = 16 * ti + 4 * fq + r;
                const float dn = fmaxf(fabsf(np_[4][r]), fast_exp(-gt[t] - Mt[r])); const float inv = 1.0f / dn;
                const int sp = dir == 0 ? cc * 64 + t : Ts - 1 - (cc * 64 + t);
                bf16_t* orow = om + (size_t)tok_row(lat, b, sp) * 256 + h * 64;
#pragma unroll
                for (int tj = 0; tj < 4; ++tj) orow[16 * tj + fr] = f2bf(np_[tj][r] * inv); }
        }
        m_in = gt[63] + M63;
        LDS_BARRIER();
#pragma unroll
        for (int dj = 0; dj < 4; ++dj)
#pragma unroll
            for (int r = 0; r < 4; ++r) Cs[(16 * ti + 4 * fq + r) * ST + 16 * dj + fr] = f2bf(cacc[dj][r]);
#pragma unroll
        for (int r = 0; r < 4; ++r) Cs[(64 + 4 * fq + r) * ST + 16 * wh + fr] = f2bf(cacc[4][r]);
        cur = nxt;
    }
    wg_release_acquire();
    merge_head(p, l, b, 0, h, tid);
}

template <int KS, int HALF, int DJ> struct GlaTr { static constexpr int v = ((32 * KS + 4 * HALF) * 40 + 16 * DJ) * 2; };
struct GlChunk { f32x4 lr[4]; unsigned q[2][2], k[2][2]; u32x4 v[2]; };
DEV void gla_unit(const Params& p, int l, int b, int h, LAS unsigned char* lds) {
    constexpr int ST = 72, SQ = 40;
    constexpr int DSZ = 5 * 64 * SQ * 2 + 32 * ST * 2 + 2 * 64 * ST * 2 + 64 * 33 * 4 + 544 * 4;
    static_assert(2 * DSZ <= LDS_BYTES - 32, "gla lds");
    const int tid = opaque_tid(), lane = tid & 63, w = tid >> 6, dir = w >> 2, wh = w & 3, t4 = tid & 255, fr = lane & 15, fq = lane >> 4;
    LAS unsigned char* db = lds + dir * DSZ;
    LAS bf16_t* Qs = (LAS bf16_t*)db;
    LAS bf16_t* Ks = Qs + 64 * SQ;
    LAS bf16_t* Ss = Ks + 64 * SQ;
    LAS bf16_t* Ah = Ss + 64 * SQ;
    LAS bf16_t* Al = Ah + 64 * SQ;
    LAS bf16_t* KT = Al + 64 * SQ;
    LAS bf16_t* VT = KT + 32 * ST;
    LAS bf16_t* Ps = VT + 64 * ST;
    LAS float* bc = (LAS float*)(Ps + 64 * ST);
    LAS float* w2s = bc + 64 * 33;
    const bf16_t* proj = (const bf16_t*)(p.ws + WS_R1 + R1_PROJ); const float* gates = (const float*)(p.ws + WS_R1 + R1_GATES);
    bf16_t* og = (bf16_t*)(p.ws + WS_R1 + R1_OG) + (size_t)dir * NTOK * 256;
    const float* ropeG = (const float*)(p.ws + WS_ROPE) + 2048;
    __syncthreads();
    for (int i = t4; i < 16 * 32; i += 256) { const int r = i >> 5, d = i & 31; w2s[i] = p.in[9][(((size_t)l * 2 + dir) * 16 + r) * 128 + h * 32 + d]; }
    if (t4 < 32) w2s[512 + t4] = p.in[10][((size_t)l * 2 + dir) * 128 + h * 32 + t4];
    for (int i = t4; i < 64 * SQ; i += 256) Ss[i] = 0;
    __syncthreads();
    f32x4 sacc[2];
    sacc[0] = (f32x4){0.f, 0.f, 0.f, 0.f}; sacc[1] = (f32x4){0.f, 0.f, 0.f, 0.f};
    const int ti = wh;
    const int pt = t4 >> 2, pgq = t4 & 3;
    bf16x8 lf_[2];
#pragma unroll
    for (int ks = 0; ks < 2; ++ks)
#pragma unroll
        for (int j = 0; j < 8; ++j) lf_[ks][j] = (32 * ks + 8 * fq + j <= 16 * ti + fr) ? (short)0x3F80 : (short)0;
    auto chunk_load = [&](int c, GlChunk& R) {
        const bool lat = c >= NCH_C; const int cc = lat ? c - NCH_C : c; const int Ts = lat ? T_ : TC_;
        const int sp = dir == 0 ? cc * 64 + pt : Ts - 1 - (cc * 64 + pt);
        const size_t row = (size_t)tok_row(lat, b, sp);
        const float* lr = gates + row * NG + 16 + dir * 16;
#pragma unroll
        for (int r = 0; r < 4; ++r) R.lr[r] = *(const f32x4*)(lr + 4 * r);
        const bf16_t* pr = proj + row * PROJ_N;
#pragma unroll
        for (int sub = 0; sub < 2; ++sub) { const int pg = pgq * 2 + sub; const int hf = pg >> 2, i0 = 2 * (pg & 3), dA = 16 * hf + i0, dB = dA + 8;
            R.q[sub][0] = *(const unsigned*)(pr + C_GQ + h * 32 + dA); R.q[sub][1] = *(const unsigned*)(pr + C_GQ + h * 32 + dB);
            R.k[sub][0] = *(const unsigned*)(pr + C_GK + h * 32 + dA); R.k[sub][1] = *(const unsigned*)(pr + C_GK + h * 32 + dB);
            R.v[sub] = *(const u32x4*)(pr + C_GV + h * 64 + pg * 8); } };
    GlChunk cur, nxt;
    chunk_load(0, cur); nxt = cur;
    for (int c = 0; c < NCH; ++c) {
        const bool lat = c >= NCH_C; const int cc = lat ? c - NCH_C : c; const int Ts = lat ? T_ : TC_;
        const int sp = dir == 0 ? cc * 64 + pt : Ts - 1 - (cc * 64 + pt);
        { float lrv[16];
#pragma unroll
          for (int r = 0; r < 16; r += 4) { lrv[r] = cur.lr[r >> 2][0]; lrv[r + 1] = cur.lr[r >> 2][1]; lrv[r + 2] = cur.lr[r >> 2][2]; lrv[r + 3] = cur.lr[r >> 2][3]; }
          float av[8];
#pragma unroll
          for (int j = 0; j < 8; ++j) { const int d = pgq * 8 + j; float z = w2s[512 + d];
#pragma unroll
              for (int r = 0; r < 16; ++r) z += lrv[r] * w2s[r * 32 + d];
              av[j] = logsig_fast(z) * (1.0f / 16.0f); }
          u32x4 hi, lo;
#pragma unroll
          for (int j = 0; j < 4; ++j) { const bf16_t h0 = f2bf(av[2 * j]), h1 = f2bf(av[2 * j + 1]);
              hi[j] = (unsigned)h0 | ((unsigned)h1 << 16); lo[j] = (unsigned)f2bf(av[2 * j] - bf2f(h0)) | ((unsigned)f2bf(av[2 * j + 1] - bf2f(h1)) << 16); }
          *(LAS u32x4*)(Ah + pt * SQ + pgq * 8) = hi; *(LAS u32x4*)(Al + pt * SQ + pgq * 8) = lo; }
        LDS_BARRIER();
        {
            const lds_addr_t ah = lds_addr(Ah + (8 * fq + (fr >> 2)) * SQ + 4 * (fr & 3)), al = lds_addr(Al + (8 * fq + (fr >> 2)) * SQ + 4 * (fr & 3));
#define GLA_CS(DJ) do { \
            const bf16x4 h00 = tr_read4<GlaTr<0, 0, DJ>::v>(ah), h01 = tr_read4<GlaTr<0, 1, DJ>::v>(ah), h10 = tr_read4<GlaTr<1, 0, DJ>::v>(ah), h11 = tr_read4<GlaTr<1, 1, DJ>::v>(ah); \
            const bf16x4 l00 = tr_read4<GlaTr<0, 0, DJ>::v>(al), l01 = tr_read4<GlaTr<0, 1, DJ>::v>(al), l10 = tr_read4<GlaTr<1, 0, DJ>::v>(al), l11 = tr_read4<GlaTr<1, 1, DJ>::v>(al); \
            LGKM_WAIT0(); \
            f32x4 acc = (f32x4){0.f, 0.f, 0.f, 0.f}; \
            acc = mfma16(lf_[0], (bf16x8){h00[0], h00[1], h00[2], h00[3], h01[0], h01[1], h01[2], h01[3]}, acc); \
            acc = mfma16(lf_[1], (bf16x8){h10[0], h10[1], h10[2], h10[3], h11[0], h11[1], h11[2], h11[3]}, acc); \
            acc = mfma16(lf_[0], (bf16x8){l00[0], l00[1], l00[2], l00[3], l01[0], l01[1], l01[2], l01[3]}, acc); \
            acc = mfma16(lf_[1], (bf16x8){l10[0], l10[1], l10[2], l10[3], l11[0], l11[1], l11[2], l11[3]}, acc); \
            _Pragma("unroll") for (int r = 0; r < 4; ++r) bc[(16 * ti + 4 * fq + r) * 33 + 16 * DJ + fr] = acc[r]; } while (0)
            GLA_CS(0); GLA_CS(1);
#undef GLA_CS
        }
        WAVE_SYNC();
#pragma unroll
        for (int sub = 0; sub < 2; ++sub) {
            const int pg = pgq * 2 + sub;
            const int hf = pg >> 2, i0 = 2 * (pg & 3), dA = 16 * hf + i0, dB = dA + 8;
            const unsigned q1 = cur.q[sub][0], q2 = cur.q[sub][1], k1 = cur.k[sub][0], k2 = cur.k[sub][1];
            const float qs_ = 0.17677669529663687f;
            float qa[2] = {bflo(q1) * qs_, bfhi(q1) * qs_}, qb[2] = {bflo(q2) * qs_, bfhi(q2) * qs_}, ka[2] = {bflo(k1), bfhi(k1)}, kb[2] = {bflo(k2), bfhi(k2)};
            if (lat) { const int pos = hf == 0 ? (sp >> 6) : (sp & 63);
#pragma unroll
                for (int j = 0; j < 2; ++j) { const float cs = ropeG[(pos * 8 + i0 + j) * 2], sn = ropeG[(pos * 8 + i0 + j) * 2 + 1];
                    const float x1 = qa[j] * cs - qb[j] * sn, x2 = qa[j] * sn + qb[j] * cs; qa[j] = x1; qb[j] = x2;
                    const float y1 = ka[j] * cs - kb[j] * sn, y2 = ka[j] * sn + kb[j] * cs; ka[j] = y1; kb[j] = y2; } }
#pragma unroll
            for (int j = 0; j < 2; ++j) { const float bA = bc[pt * 33 + dA + j], bB = bc[pt * 33 + dB + j];
                qa[j] *= fast_exp(bA); qb[j] *= fast_exp(bB); ka[j] *= fast_exp(-bA); kb[j] *= fast_exp(-bB); }
            *(LAS unsigned*)(Qs + pt * SQ + dA) = pack2(qa[0], qa[1]); *(LAS unsigned*)(Qs + pt * SQ + dB) = pack2(qb[0], qb[1]);
            *(LAS unsigned*)(Ks + pt * SQ + dA) = pack2(ka[0], ka[1]); *(LAS unsigned*)(Ks + pt * SQ + dB) = pack2(kb[0], kb[1]);
#pragma unroll
            for (int j = 0; j < 2; ++j) { KT[(dA + j) * ST + pt] = f2bf(ka[j]); KT[(dB + j) * ST + pt] = f2bf(kb[j]); }
            const u32x4 vv = cur.v[sub];
#pragma unroll
            for (int j = 0; j < 4; ++j) { VT[(pg * 8 + 2 * j) * ST + pt] = (bf16_t)(vv[j] & 0xFFFFu); VT[(pg * 8 + 2 * j + 1) * ST + pt] = (bf16_t)(vv[j] >> 16); }
        }
        LDS_BARRIER();
        if (c + 1 < NCH) chunk_load(c + 1, nxt);
        {
            const bf16x8 a0 = lds_frag(Qs, 16 * ti + fr, SQ, 8 * fq);
#pragma unroll
            for (int tj = 0; tj < 4; ++tj) {
                f32x4 s = (f32x4){0.f, 0.f, 0.f, 0.f};
                s = mfma16(a0, lds_frag(Ks, 16 * tj + fr, SQ, 8 * fq), s);
                const int sc_ = 16 * tj + fr;
#pragma unroll
                for (int r = 0; r < 4; ++r) { const int t = 16 * ti + 4 * fq + r; Ps[t * ST + sc_] = f2bf(sc_ <= t ? s[r] : 0.f); } }
        }
        WAVE_SYNC();
        {
            const bf16x8 p0 = lds_frag(Ps, 16 * ti + fr, ST, 8 * fq), p1 = lds_frag(Ps, 16 * ti + fr, ST, 32 + 8 * fq), q0 = lds_frag(Qs, 16 * ti + fr, SQ, 8 * fq);
            f32x4 o[4];
#pragma unroll
            for (int tj = 0; tj < 4; ++tj) { o[tj] = (f32x4){0.f, 0.f, 0.f, 0.f};
                o[tj] = mfma16(p0, lds_frag(VT, 16 * tj + fr, ST, 8 * fq), o[tj]);
                o[tj] = mfma16(p1, lds_frag(VT, 16 * tj + fr, ST, 32 + 8 * fq), o[tj]);
                o[tj] = mfma16(q0, lds_frag(Ss, 16 * tj + fr, SQ, 8 * fq), o[tj]); }
#pragma unroll
            for (int r = 0; r < 4; ++r) { const int t = 16 * ti + 4 * fq + r; const int sp2 = dir == 0 ? cc * 64 + t : Ts - 1 - (cc * 64 + t);
                bf16_t* orow = og + (size_t)tok_row(lat, b, sp2) * 256 + h * 64;
#pragma unroll
                for (int tj = 0; tj < 4; ++tj) orow[16 * tj + fr] = f2bf(o[tj][r]); }
            const bf16x8 v0 = lds_frag(VT, 16 * wh + fr, ST, 8 * fq), v1 = lds_frag(VT, 16 * wh + fr, ST, 32 + 8 * fq);
#pragma unroll
            for (int dj = 0; dj < 2; ++dj) {
                sacc[dj] = mfma16(v0, lds_frag(KT, 16 * dj + fr, ST, 8 * fq), sacc[dj]);
                sacc[dj] = mfma16(v1, lds_frag(KT, 16 * dj + fr, ST, 32 + 8 * fq), sacc[dj]);
                sacc[dj] = sacc[dj] * fast_exp(bc[63 * 33 + 16 * dj + fr]); }
        }
        LDS_BARRIER();
#pragma unroll
        for (int dj = 0; dj < 2; ++dj)
#pragma unroll
            for (int r = 0; r < 4; ++r) Ss[(16 * wh + 4 * fq + r) * SQ + 16 * dj + fr] = f2bf(sacc[dj][r]);
        cur = nxt;
    }
    wg_release_acquire();
    merge_head(p, l, b, 1, h, tid);
}

template <int KS, int T16, int VT> struct TrOff { static constexpr int v = ((32 * KS + 16 * T16) * 72 + 16 * VT) * 2; };
template <int NT>
DEV void attn_ldkv(const LAS bf16_t* Kb, lds_addr_t vb, bf16x8 (&kf)[NT][2], bf16x8 (&vf)[NT / 2][4], int fr, int fq) {
#pragma unroll
    for (int kt = 0; kt < NT; ++kt) { kf[kt][0] = lds_frag(Kb, 16 * kt + fr, 72, 8 * fq); kf[kt][1] = lds_frag(Kb, 16 * kt + fr, 72, 32 + 8 * fq); }
    bf16x4 lo[NT / 2][4], hi[NT / 2][4];
#define ATT_TR(KS) do { lo[KS][0] = tr_read4<TrOff<KS, 0, 0>::v>(vb); hi[KS][0] = tr_read4<TrOff<KS, 1, 0>::v>(vb); lo[KS][1] = tr_read4<TrOff<KS, 0, 1>::v>(vb); hi[KS][1] = tr_read4<TrOff<KS, 1, 1>::v>(vb); \
        lo[KS][2] = tr_read4<TrOff<KS, 0, 2>::v>(vb); hi[KS][2] = tr_read4<TrOff<KS, 1, 2>::v>(vb); lo[KS][3] = tr_read4<TrOff<KS, 0, 3>::v>(vb); hi[KS][3] = tr_read4<TrOff<KS, 1, 3>::v>(vb); } while (0)
    ATT_TR(0);
    if constexpr (NT == 4) { ATT_TR(1); }
#undef ATT_TR
    LGKM_WAIT0();
#pragma unroll
    for (int ks = 0; ks < NT / 2; ++ks)
#pragma unroll
        for (int vt = 0; vt < 4; ++vt) vf[ks][vt] = (bf16x8){lo[ks][vt][0], lo[ks][vt][1], lo[ks][vt][2], lo[ks][vt][3], hi[ks][vt][0], hi[ks][vt][1], hi[ks][vt][2], hi[ks][vt][3]};
}
template <int NT, bool LOC>
DEV void attn_tile(const bf16x8 (&kf)[NT][2], const bf16x8 (&vf)[NT / 2][4], bf16x8 qf0, bf16x8 qf1, f32x4 (&o)[4], float& mrun, float& lrun, const LAS float* rpl, int d0) {
    f32x4 s[NT];
#pragma unroll
    for (int kt = 0; kt < NT; ++kt) { s[kt] = (f32x4){0.f, 0.f, 0.f, 0.f}; s[kt] = mfma16(kf[kt][0], qf0, s[kt]); s[kt] = mfma16(kf[kt][1], qf1, s[kt]); }
    float mx = -INFINITY;
#pragma unroll
    for (int kt = 0; kt < NT; ++kt)
#pragma unroll
        for (int j = 0; j < 4; ++j) { float v;
            if (LOC) { const bool ok = (unsigned)(16 * kt + j - d0) < 16u; v = ok ? s[kt][j] * 0.18033688f + rpl[16 * kt + j] : -INFINITY; }
            else v = s[kt][j] * 0.18033688f;
            s[kt][j] = v; mx = fmaxf(mx, v); }
    mx = xrow16_max(mx);
    if (wave_any(mx > mrun + 8.0f)) {
        const float mnew = fmaxf(mrun, mx);
        const float alpha = fast_exp2(mrun - mnew);
        lrun = lrun * alpha; mrun = mnew;
#pragma unroll
        for (int vt = 0; vt < 4; ++vt) o[vt] = o[vt] * alpha;
    }
    float ps = 0.f;
#pragma unroll
    for (int kt = 0; kt < NT; ++kt)
#pragma unroll
        for (int j = 0; j < 4; ++j) { const float pv = fast_exp2(s[kt][j] - mrun); s[kt][j] = pv; ps += pv; }
    lrun += ps;
#pragma unroll
    for (int ks = 0; ks < NT / 2; ++ks) { u32x4 pu; pu[0] = pack2(s[2 * ks][0], s[2 * ks][1]); pu[1] = pack2(s[2 * ks][2], s[2 * ks][3]); pu[2] = pack2(s[2 * ks + 1][0], s[2 * ks + 1][1]); pu[3] = pack2(s[2 * ks + 1][2], s[2 * ks + 1][3]);
        bf16x8 pf; __builtin_memcpy(&pf, &pu, 16);
#pragma unroll
        for (int vt = 0; vt < 4; ++vt) o[vt] = mfma16(vf[ks][vt], pf, o[vt]); }
}
template <bool LOCAL>
DEV void attn_unit(const Params& p, int l, int b, int head, int r0, LAS unsigned char* lds) {
    constexpr int NQT = 2, ST = 72, HB = 64 * ST, BUF = 2 * HB;
    LAS bf16_t* kv = (LAS bf16_t*)lds;
    LAS float* rp = (LAS float*)(kv + 2 * BUF) + 64;
    const int tid = opaque_tid(), lane = tid & 63, w = tid >> 6, fr = lane & 15, fq = lane >> 4;
    const int qt = w & 3, qc = 16 * qt + fr, rw = r0 + 2 * (w >> 2);
    const bf16_t* proj = (const bf16_t*)(p.ws + WS_R1 + R1_PROJ);
    bf16_t* ymix = (bf16_t*)(p.ws + WS_YMIX);
    const int rs_first = r0 - 4 < 0 ? 0 : (r0 - 4 > GRID_R - 8 ? GRID_R - 8 : r0 - 4);
    const int rl = r0 + 3, rs_last = rl - 4 < 0 ? 0 : (rl - 4 > GRID_R - 8 ? GRID_R - 8 : rl - 4);
    const int kr_lo = rs_first, nloc = LOCAL ? rs_last + 8 - rs_first : 0, nblk = nloc + NCH_C;
    const int skey = tid >> 3, sg8 = (tid & 7) * 8;
    const bf16_t* sbase = proj + (size_t)head * 64 + sg8;
    u32x4 kr0, vr0, kr1, vr1;
#define ATT_KROW(kb) ((kb) < nloc ? tok_row(true, b, (kr_lo + (kb)) * 64) : tok_row(false, b, ((kb) - nloc) * 64))
#define ATT_LOAD(kb, KR, VR) do { const bf16_t* pr_ = sbase + (size_t)(ATT_KROW(kb) + skey) * PROJ_N; KR = *(const u32x4*)(pr_ + C_NK); VR = *(const u32x4*)(pr_ + C_NV); } while (0)
#define ATT_STORE(bi, KR, VR) do { LAS bf16_t* d_ = kv + (bi) * BUF + skey * ST + sg8; *(LAS u32x4*)(d_) = KR; *(LAS u32x4*)(d_ + HB) = VR; } while (0)
    __syncthreads();
    ATT_LOAD(0, kr0, vr0);
    ATT_LOAD(1, kr1, vr1);
    if (LOCAL) for (int i = tid; i < 15 * 31; i += 512) rp[i] = p.in[13][((size_t)l * 8 + head) * 465 + i] * 1.44269504f;
    bf16x8 qf[NQT][2]; f32x4 o[NQT][4]; float mrun[NQT], lrun[NQT];
#pragma unroll
    for (int i = 0; i < NQT; ++i) { const bf16_t* qp = proj + (size_t)tok_row(LOCAL, b, (rw + i) * 64 + qc) * PROJ_N + C_NQ + head * 64;
        qf[i][0] = *(const bf16x8*)(qp + 8 * fq); qf[i][1] = *(const bf16x8*)(qp + 32 + 8 * fq); mrun[i] = -INFINITY; lrun[i] = 0.f;
#pragma unroll
        for (int vt = 0; vt < 4; ++vt) o[i][vt] = (f32x4){0.f, 0.f, 0.f, 0.f}; }
    ATT_STORE(0, kr0, vr0);
    ATT_LOAD(2, kr0, vr0);
    const int cs = qc - 8 < 0 ? 0 : (qc - 8 > 48 ? 48 : qc - 8);
    const int koff = qt == 0 ? 0 : (qt == 1 ? 8 : (qt == 2 ? 24 : 32));
    const int d0 = cs - koff - 4 * fq;
    const LAS float* rpl0 = rp + koff + 4 * fq - qc + 15;
    const int rs0 = rw - 4 < 0 ? 0 : (rw - 4 > GRID_R - 8 ? GRID_R - 8 : rw - 4), rs1 = rw - 3 < 0 ? 0 : (rw - 3 > GRID_R - 8 ? GRID_R - 8 : rw - 3);
    LDS_BARRIER();
#define ATT_ITER(kb, KR, VR) do { const int bi = (kb) & 1; \
        if ((kb) + 1 < nblk) ATT_STORE(bi ^ 1, KR, VR); \
        if ((kb) + 3 < nblk) ATT_LOAD((kb) + 3, KR, VR); \
        const LAS bf16_t* Kb = kv + bi * BUF; \
        const LAS bf16_t* Vl = kv + bi * BUF + HB + (4 * fq + (fr >> 2)) * ST + 4 * (fr & 3); \
        if ((kb) < nloc) { \
            const int krow = kr_lo + (kb); \
            const bool a0 = krow >= rs0 && krow < rs0 + 8, a1 = krow >= rs1 && krow < rs1 + 8; \
            if (a0 || a1) { \
                bf16x8 kf[2][2], vf[1][4]; \
                attn_ldkv<2>(Kb + koff * ST, lds_addr(Vl + koff * ST), kf, vf, fr, fq); \
                if (a0) attn_tile<2, true>(kf, vf, qf[0][0], qf[0][1], o[0], mrun[0], lrun[0], rpl0 + (krow - rw + 7) * 31, d0); \
                if (a1) attn_tile<2, true>(kf, vf, qf[1][0], qf[1][1], o[1], mrun[1], lrun[1], rpl0 + (krow - rw - 1 + 7) * 31, d0); \
            } \
        } else { \
            _Pragma("unroll") for (int hf = 0; hf < 2; ++hf) { \
                bf16x8 kf[2][2], vf[1][4]; \
                attn_ldkv<2>(Kb + 32 * hf * ST, lds_addr(Vl + 32 * hf * ST), kf, vf, fr, fq); \
                _Pragma("unroll") for (int i = 0; i < NQT; ++i) attn_tile<2, false>(kf, vf, qf[i][0], qf[i][1], o[i], mrun[i], lrun[i], rpl0, d0); } \
        } \
        LDS_BARRIER(); } while (0)
#pragma unroll 1
    for (int kb = 0; kb < nblk; kb += 2) {
        ATT_ITER(kb, kr1, vr1);
        if (kb + 1 < nblk) ATT_ITER(kb + 1, kr0, vr0);
    }
#undef ATT_ITER
#undef ATT_KROW
#undef ATT_LOAD
#undef ATT_STORE
#pragma unroll
    for (int i = 0; i < NQT; ++i) { const float lr = xrow16_sum(lrun[i]);
        const float inv = 1.0f / lr;
        bf16_t* yr = ymix + (size_t)tok_row(LOCAL, b, (rw + i) * 64 + qc) * D_ + 512 + head * 64;
#pragma unroll
        for (int vt = 0; vt < 4; ++vt) { u32x2 ov; ov[0] = pack2(o[i][vt][0] * inv, o[i][vt][1] * inv); ov[1] = pack2(o[i][vt][2] * inv, o[i][vt][3] * inv); *(u32x2*)(yr + 16 * vt + 4 * fq) = ov; } }
}

DEV void phase_mixer(const Params& p, int l, LAS unsigned char* lds) {
    const bool need_ctx = l < DEPTH_ - 1;
#ifndef REP_K
#define REP_K -1
#endif
#ifndef NO_SCAN
    for (int rep_ = 0; rep_ < ((REP_K == 20 || REP_K == 99) ? 2 : 1); ++rep_)
    for (int u = blockIdx.x; u < B_ * 8; u += gridDim.x) { if (u < B_ * 4) mlstm_unit(p, l, u >> 2, u & 3, lds); else gla_unit(p, l, (u - B_ * 4) >> 2, u & 3, lds); }
#endif
    static_assert(GRID_R % 4 == 0 && NCH_C == 4, "attention unit grouping");
    const int nloc = B_ * 8 * (GRID_R / 4), nctx = need_ctx ? B_ * 8 : 0;
#ifdef HOST_EMU
    for (int u = blockIdx.x; u < nloc + nctx; u += gridDim.x) {
        if (u < nloc) { const int rg = u % (GRID_R / 4), head = (u / (GRID_R / 4)) & 7, b = u / (GRID_R / 4 * 8); attn_unit<true>(p, l, b, head, rg * 4, lds); }
        else { const int q = u - nloc, head = q & 7, b = q >> 3; attn_unit<false>(p, l, b, head, 0, lds); }
    }
#else
    for (int rep_ = 0; rep_ < ((REP_K == 22 || REP_K == 99) ? 2 : 1); ++rep_) {
        unsigned* ctr = (unsigned*)(p.ws + WS_CTL) + XB_QUEUE + l * 2 + rep_;
        volatile LAS int* qs = (volatile LAS int*)(lds + LDS_BYTES - 32);
        const int tid = opaque_tid();
        __syncthreads();
        if (tid == 0) qs[0] = (int)atomicAdd(ctr, 1u);
        __syncthreads();
        int u = qs[0];
        while (u < nloc + nctx) {
            int pend = 0;
            if (tid == 0) pend = (int)atomicAdd(ctr, 1u);
            if (u < nloc) { const int rg = u % (GRID_R / 4), head = (u / (GRID_R / 4)) & 7, b = u / (GRID_R / 4 * 8); attn_unit<true>(p, l, b, head, rg * 4, lds); }
            else { const int q = u - nloc, head = q & 7, b = q >> 3; attn_unit<false>(p, l, b, head, 0, lds); }
            __syncthreads();
            if (tid == 0) qs[0] = pend;
            __syncthreads();
            u = qs[0];
        }
    }
#endif
}

DEV void ln_stats(const float (&v)[2][8], float& mu, float& rstd) {
    float s = 0.f;
#pragma unroll
    for (int i = 0; i < 2; ++i)
#pragma unroll
        for (int j = 0; j < 8; ++j) s += v[i][j];
    mu = wave_sum(s) * (1.0f / 1024.0f);
    float q = 0.f;
#pragma unroll
    for (int i = 0; i < 2; ++i)
#pragma unroll
        for (int j = 0; j < 8; ++j) { const float d = v[i][j] - mu; q += d * d; }
    rstd = 1.0f / sqrtf(wave_sum(q) * (1.0f / 1024.0f) + LN_EPS);
}
DEV void ln_apply(float (&v)[2][8], float mu, float rstd, const float* g, const float* bta, int lane) {
#pragma unroll
    for (int i = 0; i < 2; ++i) { const int c = lane * 8 + i * 512; const f32x4 ga = *(const f32x4*)(g + c), gb2 = *(const f32x4*)(g + c + 4), ba = *(const f32x4*)(bta + c), bb2 = *(const f32x4*)(bta + c + 4);
#pragma unroll
        for (int j = 0; j < 8; ++j) v[i][j] = (v[i][j] - mu) * rstd * (j < 4 ? ga[j] : gb2[j - 4]) + (j < 4 ? ba[j] : bb2[j - 4]); }
}
struct LnPar { f32x4 g[2][2], b[2][2]; };
DEV void ln_par_load(LnPar& P, const float* g, const float* bta, int lane) {
#pragma unroll
    for (int i = 0; i < 2; ++i) { const int c = lane * 8 + i * 512; P.g[i][0] = *(const f32x4*)(g + c); P.g[i][1] = *(const f32x4*)(g + c + 4); P.b[i][0] = *(const f32x4*)(bta + c); P.b[i][1] = *(const f32x4*)(bta + c + 4); }
}
DEV void ln_apply(float (&v)[2][8], float mu, float rstd, const LnPar& P) {
#pragma unroll
    for (int i = 0; i < 2; ++i)
#pragma unroll
        for (int j = 0; j < 8; ++j) v[i][j] = (v[i][j] - mu) * rstd * (j < 4 ? P.g[i][0][j] : P.g[i][1][j - 4]) + (j < 4 ? P.b[i][0][j] : P.b[i][1][j - 4]);
}
DEV void ln_row(float (&v)[2][8], const LnPar& P) {
    float s = 0.f;
#pragma unroll
    for (int i = 0; i < 2; ++i)
#pragma unroll
        for (int j = 0; j < 8; ++j) s += v[i][j];
    const float mu = wave_sum(s) * (1.0f / 1024.0f);
    float q = 0.f;
#pragma unroll
    for (int i = 0; i < 2; ++i)
#pragma unroll
        for (int j = 0; j < 8; ++j) { v[i][j] -= mu; q += v[i][j] * v[i][j]; }
    const float rstd = 1.0f / sqrtf(wave_sum(q) * (1.0f / 1024.0f) + LN_EPS);
#pragma unroll
    for (int i = 0; i < 2; ++i)
#pragma unroll
        for (int j = 0; j < 8; ++j) v[i][j] = v[i][j] * rstd * (j < 4 ? P.g[i][0][j] : P.g[i][1][j - 4]) + (j < 4 ? P.b[i][0][j] : P.b[i][1][j - 4]);
}
DEV void ln_row(float (&v)[2][8], const float* g, const float* bta, int lane) {
    float s = 0.f;
#pragma unroll
    for (int i = 0; i < 2; ++i)
#pragma unroll
        for (int j = 0; j < 8; ++j) s += v[i][j];
    const float mu = wave_sum(s) * (1.0f / 1024.0f);
    float q = 0.f;
#pragma unroll
    for (int i = 0; i < 2; ++i)
#pragma unroll
        for (int j = 0; j < 8; ++j) { v[i][j] -= mu; q += v[i][j] * v[i][j]; }
    const float rstd = 1.0f / sqrtf(wave_sum(q) * (1.0f / 1024.0f) + LN_EPS);
#pragma unroll
    for (int i = 0; i < 2; ++i) { const int c = lane * 8 + i * 512; const f32x4 ga = *(const f32x4*)(g + c), gb2 = *(const f32x4*)(g + c + 4), ba = *(const f32x4*)(bta + c), bb2 = *(const f32x4*)(bta + c + 4);
#pragma unroll
        for (int j = 0; j < 8; ++j) v[i][j] = v[i][j] * rstd * (j < 4 ? ga[j] : gb2[j - 4]) + (j < 4 ? ba[j] : bb2[j - 4]); }
}

DEV void phase_ln1_router(const Params& p, int l, LAS unsigned char* lds) {
    LAS float* wrT = (LAS float*)lds;
    const int tid = opaque_tid(), lane = tid & 63, gw = blockIdx.x * 8 + (tid >> 6), nw = gridDim.x * 8;
    const int ntok = l < DEPTH_ - 1 ? NTOK : NL;
    const float* wr = p.in[17] + (size_t)l * 1024 * 16;
    __syncthreads();
    for (int i = tid; i < 16 * 1024; i += 512) { const int k = i >> 4, e = i & 15; wrT[e * 1024 + k] = wr[i]; }
    __syncthreads();
    const float* mods = (const float*)(p.ws + WS_MODS) + (size_t)l * (B_ + 1) * 6144;
    bf16_t* ub = (bf16_t*)(p.ws + WS_U); float* aff = (float*)(p.ws + WS_AFF);
    const bf16_t* xh = (const bf16_t*)(p.ws + WS_XH); bf16_t* x1h = (bf16_t*)(p.ws + WS_X1H); const bf16_t* yo = (const bf16_t*)(p.ws + WS_YO);
    const float alpha = sqrtf(sqrtf((float)(2 * DEPTH_)));
    const float* lg = p.in[15] + (size_t)l * 1024; const float* lb = p.in[16] + (size_t)l * 1024;
    constexpr int NR = 4;
    static_assert(T_ % NR == 0 && TC_ % NR == 0, "row groups stay inside one sample");
    for (int grp = gw; grp * NR < ntok; grp += nw) {
        const int row0 = grp * NR;
        u32x4 xraw[NR][2], yraw[NR][2];
#pragma unroll
        for (int r = 0; r < NR; ++r) { const int rw = row0 + r;
#pragma unroll
            for (int i = 0; i < 2; ++i) { const int c = lane * 8 + i * 512;
                yraw[r][i] = ld_stream((const u32x4*)(yo + (size_t)rw * D_ + c));
                xraw[r][i] = (u32x4){0u, 0u, 0u, 0u}; if (l != 0) xraw[r][i] = ld_stream((const u32x4*)(xh + (size_t)rw * D_ + c)); } }
        const bool isl = row0 < NL; const int bb = isl ? row0 / T_ : B_;
        const float* md = mods + (size_t)bb * 6144;
        f32x4 mg[2][2], msc[2][2], msh[2][2];
#pragma unroll
        for (int i = 0; i < 2; ++i) { const int c = lane * 8 + i * 512;
            mg[i][0] = *(const f32x4*)(md + 2048 + c); mg[i][1] = *(const f32x4*)(md + 2048 + c + 4);
            msc[i][0] = *(const f32x4*)(md + 4096 + c) + 1.0f; msc[i][1] = *(const f32x4*)(md + 4096 + c + 4) + 1.0f;
            msh[i][0] = *(const f32x4*)(md + 3072 + c); msh[i][1] = *(const f32x4*)(md + 3072 + c + 4); }
        f32x2 up[NR / 2][2][8];
#pragma unroll
        for (int r = 0; r < NR; ++r) {
            const int row = row0 + r;
            float uu[2][8];
            {
                float v[2][8];
#pragma unroll
                for (int i = 0; i < 2; ++i) { const int c = lane * 8 + i * 512; float xv[8];
                    if (l == 0) { const float* xr = isl ? p.in[0] + (size_t)row * D_ : p.in[2] + (size_t)(row - NL) * D_; const f32x4 a = *(const f32x4*)(xr + c), b2 = *(const f32x4*)(xr + c + 4);
#pragma unroll
                        for (int j = 0; j < 4; ++j) { xv[j] = a[j]; xv[4 + j] = b2[j]; } }
                    else unpack8_h(xraw[r][i], xv);
                    const u32x4 yv = yraw[r][i];
#pragma unroll
                    for (int j = 0; j < 4; ++j) { v[i][j] = alpha * xv[j] + mg[i][0][j] * ((j & 1) ? bfhi(yv[j >> 1]) : bflo(yv[j >> 1])); v[i][4 + j] = alpha * xv[4 + j] + mg[i][1][j] * ((j & 1) ? bfhi(yv[2 + (j >> 1)]) : bflo(yv[2 + (j >> 1)])); } }
                float mu, rstd; ln_stats(v, mu, rstd);
                ln_apply(v, mu, rstd, lg, lb, lane);
#pragma unroll
                for (int i = 0; i < 2; ++i) { const int c = lane * 8 + i * 512;
                    st_stream((u32x4*)(x1h + (size_t)row * D_ + c), pack8_h(v[i]));
#pragma unroll
                    for (int j = 0; j < 8; ++j) uu[i][j] = v[i][j] * (j < 4 ? msc[i][0][j] : msc[i][1][j - 4]) + (j < 4 ? msh[i][0][j] : msh[i][1][j - 4]);
#if MOE_F8
                    u32x2 o; o[0] = pack4_f8(uu[i][0], uu[i][1], uu[i][2], uu[i][3]); o[1] = pack4_f8(uu[i][4], uu[i][5], uu[i][6], uu[i][7]);
                    st_stream((u32x2*)((unsigned char*)ub + (size_t)row * D_ + c), o); }
#else
                    u32x4 o; o[0] = pack2(uu[i][0], uu[i][1]); o[1] = pack2(uu[i][2], uu[i][3]); o[2] = pack2(uu[i][4], uu[i][5]); o[3] = pack2(uu[i][6], uu[i][7]);
                    *(u32x4*)(ub + (size_t)row * D_ + c) = o; }
#endif
            }
#pragma unroll
            for (int i = 0; i < 2; ++i)
#pragma unroll
                for (int j = 0; j < 8; ++j) up[r >> 1][i][j][r & 1] = uu[i][j];
            SCHED_BAR();
        }
#ifndef HOST_EMU
        asm volatile("" ::: "memory");
#endif
        float p8a[NR][8];
#pragma unroll
        for (int j = 0; j < 8; ++j) { f32x2 pe[NR / 2][2];
#pragma unroll
            for (int hh = 0; hh < 2; ++hh) { const int e = j + 8 * hh; f32x2 acc[NR / 2];
#pragma unroll
                for (int q = 0; q < NR / 2; ++q) acc[q] = (f32x2){0.f, 0.f};
#pragma unroll
                for (int i = 0; i < 2; ++i) { const int c = lane * 8 + i * 512; const f32x4 w0 = *(const LAS f32x4*)(wrT + e * 1024 + c), w1 = *(const LAS f32x4*)(wrT + e * 1024 + c + 4);
#pragma unroll
                    for (int q = 0; q < NR / 2; ++q) {
                        acc[q] += up[q][i][0] * w0[0]; acc[q] += up[q][i][1] * w0[1]; acc[q] += up[q][i][2] * w0[2]; acc[q] += up[q][i][3] * w0[3];
                        acc[q] += up[q][i][4] * w1[0]; acc[q] += up[q][i][5] * w1[1]; acc[q] += up[q][i][6] * w1[2]; acc[q] += up[q][i][7] * w1[3]; } }
#pragma unroll
                for (int q = 0; q < NR / 2; ++q) pe[q][hh] = acc[q]; }
#pragma unroll
            for (int q = 0; q < NR / 2; ++q) { p8a[2 * q][j] = xsum32(pe[q][0][0], pe[q][1][0]); p8a[2 * q + 1][j] = xsum32(pe[q][0][1], pe[q][1][1]); } }
#pragma unroll
        for (int r = 0; r < NR; ++r) {
            const int row = row0 + r;
            float p4[4], p2[2];
#pragma unroll
            for (int j = 0; j < 4; ++j) p4[j] = xsum16(p8a[r][j], p8a[r][4 + j]);
#pragma unroll
            for (int j = 0; j < 2; ++j) p2[j] = xsum8(p4[j], p4[2 + j], lane);
            float mine = quad_sum(xsum4(p2[0], p2[1], lane));
            const float mx = wave_max(mine);
            mine = expf(mine - mx);
            const float sm = wave_sum(mine) * 0.25f;
            if (row < ntok && (lane & 3) == 0) aff[(size_t)row * 16 + (lane >> 2)] = mine / sm;
        }
    }
}

#ifdef HOST_EMU
static inline void lds_inc(unsigned* p) { (*p)++; }
#else
DEV void lds_inc(LAS unsigned* p) { __hip_atomic_fetch_add(p, 1u, __ATOMIC_RELAXED, __HIP_MEMORY_SCOPE_WORKGROUP); }
#endif
DEV void phase_topk(const Params& p, int l, LAS unsigned char* lds) {
    LAS unsigned* keys = (LAS unsigned*)lds;
    LAS unsigned* hist = keys + T_;
    LAS unsigned* misc = hist + 256;
    const int tid = opaque_tid(), lane = tid & 63, w = tid >> 6;
    const bool need_ctx = l < DEPTH_ - 1;
    const float* aff = (const float*)(p.ws + WS_AFF); int* slot = (int*)(p.ws + WS_SLOT); int* rowtab = (int*)(p.ws + WS_ROWTAB);
    const int nun = B_ * 16 * (need_ctx ? 2 : 1);
    for (int u = blockIdx.x; u < nun; u += gridDim.x) {
        const bool lat = u < B_ * 16; const int q = lat ? u : u - B_ * 16, b = q >> 4, e = q & 15;
        const int n = lat ? T_ : TC_, cap = lat ? CAP_L : CAP_C, row0 = tok_row(lat, b, 0);
        __syncthreads();
        unsigned kv[4];
#pragma unroll
        for (int j = 0; j < 4; ++j) { const int t = tid * 4 + j; kv[j] = t < n ? f_as_u(aff[(size_t)(row0 + t) * 16 + e]) : 0u; }
        unsigned prefix = 0u, remaining = (unsigned)cap;
#pragma unroll 1
        for (int pass = 0; pass < 4; ++pass) {
            const int shift = 24 - 8 * pass;
            if (tid < 256) hist[tid] = 0u;
            __syncthreads();
#pragma unroll
            for (int j = 0; j < 4; ++j) { const int t = tid * 4 + j;
                if (t < n && (pass == 0 || (kv[j] >> (shift + 8)) == prefix)) lds_inc(&hist[(kv[j] >> shift) & 255u]); }
            __syncthreads();
            if (w == 0) {
                const unsigned h0 = hist[4 * lane], h1 = hist[4 * lane + 1], h2 = hist[4 * lane + 2], h3 = hist[4 * lane + 3];
                const unsigned sl = h0 + h1 + h2 + h3;
                unsigned S = sl;
                for (int d = 1; d < 64; d <<= 1) { const unsigned o = (unsigned)shfl_idx_i((int)S, lane + d < 64 ? lane + d : lane); if (lane + d < 64) S += o; }
                const unsigned above = S - sl;
                if (above < remaining && remaining <= S) {
                    unsigned acc = above; int bin;
                    if (acc + h3 >= remaining) { bin = 3; } else { acc += h3; if (acc + h2 >= remaining) { bin = 2; } else { acc += h2; if (acc + h1 >= remaining) { bin = 1; } else { acc += h1; bin = 0; } } }
                    misc[0] = (unsigned)(4 * lane + bin); misc[1] = remaining - acc; }
            }
            __syncthreads();
            prefix = (prefix << 8) | misc[0]; remaining = misc[1];
        }
        unsigned cnt = 0u;
#pragma unroll
        for (int j = 0; j < 4; ++j) { const int t = tid * 4 + j; if (t < n) cnt += (kv[j] > prefix ? 1u : 0u) + (kv[j] == prefix ? 65536u : 0u); }
        unsigned inc = cnt;
        for (int d = 1; d < 64; d <<= 1) { const unsigned o2 = (unsigned)shfl_idx_i((int)inc, lane >= d ? lane - d : lane); if (lane >= d) inc += o2; }
        if (lane == 63) misc[8 + w] = inc;
        __syncthreads();
        unsigned base = 0u, total = 0u;
#pragma unroll
        for (int ww = 0; ww < 8; ++ww) { const unsigned tw = misc[8 + ww]; if (ww < w) base += tw; total += tw; }
        unsigned run = base + inc - cnt;
        const unsigned ngt = total & 0xFFFFu;
#pragma unroll
        for (int j = 0; j < 4; ++j) { const int t = tid * 4 + j;
            if (t < n) { const bool gt = kv[j] > prefix, eq = kv[j] == prefix; const unsigned rg = run & 0xFFFFu, re = run >> 16;
                int sl = -1;
                if (gt) sl = (int)rg; else if (eq && re < remaining) sl = (int)(ngt + re);
                slot[(size_t)(row0 + t) * 16 + e] = sl;
                if (sl >= 0) rowtab[e * MROWS + (lat ? b * CAP_L + sl : ROWS_L + b * CAP_C + sl)] = row0 + t;
                run += (gt ? 1u : 0u) + (eq ? 65536u : 0u); } }
    }
    { const int used = need_ctx ? ROWS_L + ROWS_C : ROWS_L; const int mr = need_ctx ? MROWS : MROWS_LAST;
      if (blockIdx.x == gridDim.x - 1) for (int i = tid; i < 16 * (mr - used); i += 512) { const int e = i / (mr - used), r = used + i % (mr - used); rowtab[e * MROWS + r] = 0; } }
}

DEV void phase_combine(const Params& p, int l) {
    const int tid = opaque_tid(), lane = tid & 63, gw = blockIdx.x * 8 + (tid >> 6), nw = gridDim.x * 8;
    const bool need_ctx = l < DEPTH_ - 1; const int ntok = need_ctx ? NTOK : NL;
    const float* mods = (const float*)(p.ws + WS_MODS) + (size_t)l * (B_ + 1) * 6144;
    const float* modn = mods + (size_t)(B_ + 1) * 6144;
    const bf16_t* x1h = (const bf16_t*)(p.ws + WS_X1H); bf16_t* xh = (bf16_t*)(p.ws + WS_XH); bf16_t* ub = (bf16_t*)(p.ws + WS_U);
    const float* aff = (const float*)(p.ws + WS_AFF); const int* slot = (const int*)(p.ws + WS_SLOT); const bf16_t* yexp = (const bf16_t*)(p.ws + WS_YEXP);
    const float* lg = p.in[21] + (size_t)l * 1024; const float* lb = p.in[22] + (size_t)l * 1024;
    const float alpha = sqrtf(sqrtf((float)(2 * DEPTH_)));
    static_assert(T_ % 2 == 0 && TC_ % 2 == 0 && NL % 2 == 0, "row pairs stay inside one sample");
    int slot_n[2]; float aff_n[2];
#pragma unroll
    for (int r = 0; r < 2; ++r) { const int row = 2 * gw + r; slot_n[r] = -1; aff_n[r] = 0.f;
        if (row < ntok && lane < 16) { slot_n[r] = slot[(size_t)row * 16 + lane]; aff_n[r] = aff[(size_t)row * 16 + lane]; } }
    for (int row0 = 2 * gw; row0 < ntok; row0 += 2 * nw) {
        int myslot[2]; float myaff[2]; int rbase[2]; unsigned em[2];
        float v[2][2][8], f[2][2][8];
#pragma unroll
        for (int r = 0; r < 2; ++r) { const int row = row0 + r; const bool act = row < ntok; const int rw = act ? row : row0;
            const bool isl = rw < NL; const int bidx = isl ? rw / T_ : (rw - NL) / TC_;
            rbase[r] = isl ? bidx * CAP_L : ROWS_L + bidx * CAP_C;
            myslot[r] = slot_n[r]; myaff[r] = aff_n[r];
            { const int rown = row + 2 * nw; slot_n[r] = -1; aff_n[r] = 0.f; if (rown < ntok && lane < 16) { slot_n[r] = slot[(size_t)rown * 16 + lane]; aff_n[r] = aff[(size_t)rown * 16 + lane]; } }
#pragma unroll
            for (int i = 0; i < 2; ++i) unpack8_h(ld_stream((const u32x4*)(x1h + (size_t)rw * D_ + lane * 8 + i * 512)), v[r][i]);
#pragma unroll
            for (int i = 0; i < 2; ++i)
#pragma unroll
                for (int j = 0; j < 8; ++j) f[r][i][j] = 0.f;
            unsigned m_ = 0u;
#pragma unroll
            for (int e = 0; e < 16; ++e) m_ |= (rdlane_i(myslot[r], e) >= 0 ? 1u : 0u) << e;
            em[r] = act ? m_ : 0u; }
        while (em[0] | em[1]) {
#if MOE_F8 && YEXP_F8
            u32x2 yv[2][4][2]; float ga[2][4];
#pragma unroll
            for (int r = 0; r < 2; ++r)
#pragma unroll
                for (int k = 0; k < 4; ++k) { const bool ok = em[r] != 0u; const int ee = ok ? __builtin_ctz(em[r]) : 0; em[r] &= em[r] - 1u;
                    const int sl = rdlane_i(myslot[r], ee); ga[r][k] = ok ? rdlane_f(myaff[r], ee) * (1.0f / F8_SY) : 0.f;
                    const unsigned char* yr = (const unsigned char*)yexp + ((size_t)ee * MROWS + rbase[r] + (sl > 0 ? sl : 0)) * D_;
                    yv[r][k][0] = ld_stream((const u32x2*)(yr + lane * 8)); yv[r][k][1] = ld_stream((const u32x2*)(yr + lane * 8 + 512)); }
#pragma unroll
            for (int r = 0; r < 2; ++r)
#pragma unroll
                for (int k = 0; k < 4; ++k)
#pragma unroll
                    for (int i = 0; i < 2; ++i)
#pragma unroll
                        for (int j = 0; j < 2; ++j) { const f32x2 lo = __builtin_amdgcn_cvt_pk_f32_fp8((int)yv[r][k][i][j], false), hi = __builtin_amdgcn_cvt_pk_f32_fp8((int)yv[r][k][i][j], true);
                            f[r][i][4 * j] += ga[r][k] * lo[0]; f[r][i][4 * j + 1] += ga[r][k] * lo[1]; f[r][i][4 * j + 2] += ga[r][k] * hi[0]; f[r][i][4 * j + 3] += ga[r][k] * hi[1]; }
#else
            u32x4 yv[2][4][2]; float ga[2][4];
#pragma unroll
            for (int r = 0; r < 2; ++r)
#pragma unroll
                for (int k = 0; k < 4; ++k) { const bool ok = em[r] != 0u; const int ee = ok ? __builtin_ctz(em[r]) : 0; em[r] &= em[r] - 1u;
                    const int sl = rdlane_i(myslot[r], ee); ga[r][k] = ok ? rdlane_f(myaff[r], ee) : 0.f;
                    const bf16_t* yr = yexp + ((size_t)ee * MROWS + rbase[r] + (sl > 0 ? sl : 0)) * D_;
                    yv[r][k][0] = *(const u32x4*)(yr + lane * 8); yv[r][k][1] = *(const u32x4*)(yr + lane * 8 + 512); }
#pragma unroll
            for (int r = 0; r < 2; ++r)
#pragma unroll
                for (int k = 0; k < 4; ++k)
#pragma unroll
                    for (int i = 0; i < 2; ++i)
#pragma unroll
                        for (int j = 0; j < 4; ++j) { f[r][i][2 * j] += ga[r][k] * bflo(yv[r][k][i][j]); f[r][i][2 * j + 1] += ga[r][k] * bfhi(yv[r][k][i][j]); }
#endif
        }
        {
            const bool isl0 = row0 < NL; const int bb0 = isl0 ? row0 / T_ : B_;
            const float* md = mods + (size_t)bb0 * 6144; const float* mn = modn + (size_t)bb0 * 6144;
            f32x4 mg2[2][2], nsc[2][2], nsh[2][2];
            LnPar lnp; ln_par_load(lnp, lg, lb, lane);
#pragma unroll
            for (int i = 0; i < 2; ++i) { const int c = lane * 8 + i * 512;
                mg2[i][0] = *(const f32x4*)(md + 5120 + c); mg2[i][1] = *(const f32x4*)(md + 5120 + c + 4);
                if (need_ctx) { nsc[i][0] = *(const f32x4*)(mn + 1024 + c) + 1.0f; nsc[i][1] = *(const f32x4*)(mn + 1024 + c + 4) + 1.0f; nsh[i][0] = *(const f32x4*)(mn + c); nsh[i][1] = *(const f32x4*)(mn + c + 4); }
                else { nsc[i][0] = nsc[i][1] = nsh[i][0] = nsh[i][1] = (f32x4){0.f, 0.f, 0.f, 0.f}; } }
#pragma unroll
            for (int r = 0; r < 2; ++r) { const int row = row0 + r;
                if (row < ntok) {
#pragma unroll
                    for (int i = 0; i < 2; ++i)
#pragma unroll
                        for (int j = 0; j < 4; ++j) { v[r][i][j] = alpha * v[r][i][j] + mg2[i][0][j] * f[r][i][j]; v[r][i][4 + j] = alpha * v[r][i][4 + j] + mg2[i][1][j] * f[r][i][4 + j]; }
                    ln_row(v[r], lnp);
#pragma unroll
                    for (int i = 0; i < 2; ++i) { const int c = lane * 8 + i * 512;
                        if (!need_ctx) { float* xw = p.out + (size_t)row * D_; *(f32x4*)(xw + c) = (f32x4){v[r][i][0], v[r][i][1], v[r][i][2], v[r][i][3]}; *(f32x4*)(xw + c + 4) = (f32x4){v[r][i][4], v[r][i][5], v[r][i][6], v[r][i][7]}; }
                        else {
                            st_stream((u32x4*)(xh + (size_t)row * D_ + c), pack8_h(v[r][i]));
                            float uu[8];
#pragma unroll
                            for (int j = 0; j < 8; ++j) uu[j] = v[r][i][j] * (j < 4 ? nsc[i][0][j] : nsc[i][1][j - 4]) + (j < 4 ? nsh[i][0][j] : nsh[i][1][j - 4]);
                            u32x4 o; o[0] = pack2(uu[0], uu[1]); o[1] = pack2(uu[2], uu[3]); o[2] = pack2(uu[4], uu[5]); o[3] = pack2(uu[6], uu[7]);
                            *(u32x4*)(ub + (size_t)row * D_ + c) = o; } }
                }
            }
        }
    }
}

__global__ void __launch_bounds__(512, 2) fwd(Params p) {
#ifdef HOST_EMU
    unsigned char* smem = emu::tls.dynsmem;
#else
    extern __shared__ __attribute__((aligned(16))) unsigned char smem_raw[];
    LAS unsigned char* smem = (LAS unsigned char*)smem_raw;
#endif
#ifdef HOST_EMU
    XcdBarrier bar = xcd_barrier_post(nullptr, nullptr);
#else
    volatile LAS unsigned* xbw = (volatile LAS unsigned*)(smem + LDS_BYTES - 16);
    if (threadIdx.x == 0) { xbw[0] = 0u; xbw[1] = 0u; xbw[2] = 0u; xbw[3] = 0u; }
    __syncthreads();
    XcdBarrier bar = xcd_barrier_post((unsigned*)(p.ws + WS_CTL), xbw);
#endif
#define SEAM(id) if ((id) > p.ph_lo && (id) < p.ph_hi) { xcd_barrier(bar); if (REP_K == 30) xcd_barrier(bar); }
#ifndef REP_K
#define REP_K -1
#endif
#define REPEAT(k) for (int rep_ = 0; rep_ < ((REP_K == (k) || REP_K == 99) ? 2 : 1); ++rep_)
#define REPBAR() if (rep_) xcd_barrier(bar)
#ifndef PH_MASK
#define PH_MASK 0xFFFF
#endif
#define RUN(id) if ((id) >= p.ph_lo && (id) < p.ph_hi)
#define RUNK(k) if (((PH_MASK >> (k)) & 1) && (base + (k)) >= p.ph_lo && (base + (k)) < p.ph_hi)
    if ((PH_MASK >> 15) & 1) RUN(0) REPEAT(15) { REPBAR(); phase_mods(p, smem); }
    const float alpha = sqrtf(sqrtf((float)(2 * DEPTH_)));
    for (int l = 0; l < DEPTH_; ++l) {
        const int base = 1 + l * NPH;
        const bool need_ctx = l < DEPTH_ - 1;
        SEAM(base + 0); RUNK(0) REPEAT(0) { REPBAR(); phase_convert(p, l, smem); }
        SEAM(base + 1); RUNK(1) REPEAT(1) { REPBAR();
            pg8::Gemm g; g.A = (const bf16_t*)(p.ws + WS_U); g.Bt = (const bf16_t*)(p.ws + WS_BTIN); g.K = D_; g.rowtab = nullptr;
            pg8::Order S; S.init(1, NTOK / 256, NTOK / 256, PROJ_NP / 256, gridDim.x, blockIdx.x);
            EpiProj E; E.proj = (bf16_t*)(p.ws + WS_R1 + R1_PROJ); E.gates = (float*)(p.ws + WS_R1 + R1_GATES); E.bias = (const float*)(p.ws + WS_BIAS);
            pg8::gemm_phase<EpiProj, false>(smem, g, S, E);
        }
        SEAM(base + 2); RUNK(2) REPEAT(2) { REPBAR(); phase_mixer(p, l, smem); }
        SEAM(base + 4); RUNK(4) REPEAT(4) { REPBAR();
            pg8::Gemm g; g.A = (const bf16_t*)(p.ws + WS_YMIX); g.Bt = (const bf16_t*)(p.ws + WS_BTOUT); g.K = D_; g.rowtab = nullptr;
            const int mt = (need_ctx ? NTOK : NL) / 256;
            pg8::Order S; S.init(1, mt, mt, D_ / 256, gridDim.x, blockIdx.x);
            EpiDown<false> E; E.y = (bf16_t*)(p.ws + WS_YO); E.sc = 1.0f;
            pg8::gemm_phase<EpiDown<false>, false>(smem, g, S, E);
        }
        SEAM(base + 5); RUNK(5) REPEAT(5) { REPBAR(); phase_ln1_router(p, l, smem); }
        SEAM(base + 6); RUNK(6) REPEAT(6) { REPBAR(); phase_topk(p, l, smem); }
        SEAM(base + 7); RUNK(7) REPEAT(7) { REPBAR();
            pg8::Gemm g; g.A = (const bf16_t*)(p.ws + WS_U); g.Bt = (const bf16_t*)(p.ws + WS_BTGU); g.K = MOE_F8 ? D_ / 2 : D_; g.rowtab = (const int*)(p.ws + WS_ROWTAB);
            pg8::Order S; S.init(NE, (need_ctx ? MROWS : MROWS_LAST) / 256, MROWS / 256, 2 * FF / 256, gridDim.x, blockIdx.x);
            EpiSwiglu E; E.h = (bf16_t*)(p.ws + WS_R1);
            pg8::gemm_phase<EpiSwiglu, true, MOE_F8 != 0>(smem, g, S, E);
        }
        SEAM(base + 8); RUNK(8) REPEAT(8) { REPBAR();
            pg8::Gemm g; g.A = (const bf16_t*)(p.ws + WS_R1); g.Bt = (const bf16_t*)(p.ws + WS_BTDN); g.K = MOE_F8 ? FF / 2 : FF; g.rowtab = nullptr;
            pg8::Order S; S.init(NE, (need_ctx ? MROWS : MROWS_LAST) / 256, MROWS / 256, D_ / 256, gridDim.x, blockIdx.x);
            EpiDown<(MOE_F8 && YEXP_F8)> E; E.y = (bf16_t*)(p.ws + WS_YEXP);
#if MOE_F8
            E.sc = (YEXP_F8 ? F8_SY : 1.0f) / (F8_SH * F8_SW2);
#else
            E.sc = 1.0f;
#endif
            pg8::gemm_phase<EpiDown<(MOE_F8 && YEXP_F8)>, false, MOE_F8 != 0>(smem, g, S, E);
        }
        SEAM(base + 9); RUNK(9) REPEAT(9) { REPBAR(); phase_combine(p, l); }
    }
}

extern "C" void kernel_launch(void* const* d_in, const int* in_sizes, int n_in, void* d_out, int out_size, void* d_ws, size_t ws_size, hipStream_t stream) {
    static int grid = 0;
    if (grid == 0) {
        if (n_in != 23 || out_size != NL * D_ || ws_size < WS_END) { fprintf(stderr, "kernel_launch: bad shapes: n_in %d out %d ws %zu (need %zu)\n", n_in, out_size, ws_size, (size_t)WS_END); grid = -1; return; }
        int dev = 0, cus = 0;
        if (hipGetDevice(&dev) != hipSuccess || hipDeviceGetAttribute(&cus, hipDeviceAttributeMultiprocessorCount, dev) != hipSuccess) { grid = -1; return; }
        if (hipFuncSetAttribute((const void*)fwd, hipFuncAttributeMaxDynamicSharedMemorySize, LDS_BYTES) != hipSuccess) { fprintf(stderr, "kernel_launch: hipFuncSetAttribute failed\n"); grid = -1; return; }
        (void)hipGetLastError();
        grid = cus;
    }
    if (grid < 0) return;
#ifdef HOST_EMU
    g_emu_bar.store(0);
#endif
    (void)hipMemsetAsync((char*)d_ws + WS_CTL, 0, WS_CTL_BYTES, stream);
    Params p{};
    for (int i = 0; i < 23; ++i) p.in[i] = (const float*)d_in[i];
    p.out = (float*)d_out; p.ws = (unsigned char*)d_ws;
#if ONE_LAUNCH
    p.ph_lo = 0; p.ph_hi = NPHASES;
#ifdef HOST_EMU
    if (getenv("EMU_PH_HI")) p.ph_hi = atoi(getenv("EMU_PH_HI"));
#endif
    hipLaunchKernelGGL(fwd, dim3(grid), dim3(512), LDS_BYTES, stream, p);
#else
    int nph = NPHASES;
#ifdef HOST_EMU
    if (getenv("EMU_PH_HI")) nph = atoi(getenv("EMU_PH_HI"));
#endif
    for (int ph = 0; ph < nph; ++ph) { p.ph_lo = ph; p.ph_hi = ph + 1; hipLaunchKernelGGL(fwd, dim3(grid), dim3(512), LDS_BYTES, stream, p); }
#endif
}
```

```cpp
#ifdef HOST_EMU
#include "emu.h"
#else
#include <hip/hip_runtime.h>
#include <cstdio>
#include <cstdint>
#endif

#ifndef CFG_BATCH
#define CFG_BATCH 32
#define CFG_SEQ 2048
#define CFG_CTX 256
#define CFG_DEPTH 4
#endif
#ifndef ONE_LAUNCH
#define ONE_LAUNCH 1
#endif
#ifndef MOE_F8
#ifdef HOST_EMU
#define MOE_F8 0
#else
#define MOE_F8 1
#endif
#endif
#ifndef YEXP_F8
#define YEXP_F8 1
#endif

#define DEV __device__ __forceinline__
typedef unsigned short bf16_t;
typedef short bf16x8 __attribute__((ext_vector_type(8)));
typedef short bf16x4 __attribute__((ext_vector_type(4)));
typedef float f32x4 __attribute__((ext_vector_type(4)));
typedef float f32x2 __attribute__((ext_vector_type(2)));
typedef unsigned u32x4 __attribute__((ext_vector_type(4)));
typedef unsigned u32x2 __attribute__((ext_vector_type(2)));
typedef int i32x8 __attribute__((ext_vector_type(8)));

constexpr int B_ = CFG_BATCH, T_ = CFG_SEQ, TC_ = CFG_CTX, DEPTH_ = CFG_DEPTH;
constexpr int D_ = 1024, NL = B_ * T_, NC = B_ * TC_, NTOK = NL + NC;
constexpr int PROJ_W0 = 3376, PROJ_N = 3328, PROJ_NP = 3584, NG = 48;
constexpr int FF = 2048, NE = 16;
constexpr int CAP_L = 2 * T_ / NE, CAP_C = 2 * TC_ / NE;
constexpr int ROWS_L = B_ * CAP_L, ROWS_C = B_ * CAP_C;
constexpr int MROWS = ((ROWS_L + ROWS_C + 255) / 256) * 256;
constexpr int MROWS_LAST = ((ROWS_L + 255) / 256) * 256;
constexpr int NCH_C = TC_ / 64, NCH_L = T_ / 64, NCH = NCH_C + NCH_L;
constexpr int GRID_R = T_ / 64;
constexpr float LN_EPS = 1e-5f;
constexpr int C_MQ = 0, C_MK = 256, C_MV = 512, C_MO = 768, C_GQ = 1024, C_GK = 1152, C_GV = 1280, C_GR = 1536, C_NQ = 1792, C_NK = 2304, C_NV = 2816;
static_assert(T_ % 256 == 0 && TC_ % 256 == 0 && NL % 256 == 0 && NC % 256 == 0, "shape");
static_assert(GRID_R >= 8, "rows");

constexpr size_t al256(size_t x) { return (x + 255) & ~(size_t)255; }
constexpr size_t WS_CTL = 0;
constexpr size_t WS_CTL_BYTES = 16384;
constexpr size_t WS_MODS = WS_CTL + WS_CTL_BYTES;
constexpr size_t WS_ROPE = WS_MODS + al256((size_t)DEPTH_ * (B_ + 1) * 6144 * 4);
constexpr size_t WS_BIAS = WS_ROPE + al256((64 * 16 * 2 + 64 * 8 * 2) * 4);
constexpr size_t WS_BTIN = WS_BIAS + al256(PROJ_NP * 4);
constexpr size_t WS_BTOUT = WS_BTIN + al256((size_t)PROJ_NP * D_ * 2);
constexpr size_t WBYTES = MOE_F8 ? 1 : 2;
constexpr size_t WS_BTGU = WS_BTOUT + al256((size_t)D_ * D_ * 2);
constexpr size_t WS_BTDN = WS_BTGU + al256((size_t)NE * 2 * FF * D_ * WBYTES);
constexpr size_t WS_U = WS_BTDN + al256((size_t)NE * D_ * FF * WBYTES);
constexpr size_t WS_XH = WS_U + al256((size_t)NTOK * D_ * 2);
constexpr size_t WS_AFF = WS_XH + al256((size_t)NTOK * D_ * 2);
constexpr size_t WS_SLOT = WS_AFF + al256((size_t)NTOK * 16 * 4);
constexpr size_t WS_GSCAN = WS_SLOT + al256((size_t)NTOK * 16 * 4);
constexpr size_t WS_ROWTAB = WS_GSCAN + al256((size_t)B_ * 8 * NCH * 192 * 4);
constexpr size_t WS_YMIX = WS_ROWTAB + al256((size_t)NE * MROWS * 4);
constexpr size_t WS_YEXP = WS_YMIX + al256((size_t)NTOK * D_ * 2);
constexpr size_t WS_R1 = WS_YEXP + al256((size_t)NE * MROWS * D_ * 2);
constexpr size_t R1_PROJ = 0;
constexpr size_t R1_GATES = R1_PROJ + al256((size_t)NTOK * PROJ_N * 2);
constexpr size_t R1_OM = R1_GATES + al256((size_t)NTOK * NG * 4);
constexpr size_t R1_OG = R1_OM + al256((size_t)2 * NTOK * 256 * 2);
constexpr size_t R1_QK2 = R1_OG + al256((size_t)2 * NTOK * 256 * 2);
constexpr size_t R1_END = R1_QK2 + al256((size_t)NTOK * 512 * 2);
constexpr size_t R1_H_BYTES = al256((size_t)NE * MROWS * FF * 2);
constexpr size_t WS_YO = WS_R1 + (R1_END > R1_H_BYTES ? R1_END : R1_H_BYTES);
#if MOE_F8 && YEXP_F8
constexpr size_t WS_X1H = WS_YEXP + (size_t)NE * MROWS * D_;
constexpr size_t WS_END = WS_YO + al256((size_t)NTOK * D_ * 2);
#else
constexpr size_t WS_X1H = WS_YO + al256((size_t)NTOK * D_ * 2);
constexpr size_t WS_END = WS_X1H + al256((size_t)NTOK * D_ * 2);
#endif
static_assert((size_t)NE * MROWS * D_ >= (size_t)NTOK * D_ * 2, "x1 alias");

constexpr int LDS_BYTES = 144 * 1024;
constexpr int NPH = 10;
constexpr int NPHASES = 1 + DEPTH_ * NPH;

struct Params {
    const float* in[23];
    float* out;
    unsigned char* ws;
    int ph_lo, ph_hi;
};

#ifdef HOST_EMU
#define LAS
static inline unsigned f_as_u(float f) { unsigned u; memcpy(&u, &f, 4); return u; }
static inline float u_as_f(unsigned u) { float f; memcpy(&f, &u, 4); return f; }
static inline float shfl_xor_f(float v, int m) { auto t = emu::wave_all(&v, 4); float r; memcpy(&r, t[emu::lane() ^ m], 4); return r; }
static inline float shfl_up_f(float v, int d) { auto t = emu::wave_all(&v, 4); int l = emu::lane(); float r; memcpy(&r, t[l >= d ? l - d : l], 4); return r; }
static inline float shfl_idx_f(float v, int s) { auto t = emu::wave_all(&v, 4); float r; memcpy(&r, t[s & 63], 4); return r; }
static inline int shfl_idx_i(int v, int s) { auto t = emu::wave_all(&v, 4); int r; memcpy(&r, t[s & 63], 4); return r; }
static inline int rdlane_i(int v, int s) { return shfl_idx_i(v, s); }
static inline float rdlane_f(float v, int s) { return shfl_idx_f(v, s); }
static inline f32x4 mfma16(bf16x8 a, bf16x8 b, f32x4 c) {
    struct { bf16x8 a, b; } d; d.a = a; d.b = b;
    auto t = emu::wave_all(&d, 32);
    int l = emu::lane(), col = l & 15, g = l >> 4;
    for (int r = 0; r < 4; ++r) {
        int row = 4 * g + r; float s = c[r];
        for (int k = 0; k < 32; ++k) {
            unsigned short av, bv;
            memcpy(&av, t[row + 16 * (k >> 3)] + 2 * (k & 7), 2);
            memcpy(&bv, t[col + 16 * (k >> 3)] + 16 + 2 * (k & 7), 2);
            s += u_as_f((unsigned)av << 16) * u_as_f((unsigned)bv << 16);
        }
        c[r] = s;
    }
    return c;
}
static inline void glds16(const void* g, unsigned char* l) { memcpy(l + 16 * emu::lane(), g, 16); }
#define S_BARRIER() __syncthreads()
#define WAIT_V(n)
#define WAIT_L(n)
#define SCHED_BAR()
#define SETPRIO(n)
#define RFL(x) (x)
static inline float fast_exp(float x) { return expf(x); }
static inline float fast_rcp(float x) { return 1.0f / x; }
static inline float fast_exp2(float x) { return exp2f(x); }
static inline float fast_log(float x) { return logf(x); }
#else
#define LAS __attribute__((address_space(3)))
DEV unsigned f_as_u(float f) { return __float_as_uint(f); }
DEV float u_as_f(unsigned u) { return __uint_as_float(u); }
DEV float shfl_xor_f(float v, int m) { return __shfl_xor(v, m, 64); }
DEV float shfl_up_f(float v, int d) { return __shfl_up(v, d, 64); }
DEV float shfl_idx_f(float v, int s) { return __shfl(v, s, 64); }
DEV int shfl_idx_i(int v, int s) { return __shfl(v, s, 64); }
DEV int rdlane_i(int v, int s) { return __builtin_amdgcn_readlane(v, s); }
DEV float rdlane_f(float v, int s) { return __uint_as_float((unsigned)__builtin_amdgcn_readlane((int)__float_as_uint(v), s)); }
DEV f32x4 mfma16(bf16x8 a, bf16x8 b, f32x4 c) { return __builtin_amdgcn_mfma_f32_16x16x32_bf16(a, b, c, 0, 0, 0); }
DEV void glds16(const void* g, LAS unsigned char* l) { __builtin_amdgcn_global_load_lds((const unsigned*)g, (LAS unsigned*)l, 16, 0, 0); }
#define S_BARRIER() __builtin_amdgcn_s_barrier()
#define WAIT_V(n) asm volatile("s_waitcnt vmcnt(" #n ")" ::: "memory")
#define WAIT_L(n) asm volatile("s_waitcnt lgkmcnt(" #n ")" ::: "memory")
#define SCHED_BAR() __builtin_amdgcn_sched_barrier(0)
#define SETPRIO(n) __builtin_amdgcn_s_setprio(n)
#define RFL(x) __builtin_amdgcn_readfirstlane(x)
DEV float fast_exp(float x) { return __expf(x); }
DEV float fast_rcp(float x) { return __builtin_amdgcn_rcpf(x); }
DEV float fast_exp2(float x) { return __builtin_amdgcn_exp2f(x); }
DEV float fast_log(float x) { return __logf(x); }
#endif

#ifdef HOST_EMU
DEV int opaque_tid() { return (int)threadIdx.x; }
#else
DEV int opaque_tid() { int t = threadIdx.x; asm volatile("" : "+v"(t)); return t; }
#endif
#ifdef HOST_EMU
typedef const unsigned char* lds_addr_t;
static inline lds_addr_t lds_addr(const void* p) { return (lds_addr_t)p; }
template <int OFF> static inline bf16x4 tr_read4(lds_addr_t vb) {
    const unsigned char* a = vb + OFF; auto t = emu::wave_all(&a, 8); const int l = emu::lane(), G = l >> 4, i = l & 15; bf16x4 r;
    for (int q = 0; q < 4; ++q) { const unsigned char* src; memcpy(&src, t[16 * G + 4 * q + (i >> 2)], 8); short v; memcpy(&v, src + 2 * (i & 3), 2); r[q] = v; }
    return r; }
#define LGKM_WAIT0()
#define LDS_BARRIER() __syncthreads()
#else
typedef unsigned lds_addr_t;
DEV lds_addr_t lds_addr(const LAS void* p) { return (unsigned)(size_t)p; }
template <int OFF> DEV bf16x4 tr_read4(lds_addr_t vb) { bf16x4 r; asm volatile("ds_read_b64_tr_b16 %0, %1 offset:%2" : "=&v"(r) : "v"(vb), "i"(OFF) : "memory"); return r; }
#define LGKM_WAIT0() do { asm volatile("s_waitcnt lgkmcnt(0)" ::: "memory"); __builtin_amdgcn_sched_barrier(0); } while (0)
#define LDS_BARRIER() do { asm volatile("s_waitcnt lgkmcnt(0)" ::: "memory"); __builtin_amdgcn_s_barrier(); asm volatile("" ::: "memory"); } while (0)
#endif
DEV bf16_t f2bf(float f) { unsigned u = f_as_u(f); u += 0x7FFFu + ((u >> 16) & 1u); return (bf16_t)(u >> 16); }
DEV float bf2f(bf16_t b) { return u_as_f((unsigned)b << 16); }
#ifdef HOST_EMU
DEV unsigned pack2(float lo, float hi) { return (unsigned)f2bf(lo) | ((unsigned)f2bf(hi) << 16); }
#else
DEV unsigned pack2(float lo, float hi) { unsigned r; asm volatile("v_cvt_pk_bf16_f32 %0, %1, %2" : "=v"(r) : "v"(lo), "v"(hi)); return r; }
#endif
DEV float bflo(unsigned u) { return u_as_f(u << 16); }
DEV float bfhi(unsigned u) { return u_as_f(u & 0xFFFF0000u); }
DEV float siluf(float x) { return x / (1.0f + expf(-x)); }
DEV float sigmoidf_(float x) { return 1.0f / (1.0f + expf(-x)); }
DEV float logsigf(float x) { return fminf(x, 0.0f) - log1pf(expf(-fabsf(x))); }
#ifdef HOST_EMU
DEV float xrow16_max(float x) { x = fmaxf(x, shfl_xor_f(x, 16)); return fmaxf(x, shfl_xor_f(x, 32)); }
DEV float xrow16_sum(float x) { x += shfl_xor_f(x, 16); return x + shfl_xor_f(x, 32); }
#else
DEV float xrow16_max(float x) {
    auto s = __builtin_amdgcn_permlane16_swap(__float_as_uint(x), __float_as_uint(x), false, false);
    x = fmaxf(__uint_as_float(s[0]), __uint_as_float(s[1]));
    auto t = __builtin_amdgcn_permlane32_swap(__float_as_uint(x), __float_as_uint(x), false, false);
    return fmaxf(__uint_as_float(t[0]), __uint_as_float(t[1])); }
DEV float xrow16_sum(float x) {
    auto s = __builtin_amdgcn_permlane16_swap(__float_as_uint(x), __float_as_uint(x), false, false);
    x = __uint_as_float(s[0]) + __uint_as_float(s[1]);
    auto t = __builtin_amdgcn_permlane32_swap(__float_as_uint(x), __float_as_uint(x), false, false);
    return __uint_as_float(t[0]) + __uint_as_float(t[1]); }
#endif
#if MOE_F8
constexpr float F8_SW1 = 32.0f, F8_SH = 4.0f, F8_SW2 = 128.0f, F8_SY = 16.0f;
DEV float f8clamp(float x) { return fminf(fmaxf(x, -448.0f), 448.0f); }
DEV unsigned pack4_f8(float a, float b, float c, float d) {
    int p_ = __builtin_amdgcn_cvt_pk_fp8_f32(f8clamp(a), f8clamp(b), 0, false);
    p_ = __builtin_amdgcn_cvt_pk_fp8_f32(f8clamp(c), f8clamp(d), p_, true);
    return (unsigned)p_; }
typedef int i32x4 __attribute__((ext_vector_type(4)));
DEV void mfma_f8(f32x4& c, bf16x8 a0, bf16x8 a1, bf16x8 b0, bf16x8 b1, int sc) {
    i32x4 al, ah, bl, bh; __builtin_memcpy(&al, &a0, 16); __builtin_memcpy(&ah, &a1, 16); __builtin_memcpy(&bl, &b0, 16); __builtin_memcpy(&bh, &b1, 16);
    const i32x8 A = __builtin_shufflevector(al, ah, 0, 1, 2, 3, 4, 5, 6, 7), B = __builtin_shufflevector(bl, bh, 0, 1, 2, 3, 4, 5, 6, 7);
    asm volatile("v_mfma_scale_f32_16x16x128_f8f6f4 %0, %1, %2, %0, %3, %3 op_sel_hi:[0,0,0]" : "+v"(c) : "v"(A), "v"(B), "v"(sc)); }
#define MFMA_DRAIN() asm volatile("s_nop 15\n\ts_nop 15" ::: "memory")
#endif
typedef _Float16 h16x8 __attribute__((ext_vector_type(8)));
DEV u32x4 pack8_h(const float (&v)[8]) { h16x8 h; for (int j = 0; j < 8; ++j) h[j] = (_Float16)v[j]; u32x4 o; __builtin_memcpy(&o, &h, 16); return o; }
DEV void unpack8_h(u32x4 u, float (&v)[8]) { h16x8 h; __builtin_memcpy(&h, &u, 16); for (int j = 0; j < 8; ++j) v[j] = (float)h[j]; }
#ifdef HOST_EMU
DEV bool wave_any(bool b) { float v = b ? 1.f : 0.f; for (int m = 32; m >= 1; m >>= 1) v = fmaxf(v, shfl_xor_f(v, m)); return v > 0.f; }
#else
DEV bool wave_any(bool b) { return __builtin_amdgcn_ballot_w64(b) != 0ull; }
#endif
#ifdef HOST_EMU
template <class T> static inline void st_stream(T* q, T v) { *q = v; }
#else
template <class T> DEV void st_stream(T* q, T v) { __builtin_nontemporal_store(v, q); }
#endif
#ifdef HOST_EMU
template <class T> static inline T ld_stream(const T* q) { return *q; }
#else
template <class T> DEV T ld_stream(const T* q) { return __builtin_nontemporal_load(q); }
#endif
DEV float silu_fast(float x) { return x * fast_rcp(1.0f + fast_exp(-x)); }
DEV float sigmoid_fast(float x) { return fast_rcp(1.0f + fast_exp(-x)); }
DEV float logsig_fast(float x) { return fminf(x, 0.0f) - fast_log(1.0f + fast_exp(-fabsf(x))); }
#ifdef HOST_EMU
DEV float wave_sum(float v) { for (int m = 32; m >= 1; m >>= 1) v += shfl_xor_f(v, m); return v; }
DEV float wave_max(float v) { for (int m = 32; m >= 1; m >>= 1) v = fmaxf(v, shfl_xor_f(v, m)); return v; }
DEV float xsum32(float a, float b) { const float pa = shfl_xor_f(a, 32), pb = shfl_xor_f(b, 32); return (emu::lane() & 32) ? b + pb : a + pa; }
DEV float xsum16(float a, float b) { const float pa = shfl_xor_f(a, 16), pb = shfl_xor_f(b, 16); return (emu::lane() & 16) ? b + pb : a + pa; }
DEV float xsum8(float a, float b, int lane) { const float pa = shfl_xor_f(a, 8), pb = shfl_xor_f(b, 8); return (lane & 8) ? b + pb : a + pa; }
DEV float xsum4(float a, float b, int lane) { const float pa = shfl_xor_f(a, 4), pb = shfl_xor_f(b, 4); return (lane & 4) ? b + pb : a + pa; }
DEV float quad_sum(float v) { v += shfl_xor_f(v, 1); return v + shfl_xor_f(v, 2); }
#else
template <int CTRL> DEV float dpp_f(float x) { return __uint_as_float((unsigned)__builtin_amdgcn_update_dpp(0, (int)__float_as_uint(x), CTRL, 0xF, 0xF, false)); }
DEV float wave_sum(float v) {
    v += dpp_f<0x128>(v); v += dpp_f<0x124>(v); v += dpp_f<0x122>(v); v += dpp_f<0x121>(v);
    return xrow16_sum(v); }
DEV float wave_max(float v) {
    v = fmaxf(v, dpp_f<0x128>(v)); v = fmaxf(v, dpp_f<0x124>(v)); v = fmaxf(v, dpp_f<0x122>(v)); v = fmaxf(v, dpp_f<0x121>(v));
    return xrow16_max(v); }
DEV float xsum32(float a, float b) { auto s_ = __builtin_amdgcn_permlane32_swap(__float_as_uint(a), __float_as_uint(b), false, false); return __uint_as_float(s_[0]) + __uint_as_float(s_[1]); }
DEV float xsum16(float a, float b) { auto s_ = __builtin_amdgcn_permlane16_swap(__float_as_uint(a), __float_as_uint(b), false, false); return __uint_as_float(s_[0]) + __uint_as_float(s_[1]); }
DEV float xsum8(float a, float b, int lane) { const bool hi = (lane & 8) != 0; return (hi ? b : a) + dpp_f<0x128>(hi ? a : b); }
DEV float xsum4(float a, float b, int lane) { const bool hi = (lane & 4) != 0; return (hi ? b : a) + __shfl_xor(hi ? a : b, 4, 64); }
DEV float quad_sum(float v) { v += dpp_f<0xB1>(v); return v + dpp_f<0x4E>(v); }
#endif

#ifdef HOST_EMU
static std::atomic<unsigned> g_emu_bar{0};
struct XcdBarrier { unsigned n; };
static inline XcdBarrier xcd_barrier_post(unsigned*, unsigned*) { XcdBarrier b; b.n = 0; return b; }
static inline void xcd_barrier(XcdBarrier& b) {
    __syncthreads();
    if (threadIdx.x == 0) { b.n++; g_emu_bar.fetch_add(1); while (g_emu_bar.load() < b.n * gridDim.x) std::this_thread::yield(); }
    __syncthreads();
}
#else
#define XB_TMO      128
#define XB_XCNT(j)  (256  + 64 * (j))
#define XB_XSUB(j)  (1280 + 64 * (j))
#define XB_XGEN(j)  (2304 + 64 * (j))
#define XB_TOP      3328
#define XB_TOPGEN   3392
#define XCD_BAR_WORDS 3456
#define XB_QUEUE     3584
#define XB_SPIN_CAP (1u << 22)
DEV unsigned xb_ld(unsigned* p)              { return __hip_atomic_load(p, __ATOMIC_RELAXED, __HIP_MEMORY_SCOPE_AGENT); }
DEV unsigned xb_add(unsigned* p, unsigned v) { return __hip_atomic_fetch_add(p, v, __ATOMIC_RELAXED, __HIP_MEMORY_SCOPE_AGENT); }
DEV unsigned xb_xcc_id() { return (unsigned)__builtin_amdgcn_s_getreg((3 << 11) | 20) & 0xFu; }
#define XB_SPIN(cond, bar) do { unsigned _sp = 0; while (cond) { __builtin_amdgcn_s_sleep(1); \
    if ((++_sp & 255u) == 0u) { if (xb_ld(&(bar)[XB_TMO])) break; if (_sp > XB_SPIN_CAP) { atomicAdd(&(bar)[XB_TMO], 1u); break; } } } } while (0)
struct XcdBarrier { unsigned* bar; unsigned x; volatile LAS unsigned* st; };
DEV XcdBarrier xcd_barrier_post(unsigned* bar, volatile LAS unsigned* st) {
    XcdBarrier b; b.bar = bar; b.x = xb_xcc_id(); b.st = st;
    if (threadIdx.x == 0) (void)xb_add(&bar[XB_XCNT(b.x)], 1u);
    return b;
}
DEV void xcd_barrier_complete(unsigned* bar, unsigned x, unsigned& nloc, unsigned& nx) {
    const unsigned G = gridDim.x * gridDim.y * gridDim.z;
    unsigned sum, cnt, mine, sp = 0u;
    for (;;) {
        sum = 0u; cnt = 0u; mine = 0u;
#pragma unroll
        for (unsigned j = 0; j < 16; ++j) { const unsigned c = xb_ld(&bar[XB_XCNT(j)]); sum += c; cnt += (c > 0u) ? 1u : 0u; mine = (j == x) ? c : mine; }
        if (sum == G) break;
        __builtin_amdgcn_s_sleep(1);
        if ((++sp & 255u) == 0u) { if (xb_ld(&bar[XB_TMO])) break; if (sp > XB_SPIN_CAP) { atomicAdd(&bar[XB_TMO], 1u); break; } }
    }
    nloc = mine > 0u ? mine : 1u; nx = cnt > 0u ? cnt : 1u;
}
DEV void xcd_barrier(const XcdBarrier& b) {
    asm volatile("s_waitcnt vmcnt(0)" ::: "memory");
    __syncthreads();
    if (threadIdx.x == 0) {
        unsigned* bar = b.bar;
        __builtin_amdgcn_s_waitcnt(0);
        unsigned nloc = b.st[0], nx = b.st[1];
        if (nloc == 0u) { xcd_barrier_complete(bar, b.x, nloc, nx); b.st[0] = nloc; b.st[1] = nx; }
        const unsigned old = xb_add(&bar[XB_XSUB(b.x)], 1u);
        const unsigned gen = old / nloc;
        if (old + 1u == (gen + 1u) * nloc) {
            __builtin_amdgcn_fence(__ATOMIC_RELEASE, "agent");
            asm volatile("s_waitcnt vmcnt(0)" ::: "memory");
            const unsigned og = xb_add(&bar[XB_TOP], 1u);
            const unsigned tg = og / nx;
            if (og + 1u == (tg + 1u) * nx) xb_add(&bar[XB_TOPGEN], 1u);
            else XB_SPIN(xb_ld(&bar[XB_TOPGEN]) == tg, bar);
            __builtin_amdgcn_fence(__ATOMIC_ACQUIRE, "agent");
            xb_add(&bar[XB_XGEN(b.x)], 1u);
            asm volatile("s_waitcnt vmcnt(0)" ::: "memory");
        } else {
            XB_SPIN(xb_ld(&bar[XB_XGEN(b.x)]) == gen, bar);
            __builtin_amdgcn_fence(__ATOMIC_ACQUIRE, "agent");
            asm volatile("s_waitcnt vmcnt(0)" ::: "memory");
        }
    }
    __syncthreads();
}
#endif

namespace pg8 {
constexpr int BM = 256, BK = 64, HALF = 128, HTB = HALF * BK * 2, STAGE_BYTES = 8 * HTB, NXCD = 8, WGM = 8;
DEV int lds_byte(int r, int c) { const int st = (r >> 4) * 2 + (c >> 5), rr = r & 15, cc = c & 31, ob = rr * 64 + cc * 2; return st * 1024 + (ob ^ (((ob >> 9) & 1) << 5)); }
DEV void stage_rc(int b, int& R, int& C) { const int st = b / 1024, sb = b % 1024, swz = sb ^ (((sb >> 9) & 1) << 5); R = (st >> 1) * 16 + swz / 64; C = (st & 1) * 32 + (swz % 64) / 2; }
DEV int perm32(int rho) { const int n = rho >> 4, i = rho & 15; return 8 * (i >> 2) + 4 * n + (i & 3); }

struct Unit { int pm, pn, pb; };
struct Gemm { const bf16_t* A; const bf16_t* Bt; int K; const int* rowtab; };

struct Order {
    int nM, nN, nwg, G, c, mt, mts;
    DEV void init(int ngrp, int mt_, int mts_, int nN_, int G_, int c_) { mt = mt_; mts = mts_; nM = ngrp * mt_; nN = nN_; nwg = nM * nN; G = G_; c = c_; }
    DEV bool next(int i, Unit& u) const {
        const long L = (long)i * G + c; if (L >= nwg) return false;
        int wgid = (int)L; { const int q = nwg / NXCD, r = nwg % NXCD, xcd = wgid % NXCD, off = wgid / NXCD; wgid = (xcd < r ? xcd * (q + 1) : r * (q + 1) + (xcd - r) * q) + off; }
        const int nig = WGM * nN, gid = wgid / nig, fm = gid * WGM, gsz = (nM - fm) < WGM ? (nM - fm) : WGM;
        const int pmv = fm + ((wgid % nig) % gsz); u.pn = (wgid % nig) / gsz;
        const int e = pmv / mt, pl = pmv - e * mt; u.pm = e * mts + pl; u.pb = e * nN + u.pn; return true;
    }
};

template <class Epi, bool GATHER, bool F8 = false>
DEV void gemm_phase(LAS unsigned char* lds, const Gemm g, const Order& S, const Epi& E) {
    const int tid = opaque_tid(), wid = RFL(tid >> 6), lane = tid & 63, wr = wid >> 2, wc = wid & 3, fr = lane & 15, fq = lane >> 4;
    const int K = g.K, nt = K / BK;
    unsigned voffA[2], voffB[2];
#pragma unroll
    for (int i = 0; i < 2; ++i) { int R, C; stage_rc(tid * 16 + i * 8192, R, C); const int Rb = Epi::PERM ? ((R & ~31) + perm32(R & 31)) : R;
        voffA[i] = (unsigned)(R * K + C) * 2u; voffB[i] = (unsigned)(Rb * K + C) * 2u; }
    const size_t kstep = (size_t)(BK * 2);
    const size_t hstep = (size_t)HALF * K * 2;
    const size_t tstep = 2 * hstep;
    const unsigned ldsw = (unsigned)wid * 1024u;
    const int aoff = lds_byte(wr * 64 + fr, fq * 8), boff = lds_byte(wc * 32 + fr, fq * 8);
#define PG8_SA(b, h) (((b) * 2 + (h)) * HTB)
#define PG8_SB(b, h) ((4 + (b) * 2 + (h)) * HTB)
#define PG8_STAGE(bufoff, gbase, voff) do { _Pragma("unroll") for (int _i = 0; _i < 2; ++_i) \
        glds16((const char*)(gbase) + (voff)[_i], lds + (bufoff) + ldsw + _i * 8192); } while (0)
#define PG8_STAGE_A(bufoff, gbase, h, nx) do { _Pragma("unroll") for (int _i = 0; _i < 2; ++_i) { \
        if constexpr (GATHER) glds16((const char*)(gbase) + ((nx) ? na[h][_i] : ca[h][_i]), lds + (bufoff) + ldsw + _i * 8192); \
        else glds16((const char*)(gbase) + (size_t)(h) * hstep + voffA[_i], lds + (bufoff) + ldsw + _i * 8192); } } while (0)
#define PG8_LDA(dst, b, h) do { _Pragma("unroll") for (int m = 0; m < 4; ++m) _Pragma("unroll") for (int k = 0; k < 2; ++k) dst[m][k] = *(const LAS bf16x8*)(lds + PG8_SA(b, h) + aoff + m * 2048 + k * 1024); } while (0)
#define PG8_LDB(dst, b, h) do { _Pragma("unroll") for (int n = 0; n < 2; ++n) _Pragma("unroll") for (int k = 0; k < 2; ++k) dst[n][k] = *(const LAS bf16x8*)(lds + PG8_SB(b, h) + boff + n * 2048 + k * 1024); } while (0)
#if MOE_F8
#define PG8_MMA(ai, bj, At, Bt) do { SETPRIO(1); _Pragma("unroll") for (int m = 0; m < 4; ++m) _Pragma("unroll") for (int n = 0; n < 2; ++n) { \
        if constexpr (F8) mfma_f8(acc[ai][bj][m][n], Bt[n][0], Bt[n][1], At[m][0], At[m][1], f8sc); \
        else { _Pragma("unroll") for (int k = 0; k < 2; ++k) acc[ai][bj][m][n] = mfma16(Bt[n][k], At[m][k], acc[ai][bj][m][n]); } } SETPRIO(0); } while (0)
#else
#define PG8_MMA(ai, bj, At, Bt) do { SETPRIO(1); _Pragma("unroll") for (int m = 0; m < 4; ++m) _Pragma("unroll") for (int n = 0; n < 2; ++n) _Pragma("unroll") for (int k = 0; k < 2; ++k) \
        acc[ai][bj][m][n] = mfma16(Bt[n][k], At[m][k], acc[ai][bj][m][n]); SETPRIO(0); } while (0)
#endif
    Unit cur, nxt; int ui = 0;
    if (!S.next(0, cur)) return;
#if MOE_F8
    int f8sc = 0x7F7F7F7F; asm volatile("" : "+v"(f8sc));
#endif
    f32x4 acc[2][2][4][2];
#pragma unroll
    for (int a = 0; a < 2; ++a)
#pragma unroll
        for (int b = 0; b < 2; ++b)
#pragma unroll
            for (int m = 0; m < 4; ++m)
#pragma unroll
                for (int n = 0; n < 2; ++n) acc[a][b][m][n] = (f32x4){0.f, 0.f, 0.f, 0.f};
    bf16x8 At[4][2], B0[2][2], B1[2][2];
    unsigned ca[2][2], na[2][2];
    const char* cA; const char* nA;
    const char* cB = (const char*)g.Bt + (size_t)cur.pb * tstep;
#define PG8_SETA(u, base, off) do { if constexpr (GATHER) { base = (const char*)g.A; \
            _Pragma("unroll") for (int _h = 0; _h < 2; ++_h) _Pragma("unroll") for (int _i = 0; _i < 2; ++_i) { int _R, _C; stage_rc(tid * 16 + _i * 8192, _R, _C); \
                off[_h][_i] = (unsigned)g.rowtab[(u).pm * 256 + _h * 128 + _R] * (unsigned)(K * 2) + (unsigned)_C * 2u; } } \
        else { base = (const char*)g.A + (size_t)(u).pm * tstep; } } while (0)
    PG8_SETA(cur, cA, ca);
    nA = cA;
    if constexpr (GATHER) {
#pragma unroll
        for (int _h = 0; _h < 2; ++_h)
#pragma unroll
            for (int _i = 0; _i < 2; ++_i) na[_h][_i] = ca[_h][_i]; }
    PG8_STAGE(PG8_SB(0, 0), cB, voffB); PG8_STAGE_A(PG8_SA(0, 0), cA, 0, false); PG8_STAGE(PG8_SB(0, 1), cB + hstep, voffB); PG8_STAGE_A(PG8_SA(0, 1), cA, 1, false);
    if (wr == 1) S_BARRIER();
    WAIT_V(4); S_BARRIER();
    PG8_STAGE(PG8_SB(1, 0), cB + kstep, voffB); PG8_STAGE_A(PG8_SA(1, 0), cA + kstep, 0, false); PG8_STAGE(PG8_SB(1, 1), cB + hstep + kstep, voffB);
    WAIT_V(6); S_BARRIER();
    for (;;) {
        const bool has_next = S.next(ui + 1, nxt);
        const char* nB = cB;
        if (has_next) { PG8_SETA(nxt, nA, na); nB = (const char*)g.Bt + (size_t)nxt.pb * tstep; }
        else { nA = cA;
            if constexpr (GATHER) {
#pragma unroll
                for (int _h = 0; _h < 2; ++_h)
#pragma unroll
                    for (int _i = 0; _i < 2; ++_i) na[_h][_i] = ca[_h][_i]; } }
        for (int t = 0; t < nt; t += 2) {
            const bool last = (t == nt - 2);
            const char* a1 = cA + (size_t)(t + 1) * kstep;
            const char* a2 = last ? nA : cA + (size_t)(t + 2) * kstep; const char* b2 = last ? nB : cB + (size_t)(t + 2) * kstep;
            const char* a3 = a2 + kstep; const char* b3 = b2 + kstep;
            PG8_LDB(B0, 0, 0); SCHED_BAR(); PG8_LDA(At, 0, 0); PG8_STAGE_A(PG8_SA(1, 1), a1, 1, false);
            WAIT_L(8); S_BARRIER(); WAIT_L(0); PG8_MMA(0, 0, At, B0); S_BARRIER(); SCHED_BAR();
            PG8_LDB(B1, 0, 1); PG8_STAGE(PG8_SB(0, 0), b2, voffB);
            S_BARRIER(); WAIT_L(0); PG8_MMA(0, 1, At, B1); S_BARRIER();
            PG8_LDA(At, 0, 1); PG8_STAGE_A(PG8_SA(0, 0), a2, 0, last);
            S_BARRIER(); WAIT_L(0); PG8_MMA(1, 0, At, B0); S_BARRIER(); SCHED_BAR();
            PG8_STAGE(PG8_SB(0, 1), b2 + hstep, voffB);
            WAIT_V(6); S_BARRIER(); PG8_MMA(1, 1, At, B1); S_BARRIER();
            PG8_LDB(B0, 1, 0); SCHED_BAR(); PG8_LDA(At, 1, 0); PG8_STAGE_A(PG8_SA(0, 1), a2, 1, last);
            WAIT_L(8); S_BARRIER(); WAIT_L(0); PG8_MMA(0, 0, At, B0); S_BARRIER(); SCHED_BAR();
            PG8_LDB(B1, 1, 1); PG8_STAGE(PG8_SB(1, 0), b3, voffB);
            S_BARRIER(); WAIT_L(0); PG8_MMA(0, 1, At, B1); S_BARRIER();
            PG8_LDA(At, 1, 1); PG8_STAGE_A(PG8_SA(1, 0), a3, 0, last);
            S_BARRIER(); WAIT_L(0); PG8_MMA(1, 0, At, B0); S_BARRIER(); SCHED_BAR();
            PG8_STAGE(PG8_SB(1, 1), b3 + hstep, voffB);
            WAIT_V(6); S_BARRIER(); PG8_MMA(1, 1, At, B1); S_BARRIER();
        }
#if MOE_F8
        if constexpr (F8) MFMA_DRAIN();
#endif
        E(acc, cur, wr, wc, fr, fq);
        if (!has_next) break;
#pragma unroll
        for (int a = 0; a < 2; ++a)
#pragma unroll
            for (int b = 0; b < 2; ++b)
#pragma unroll
                for (int m = 0; m < 4; ++m)
#pragma unroll
                    for (int n = 0; n < 2; ++n) acc[a][b][m][n] = (f32x4){0.f, 0.f, 0.f, 0.f};
        cur = nxt; cA = nA; cB = nB; ++ui;
        if constexpr (GATHER) {
#pragma unroll
            for (int _h = 0; _h < 2; ++_h)
#pragma unroll
                for (int _i = 0; _i < 2; ++_i) ca[_h][_i] = na[_h][_i]; }
    }
    WAIT_V(0);
    if (wr == 0) S_BARRIER();
    S_BARRIER();
#undef PG8_SA
#undef PG8_SB
#undef PG8_STAGE
#undef PG8_STAGE_A
#undef PG8_LDA
#undef PG8_LDB
#undef PG8_MMA
#undef PG8_SETA
}
}
using pg8::Unit;

struct EpiProj {
    static constexpr bool PERM = true;
    bf16_t* proj; float* gates; const float* bias;
    DEV void operator()(const f32x4 (&acc)[2][2][4][2], const Unit& u, int wr, int wc, int fr, int fq) const {
        const int row0 = u.pm * 256 + wr * 64 + fr; const int colt = u.pn * 256, cl = wc * 32 + 8 * fq;
        if (u.pn < PROJ_N / 256) {
#pragma unroll
            for (int bj = 0; bj < 2; ++bj) { const f32x4 b0 = *(const f32x4*)(bias + colt + cl + bj * 128), b1 = *(const f32x4*)(bias + colt + cl + bj * 128 + 4);
#pragma unroll
                for (int ai = 0; ai < 2; ++ai)
#pragma unroll
                    for (int m = 0; m < 4; ++m) { bf16_t* rowp = proj + (size_t)(row0 + ai * 128 + m * 16) * PROJ_N + colt + cl + bj * 128;
                        const f32x4 v0 = acc[ai][bj][m][0] + b0, v1 = acc[ai][bj][m][1] + b1;
                        u32x4 o; o[0] = pack2(v0[0], v0[1]); o[1] = pack2(v0[2], v0[3]); o[2] = pack2(v1[0], v1[1]); o[3] = pack2(v1[2], v1[3]);
                        *(u32x4*)rowp = o; } }
        } else if (cl < NG) {
            const f32x4 b0 = *(const f32x4*)(bias + colt + cl), b1 = *(const f32x4*)(bias + colt + cl + 4);
#pragma unroll
            for (int ai = 0; ai < 2; ++ai)
#pragma unroll
                for (int m = 0; m < 4; ++m) { float* rowp = gates + (size_t)(row0 + ai * 128 + m * 16) * NG + cl;
                    *(f32x4*)(rowp) = acc[ai][0][m][0] + b0; *(f32x4*)(rowp + 4) = acc[ai][0][m][1] + b1; }
        }
    }
};
struct EpiSwiglu {
    static constexpr bool PERM = true;
    bf16_t* h;
    DEV void operator()(const f32x4 (&acc)[2][2][4][2], const Unit& u, int wr, int wc, int fr, int fq) const {
        const int row0 = u.pm * 256 + wr * 64 + fr; const int col0 = u.pn * 128 + wc * 32 + 8 * fq;
#if MOE_F8
        unsigned char* h8 = (unsigned char*)h;
        constexpr float isw = 1.0f / F8_SW1, kd = F8_SW1 * F8_SW1 / F8_SH;
#pragma unroll
        for (int ai = 0; ai < 2; ++ai)
#pragma unroll
            for (int m = 0; m < 4; ++m) { unsigned char* rowp = h8 + (size_t)(row0 + ai * 128 + m * 16) * FF + col0;
                float v[8];
#pragma unroll
                for (int n = 0; n < 2; ++n)
#pragma unroll
                    for (int j = 0; j < 4; ++j) {
                        const float e = fast_exp2(acc[ai][0][m][n][j] * (-isw * 1.44269504f)); v[n * 4 + j] = acc[ai][0][m][n][j] * acc[ai][1][m][n][j] * fast_rcp(e * kd + kd); }
                u32x2 o; o[0] = pack4_f8(v[0], v[1], v[2], v[3]); o[1] = pack4_f8(v[4], v[5], v[6], v[7]);
                *(u32x2*)rowp = o; }
        return;
#endif
#pragma unroll
        for (int ai = 0; ai < 2; ++ai)
#pragma unroll
            for (int m = 0; m < 4; ++m) { bf16_t* rowp = h + (size_t)(row0 + ai * 128 + m * 16) * FF + col0;
                float v[8];
#pragma unroll
                for (int n = 0; n < 2; ++n)
#pragma unroll
                    for (int j = 0; j < 4; ++j) { const float gt = acc[ai][0][m][n][j], up = acc[ai][1][m][n][j]; v[n * 4 + j] = gt * fast_rcp(1.0f + fast_exp(-gt)) * up; }
                u32x4 o; o[0] = pack2(v[0], v[1]); o[1] = pack2(v[2], v[3]); o[2] = pack2(v[4], v[5]); o[3] = pack2(v[6], v[7]);
                *(u32x4*)rowp = o; }
    }
};
template <bool F8OUT>
struct EpiDown {
    static constexpr bool PERM = true;
    bf16_t* y; float sc;
    DEV void operator()(const f32x4 (&acc)[2][2][4][2], const Unit& u, int wr, int wc, int fr, int fq) const {
        const int row0 = u.pm * 256 + wr * 64 + fr; const int col0 = u.pn * 256 + wc * 32 + 8 * fq;
#pragma unroll
        for (int ai = 0; ai < 2; ++ai)
#pragma unroll
            for (int m = 0; m < 4; ++m) {
#pragma unroll
                for (int bj = 0; bj < 2; ++bj) {
                    const f32x4 v0 = acc[ai][bj][m][0] * sc, v1 = acc[ai][bj][m][1] * sc;
#if MOE_F8
                    if constexpr (F8OUT) { unsigned char* rowp = (unsigned char*)y + (size_t)(row0 + ai * 128 + m * 16) * D_ + col0;
                        u32x2 o; o[0] = pack4_f8(v0[0], v0[1], v0[2], v0[3]); o[1] = pack4_f8(v1[0], v1[1], v1[2], v1[3]);
                        *(u32x2*)(rowp + bj * 128) = o; }
                    else
#endif
                    { bf16_t* rowp = y + (size_t)(row0 + ai * 128 + m * 16) * D_ + col0;
                        u32x4 o; o[0] = pack2(v0[0], v0[1]); o[1] = pack2(v0[2], v0[3]); o[2] = pack2(v1[0], v1[1]); o[3] = pack2(v1[2], v1[3]);
                        *(u32x4*)(rowp + bj * 128) = o; } } }
    }
};

DEV void phase_mods(const Params& p, LAS unsigned char* lds) {
    LAS float* sc = (LAS float*)lds;
    const int tid = opaque_tid(), col = tid & 63, ks = tid >> 6;
    float* mods = (float*)(p.ws + WS_MODS);
    constexpr int NB = B_ + 1;
    for (int u = blockIdx.x; u < DEPTH_ * 96; u += gridDim.x) {
        const int l = u / 96, cb = (u % 96) * 64;
        __syncthreads();
        for (int i = tid; i < NB * 1024; i += 512) { const int bb = i >> 10, k = i & 1023; const float cv = bb < B_ ? p.in[1][(size_t)bb * 1024 + k] : p.in[3][k]; sc[i] = siluf(cv); }
        __syncthreads();
        float acc[NB];
#pragma unroll
        for (int bb = 0; bb < NB; ++bb) acc[bb] = 0.f;
        const float* w = p.in[4] + (size_t)l * 1024 * 6144 + cb + col;
        for (int k = ks * 128; k < ks * 128 + 128; ++k) { const float wv = w[(size_t)k * 6144];
#pragma unroll
            for (int bb = 0; bb < NB; ++bb) acc[bb] += sc[bb * 1024 + k] * wv; }
        __syncthreads();
#pragma unroll
        for (int bb = 0; bb < NB; ++bb) sc[(ks * NB + bb) * 64 + col] = acc[bb];
        __syncthreads();
        for (int i = tid; i < NB * 64; i += 512) { const int bb = i >> 6, c2 = i & 63; float s = p.in[5][(size_t)l * 6144 + cb + c2];
            for (int q = 0; q < 8; ++q) s += sc[(q * NB + bb) * 64 + c2];
            mods[((size_t)l * NB + bb) * 6144 + cb + c2] = s; }
    }
    if (blockIdx.x == gridDim.x - 1) {
        float* rope = (float*)(p.ws + WS_ROPE);
        for (int i = tid; i < 64 * 16; i += 512) { const int pos = i >> 4, f = i & 15; const float inv = powf(10000.0f, -(float)f / 16.0f); const float a = (float)pos * inv; rope[i * 2] = cosf(a); rope[i * 2 + 1] = sinf(a); }
        for (int i = tid; i < 64 * 8; i += 512) { const int pos = i >> 3, f = i & 7; const float inv = powf(10000.0f, -(float)f / 8.0f); const float a = (float)pos * inv; rope[2048 + i * 2] = cosf(a); rope[2048 + i * 2 + 1] = sinf(a); }
    }
}

DEV int win_srccol(int n) {
    if (n < 1024) return n; if (n < 1792) return n + 16; if (n < 3328) return n + 48;
    if (n < 3344) return 1024 + (n - 3328); if (n < 3376) return 1808 + (n - 3344); return -1;
}
template <bool WIN>
DEV void conv_tile(const float* src, int ldn, int srcc0, bf16_t* dst, int ldk, int n0, int k0, LAS float* tile) {
    const int tid = opaque_tid(), nn = tid & 63, kk = tid >> 6;
    int sc_ = WIN ? win_srccol(n0 + nn) : srcc0 + nn;
#pragma unroll
    for (int i = 0; i < 8; ++i) { const int k = kk + 8 * i; tile[k * 65 + nn] = sc_ >= 0 ? src[(size_t)(k0 + k) * ldn + sc_] : 0.f; }
    __syncthreads();
    { const int n = tid >> 3, k8 = (tid & 7) * 8; float v[8];
#pragma unroll
      for (int j = 0; j < 8; ++j) v[j] = tile[(k8 + j) * 65 + n];
      u32x4 o; o[0] = pack2(v[0], v[1]); o[1] = pack2(v[2], v[3]); o[2] = pack2(v[4], v[5]); o[3] = pack2(v[6], v[7]);
      *(u32x4*)(dst + (size_t)(n0 + n) * ldk + k0 + k8) = o; }
    __syncthreads();
}
#if MOE_F8
constexpr float F8_SW1_ = F8_SW1, F8_SW2_ = F8_SW2;
#else
constexpr float F8_SW1_ = 0.f, F8_SW2_ = 0.f;
#endif
struct ConvTile { const float* s0; const float* s1; int ld; bf16_t* dst; int ldk; int n0, k0; int kind; };
#ifdef HOST_EMU
template <class T> static inline T* rfl_ptr(T* q) { return q; }
#else
template <class T> DEV T* rfl_ptr(T* q) { const unsigned long long v = (unsigned long long)q; const unsigned lo = (unsigned)RFL((int)(unsigned)v), hi = (unsigned)RFL((int)(unsigned)(v >> 32)); return (T*)(((unsigned long long)hi << 32) | lo); }
#endif
DEV ConvTile conv_desc(const Params& p, int l, int t_) {
    const int t = RFL(t_);
    ConvTile c;
    bf16_t* btin = (bf16_t*)(p.ws + WS_BTIN); bf16_t* btout = (bf16_t*)(p.ws + WS_BTOUT); bf16_t* btgu = (bf16_t*)(p.ws + WS_BTGU); bf16_t* btdn = (bf16_t*)(p.ws + WS_BTDN);
    const float* w_in = p.in[6] + (size_t)l * D_ * PROJ_W0; const float* w_out = p.in[14] + (size_t)l * D_ * D_;
    const float* w_gate = p.in[18] + (size_t)l * NE * D_ * FF; const float* w_up = p.in[19] + (size_t)l * NE * D_ * FF; const float* w_down = p.in[20] + (size_t)l * NE * FF * D_;
    constexpr int T_IN = 13 * 16, T_OUT = 4 * 16, T_GU = NE * 16 * 16;
    if (t < T_IN) { const int nb = t / 16, kt = t % 16; const int sc = win_srccol(nb * 256);
        c.kind = 0; c.s0 = w_in + sc; c.s1 = w_in + sc + 128; c.ld = PROJ_W0; c.dst = btin; c.ldk = D_; c.n0 = nb * 256; c.k0 = kt * 64; }
    else if (t < T_IN + T_OUT) { const int q = t - T_IN, nb = q / 16, kt = q % 16;
        c.kind = 0; c.s0 = w_out + nb * 256; c.s1 = c.s0 + 128; c.ld = D_; c.dst = btout; c.ldk = D_; c.n0 = nb * 256; c.k0 = kt * 64; }
    else if (t < T_IN + T_OUT + T_GU) { const int q = t - T_IN - T_OUT, e = q / 256, r = q % 256, nb = r / 16, kt = r % 16;
        c.kind = MOE_F8 ? 1 : 0; c.s0 = w_gate + (size_t)e * D_ * FF + nb * 128; c.s1 = w_up + (size_t)e * D_ * FF + nb * 128; c.ld = FF; c.dst = btgu + (size_t)e * 2 * FF * D_ / (MOE_F8 ? 2 : 1); c.ldk = D_; c.n0 = nb * 256; c.k0 = kt * 64; }
    else { const int q = t - T_IN - T_OUT - T_GU, e = q / 128, r = q % 128, nb = r / 32, kt = r % 32;
        c.kind = MOE_F8 ? 2 : 0; c.s0 = w_down + (size_t)e * FF * D_ + nb * 256; c.s1 = c.s0 + 128; c.ld = D_; c.dst = btdn + (size_t)e * D_ * FF / (MOE_F8 ? 2 : 1); c.ldk = FF; c.n0 = nb * 256; c.k0 = kt * 64; }
    c.s0 = rfl_ptr(c.s0); c.s1 = rfl_ptr(c.s1); c.dst = rfl_ptr(c.dst); c.ld = RFL(c.ld); c.ldk = RFL(c.ldk); c.n0 = RFL(c.n0); c.k0 = RFL(c.k0); c.kind = RFL(c.kind);
    return c;
}
DEV void conv_issue(const ConvTile& c, f32x4 (&r)[8], int tid) {
    const int nn4 = (tid & 63) * 4; const float* src = (nn4 < 128 ? c.s0 + nn4 : c.s1 + (nn4 - 128)) + (size_t)(c.k0 + (tid >> 6)) * c.ld;
#pragma unroll
    for (int i = 0; i < 8; ++i) r[i] = ld_stream((const f32x4*)(src + (size_t)(8 * i) * c.ld));
}
DEV void conv_finish(const ConvTile& c, const f32x4 (&r)[8], LAS float* tile, int tid) {
    const int nn4 = (tid & 63) * 4, kk = tid >> 6;
#pragma unroll
    for (int i = 0; i < 8; ++i) { LAS float* d = tile + (kk + 8 * i) * 257 + nn4; d[0] = r[i][0]; d[1] = r[i][1]; d[2] = r[i][2]; d[3] = r[i][3]; }
    __syncthreads();
#if MOE_F8
    if (c.kind != 0) { const int n = tid >> 1, kh = (tid & 1) * 32; unsigned char* drow = (unsigned char*)c.dst + (size_t)(c.n0 + n) * c.ldk + c.k0 + kh;
#pragma unroll
      for (int q = 0; q < 2; ++q) { float v[16];
          if (c.kind == 1) {
#pragma unroll
              for (int j = 0; j < 16; ++j) v[j] = tile[(kh + 16 * q + j) * 257 + n] * F8_SW1; }
          else {
#pragma unroll
              for (int j = 0; j < 16; ++j) v[j] = tile[(kh + 16 * q + j) * 257 + n] * F8_SW2; }
          u32x4 o; o[0] = pack4_f8(v[0], v[1], v[2], v[3]); o[1] = pack4_f8(v[4], v[5], v[6], v[7]); o[2] = pack4_f8(v[8], v[9], v[10], v[11]); o[3] = pack4_f8(v[12], v[13], v[14], v[15]);
          *(u32x4*)(drow + 16 * q) = o; } }
    else
#endif
    { const int n = tid >> 1, kh = (tid & 1) * 32; bf16_t* drow = c.dst + (size_t)(c.n0 + n) * c.ldk + c.k0 + kh;
#pragma unroll
      for (int q = 0; q < 4; ++q) { float v[8];
#pragma unroll
          for (int j = 0; j < 8; ++j) v[j] = tile[(kh + 8 * q + j) * 257 + n];
          u32x4 o; o[0] = pack2(v[0], v[1]); o[1] = pack2(v[2], v[3]); o[2] = pack2(v[4], v[5]); o[3] = pack2(v[6], v[7]);
          *(u32x4*)(drow + 8 * q) = o; } }
    __syncthreads();
}
DEV void phase_convert(const Params& p, int l, LAS unsigned char* lds) {
    LAS float* tile = (LAS float*)lds;
    const int tid = opaque_tid();
    constexpr int T_MAIN = 13 * 16 + 4 * 16 + NE * 16 * 16 + NE * 4 * 32;
    {
        f32x4 ra[8], rb[8];
        int t = blockIdx.x;
        ConvTile ca, cb;
        if (t < T_MAIN) { ca = conv_desc(p, l, t); conv_issue(ca, ra, tid); }
        while (t < T_MAIN) {
            const int t1 = t + gridDim.x;
            if (t1 < T_MAIN) { cb = conv_desc(p, l, t1); conv_issue(cb, rb, tid); }
            conv_finish(ca, ra, tile, tid);
            const int t2 = t1 + gridDim.x;
            if (t1 < T_MAIN) { if (t2 < T_MAIN) { ca = conv_desc(p, l, t2); conv_issue(ca, ra, tid); } conv_finish(cb, rb, tile, tid); }
            t = t2;
        }
    }
    { bf16_t* btin = (bf16_t*)(p.ws + WS_BTIN); const float* w_in = p.in[6] + (size_t)l * D_ * PROJ_W0;
      for (int t = blockIdx.x; t < 4 * 16; t += gridDim.x) conv_tile<true>(w_in, PROJ_W0, 0, btin, D_, PROJ_N + (t / 16) * 64, (t % 16) * 64, tile); }
    if (blockIdx.x == 0) { float* bias = (float*)(p.ws + WS_BIAS); const float* b_in = p.in[7] + (size_t)l * PROJ_W0;
        for (int i = tid; i < PROJ_NP; i += 512) { const int s = win_srccol(i); bias[i] = s >= 0 ? b_in[s] : 0.f; } }
    if (l == 0) {
        const float* mods = (const float*)(p.ws + WS_MODS); bf16_t* ub = (bf16_t*)(p.ws + WS_U);
        const int lane = tid & 63, gw = blockIdx.x * 8 + (tid >> 6), nw = gridDim.x * 8;
        static_assert(T_ % 4 == 0 && TC_ % 4 == 0 && NL % 4 == 0, "row groups stay inside one sample");
        for (int grp = gw; grp * 4 < NTOK; grp += nw) {
            const int row0 = grp * 4;
            const bool isl = row0 < NL; const int bb = isl ? row0 / T_ : B_;
            const float* md = mods + (size_t)bb * 6144;
            f32x4 xa[4][2], xb[4][2];
#pragma unroll
            for (int r = 0; r < 4; ++r) { const int row = row0 + r; const float* xr = isl ? p.in[0] + (size_t)row * D_ : p.in[2] + (size_t)(row - NL) * D_;
#pragma unroll
                for (int i = 0; i < 2; ++i) { const int c = lane * 8 + i * 512; xa[r][i] = *(const f32x4*)(xr + c); xb[r][i] = *(const f32x4*)(xr + c + 4); } }
#pragma unroll
            for (int i = 0; i < 2; ++i) { const int c = lane * 8 + i * 512;
                const f32x4 s0 = *(const f32x4*)(md + 1024 + c) + 1.0f, s1 = *(const f32x4*)(md + 1024 + c + 4) + 1.0f, h0 = *(const f32x4*)(md + c), h1 = *(const f32x4*)(md + c + 4);
#pragma unroll
                for (int r = 0; r < 4; ++r) { const f32x4 a = xa[r][i] * s0 + h0, b = xb[r][i] * s1 + h1;
                    u32x4 o; o[0] = pack2(a[0], a[1]); o[1] = pack2(a[2], a[3]); o[2] = pack2(b[0], b[1]); o[3] = pack2(b[2], b[3]);
                    *(u32x4*)(ub + (size_t)(row0 + r) * D_ + c) = o; } }
        }
    }
}

DEV int tok_row(bool lat, int b, int pos) { return lat ? b * T_ + pos : NL + b * TC_ + pos; }
DEV bf16x8 lds_frag(const LAS bf16_t* base, int row, int stride, int col) { return *(const LAS bf16x8*)(base + row * stride + col); }

#ifdef HOST_EMU
#define WAVE_SYNC() do { int z_ = 0; (void)emu::wave_all(&z_, 4); } while (0)
#else
#define WAVE_SYNC() __builtin_amdgcn_wave_barrier()
#endif
#ifdef HOST_EMU
DEV void wg_release_acquire() { __syncthreads(); }
#else
DEV void wg_release_acquire() {
    __builtin_amdgcn_fence(__ATOMIC_RELEASE, "workgroup"); asm volatile("s_waitcnt vmcnt(0)" ::: "memory"); __syncthreads();
    __builtin_amdgcn_fence(__ATOMIC_ACQUIRE, "agent"); asm volatile("s_waitcnt vmcnt(0)" ::: "memory"); }
#endif
DEV void merge_head(const Params& p, int l, int b, int part, int h, int tid) {
    const bool need_ctx = l < DEPTH_ - 1;
    const bf16_t* proj = (const bf16_t*)(p.ws + WS_R1 + R1_PROJ); bf16_t* ymix = (bf16_t*)(p.ws + WS_YMIX);
    const bf16_t* o0 = (const bf16_t*)(p.ws + WS_R1 + (part ? R1_OG : R1_OM)); const bf16_t* o1 = o0 + (size_t)NTOK * 256;
    const int ch = h * 64 + (tid & 7) * 8;
    const float* gn = (part ? p.in[12] : p.in[11]) + (size_t)l * 256 + ch;
    const f32x4 g0 = *(const f32x4*)gn, g1 = *(const f32x4*)(gn + 4);
    const int ntk = T_ + (need_ctx ? TC_ : 0);
    for (int i0 = tid >> 3; i0 < ntk; i0 += 256) {
        int rows[4]; u32x4 oa[4], ob[4]; u32x4 gtv[4];
#pragma unroll
        for (int k = 0; k < 4; ++k) { const int i = i0 + 64 * k; const int row = i < T_ ? b * T_ + i : NL + b * TC_ + (i - T_); rows[k] = row;
            oa[k] = *(const u32x4*)(o0 + (size_t)row * 256 + ch); ob[k] = *(const u32x4*)(o1 + (size_t)row * 256 + ch);
            gtv[k] = *(const u32x4*)(proj + (size_t)row * PROJ_N + (part ? C_GR : C_MO) + ch); }
#pragma unroll
        for (int k = 0; k < 4; ++k) {
            const f32x4 x0 = (f32x4){bflo(oa[k][0]) + bflo(ob[k][0]), bfhi(oa[k][0]) + bfhi(ob[k][0]), bflo(oa[k][1]) + bflo(ob[k][1]), bfhi(oa[k][1]) + bfhi(ob[k][1])};
            const f32x4 x1 = (f32x4){bflo(oa[k][2]) + bflo(ob[k][2]), bfhi(oa[k][2]) + bfhi(ob[k][2]), bflo(oa[k][3]) + bflo(ob[k][3]), bfhi(oa[k][3]) + bfhi(ob[k][3])};
            float s = x0[0] + x0[1] + x0[2] + x0[3] + x1[0] + x1[1] + x1[2] + x1[3];
            s += shfl_xor_f(s, 1); s += shfl_xor_f(s, 2); s += shfl_xor_f(s, 4);
            const float mu = s * (1.0f / 64.0f);
            const f32x4 d0 = x0 - mu, d1 = x1 - mu;
            float q = d0[0] * d0[0] + d0[1] * d0[1] + d0[2] * d0[2] + d0[3] * d0[3] + d1[0] * d1[0] + d1[1] * d1[1] + d1[2] * d1[2] + d1[3] * d1[3];
            q += shfl_xor_f(q, 1); q += shfl_xor_f(q, 2); q += shfl_xor_f(q, 4);
            const float rstd = 1.0f / sqrtf(q * (1.0f / 64.0f) + LN_EPS);
            float gv[8];
#pragma unroll
            for (int j = 0; j < 4; ++j) { gv[2 * j] = bflo(gtv[k][j]); gv[2 * j + 1] = bfhi(gtv[k][j]); }
            float y[8];
#pragma unroll
            for (int j = 0; j < 8; ++j) { const float nv = (j < 4 ? d0[j] : d1[j - 4]) * rstd * (j < 4 ? g0[j] : g1[j - 4]); y[j] = nv * (part ? silu_fast(gv[j]) : sigmoid_fast(gv[j])); }
            u32x4 ov; ov[0] = pack2(y[0], y[1]); ov[1] = pack2(y[2], y[3]); ov[2] = pack2(y[4], y[5]); ov[3] = pack2(y[6], y[7]);
            *(u32x4*)(ymix + (size_t)rows[k] * D_ + part * 256 + ch) = ov;
        }
    }
}

struct MlItem { u32x2 q1[3], q2[3], k1[3], k2[3]; };
struct MlChunk { u32x2 q[2][2], k[2][2]; u32x4 v[2]; float gtv, g_pt, cm63; };
DEV void mlstm_unit(const Params& p, int l, int b, int h, LAS unsigned char* lds) {
    constexpr int ST = 72;
    constexpr int DSZ = 4 * 64 * ST * 2 + 2 * 80 * ST * 2 + 3 * 64 * 4 + 3 * 128 * 4;
    static_assert(2 * DSZ <= LDS_BYTES - 32, "mlstm lds");
    const int tid = opaque_tid(), lane = tid & 63, w = tid >> 6, dir = w >> 2, wh = w & 3, t4 = tid & 255, fr = lane & 15, fq = lane >> 4;
    LAS unsigned char* db = lds + dir * DSZ;
    LAS bf16_t* Qs = (LAS bf16_t*)db;
    LAS bf16_t* Ks = Qs + 64 * ST;
    LAS bf16_t* KT = Ks + 64 * ST;
    LAS bf16_t* Ps = KT + 64 * ST;
    LAS bf16_t* VT = Ps + 64 * ST;
    LAS bf16_t* Cs = VT + 80 * ST;
    LAS float* gt = (LAS float*)(Cs + 80 * ST);
    LAS float* cw = gt + 3 * 64;
    const bf16_t* proj = (const bf16_t*)(p.ws + WS_R1 + R1_PROJ); const float* gates = (const float*)(p.ws + WS_R1 + R1_GATES);
    bf16_t* qk2 = (bf16_t*)(p.ws + WS_R1 + R1_QK2);
    bf16_t* om = (bf16_t*)(p.ws + WS_R1 + R1_OM) + (size_t)dir * NTOK * 256;
    float* gbuf = (float*)(p.ws + WS_GSCAN) + (size_t)((b * 4 + h) * 2 + dir) * NCH * 192;
    const float* ropeM = (const float*)(p.ws + WS_ROPE);
    __syncthreads();
    for (int i = t4; i < 3 * 128; i += 256) { const int j = i / 128, c = i % 128; cw[i] = p.in[8][((size_t)l * 3 + j) * 512 + (c < 64 ? h * 64 + c : 256 + h * 64 + (c - 64))]; }
    for (int i = t4; i < 80 * ST; i += 256) Cs[i] = 0;
    for (int i = t4; i < 16 * ST; i += 256) VT[64 * ST + i] = (bf16_t)0x3F80;
    for (int c0 = wh; c0 < NCH; c0 += 12) {
        float ig[3], fg[3];
#pragma unroll
        for (int k = 0; k < 3; ++k) { const int c = c0 + 4 * k; ig[k] = fg[k] = 0.f;
            if (c < NCH) { const bool lat = c >= NCH_C; const int cc = lat ? c - NCH_C : c; const int Ts = lat ? T_ : TC_;
                const int sp = dir == 0 ? cc * 64 + lane : Ts - 1 - (cc * 64 + lane);
                const float* gr = gates + (size_t)tok_row(lat, b, sp) * NG + dir * 8 + h; ig[k] = gr[0]; fg[k] = gr[4]; } }
#pragma unroll
        for (int k = 0; k < 3; ++k) { const int c = c0 + 4 * k;
            if (c < NCH) {
                float bs = logsigf(fg[k]);
                for (int d = 1; d < 64; d <<= 1) { const float o = shfl_up_f(bs, d); if (lane >= d) bs += o; }
                const float g = ig[k] - bs;
                float cm = g;
                for (int d = 1; d < 64; d <<= 1) { const float o = shfl_up_f(cm, d); if (lane >= d) cm = fmaxf(cm, o); }
                gbuf[c * 192 + lane] = bs; gbuf[c * 192 + 64 + lane] = g; gbuf[c * 192 + 128 + lane] = cm; } }
    }
    __syncthreads();
    {
        constexpr int NIT = (TC_ + T_) * 8;
        auto item_load = [&](int it, MlItem& R) {
            const int tk = it >> 3, pg = it & 7; const bool lat = tk >= TC_; const int sp = lat ? tk - TC_ : tk, Ts = lat ? T_ : TC_;
            const int hf = pg >> 2, i0 = 4 * (pg & 3), dA = 32 * hf + i0, dB = dA + 16;
#pragma unroll
            for (int tap = 0; tap < 3; ++tap) { const int sp2 = sp + tap - 1; const bool ok = sp2 >= 0 && sp2 < Ts; const int spc = ok ? sp2 : sp;
                const bf16_t* pr = proj + (size_t)tok_row(lat, b, spc) * PROJ_N + h * 64;
                const u32x2 z = (u32x2){0u, 0u};
                const u32x2 a = *(const u32x2*)(pr + C_MQ + dA), bq = *(const u32x2*)(pr + C_MQ + dB), c = *(const u32x2*)(pr + C_MK + dA), d = *(const u32x2*)(pr + C_MK + dB);
                R.q1[tap] = ok ? a : z; R.q2[tap] = ok ? bq : z; R.k1[tap] = ok ? c : z; R.k2[tap] = ok ? d : z; } };
        auto item_finish = [&](int it, const MlItem& R) {
            const int tk = it >> 3, pg = it & 7; const bool lat = tk >= TC_; const int sp = lat ? tk - TC_ : tk;
            const int hf = pg >> 2, i0 = 4 * (pg & 3), dA = 32 * hf + i0, dB = dA + 16;
            float qa[4], qb[4], ka[4], kb[4];
#pragma unroll
            for (int j = 0; j < 4; ++j) { qa[j] = qb[j] = ka[j] = kb[j] = 0.f; }
#pragma unroll
            for (int tap = 0; tap < 3; ++tap) { const LAS float* wq = cw + tap * 128;
                qa[0] += wq[dA] * bflo(R.q1[tap][0]); qa[1] += wq[dA + 1] * bfhi(R.q1[tap][0]); qa[2] += wq[dA + 2] * bflo(R.q1[tap][1]); qa[3] += wq[dA + 3] * bfhi(R.q1[tap][1]);
                qb[0] += wq[dB] * bflo(R.q2[tap][0]); qb[1] += wq[dB + 1] * bfhi(R.q2[tap][0]); qb[2] += wq[dB + 2] * bflo(R.q2[tap][1]); qb[3] += wq[dB + 3] * bfhi(R.q2[tap][1]);
                ka[0] += wq[64 + dA] * bflo(R.k1[tap][0]); ka[1] += wq[64 + dA + 1] * bfhi(R.k1[tap][0]); ka[2] += wq[64 + dA + 2] * bflo(R.k1[tap][1]); ka[3] += wq[64 + dA + 3] * bfhi(R.k1[tap][1]);
                kb[0] += wq[64 + dB] * bflo(R.k2[tap][0]); kb[1] += wq[64 + dB + 1] * bfhi(R.k2[tap][0]); kb[2] += wq[64 + dB + 2] * bflo(R.k2[tap][1]); kb[3] += wq[64 + dB + 3] * bfhi(R.k2[tap][1]); }
#pragma unroll
            for (int j = 0; j < 4; ++j) { qa[j] = silu_fast(qa[j]); qb[j] = silu_fast(qb[j]); ka[j] = silu_fast(ka[j]) * 0.125f; kb[j] = silu_fast(kb[j]) * 0.125f; }
            if (lat) { const int pos = hf == 0 ? (sp >> 6) : (sp & 63);
#pragma unroll
                for (int j = 0; j < 4; ++j) { const float cs = ropeM[(pos * 16 + i0 + j) * 2], sn = ropeM[(pos * 16 + i0 + j) * 2 + 1];
                    const float q1 = qa[j] * cs - qb[j] * sn, q2 = qa[j] * sn + qb[j] * cs; qa[j] = q1; qb[j] = q2;
                    const float k1 = ka[j] * cs - kb[j] * sn, k2 = ka[j] * sn + kb[j] * cs; ka[j] = k1; kb[j] = k2; } }
            bf16_t* dst = qk2 + (size_t)tok_row(lat, b, sp) * 512 + h * 128;
            u32x2 o;
            o[0] = pack2(qa[0], qa[1]); o[1] = pack2(qa[2], qa[3]); *(u32x2*)(dst + dA) = o;
            o[0] = pack2(qb[0], qb[1]); o[1] = pack2(qb[2], qb[3]); *(u32x2*)(dst + dB) = o;
            o[0] = pack2(ka[0], ka[1]); o[1] = pack2(ka[2], ka[3]); *(u32x2*)(dst + 64 + dA) = o;
            o[0] = pack2(kb[0], kb[1]); o[1] = pack2(kb[2], kb[3]); *(u32x2*)(dst + 64 + dB) = o; };
        for (int it0 = tid; it0 < NIT; it0 += 1024) {
            MlItem A, B; const bool two = it0 + 512 < NIT;
            item_load(it0, A); if (two) item_load(it0 + 512, B);
            item_finish(it0, A); if (two) item_finish(it0 + 512, B);
        }
    }
    wg_release_acquire();
    f32x4 cacc[5];
#pragma unroll
    for (int i = 0; i < 5; ++i) cacc[i] = (f32x4){0.f, 0.f, 0.f, 0.f};
    const int ti = wh;
    const int pt = t4 >> 2, pgq = t4 & 3;
    float m_in = 0.f;
    auto chunk_load = [&](int c, MlChunk& R) {
        const bool lat = c >= NCH_C; const int cc = lat ? c - NCH_C : c; const int Ts = lat ? T_ : TC_;
        const int sp = dir == 0 ? cc * 64 + pt : Ts - 1 - (cc * 64 + pt);
        const size_t row = (size_t)tok_row(lat, b, sp);
#pragma unroll
        for (int sub = 0; sub < 2; ++sub) { const int pg = pgq * 2 + sub; const int hf = pg >> 2, i0 = 4 * (pg & 3), dA = 32 * hf + i0, dB = dA + 16;
            const bf16_t* src = qk2 + row * 512 + h * 128;
            R.q[sub][0] = *(const u32x2*)(src + dA); R.q[sub][1] = *(const u32x2*)(src + dB); R.k[sub][0] = *(const u32x2*)(src + 64 + dA); R.k[sub][1] = *(const u32x2*)(src + 64 + dB);
            R.v[sub] = *(const u32x4*)(proj + row * PROJ_N + C_MV + h * 64 + pg * 8); }
        R.gtv = gbuf[c * 192 + (t4 < 192 ? t4 : 0)]; R.g_pt = gbuf[c * 192 + 64 + pt]; R.cm63 = gbuf[c * 192 + 128 + 63]; };
    MlChunk cur, nxt;
    chunk_load(0, cur); nxt = cur;
    for (int c = 0; c < NCH; ++c) {
        const bool lat = c >= NCH_C; const int cc = lat ? c - NCH_C : c; const int Ts = lat ? T_ : TC_;
        {
            if (t4 < 192) gt[t4] = cur.gtv;
            const float wsc = fast_exp(cur.g_pt - fmaxf(m_in, cur.cm63));
#pragma unroll
            for (int sub = 0; sub < 2; ++sub) { const int pg = pgq * 2 + sub; const int hf = pg >> 2, i0 = 4 * (pg & 3), dA = 32 * hf + i0, dB = dA + 16;
                *(LAS u32x2*)(Qs + pt * ST + dA) = cur.q[sub][0]; *(LAS u32x2*)(Qs + pt * ST + dB) = cur.q[sub][1];
                *(LAS u32x2*)(Ks + pt * ST + dA) = cur.k[sub][0]; *(LAS u32x2*)(Ks + pt * ST + dB) = cur.k[sub][1];
                const float ka[4] = {bflo(cur.k[sub][0][0]), bfhi(cur.k[sub][0][0]), bflo(cur.k[sub][0][1]), bfhi(cur.k[sub][0][1])};
                const float kb[4] = {bflo(cur.k[sub][1][0]), bfhi(cur.k[sub][1][0]), bflo(cur.k[sub][1][1]), bfhi(cur.k[sub][1][1])};
#pragma unroll
                for (int j = 0; j < 4; ++j) { KT[(dA + j) * ST + pt] = f2bf(ka[j] * wsc); KT[(dB + j) * ST + pt] = f2bf(kb[j] * wsc); }
                const u32x4 vv = cur.v[sub];
#pragma unroll
                for (int j = 0; j < 4; ++j) { VT[(pg * 8 + 2 * j) * ST + pt] = (bf16_t)(vv[j] & 0xFFFFu); VT[(pg * 8 + 2 * j + 1) * ST + pt] = (bf16_t)(vv[j] >> 16); } }
        }
        LDS_BARRIER();
        if (c + 1 < NCH) chunk_load(c + 1, nxt);
        const float M63 = fmaxf(m_in, gt[128 + 63]);
        float Mt[4];
#pragma unroll
        for (int r = 0; r < 4; ++r) Mt[r] = fmaxf(m_in, gt[128 + 16 * ti + 4 * fq + r]);
        {
            const bf16x8 a0 = lds_frag(Qs, 16 * ti + fr, ST, 8 * fq), a1 = lds_frag(Qs, 16 * ti + fr, ST, 32 + 8 * fq);
#pragma unroll
            for (int tj = 0; tj < 4; ++tj) {
                f32x4 s = (f32x4){0.f, 0.f, 0.f, 0.f};
                s = mfma16(a0, lds_frag(Ks, 16 * tj + fr, ST, 8 * fq), s);
                s = mfma16(a1, lds_frag(Ks, 16 * tj + fr, ST, 32 + 8 * fq), s);
                const int sc_ = 16 * tj + fr; const float gs = gt[64 + sc_];
#pragma unroll
                for (int r = 0; r < 4; ++r) { const int t = 16 * ti + 4 * fq + r;
                    const float pv = sc_ <= t ? s[r] * fast_exp(gs - Mt[r]) : 0.f; Ps[t * ST + sc_] = f2bf(pv); } }
            const float decay = fast_exp(m_in - M63);
            const bf16x8 v0 = lds_frag(VT, 16 * ti + fr, ST, 8 * fq), v1 = lds_frag(VT, 16 * ti + fr, ST, 32 + 8 * fq);
#pragma unroll
            for (int dj = 0; dj < 4; ++dj) { cacc[dj] = cacc[dj] * decay;
                cacc[dj] = mfma16(v0, lds_frag(KT, 16 * dj + fr, ST, 8 * fq), cacc[dj]);
                cacc[dj] = mfma16(v1, lds_frag(KT, 16 * dj + fr, ST, 32 + 8 * fq), cacc[dj]); }
            cacc[4] = cacc[4] * decay;
            cacc[4] = mfma16(lds_frag(VT, 64 + fr, ST, 8 * fq), lds_frag(KT, 16 * wh + fr, ST, 8 * fq), cacc[4]);
            cacc[4] = mfma16(lds_frag(VT, 64 + fr, ST, 32 + 8 * fq), lds_frag(KT, 16 * wh + fr, ST, 32 + 8 * fq), cacc[4]);
        }
        WAVE_SYNC();
        {
            const bf16x8 p0 = lds_frag(Ps, 16 * ti + fr, ST, 8 * fq), p1 = lds_frag(Ps, 16 * ti + fr, ST, 32 + 8 * fq);
            const bf16x8 q0 = lds_frag(Qs, 16 * ti + fr, ST, 8 * fq), q1 = lds_frag(Qs, 16 * ti + fr, ST, 32 + 8 * fq);
            f32x4 np_[5];
            float ev[4];
#pragma unroll
            for (int r = 0; r < 4; ++r) ev[r] = fast_exp(m_in - Mt[r]);
#pragma unroll
            for (int tj = 0; tj < 5; ++tj) { f32x4 nc = (f32x4){0.f, 0.f, 0.f, 0.f}; np_[tj] = (f32x4){0.f, 0.f, 0.f, 0.f};
                np_[tj] = mfma16(p0, lds_frag(VT, 16 * tj + fr, ST, 8 * fq), np_[tj]);
                np_[tj] = mfma16(p1, lds_frag(VT, 16 * tj + fr, ST, 32 + 8 * fq), np_[tj]);
                nc = mfma16(q0, lds_frag(Cs, 16 * tj + fr, ST, 8 * fq), nc);
                nc = mfma16(q1, lds_frag(Cs, 16 * tj + fr, ST, 32 + 8 * fq), nc);
#pragma unroll
                for (int r = 0; r < 4; ++r) np_[tj][r] += ev[r] * nc[r]; }
#pragma unroll
            for (int r = 0; r < 4; ++r) { const int t = 16 * ti + 4 * fq + r;
                const float dn = fmaxf(fabsf(np_[4][r]), fast_exp(-gt[t] - Mt[r])); const float inv = 1.0f / dn;
                const int sp = dir == 0 ? cc * 64 + t : Ts - 1 - (cc * 64 + t);
                bf16_t* orow = om + (size_t)tok_row(lat, b, sp) * 256 + h * 64;
#pragma unroll
                for (int tj = 0; tj < 4; ++tj) orow[16 * tj + fr] = f2bf(np_[tj][r] * inv); }
        }
        m_in = gt[63] + M63;
        LDS_BARRIER();
#pragma unroll
        for (int dj = 0; dj < 4; ++dj)
#pragma unroll
            for (int r = 0; r < 4; ++r) Cs[(16 * ti + 4 * fq + r) * ST + 16 * dj + fr] = f2bf(cacc[dj][r]);
#pragma unroll
        for (int r = 0; r < 4; ++r) Cs[(64 + 4 * fq + r) * ST + 16 * wh + fr] = f2bf(cacc[4][r]);
        cur = nxt;
    }
    wg_release_acquire();
    merge_head(p, l, b, 0, h, tid);
}

template <int KS, int HALF, int DJ> struct GlaTr { static constexpr int v = ((32 * KS + 4 * HALF) * 40 + 16 * DJ) * 2; };
struct GlChunk { f32x4 lr[4]; unsigned q[2][2], k[2][2]; u32x4 v[2]; };
DEV void gla_unit(const Params& p, int l, int b, int h, LAS unsigned char* lds) {
    constexpr int ST = 72, SQ = 40;
    constexpr int DSZ = 5 * 64 * SQ * 2 + 32 * ST * 2 + 2 * 64 * ST * 2 + 64 * 33 * 4 + 544 * 4;
    static_assert(2 * DSZ <= LDS_BYTES - 32, "gla lds");
    const int tid = opaque_tid(), lane = tid & 63, w = tid >> 6, dir = w >> 2, wh = w & 3, t4 = tid & 255, fr = lane & 15, fq = lane >> 4;
    LAS unsigned char* db = lds + dir * DSZ;
    LAS bf16_t* Qs = (LAS bf16_t*)db;
    LAS bf16_t* Ks = Qs + 64 * SQ;
    LAS bf16_t* Ss = Ks + 64 * SQ;
    LAS bf16_t* Ah = Ss + 64 * SQ;
    LAS bf16_t* Al = Ah + 64 * SQ;
    LAS bf16_t* KT = Al + 64 * SQ;
    LAS bf16_t* VT = KT + 32 * ST;
    LAS bf16_t* Ps = VT + 64 * ST;
    LAS float* bc = (LAS float*)(Ps + 64 * ST);
    LAS float* w2s = bc + 64 * 33;
    const bf16_t* proj = (const bf16_t*)(p.ws + WS_R1 + R1_PROJ); const float* gates = (const float*)(p.ws + WS_R1 + R1_GATES);
    bf16_t* og = (bf16_t*)(p.ws + WS_R1 + R1_OG) + (size_t)dir * NTOK * 256;
    const float* ropeG = (const float*)(p.ws + WS_ROPE) + 2048;
    __syncthreads();
    for (int i = t4; i < 16 * 32; i += 256) { const int r = i >> 5, d = i & 31; w2s[i] = p.in[9][(((size_t)l * 2 + dir) * 16 + r) * 128 + h * 32 + d]; }
    if (t4 < 32) w2s[512 + t4] = p.in[10][((size_t)l * 2 + dir) * 128 + h * 32 + t4];
    for (int i = t4; i < 64 * SQ; i += 256) Ss[i] = 0;
    __syncthreads();
    f32x4 sacc[2];
    sacc[0] = (f32x4){0.f, 0.f, 0.f, 0.f}; sacc[1] = (f32x4){0.f, 0.f, 0.f, 0.f};
    const int ti = wh;
    const int pt = t4 >> 2, pgq = t4 & 3;
    bf16x8 lf_[2];
#pragma unroll
    for (int ks = 0; ks < 2; ++ks)
#pragma unroll
        for (int j = 0; j < 8; ++j) lf_[ks][j] = (32 * ks + 8 * fq + j <= 16 * ti + fr) ? (short)0x3F80 : (short)0;
    auto chunk_load = [&](int c, GlChunk& R) {
        const bool lat = c >= NCH_C; const int cc = lat ? c - NCH_C : c; const int Ts = lat ? T_ : TC_;
        const int sp = dir == 0 ? cc * 64 + pt : Ts - 1 - (cc * 64 + pt);
        const size_t row = (size_t)tok_row(lat, b, sp);
        const float* lr = gates + row * NG + 16 + dir * 16;
#pragma unroll
        for (int r = 0; r < 4; ++r) R.lr[r] = *(const f32x4*)(lr + 4 * r);
        const bf16_t* pr = proj + row * PROJ_N;
#pragma unroll
        for (int sub = 0; sub < 2; ++sub) { const int pg = pgq * 2 + sub; const int hf = pg >> 2, i0 = 2 * (pg & 3), dA = 16 * hf + i0, dB = dA + 8;
            R.q[sub][0] = *(const unsigned*)(pr + C_GQ + h * 32 + dA); R.q[sub][1] = *(const unsigned*)(pr + C_GQ + h * 32 + dB);
            R.k[sub][0] = *(const unsigned*)(pr + C_GK + h * 32 + dA); R.k[sub][1] = *(const unsigned*)(pr + C_GK + h * 32 + dB);
            R.v[sub] = *(const u32x4*)(pr + C_GV + h * 64 + pg * 8); } };
    GlChunk cur, nxt;
    chunk_load(0, cur); nxt = cur;
    for (int c = 0; c < NCH; ++c) {
        const bool lat = c >= NCH_C; const int cc = lat ? c - NCH_C : c; const int Ts = lat ? T_ : TC_;
        const int sp = dir == 0 ? cc * 64 + pt : Ts - 1 - (cc * 64 + pt);
        { float lrv[16];
#pragma unroll
          for (int r = 0; r < 16; r += 4) { lrv[r] = cur.lr[r >> 2][0]; lrv[r + 1] = cur.lr[r >> 2][1]; lrv[r + 2] = cur.lr[r >> 2][2]; lrv[r + 3] = cur.lr[r >> 2][3]; }
          float av[8];
#pragma unroll
          for (int j = 0; j < 8; ++j) { const int d = pgq * 8 + j; float z = w2s[512 + d];
#pragma unroll
              for (int r = 0; r < 16; ++r) z += lrv[r] * w2s[r * 32 + d];
              av[j] = logsig_fast(z) * (1.0f / 16.0f); }
          u32x4 hi, lo;
#pragma unroll
          for (int j = 0; j < 4; ++j) { const bf16_t h0 = f2bf(av[2 * j]), h1 = f2bf(av[2 * j + 1]);
              hi[j] = (unsigned)h0 | ((unsigned)h1 << 16); lo[j] = (unsigned)f2bf(av[2 * j] - bf2f(h0)) | ((unsigned)f2bf(av[2 * j + 1] - bf2f(h1)) << 16); }
          *(LAS u32x4*)(Ah + pt * SQ + pgq * 8) = hi; *(LAS u32x4*)(Al + pt * SQ + pgq * 8) = lo; }
        LDS_BARRIER();
        {
            const lds_addr_t ah = lds_addr(Ah + (8 * fq + (fr >> 2)) * SQ + 4 * (fr & 3)), al = lds_addr(Al + (8 * fq + (fr >> 2)) * SQ + 4 * (fr & 3));
#define GLA_CS(DJ) do { \
            const bf16x4 h00 = tr_read4<GlaTr<0, 0, DJ>::v>(ah), h01 = tr_read4<GlaTr<0, 1, DJ>::v>(ah), h10 = tr_read4<GlaTr<1, 0, DJ>::v>(ah), h11 = tr_read4<GlaTr<1, 1, DJ>::v>(ah); \
            const bf16x4 l00 = tr_read4<GlaTr<0, 0, DJ>::v>(al), l01 = tr_read4<GlaTr<0, 1, DJ>::v>(al), l10 = tr_read4<GlaTr<1, 0, DJ>::v>(al), l11 = tr_read4<GlaTr<1, 1, DJ>::v>(al); \
            LGKM_WAIT0(); \
            f32x4 acc = (f32x4){0.f, 0.f, 0.f, 0.f}; \
            acc = mfma16(lf_[0], (bf16x8){h00[0], h00[1], h00[2], h00[3], h01[0], h01[1], h01[2], h01[3]}, acc); \
            acc = mfma16(lf_[1], (bf16x8){h10[0], h10[1], h10[2], h10[3], h11[0], h11[1], h11[2], h11[3]}, acc); \
            acc = mfma16(lf_[0], (bf16x8){l00[0], l00[1], l00[2], l00[3], l01[0], l01[1], l01[2], l01[3]}, acc); \
            acc = mfma16(lf_[1], (bf16x8){l10[0], l10[1], l10[2], l10[3], l11[0], l11[1], l11[2], l11[3]}, acc); \
            _Pragma("unroll") for (int r = 0; r < 4; ++r) bc[(16 * ti + 4 * fq + r) * 33 + 16 * DJ + fr] = acc[r]; } while (0)
            GLA_CS(0); GLA_CS(1);
#undef GLA_CS
        }
        WAVE_SYNC();
#pragma unroll
        for (int sub = 0; sub < 2; ++sub) {
            const int pg = pgq * 2 + sub;
            const int hf = pg >> 2, i0 = 2 * (pg & 3), dA = 16 * hf + i0, dB = dA + 8;
            const unsigned q1 = cur.q[sub][0], q2 = cur.q[sub][1], k1 = cur.k[sub][0], k2 = cur.k[sub][1];
            const float qs_ = 0.17677669529663687f;
            float qa[2] = {bflo(q1) * qs_, bfhi(q1) * qs_}, qb[2] = {bflo(q2) * qs_, bfhi(q2) * qs_}, ka[2] = {bflo(k1), bfhi(k1)}, kb[2] = {bflo(k2), bfhi(k2)};
            if (lat) { const int pos = hf == 0 ? (sp >> 6) : (sp & 63);
#pragma unroll
                for (int j = 0; j < 2; ++j) { const float cs = ropeG[(pos * 8 + i0 + j) * 2], sn = ropeG[(pos * 8 + i0 + j) * 2 + 1];
                    const float x1 = qa[j] * cs - qb[j] * sn, x2 = qa[j] * sn + qb[j] * cs; qa[j] = x1; qb[j] = x2;
                    const float y1 = ka[j] * cs - kb[j] * sn, y2 = ka[j] * sn + kb[j] * cs; ka[j] = y1; kb[j] = y2; } }
#pragma unroll
            for (int j = 0; j < 2; ++j) { const float bA = bc[pt * 33 + dA + j], bB = bc[pt * 33 + dB + j];
                qa[j] *= fast_exp(bA); qb[j] *= fast_exp(bB); ka[j] *= fast_exp(-bA); kb[j] *= fast_exp(-bB); }
            *(LAS unsigned*)(Qs + pt * SQ + dA) = pack2(qa[0], qa[1]); *(LAS unsigned*)(Qs + pt * SQ + dB) = pack2(qb[0], qb[1]);
            *(LAS unsigned*)(Ks + pt * SQ + dA) = pack2(ka[0], ka[1]); *(LAS unsigned*)(Ks + pt * SQ + dB) = pack2(kb[0], kb[1]);
#pragma unroll
            for (int j = 0; j < 2; ++j) { KT[(dA + j) * ST + pt] = f2bf(ka[j]); KT[(dB + j) * ST + pt] = f2bf(kb[j]); }
            const u32x4 vv = cur.v[sub];
#pragma unroll
            for (int j = 0; j < 4; ++j) { VT[(pg * 8 + 2 * j) * ST + pt] = (bf16_t)(vv[j] & 0xFFFFu); VT[(pg * 8 + 2 * j + 1) * ST + pt] = (bf16_t)(vv[j] >> 16); }
        }
        LDS_BARRIER();
        if (c + 1 < NCH) chunk_load(c + 1, nxt);
        {
            const bf16x8 a0 = lds_frag(Qs, 16 * ti + fr, SQ, 8 * fq);
#pragma unroll
            for (int tj = 0; tj < 4; ++tj) {
                f32x4 s = (f32x4){0.f, 0.f, 0.f, 0.f};
                s = mfma16(a0, lds_frag(Ks, 16 * tj + fr, SQ, 8 * fq), s);
                const int sc_ = 16 * tj + fr;
#pragma unroll
                for (int r = 0; r < 4; ++r) { const int t = 16 * ti + 4 * fq + r; Ps[t * ST + sc_] = f2bf(sc_ <= t ? s[r] : 0.f); } }
        }
        WAVE_SYNC();
        {
            const bf16x8 p0 = lds_frag(Ps, 16 * ti + fr, ST, 8 * fq), p1 = lds_frag(Ps, 16 * ti + fr, ST, 32 + 8 * fq), q0 = lds_frag(Qs, 16 * ti + fr, SQ, 8 * fq);
            f32x4 o[4];
#pragma unroll
            for (int tj = 0; tj < 4; ++tj) { o[tj] = (f32x4){0.f, 0.f, 0.f, 0.f};
                o[tj] = mfma16(p0, lds_frag(VT, 16 * tj + fr, ST, 8 * fq), o[tj]);
                o[tj] = mfma16(p1, lds_frag(VT, 16 * tj + fr, ST, 32 + 8 * fq), o[tj]);
                o[tj] = mfma16(q0, lds_frag(Ss, 16 * tj + fr, SQ, 8 * fq), o[tj]); }
#pragma unroll
            for (int r = 0; r < 4; ++r) { const int t = 16 * ti + 4 * fq + r; const int sp2 = dir == 0 ? cc * 64 + t : Ts - 1 - (cc * 64 + t);
                bf16_t* orow = og + (size_t)tok_row(lat, b, sp2) * 256 + h * 64;
#pragma unroll
                for (int tj = 0; tj < 4; ++tj) orow[16 * tj + fr] = f2bf(o[tj][r]); }
            const bf16x8 v0 = lds_frag(VT, 16 * wh + fr, ST, 8 * fq), v1 = lds_frag(VT, 16 * wh + fr, ST, 32 + 8 * fq);
#pragma unroll
            for (int dj = 0; dj < 2; ++dj) {
                sacc[dj] = mfma16(v0, lds_frag(KT, 16 * dj + fr, ST, 8 * fq), sacc[dj]);
                sacc[dj] = mfma16(v1, lds_frag(KT, 16 * dj + fr, ST, 32 + 8 * fq), sacc[dj]);
                sacc[dj] = sacc[dj] * fast_exp(bc[63 * 33 + 16 * dj + fr]); }
        }
        LDS_BARRIER();
#pragma unroll
        for (int dj = 0; dj < 2; ++dj)
#pragma unroll
            for (int r = 0; r < 4; ++r) Ss[(16 * wh + 4 * fq + r) * SQ + 16 * dj + fr] = f2bf(sacc[dj][r]);
        cur = nxt;
    }
    wg_release_acquire();
    merge_head(p, l, b, 1, h, tid);
}

template <int KS, int T16, int VT> struct TrOff { static constexpr int v = ((32 * KS + 16 * T16) * 72 + 16 * VT) * 2; };
template <int NT>
DEV void attn_ldkv(const LAS bf16_t* Kb, lds_addr_t vb, bf16x8 (&kf)[NT][2], bf16x8 (&vf)[NT / 2][4], int fr, int fq) {
#pragma unroll
    for (int kt = 0; kt < NT; ++kt) { kf[kt][0] = lds_frag(Kb, 16 * kt + fr, 72, 8 * fq); kf[kt][1] = lds_frag(Kb, 16 * kt + fr, 72, 32 + 8 * fq); }
    bf16x4 lo[NT / 2][4], hi[NT / 2][4];
#define ATT_TR(KS) do { lo[KS][0] = tr_read4<TrOff<KS, 0, 0>::v>(vb); hi[KS][0] = tr_read4<TrOff<KS, 1, 0>::v>(vb); lo[KS][1] = tr_read4<TrOff<KS, 0, 1>::v>(vb); hi[KS][1] = tr_read4<TrOff<KS, 1, 1>::v>(vb); \
        lo[KS][2] = tr_read4<TrOff<KS, 0, 2>::v>(vb); hi[KS][2] = tr_read4<TrOff<KS, 1, 2>::v>(vb); lo[KS][3] = tr_read4<TrOff<KS, 0, 3>::v>(vb); hi[KS][3] = tr_read4<TrOff<KS, 1, 3>::v>(vb); } while (0)
    ATT_TR(0);
    if constexpr (NT == 4) { ATT_TR(1); }
#undef ATT_TR
    LGKM_WAIT0();
#pragma unroll
    for (int ks = 0; ks < NT / 2; ++ks)
#pragma unroll
        for (int vt = 0; vt < 4; ++vt) vf[ks][vt] = (bf16x8){lo[ks][vt][0], lo[ks][vt][1], lo[ks][vt][2], lo[ks][vt][3], hi[ks][vt][0], hi[ks][vt][1], hi[ks][vt][2], hi[ks][vt][3]};
}
template <int NT, bool LOC>
DEV void attn_tile(const bf16x8 (&kf)[NT][2], const bf16x8 (&vf)[NT / 2][4], bf16x8 qf0, bf16x8 qf1, f32x4 (&o)[4], float& mrun, float& lrun, const LAS float* rpl, int d0) {
    f32x4 s[NT];
#pragma unroll
    for (int kt = 0; kt < NT; ++kt) { s[kt] = (f32x4){0.f, 0.f, 0.f, 0.f}; s[kt] = mfma16(kf[kt][0], qf0, s[kt]); s[kt] = mfma16(kf[kt][1], qf1, s[kt]); }
    float mx = -INFINITY;
#pragma unroll
    for (int kt = 0; kt < NT; ++kt)
#pragma unroll
        for (int j = 0; j < 4; ++j) { float v;
            if (LOC) { const bool ok = (unsigned)(16 * kt + j - d0) < 16u; v = ok ? s[kt][j] * 0.18033688f + rpl[16 * kt + j] : -INFINITY; }
            else v = s[kt][j] * 0.18033688f;
            s[kt][j] = v; mx = fmaxf(mx, v); }
    mx = xrow16_max(mx);
    if (wave_any(mx > mrun + 8.0f)) {
        const float mnew = fmaxf(mrun, mx);
        const float alpha = fast_exp2(mrun - mnew);
        lrun = lrun * alpha; mrun = mnew;
#pragma unroll
        for (int vt = 0; vt < 4; ++vt) o[vt] = o[vt] * alpha;
    }
    float ps = 0.f;
#pragma unroll
    for (int kt = 0; kt < NT; ++kt)
#pragma unroll
        for (int j = 0; j < 4; ++j) { const float pv = fast_exp2(s[kt][j] - mrun); s[kt][j] = pv; ps += pv; }
    lrun += ps;
#pragma unroll
    for (int ks = 0; ks < NT / 2; ++ks) { u32x4 pu; pu[0] = pack2(s[2 * ks][0], s[2 * ks][1]); pu[1] = pack2(s[2 * ks][2], s[2 * ks][3]); pu[2] = pack2(s[2 * ks + 1][0], s[2 * ks + 1][1]); pu[3] = pack2(s[2 * ks + 1][2], s[2 * ks + 1][3]);
        bf16x8 pf; __builtin_memcpy(&pf, &pu, 16);
#pragma unroll
        for (int vt = 0; vt < 4; ++vt) o[vt] = mfma16(vf[ks][vt], pf, o[vt]); }
}
template <bool LOCAL>
DEV void attn_unit(const Params& p, int l, int b, int head, int r0, LAS unsigned char* lds) {
    constexpr int NQT = 2, ST = 72, HB = 64 * ST, BUF = 2 * HB;
    LAS bf16_t* kv = (LAS bf16_t*)lds;
    LAS float* rp = (LAS float*)(kv + 2 * BUF) + 64;
    const int tid = opaque_tid(), lane = tid & 63, w = tid >> 6, fr = lane & 15, fq = lane >> 4;
    const int qt = w & 3, qc = 16 * qt + fr, rw = r0 + 2 * (w >> 2);
    const bf16_t* proj = (const bf16_t*)(p.ws + WS_R1 + R1_PROJ);
    bf16_t* ymix = (bf16_t*)(p.ws + WS_YMIX);
    const int rs_first = r0 - 4 < 0 ? 0 : (r0 - 4 > GRID_R - 8 ? GRID_R - 8 : r0 - 4);
    const int rl = r0 + 3, rs_last = rl - 4 < 0 ? 0 : (rl - 4 > GRID_R - 8 ? GRID_R - 8 : rl - 4);
    const int kr_lo = rs_first, nloc = LOCAL ? rs_last + 8 - rs_first : 0, nblk = nloc + NCH_C;
    const int skey = tid >> 3, sg8 = (tid & 7) * 8;
    const bf16_t* sbase = proj + (size_t)head * 64 + sg8;
    u32x4 kr0, vr0, kr1, vr1;
#define ATT_KROW(kb) ((kb) < nloc ? tok_row(true, b, (kr_lo + (kb)) * 64) : tok_row(false, b, ((kb) - nloc) * 64))
#define ATT_LOAD(kb, KR, VR) do { const bf16_t* pr_ = sbase + (size_t)(ATT_KROW(kb) + skey) * PROJ_N; KR = *(const u32x4*)(pr_ + C_NK); VR = *(const u32x4*)(pr_ + C_NV); } while (0)
#define ATT_STORE(bi, KR, VR) do { LAS bf16_t* d_ = kv + (bi) * BUF + skey * ST + sg8; *(LAS u32x4*)(d_) = KR; *(LAS u32x4*)(d_ + HB) = VR; } while (0)
    __syncthreads();
    ATT_LOAD(0, kr0, vr0);
    ATT_LOAD(1, kr1, vr1);
    if (LOCAL) for (int i = tid; i < 15 * 31; i += 512) rp[i] = p.in[13][((size_t)l * 8 + head) * 465 + i] * 1.44269504f;
    bf16x8 qf[NQT][2]; f32x4 o[NQT][4]; float mrun[NQT], lrun[NQT];
#pragma unroll
    for (int i = 0; i < NQT; ++i) { const bf16_t* qp = proj + (size_t)tok_row(LOCAL, b, (rw + i) * 64 + qc) * PROJ_N + C_NQ + head * 64;
        qf[i][0] = *(const bf16x8*)(qp + 8 * fq); qf[i][1] = *(const bf16x8*)(qp + 32 + 8 * fq); mrun[i] = -INFINITY; lrun[i] = 0.f;
#pragma unroll
        for (int vt = 0; vt < 4; ++vt) o[i][vt] = (f32x4){0.f, 0.f, 0.f, 0.f}; }
    ATT_STORE(0, kr0, vr0);
    ATT_LOAD(2, kr0, vr0);
    const int cs = qc - 8 < 0 ? 0 : (qc - 8 > 48 ? 48 : qc - 8);
    const int koff = qt == 0 ? 0 : (qt == 1 ? 8 : (qt == 2 ? 24 : 32));
    const int d0 = cs - koff - 4 * fq;
    const LAS float* rpl0 = rp + koff + 4 * fq - qc + 15;
    const int rs0 = rw - 4 < 0 ? 0 : (rw - 4 > GRID_R - 8 ? GRID_R - 8 : rw - 4), rs1 = rw - 3 < 0 ? 0 : (rw - 3 > GRID_R - 8 ? GRID_R - 8 : rw - 3);
    LDS_BARRIER();
#define ATT_ITER(kb, KR, VR) do { const int bi = (kb) & 1; \
        if ((kb) + 1 < nblk) ATT_STORE(bi ^ 1, KR, VR); \
        if ((kb) + 3 < nblk) ATT_LOAD((kb) + 3, KR, VR); \
        const LAS bf16_t* Kb = kv + bi * BUF; \
        const LAS bf16_t* Vl = kv + bi * BUF + HB + (4 * fq + (fr >> 2)) * ST + 4 * (fr & 3); \
        if ((kb) < nloc) { \
            const int krow = kr_lo + (kb); \
            const bool a0 = krow >= rs0 && krow < rs0 + 8, a1 = krow >= rs1 && krow < rs1 + 8; \
            if (a0 || a1) { \
                bf16x8 kf[2][2], vf[1][4]; \
                attn_ldkv<2>(Kb + koff * ST, lds_addr(Vl + koff * ST), kf, vf, fr, fq); \
                if (a0) attn_tile<2, true>(kf, vf, qf[0][0], qf[0][1], o[0], mrun[0], lrun[0], rpl0 + (krow - rw + 7) * 31, d0); \
                if (a1) attn_tile<2, true>(kf, vf, qf[1][0], qf[1][1], o[1], mrun[1], lrun[1], rpl0 + (krow - rw - 1 + 7) * 31, d0); \
            } \
        } else { \
            _Pragma("unroll") for (int hf = 0; hf < 2; ++hf) { \
                bf16x8 kf[2][2], vf[1][4]; \
                attn_ldkv<2>(Kb + 32 * hf * ST, lds_addr(Vl + 32 * hf * ST), kf, vf, fr, fq); \
                _Pragma("unroll") for (int i = 0; i < NQT; ++i) attn_tile<2, false>(kf, vf, qf[i][0], qf[i][1], o[i], mrun[i], lrun[i], rpl0, d0); } \
        } \
        LDS_BARRIER(); } while (0)
#pragma unroll 1
    for (int kb = 0; kb < nblk; kb += 2) {
        ATT_ITER(kb, kr1, vr1);
        if (kb + 1 < nblk) ATT_ITER(kb + 1, kr0, vr0);
    }
#undef ATT_ITER
#undef ATT_KROW
#undef ATT_LOAD
#undef ATT_STORE
#pragma unroll
    for (int i = 0; i < NQT; ++i) { const float lr = xrow16_sum(lrun[i]);
        const float inv = 1.0f / lr;
        bf16_t* yr = ymix + (size_t)tok_row(LOCAL, b, (rw + i) * 64 + qc) * D_ + 512 + head * 64;
#pragma unroll
        for (int vt = 0; vt < 4; ++vt) { u32x2 ov; ov[0] = pack2(o[i][vt][0] * inv, o[i][vt][1] * inv); ov[1] = pack2(o[i][vt][2] * inv, o[i][vt][3] * inv); *(u32x2*)(yr + 16 * vt + 4 * fq) = ov; } }
}

DEV void phase_mixer(const Params& p, int l, LAS unsigned char* lds) {
    const bool need_ctx = l < DEPTH_ - 1;
#ifndef REP_K
#define REP_K -1
#endif
#ifndef NO_SCAN
    for (int rep_ = 0; rep_ < ((REP_K == 20 || REP_K == 99) ? 2 : 1); ++rep_)
    for (int u = blockIdx.x; u < B_ * 8; u += gridDim.x) { if (u < B_ * 4) mlstm_unit(p, l, u >> 2, u & 3, lds); else gla_unit(p, l, (u - B_ * 4) >> 2, u & 3, lds); }
#endif
    static_assert(GRID_R % 4 == 0 && NCH_C == 4, "attention unit grouping");
    const int nloc = B_ * 8 * (GRID_R / 4), nctx = need_ctx ? B_ * 8 : 0;
#ifdef HOST_EMU
    for (int u = blockIdx.x; u < nloc + nctx; u += gridDim.x) {
        if (u < nloc) { const int rg = u % (GRID_R / 4), head = (u / (GRID_R / 4)) & 7, b = u / (GRID_R / 4 * 8); attn_unit<true>(p, l, b, head, rg * 4, lds); }
        else { const int q = u - nloc, head = q & 7, b = q >> 3; attn_unit<false>(p, l, b, head, 0, lds); }
    }
#else
    for (int rep_ = 0; rep_ < ((REP_K == 22 || REP_K == 99) ? 2 : 1); ++rep_) {
        unsigned* ctr = (unsigned*)(p.ws + WS_CTL) + XB_QUEUE + l * 2 + rep_;
        volatile LAS int* qs = (volatile LAS int*)(lds + LDS_BYTES - 32);
        const int tid = opaque_tid();
        __syncthreads();
        if (tid == 0) qs[0] = (int)atomicAdd(ctr, 1u);
        __syncthreads();
        int u = qs[0];
        while (u < nloc + nctx) {
            int pend = 0;
            if (tid == 0) pend = (int)atomicAdd(ctr, 1u);
            if (u < nloc) { const int rg = u % (GRID_R / 4), head = (u / (GRID_R / 4)) & 7, b = u / (GRID_R / 4 * 8); attn_unit<true>(p, l, b, head, rg * 4, lds); }
            else { const int q = u - nloc, head = q & 7, b = q >> 3; attn_unit<false>(p, l, b, head, 0, lds); }
            __syncthreads();
            if (tid == 0) qs[0] = pend;
            __syncthreads();
            u = qs[0];
        }
    }
#endif
}

DEV void ln_stats(const float (&v)[2][8], float& mu, float& rstd) {
    float s = 0.f;
#pragma unroll
    for (int i = 0; i < 2; ++i)
#pragma unroll
        for (int j = 0; j < 8; ++j) s += v[i][j];
    mu = wave_sum(s) * (1.0f / 1024.0f);
    float q = 0.f;
#pragma unroll
    for (int i = 0; i < 2; ++i)
#pragma unroll
        for (int j = 0; j < 8; ++j) { const float d = v[i][j] - mu; q += d * d; }
    rstd = 1.0f / sqrtf(wave_sum(q) * (1.0f / 1024.0f) + LN_EPS);
}
DEV void ln_apply(float (&v)[2][8], float mu, float rstd, const float* g, const float* bta, int lane) {
#pragma unroll
    for (int i = 0; i < 2; ++i) { const int c = lane * 8 + i * 512; const f32x4 ga = *(const f32x4*)(g + c), gb2 = *(const f32x4*)(g + c + 4), ba = *(const f32x4*)(bta + c), bb2 = *(const f32x4*)(bta + c + 4);
#pragma unroll
        for (int j = 0; j < 8; ++j) v[i][j] = (v[i][j] - mu) * rstd * (j < 4 ? ga[j] : gb2[j - 4]) + (j < 4 ? ba[j] : bb2[j - 4]); }
}
struct LnPar { f32x4 g[2][2], b[2][2]; };
DEV void ln_par_load(LnPar& P, const float* g, const float* bta, int lane) {
#pragma unroll
    for (int i = 0; i < 2; ++i) { const int c = lane * 8 + i * 512; P.g[i][0] = *(const f32x4*)(g + c); P.g[i][1] = *(const f32x4*)(g + c + 4); P.b[i][0] = *(const f32x4*)(bta + c); P.b[i][1] = *(const f32x4*)(bta + c + 4); }
}
DEV void ln_apply(float (&v)[2][8], float mu, float rstd, const LnPar& P) {
#pragma unroll
    for (int i = 0; i < 2; ++i)
#pragma unroll
        for (int j = 0; j < 8; ++j) v[i][j] = (v[i][j] - mu) * rstd * (j < 4 ? P.g[i][0][j] : P.g[i][1][j - 4]) + (j < 4 ? P.b[i][0][j] : P.b[i][1][j - 4]);
}
DEV void ln_row(float (&v)[2][8], const LnPar& P) {
    float s = 0.f;
#pragma unroll
    for (int i = 0; i < 2; ++i)
#pragma unroll
        for (int j = 0; j < 8; ++j) s += v[i][j];
    const float mu = wave_sum(s) * (1.0f / 1024.0f);
    float q = 0.f;
#pragma unroll
    for (int i = 0; i < 2; ++i)
#pragma unroll
        for (int j = 0; j < 8; ++j) { v[i][j] -= mu; q += v[i][j] * v[i][j]; }
    const float rstd = 1.0f / sqrtf(wave_sum(q) * (1.0f / 1024.0f) + LN_EPS);
#pragma unroll
    for (int i = 0; i < 2; ++i)
#pragma unroll
        for (int j = 0; j < 8; ++j) v[i][j] = v[i][j] * rstd * (j < 4 ? P.g[i][0][j] : P.g[i][1][j - 4]) + (j < 4 ? P.b[i][0][j] : P.b[i][1][j - 4]);
}
DEV void ln_row(float (&v)[2][8], const float* g, const float* bta, int lane) {
    float s = 0.f;
#pragma unroll
    for (int i = 0; i < 2; ++i)
#pragma unroll
        for (int j = 0; j < 8; ++j) s += v[i][j];
    const float mu = wave_sum(s) * (1.0f / 1024.0f);
    float q = 0.f;
#pragma unroll
    for (int i = 0; i < 2; ++i)
#pragma unroll
        for (int j = 0; j < 8; ++j) { v[i][j] -= mu; q += v[i][j] * v[i][j]; }
    const float rstd = 1.0f / sqrtf(wave_sum(q) * (1.0f / 1024.0f) + LN_EPS);
#pragma unroll
    for (int i = 0; i < 2; ++i) { const int c = lane * 8 + i * 512; const f32x4 ga = *(const f32x4*)(g + c), gb2 = *(const f32x4*)(g + c + 4), ba = *(const f32x4*)(bta + c), bb2 = *(const f32x4*)(bta + c + 4);
#pragma unroll
        for (int j = 0; j < 8; ++j) v[i][j] = v[i][j] * rstd * (j < 4 ? ga[j] : gb2[j - 4]) + (j < 4 ? ba[j] : bb2[j - 4]); }
}

DEV void phase_ln1_router(const Params& p, int l, LAS unsigned char* lds) {
    LAS float* wrT = (LAS float*)lds;
    const int tid = opaque_tid(), lane = tid & 63, gw = blockIdx.x * 8 + (tid >> 6), nw = gridDim.x * 8;
    const int ntok = l < DEPTH_ - 1 ? NTOK : NL;
    const float* wr = p.in[17] + (size_t)l * 1024 * 16;
    __syncthreads();
    for (int i = tid; i < 16 * 1024; i += 512) { const int k = i >> 4, e = i & 15; wrT[e * 1024 + k] = wr[i]; }
    __syncthreads();
    const float* mods = (const float*)(p.ws + WS_MODS) + (size_t)l * (B_ + 1) * 6144;
    bf16_t* ub = (bf16_t*)(p.ws + WS_U); float* aff = (float*)(p.ws + WS_AFF);
    const bf16_t* xh = (const bf16_t*)(p.ws + WS_XH); bf16_t* x1h = (bf16_t*)(p.ws + WS_X1H); const bf16_t* yo = (const bf16_t*)(p.ws + WS_YO);
    const float alpha = sqrtf(sqrtf((float)(2 * DEPTH_)));
    const float* lg = p.in[15] + (size_t)l * 1024; const float* lb = p.in[16] + (size_t)l * 1024;
    constexpr int NR = 4;
    static_assert(T_ % NR == 0 && TC_ % NR == 0, "row groups stay inside one sample");
    for (int grp = gw; grp * NR < ntok; grp += nw) {
        const int row0 = grp * NR;
        u32x4 xraw[NR][2], yraw[NR][2];
#pragma unroll
        for (int r = 0; r < NR; ++r) { const int rw = row0 + r;
#pragma unroll
            for (int i = 0; i < 2; ++i) { const int c = lane * 8 + i * 512;
                yraw[r][i] = ld_stream((const u32x4*)(yo + (size_t)rw * D_ + c));
                xraw[r][i] = (u32x4){0u, 0u, 0u, 0u}; if (l != 0) xraw[r][i] = ld_stream((const u32x4*)(xh + (size_t)rw * D_ + c)); } }
        const bool isl = row0 < NL; const int bb = isl ? row0 / T_ : B_;
        const float* md = mods + (size_t)bb * 6144;
        f32x4 mg[2][2], msc[2][2], msh[2][2];
#pragma unroll
        for (int i = 0; i < 2; ++i) { const int c = lane * 8 + i * 512;
            mg[i][0] = *(const f32x4*)(md + 2048 + c); mg[i][1] = *(const f32x4*)(md + 2048 + c + 4);
            msc[i][0] = *(const f32x4*)(md + 4096 + c) + 1.0f; msc[i][1] = *(const f32x4*)(md + 4096 + c + 4) + 1.0f;
            msh[i][0] = *(const f32x4*)(md + 3072 + c); msh[i][1] = *(const f32x4*)(md + 3072 + c + 4); }
        f32x2 up[NR / 2][2][8];
#pragma unroll
        for (int r = 0; r < NR; ++r) {
            const int row = row0 + r;
            float uu[2][8];
            {
                float v[2][8];
#pragma unroll
                for (int i = 0; i < 2; ++i) { const int c = lane * 8 + i * 512; float xv[8];
                    if (l == 0) { const float* xr = isl ? p.in[0] + (size_t)row * D_ : p.in[2] + (size_t)(row - NL) * D_; const f32x4 a = *(const f32x4*)(xr + c), b2 = *(const f32x4*)(xr + c + 4);
#pragma unroll
                        for (int j = 0; j < 4; ++j) { xv[j] = a[j]; xv[4 + j] = b2[j]; } }
                    else unpack8_h(xraw[r][i], xv);
                    const u32x4 yv = yraw[r][i];
#pragma unroll
                    for (int j = 0; j < 4; ++j) { v[i][j] = alpha * xv[j] + mg[i][0][j] * ((j & 1) ? bfhi(yv[j >> 1]) : bflo(yv[j >> 1])); v[i][4 + j] = alpha * xv[4 + j] + mg[i][1][j] * ((j & 1) ? bfhi(yv[2 + (j >> 1)]) : bflo(yv[2 + (j >> 1)])); } }
                float mu, rstd; ln_stats(v, mu, rstd);
                ln_apply(v, mu, rstd, lg, lb, lane);
#pragma unroll
                for (int i = 0; i < 2; ++i) { const int c = lane * 8 + i * 512;
                    st_stream((u32x4*)(x1h + (size_t)row * D_ + c), pack8_h(v[i]));
#pragma unroll
                    for (int j = 0; j < 8; ++j) uu[i][j] = v[i][j] * (j < 4 ? msc[i][0][j] : msc[i][1][j - 4]) + (j < 4 ? msh[i][0][j] : msh[i][1][j - 4]);
#if MOE_F8
                    u32x2 o; o[0] = pack4_f8(uu[i][0], uu[i][1], uu[i][2], uu[i][3]); o[1] = pack4_f8(uu[i][4], uu[i][5], uu[i][6], uu[i][7]);
                    st_stream((u32x2*)((unsigned char*)ub + (size_t)row * D_ + c), o); }
#else
                    u32x4 o; o[0] = pack2(uu[i][0], uu[i][1]); o[1] = pack2(uu[i][2], uu[i][3]); o[2] = pack2(uu[i][4], uu[i][5]); o[3] = pack2(uu[i][6], uu[i][7]);
                    *(u32x4*)(ub + (size_t)row * D_ + c) = o; }
#endif
            }
#pragma unroll
            for (int i = 0; i < 2; ++i)
#pragma unroll
                for (int j = 0; j < 8; ++j) up[r >> 1][i][j][r & 1] = uu[i][j];
            SCHED_BAR();
        }
#ifndef HOST_EMU
        asm volatile("" ::: "memory");
#endif
        float p8a[NR][8];
#pragma unroll
        for (int j = 0; j < 8; ++j) { f32x2 pe[NR / 2][2];
#pragma unroll
            for (int hh = 0; hh < 2; ++hh) { const int e = j + 8 * hh; f32x2 acc[NR / 2];
#pragma unroll
                for (int q = 0; q < NR / 2; ++q) acc[q] = (f32x2){0.f, 0.f};
#pragma unroll
                for (int i = 0; i < 2; ++i) { const int c = lane * 8 + i * 512; const f32x4 w0 = *(const LAS f32x4*)(wrT + e * 1024 + c), w1 = *(const LAS f32x4*)(wrT + e * 1024 + c + 4);
#pragma unroll
                    for (int q = 0; q < NR / 2; ++q) {
                        acc[q] += up[q][i][0] * w0[0]; acc[q] += up[q][i][1] * w0[1]; acc[q] += up[q][i][2] * w0[2]; acc[q] += up[q][i][3] * w0[3];
                        acc[q] += up[q][i][4] * w1[0]; acc[q] += up[q][i][5] * w1[1]; acc[q] += up[q][i][6] * w1[2]; acc[q] += up[q][i][7] * w1[3]; } }
#pragma unroll
                for (int q = 0; q < NR / 2; ++q) pe[q][hh] = acc[q]; }
#pragma unroll
            for (int q = 0; q < NR / 2; ++q) { p8a[2 * q][j] = xsum32(pe[q][0][0], pe[q][1][0]); p8a[2 * q + 1][j] = xsum32(pe[q][0][1], pe[q][1][1]); } }
#pragma unroll
        for (int r = 0; r < NR; ++r) {
            const int row = row0 + r;
            float p4[4], p2[2];
#pragma unroll
            for (int j = 0; j < 4; ++j) p4[j] = xsum16(p8a[r][j], p8a[r][4 + j]);
#pragma unroll
            for (int j = 0; j < 2; ++j) p2[j] = xsum8(p4[j], p4[2 + j], lane);
            float mine = quad_sum(xsum4(p2[0], p2[1], lane));
            const float mx = wave_max(mine);
            mine = expf(mine - mx);
            const float sm = wave_sum(mine) * 0.25f;
            if (row < ntok && (lane & 3) == 0) aff[(size_t)row * 16 + (lane >> 2)] = mine / sm;
        }
    }
}

#ifdef HOST_EMU
static inline void lds_inc(unsigned* p) { (*p)++; }
#else
DEV void lds_inc(LAS unsigned* p) { __hip_atomic_fetch_add(p, 1u, __ATOMIC_RELAXED, __HIP_MEMORY_SCOPE_WORKGROUP); }
#endif
DEV void phase_topk(const Params& p, int l, LAS unsigned char* lds) {
    LAS unsigned* keys = (LAS unsigned*)lds;
    LAS unsigned* hist = keys + T_;
    LAS unsigned* misc = hist + 256;
    const int tid = opaque_tid(), lane = tid & 63, w = tid >> 6;
    const bool need_ctx = l < DEPTH_ - 1;
    const float* aff = (const float*)(p.ws + WS_AFF); int* slot = (int*)(p.ws + WS_SLOT); int* rowtab = (int*)(p.ws + WS_ROWTAB);
    const int nun = B_ * 16 * (need_ctx ? 2 : 1);
    for (int u = blockIdx.x; u < nun; u += gridDim.x) {
        const bool lat = u < B_ * 16; const int q = lat ? u : u - B_ * 16, b = q >> 4, e = q & 15;
        const int n = lat ? T_ : TC_, cap = lat ? CAP_L : CAP_C, row0 = tok_row(lat, b, 0);
        __syncthreads();
        unsigned kv[4];
#pragma unroll
        for (int j = 0; j < 4; ++j) { const int t = tid * 4 + j; kv[j] = t < n ? f_as_u(aff[(size_t)(row0 + t) * 16 + e]) : 0u; }
        unsigned prefix = 0u, remaining = (unsigned)cap;
#pragma unroll 1
        for (int pass = 0; pass < 4; ++pass) {
            const int shift = 24 - 8 * pass;
            if (tid < 256) hist[tid] = 0u;
            __syncthreads();
#pragma unroll
            for (int j = 0; j < 4; ++j) { const int t = tid * 4 + j;
                if (t < n && (pass == 0 || (kv[j] >> (shift + 8)) == prefix)) lds_inc(&hist[(kv[j] >> shift) & 255u]); }
            __syncthreads();
            if (w == 0) {
                const unsigned h0 = hist[4 * lane], h1 = hist[4 * lane + 1], h2 = hist[4 * lane + 2], h3 = hist[4 * lane + 3];
                const unsigned sl = h0 + h1 + h2 + h3;
                unsigned S = sl;
                for (int d = 1; d < 64; d <<= 1) { const unsigned o = (unsigned)shfl_idx_i((int)S, lane + d < 64 ? lane + d : lane); if (lane + d < 64) S += o; }
                const unsigned above = S - sl;
                if (above < remaining && remaining <= S) {
                    unsigned acc = above; int bin;
                    if (acc + h3 >= remaining) { bin = 3; } else { acc += h3; if (acc + h2 >= remaining) { bin = 2; } else { acc += h2; if (acc + h1 >= remaining) { bin = 1; } else { acc += h1; bin = 0; } } }
                    misc[0] = (unsigned)(4 * lane + bin); misc[1] = remaining - acc; }
            }
            __syncthreads();
            prefix = (prefix << 8) | misc[0]; remaining = misc[1];
        }
        unsigned cnt = 0u;
#pragma unroll
        for (int j = 0; j < 4; ++j) { const int t = tid * 4 + j; if (t < n) cnt += (kv[j] > prefix ? 1u : 0u) + (kv[j] == prefix ? 65536u : 0u); }
        unsigned inc = cnt;
        for (int d = 1; d < 64; d <<= 1) { const unsigned o2 = (unsigned)shfl_idx_i((int)inc, lane >= d ? lane - d : lane); if (lane >= d) inc += o2; }
        if (lane == 63) misc[8 + w] = inc;
        __syncthreads();
        unsigned base = 0u, total = 0u;
#pragma unroll
        for (int ww = 0; ww < 8; ++ww) { const unsigned tw = misc[8 + ww]; if (ww < w) base += tw; total += tw; }
        unsigned run = base + inc - cnt;
        const unsigned ngt = total & 0xFFFFu;
#pragma unroll
        for (int j = 0; j < 4; ++j) { const int t = tid * 4 + j;
            if (t < n) { const bool gt = kv[j] > prefix, eq = kv[j] == prefix; const unsigned rg = run & 0xFFFFu, re = run >> 16;
                int sl = -1;
                if (gt) sl = (int)rg; else if (eq && re < remaining) sl = (int)(ngt + re);
                slot[(size_t)(row0 + t) * 16 + e] = sl;
                if (sl >= 0) rowtab[e * MROWS + (lat ? b * CAP_L + sl : ROWS_L + b * CAP_C + sl)] = row0 + t;
                run += (gt ? 1u : 0u) + (eq ? 65536u : 0u); } }
    }
    { const int used = need_ctx ? ROWS_L + ROWS_C : ROWS_L; const int mr = need_ctx ? MROWS : MROWS_LAST;
      if (blockIdx.x == gridDim.x - 1) for (int i = tid; i < 16 * (mr - used); i += 512) { const int e = i / (mr - used), r = used + i % (mr - used); rowtab[e * MROWS + r] = 0; } }
}

DEV void phase_combine(const Params& p, int l) {
    const int tid = opaque_tid(), lane = tid & 63, gw = blockIdx.x * 8 + (tid >> 6), nw = gridDim.x * 8;
    const bool need_ctx = l < DEPTH_ - 1; const int ntok = need_ctx ? NTOK : NL;
    const float* mods = (const float*)(p.ws + WS_MODS) + (size_t)l * (B_ + 1) * 6144;
    const float* modn = mods + (size_t)(B_ + 1) * 6144;
    const bf16_t* x1h = (const bf16_t*)(p.ws + WS_X1H); bf16_t* xh = (bf16_t*)(p.ws + WS_XH); bf16_t* ub = (bf16_t*)(p.ws + WS_U);
    const float* aff = (const float*)(p.ws + WS_AFF); const int* slot = (const int*)(p.ws + WS_SLOT); const bf16_t* yexp = (const bf16_t*)(p.ws + WS_YEXP);
    const float* lg = p.in[21] + (size_t)l * 1024; const float* lb = p.in[22] + (size_t)l * 1024;
    const float alpha = sqrtf(sqrtf((float)(2 * DEPTH_)));
    static_assert(T_ % 2 == 0 && TC_ % 2 == 0 && NL % 2 == 0, "row pairs stay inside one sample");
    int slot_n[2]; float aff_n[2];
#pragma unroll
    for (int r = 0; r < 2; ++r) { const int row = 2 * gw + r; slot_n[r] = -1; aff_n[r] = 0.f;
        if (row < ntok && lane < 16) { slot_n[r] = slot[(size_t)row * 16 + lane]; aff_n[r] = aff[(size_t)row * 16 + lane]; } }
    for (int row0 = 2 * gw; row0 < ntok; row0 += 2 * nw) {
        int myslot[2]; float myaff[2]; int rbase[2]; unsigned em[2];
        float v[2][2][8], f[2][2][8];
#pragma unroll
        for (int r = 0; r < 2; ++r) { const int row = row0 + r; const bool act = row < ntok; const int rw = act ? row : row0;
            const bool isl = rw < NL; const int bidx = isl ? rw / T_ : (rw - NL) / TC_;
            rbase[r] = isl ? bidx * CAP_L : ROWS_L + bidx * CAP_C;
            myslot[r] = slot_n[r]; myaff[r] = aff_n[r];
            { const int rown = row + 2 * nw; slot_n[r] = -1; aff_n[r] = 0.f; if (rown < ntok && lane < 16) { slot_n[r] = slot[(size_t)rown * 16 + lane]; aff_n[r] = aff[(size_t)rown * 16 + lane]; } }
#pragma unroll
            for (int i = 0; i < 2; ++i) unpack8_h(ld_stream((const u32x4*)(x1h + (size_t)rw * D_ + lane * 8 + i * 512)), v[r][i]);
#pragma unroll
            for (int i = 0; i < 2; ++i)
#pragma unroll
                for (int j = 0; j < 8; ++j) f[r][i][j] = 0.f;
            unsigned m_ = 0u;
#pragma unroll
            for (int e = 0; e < 16; ++e) m_ |= (rdlane_i(myslot[r], e) >= 0 ? 1u : 0u) << e;
            em[r] = act ? m_ : 0u; }
        while (em[0] | em[1]) {
#if MOE_F8 && YEXP_F8
            u32x2 yv[2][4][2]; float ga[2][4];
#pragma unroll
            for (int r = 0; r < 2; ++r)
#pragma unroll
                for (int k = 0; k < 4; ++k) { const bool ok = em[r] != 0u; const int ee = ok ? __builtin_ctz(em[r]) : 0; em[r] &= em[r] - 1u;
                    const int sl = rdlane_i(myslot[r], ee); ga[r][k] = ok ? rdlane_f(myaff[r], ee) * (1.0f / F8_SY) : 0.f;
                    const unsigned char* yr = (const unsigned char*)yexp + ((size_t)ee * MROWS + rbase[r] + (sl > 0 ? sl : 0)) * D_;
                    yv[r][k][0] = ld_stream((const u32x2*)(yr + lane * 8)); yv[r][k][1] = ld_stream((const u32x2*)(yr + lane * 8 + 512)); }
#pragma unroll
            for (int r = 0; r < 2; ++r)
#pragma unroll
                for (int k = 0; k < 4; ++k)
#pragma unroll
                    for (int i = 0; i < 2; ++i)
#pragma unroll
                        for (int j = 0; j < 2; ++j) { const f32x2 lo = __builtin_amdgcn_cvt_pk_f32_fp8((int)yv[r][k][i][j], false), hi = __builtin_amdgcn_cvt_pk_f32_fp8((int)yv[r][k][i][j], true);
                            f[r][i][4 * j] += ga[r][k] * lo[0]; f[r][i][4 * j + 1] += ga[r][k] * lo[1]; f[r][i][4 * j + 2] += ga[r][k] * hi[0]; f[r][i][4 * j + 3] += ga[r][k] * hi[1]; }
#else
            u32x4 yv[2][4][2]; float ga[2][4];
#pragma unroll
            for (int r = 0; r < 2; ++r)
#pragma unroll
                for (int k = 0; k < 4; ++k) { const bool ok = em[r] != 0u; const int ee = ok ? __builtin_ctz(em[r]) : 0; em[r] &= em[r] - 1u;
                    const int sl = rdlane_i(myslot[r], ee); ga[r][k] = ok ? rdlane_f(myaff[r], ee) : 0.f;
                    const bf16_t* yr = yexp + ((size_t)ee * MROWS + rbase[r] + (sl > 0 ? sl : 0)) * D_;
                    yv[r][k][0] = *(const u32x4*)(yr + lane * 8); yv[r][k][1] = *(const u32x4*)(yr + lane * 8 + 512); }
#pragma unroll
            for (int r = 0; r < 2; ++r)
#pragma unroll
                for (int k = 0; k < 4; ++k)
#pragma unroll
                    for (int i = 0; i < 2; ++i)
#pragma unroll
                        for (int j = 0; j < 4; ++j) { f[r][i][2 * j] += ga[r][k] * bflo(yv[r][k][i][j]); f[r][i][2 * j + 1] += ga[r][k] * bfhi(yv[r][k][i][j]); }
#endif
        }
        {
            const bool isl0 = row0 < NL; const int bb0 = isl0 ? row0 / T_ : B_;
            const float* md = mods + (size_t)bb0 * 6144; const float* mn = modn + (size_t)bb0 * 6144;
            f32x4 mg2[2][2], nsc[2][2], nsh[2][2];
            LnPar lnp; ln_par_load(lnp, lg, lb, lane);
#pragma unroll
            for (int i = 0; i < 2; ++i) { const int c = lane * 8 + i * 512;
                mg2[i][0] = *(const f32x4*)(md + 5120 + c); mg2[i][1] = *(const f32x4*)(md + 5120 + c + 4);
                if (need_ctx) { nsc[i][0] = *(const f32x4*)(mn + 1024 + c) + 1.0f; nsc[i][1] = *(const f32x4*)(mn + 1024 + c + 4) + 1.0f; nsh[i][0] = *(const f32x4*)(mn + c); nsh[i][1] = *(const f32x4*)(mn + c + 4); }
                else { nsc[i][0] = nsc[i][1] = nsh[i][0] = nsh[i][1] = (f32x4){0.f, 0.f, 0.f, 0.f}; } }
#pragma unroll
            for (int r = 0; r < 2; ++r) { const int row = row0 + r;
                if (row < ntok) {
#pragma unroll
                    for (int i = 0; i < 2; ++i)
#pragma unroll
                        for (int j = 0; j < 4; ++j) { v[r][i][j] = alpha * v[r][i][j] + mg2[i][0][j] * f[r][i][j]; v[r][i][4 + j] = alpha * v[r][i][4 + j] + mg2[i][1][j] * f[r][i][4 + j]; }
                    ln_row(v[r], lnp);
#pragma unroll
                    for (int i = 0; i < 2; ++i) { const int c = lane * 8 + i * 512;
                        if (!need_ctx) { float* xw = p.out + (size_t)row * D_; *(f32x4*)(xw + c) = (f32x4){v[r][i][0], v[r][i][1], v[r][i][2], v[r][i][3]}; *(f32x4*)(xw + c + 4) = (f32x4){v[r][i][4], v[r][i][5], v[r][i][6], v[r][i][7]}; }
                        else {
                            st_stream((u32x4*)(xh + (size_t)row * D_ + c), pack8_h(v[r][i]));
                            float uu[8];
#pragma unroll
                            for (int j = 0; j < 8; ++j) uu[j] = v[r][i][j] * (j < 4 ? nsc[i][0][j] : nsc[i][1][j - 4]) + (j < 4 ? nsh[i][0][j] : nsh[i][1][j - 4]);
                            u32x4 o; o[0] = pack2(uu[0], uu[1]); o[1] = pack2(uu[2], uu[3]); o[2] = pack2(uu[4], uu[5]); o[3] = pack2(uu[6], uu[7]);
                            *(u32x4*)(ub + (size_t)row * D_ + c) = o; } }
                }
            }
        }
    }
}

__global__ void __launch_bounds__(512, 2) fwd(Params p) {
#ifdef HOST_EMU
    unsigned char* smem = emu::tls.dynsmem;
#else
    extern __shared__ __attribute__((aligned(16))) unsigned char smem_raw[];
    LAS unsigned char* smem = (LAS unsigned char*)smem_raw;
#endif
#ifdef HOST_EMU
    XcdBarrier bar = xcd_barrier_post(nullptr, nullptr);
#else
    volatile LAS unsigned* xbw = (volatile LAS unsigned*)(smem + LDS_BYTES - 16);
    if (threadIdx.x == 0) { xbw[0] = 0u; xbw[1] = 0u; xbw[2] = 0u; xbw[3] = 0u; }
    __syncthreads();
    XcdBarrier bar = xcd_barrier_post((unsigned*)(p.ws + WS_CTL), xbw);
#endif
#define SEAM(id) if ((id) > p.ph_lo && (id) < p.ph_hi) { xcd_barrier(bar); if (REP_K == 30) xcd_barrier(bar); }
#ifndef REP_K
#define REP_K -1
#endif
#define REPEAT(k) for (int rep_ = 0; rep_ < ((REP_K == (k) || REP_K == 99) ? 2 : 1); ++rep_)
#define REPBAR() if (rep_) xcd_barrier(bar)
#ifndef PH_MASK
#define PH_MASK 0xFFFF
#endif
#define RUN(id) if ((id) >= p.ph_lo && (id) < p.ph_hi)
#define RUNK(k) if (((PH_MASK >> (k)) & 1) && (base + (k)) >= p.ph_lo && (base + (k)) < p.ph_hi)
    if ((PH_MASK >> 15) & 1) RUN(0) REPEAT(15) { REPBAR(); phase_mods(p, smem); }
    const float alpha = sqrtf(sqrtf((float)(2 * DEPTH_)));
    for (int l = 0; l < DEPTH_; ++l) {
        const int base = 1 + l * NPH;
        const bool need_ctx = l < DEPTH_ - 1;
        SEAM(base + 0); RUNK(0) REPEAT(0) { REPBAR(); phase_convert(p, l, smem); }
        SEAM(base + 1); RUNK(1) REPEAT(1) { REPBAR();
            pg8::Gemm g; g.A = (const bf16_t*)(p.ws + WS_U); g.Bt = (const bf16_t*)(p.ws + WS_BTIN); g.K = D_; g.rowtab = nullptr;
            pg8::Order S; S.init(1, NTOK / 256, NTOK / 256, PROJ_NP / 256, gridDim.x, blockIdx.x);
            EpiProj E; E.proj = (bf16_t*)(p.ws + WS_R1 + R1_PROJ); E.gates = (float*)(p.ws + WS_R1 + R1_GATES); E.bias = (const float*)(p.ws + WS_BIAS);
            pg8::gemm_phase<EpiProj, false>(smem, g, S, E);
        }
        SEAM(base + 2); RUNK(2) REPEAT(2) { REPBAR(); phase_mixer(p, l, smem); }
        SEAM(base + 4); RUNK(4) REPEAT(4) { REPBAR();
            pg8::Gemm g; g.A = (const bf16_t*)(p.ws + WS_YMIX); g.Bt = (const bf16_t*)(p.ws + WS_BTOUT); g.K = D_; g.rowtab = nullptr;
            const int mt = (need_ctx ? NTOK : NL) / 256;
            pg8::Order S; S.init(1, mt, mt, D_ / 256, gridDim.x, blockIdx.x);
            EpiDown<false> E; E.y = (bf16_t*)(p.ws + WS_YO); E.sc = 1.0f;
            pg8::gemm_phase<EpiDown<false>, false>(smem, g, S, E);
        }
        SEAM(base + 5); RUNK(5) REPEAT(5) { REPBAR(); phase_ln1_router(p, l, smem); }
        SEAM(base + 6); RUNK(6) REPEAT(6) { REPBAR(); phase_topk(p, l, smem); }
        SEAM(base + 7); RUNK(7) REPEAT(7) { REPBAR();
            pg8::Gemm g; g.A = (const bf16_t*)(p.ws + WS_U); g.Bt = (const bf16_t*)(p.ws + WS_BTGU); g.K = MOE_F8 ? D_ / 2 : D_; g.rowtab = (const int*)(p.ws + WS_ROWTAB);
            pg8::Order S; S.init(NE, (need_ctx ? MROWS : MROWS_LAST) / 256, MROWS / 256, 2 * FF / 256, gridDim.x, blockIdx.x);
            EpiSwiglu E; E.h = (bf16_t*)(p.ws + WS_R1);
            pg8::gemm_phase<EpiSwiglu, true, MOE_F8 != 0>(smem, g, S, E);
        }
        SEAM(base + 8); RUNK(8) REPEAT(8) { REPBAR();
            pg8::Gemm g; g.A = (const bf16_t*)(p.ws + WS_R1); g.Bt = (const bf16_t*)(p.ws + WS_BTDN); g.K = MOE_F8 ? FF / 2 : FF; g.rowtab = nullptr;
            pg8::Order S; S.init(NE, (need_ctx ? MROWS : MROWS_LAST) / 256, MROWS / 256, D_ / 256, gridDim.x, blockIdx.x);
            EpiDown<(MOE_F8 && YEXP_F8)> E; E.y = (bf16_t*)(p.ws + WS_YEXP);
#if MOE_F8
            E.sc = (YEXP_F8 ? F8_SY : 1.0f) / (F8_SH * F8_SW2);
#else
            E.sc = 1.0f;
#endif
            pg8::gemm_phase<EpiDown<(MOE_F8 && YEXP_F8)>, false, MOE_F8 != 0>(smem, g, S, E);
        }
        SEAM(base + 9); RUNK(9) REPEAT(9) { REPBAR(); phase_combine(p, l); }
    }
}

extern "C" void kernel_launch(void* const* d_in, const int* in_sizes, int n_in, void* d_out, int out_size, void* d_ws, size_t ws_size, hipStream_t stream) {
    static int grid = 0;
    if (grid == 0) {
        if (n_in != 23 || out_size != NL * D_ || ws_size < WS_END) { fprintf(stderr, "kernel_launch: bad shapes: n_in %d out %d ws %zu (need %zu)\n", n_in, out_size, ws_size, (size_t)WS_END); grid = -1; return; }
        int dev = 0, cus = 0;
        if (hipGetDevice(&dev) != hipSuccess || hipDeviceGetAttribute(&cus, hipDeviceAttributeMultiprocessorCount, dev) != hipSuccess) { grid = -1; return; }
        if (hipFuncSetAttribute((const void*)fwd, hipFuncAttributeMaxDynamicSharedMemorySize, LDS_BYTES) != hipSuccess) { fprintf(stderr, "kernel_launch: hipFuncSetAttribute failed\n"); grid = -1; return; }
        (void)hipGetLastError();
        grid = cus;
    }
    if (grid < 0) return;
#ifdef HOST_EMU
    g_emu_bar.store(0);
#endif
    (void)hipMemsetAsync((char*)d_ws + WS_CTL, 0, WS_CTL_BYTES, stream);
    Params p{};
    for (int i = 0; i < 23; ++i) p.in[i] = (const float*)d_in[i];
    p.out = (float*)d_out; p.ws = (unsigned char*)d_ws;
#if ONE_LAUNCH
    p.ph_lo = 0; p.ph_hi = NPHASES;
#ifdef HOST_EMU
    if (getenv("EMU_PH_HI")) p.ph_hi = atoi(getenv("EMU_PH_HI"));
#endif
    hipLaunchKernelGGL(fwd, dim3(grid), dim3(512), LDS_BYTES, stream, p);
#else
    int nph = NPHASES;
#ifdef HOST_EMU
    if (getenv("EMU_PH_HI")) nph = atoi(getenv("EMU_PH_HI"));
#endif
    for (int ph = 0; ph < nph; ++ph) { p.ph_lo = ph; p.ph_hi = ph + 1; hipLaunchKernelGGL(fwd, dim3(grid), dim3(512), LDS_BYTES, stream, p); }
#endif
}
```
